# Optimizing an MI355X kernel written in HIP

```python
import jax, jax.numpy as jnp
from jax import lax
import numpy as np

D_MODEL = 4096
BATCH = 1
SEQ = 8192
DEPTH = 1

CHUNK = 64
HEAD_DIM = 128
N_HEADS_FOX = 16
N_HEADS_SB = 16
W_FOX = N_HEADS_FOX * HEAD_DIM
W_SB = N_HEADS_SB * HEAD_DIM
D_FF = 11008
CONV_WIDTH = 3
PLE_DIM = 256
Q_BLOCK = 128
EPS = 1e-6
IN_SPLITS = (W_FOX, W_FOX, W_FOX, N_HEADS_FOX, W_SB, W_SB, W_SB, D_MODEL, D_MODEL)
N_IN = sum(IN_SPLITS)
SPLIT_POINTS = tuple(int(v) for v in np.cumsum(IN_SPLITS)[:-1])

kernel_name = "fox_stickbreak_gated_hybrid_block"


def _rms_norm(x, g):
    x32 = x.astype(jnp.float32)
    y = x32 * lax.rsqrt(jnp.mean(x32 * x32, axis=-1, keepdims=True) + EPS)
    return (y * g.astype(jnp.float32)).astype(x.dtype)


def _to_blocks(t):
    B, S = t.shape[:2]
    t = t.reshape((B, S // Q_BLOCK, Q_BLOCK) + t.shape[2:])
    return jnp.moveaxis(t, 1, 0)


def _from_blocks(o):
    nb, B, Q, H, d = o.shape
    return jnp.moveaxis(o, 0, 1).reshape(B, nb * Q, H * d)


def _forgetting_attention(q, k, v, log_f):
    B, S, H, d = q.shape
    scale = d ** -0.5
    c = jnp.cumsum(log_f, axis=1)
    c_key = jnp.transpose(c, (0, 2, 1))
    q_blocks = _to_blocks(q)
    c_blocks = jnp.transpose(_to_blocks(c), (0, 1, 3, 2))
    key_pos = jnp.arange(S)

    def one_block(args):
        q_i, c_i, i = args
        q_pos = i * Q_BLOCK + jnp.arange(Q_BLOCK)
        s = jnp.einsum('bqhd,bkhd->bhqk', q_i, k,
                       preferred_element_type=jnp.float32) * scale
        s = s + c_i[..., :, None] - c_key[:, :, None, :]
        causal = key_pos[None, :] <= q_pos[:, None]
        s = jnp.where(causal, s, -jnp.inf)
        w = jax.nn.softmax(s, axis=-1)
        return jnp.einsum('bhqk,bkhd->bqhd', w.astype(v.dtype), v)

    out = lax.map(one_block, (q_blocks, c_blocks, jnp.arange(S // Q_BLOCK)))
    return _from_blocks(out)


def _stick_breaking_attention(q, k, v):
    B, S, H, d = q.shape
    scale = d ** -0.5
    q_blocks = _to_blocks(q)
    key_pos = jnp.arange(S)

    def one_block(args):
        q_i, i = args
        q_pos = i * Q_BLOCK + jnp.arange(Q_BLOCK)
        z = jnp.einsum('bqhd,bkhd->bhqk', q_i, k,
                       preferred_element_type=jnp.float32) * scale
        strict = key_pos[None, :] < q_pos[:, None]
        log_beta = jax.nn.log_sigmoid(z)
        log_one_minus = jnp.where(strict, log_beta - z, 0.0)
        tail = lax.cumsum(log_one_minus, axis=3, reverse=True) - log_one_minus
        a = jnp.where(strict, jnp.exp(log_beta + tail), 0.0)
        return jnp.einsum('bhqk,bkhd->bqhd', a.astype(v.dtype), v)

    out = lax.map(one_block, (q_blocks, jnp.arange(S // Q_BLOCK)))
    return _from_blocks(out)


def _causal_depthwise_conv(u, w, b):
    S = u.shape[1]
    u_pad = jnp.pad(u, ((0, 0), (CONV_WIDTH - 1, 0), (0, 0)))
    out = b
    for j in range(CONV_WIDTH):
        out = out + w[j] * u_pad[:, j:j + S]
    return out


def setup_inputs(seed: int = 0) -> dict:
    key = jax.random.key(seed)
    ks = jax.random.split(key, 18)
    f32 = jnp.float32

    def nrm(k, shape, scale):
        return jax.random.normal(k, shape, f32) * scale

    def gain(k, shape):
        return 1.0 + 0.05 * jax.random.normal(k, shape, f32)

    return {
        "x": nrm(ks[0], (BATCH, SEQ, D_MODEL), 1.0),
        "p": nrm(ks[1], (DEPTH, BATCH, SEQ, PLE_DIM), 1.0),
        "g_mix": gain(ks[2], (DEPTH, D_MODEL)),
        "w_in": nrm(ks[3], (DEPTH, D_MODEL, N_IN), D_MODEL ** -0.5),
        "b_f": 3.0 + 0.5 * jax.random.normal(ks[4], (DEPTH, N_HEADS_FOX), f32),
        "g_q_fox": gain(ks[5], (DEPTH, HEAD_DIM)),
        "g_k_fox": gain(ks[6], (DEPTH, HEAD_DIM)),
        "w_branch_fox": nrm(ks[7], (DEPTH, W_FOX, D_MODEL), W_FOX ** -0.5),
        "w_branch_sb": nrm(ks[8], (DEPTH, W_SB, D_MODEL), W_SB ** -0.5),
        "w_out": nrm(ks[9], (DEPTH, D_MODEL, D_MODEL), D_MODEL ** -0.5),
        "g_ffn": gain(ks[10], (DEPTH, D_MODEL)),
        "w_up": nrm(ks[11], (DEPTH, D_MODEL, 2 * D_FF), D_MODEL ** -0.5),
        "conv_w": nrm(ks[12], (DEPTH, CONV_WIDTH, 2 * D_FF), CONV_WIDTH ** -0.5),
        "conv_b": nrm(ks[13], (DEPTH, 2 * D_FF), 0.01),
        "w_down": nrm(ks[14], (DEPTH, D_FF, D_MODEL), D_FF ** -0.5),
        "g_ple": gain(ks[15], (DEPTH, D_MODEL)),
        "w_ple_gate": nrm(ks[16], (DEPTH, D_MODEL, D_MODEL), D_MODEL ** -0.5),
        "w_ple_proj": nrm(ks[17], (DEPTH, PLE_DIM, D_MODEL), PLE_DIM ** -0.5),
    }


def reference(x, p, g_mix, w_in, b_f, g_q_fox, g_k_fox, w_branch_fox, w_branch_sb,
              w_out, g_ffn, w_up, conv_w, conv_b, w_down, g_ple, w_ple_gate, w_ple_proj):
    B, S, _ = x.shape
    for i in range(DEPTH):
        h = _rms_norm(x, g_mix[i])
        proj = h @ w_in[i]
        q_a, k_a, v_a, f_a, q_b, k_b, v_b, gate_a, gate_b = jnp.split(proj, SPLIT_POINTS, axis=-1)

        q_a = _rms_norm(q_a.reshape(B, S, N_HEADS_FOX, HEAD_DIM), g_q_fox[i])
        k_a = _rms_norm(k_a.reshape(B, S, N_HEADS_FOX, HEAD_DIM), g_k_fox[i])
        v_a = v_a.reshape(B, S, N_HEADS_FOX, HEAD_DIM)
        log_f = jax.nn.log_sigmoid((f_a + b_f[i]).astype(jnp.float32))
        y_a = _forgetting_attention(q_a, k_a, v_a, log_f)

        q_b = q_b.reshape(B, S, N_HEADS_SB, HEAD_DIM)
        k_b = k_b.reshape(B, S, N_HEADS_SB, HEAD_DIM)
        v_b = v_b.reshape(B, S, N_HEADS_SB, HEAD_DIM)
        y_b = _stick_breaking_attention(q_b, k_b, v_b)

        merged = (jax.nn.sigmoid(gate_a) * (y_a @ w_branch_fox[i])
                  + jax.nn.sigmoid(gate_b) * (y_b @ w_branch_sb[i]))
        x = x + merged @ w_out[i]

        h = _rms_norm(x, g_ffn[i])
        u = _causal_depthwise_conv(h @ w_up[i], conv_w[i], conv_b[i])
        u_gate, u_val = jnp.split(u, 2, axis=-1)
        x = x + (jax.nn.silu(u_gate) * u_val) @ w_down[i]

        ple_gate = jax.nn.sigmoid(_rms_norm(x, g_ple[i]) @ w_ple_gate[i])
        x = x + ple_gate * (p[i] @ w_ple_proj[i])
    return x
```

```cpp
#include <hip/hip_runtime.h>
#include <stdint.h>
#include <stdio.h>

constexpr int S = 8192, DM = 4096, HD = 128, NH = 16, WF = 2048, DFF = 11008, PLE = 256;
constexpr int NIN = 20496;
constexpr int OQA = 0, OKA = 2048, OVA = 4096, OFA = 6144, OQB = 6160, OKB = 8208, OVB = 10256, OGA = 12304, OGB = 16400;
constexpr float EPS = 1e-6f;
constexpr float SCALE = 0.08838834764831845f;

typedef unsigned short bf16_t;
__device__ __forceinline__ float bf2f(bf16_t b) { return __uint_as_float(((unsigned)b) << 16); }
__device__ __forceinline__ bf16_t f2bf(float f) { unsigned u = __float_as_uint(f); u += 0x7fffu + ((u >> 16) & 1u); return (bf16_t)(u >> 16); }
__device__ __forceinline__ float sigmoidf_(float v) { return 1.0f / (1.0f + __expf(-v)); }
__device__ __forceinline__ float log_sigmoidf_(float v) { return fminf(v, 0.f) - log1pf(__expf(-fabsf(v))); }
__device__ __forceinline__ float softplusf_(float v) { return fmaxf(v, 0.f) + log1pf(__expf(-fabsf(v))); }

__global__ __launch_bounds__(256) void k_rmsnorm(const float* __restrict__ x, const float* __restrict__ g, float* __restrict__ h) {
    __shared__ float red[4];
    const int row = blockIdx.x, tid = threadIdx.x;
    const float4* xr = (const float4*)(x + (size_t)row * DM);
    float4 v[4]; float s = 0.f;
#pragma unroll
    for (int j = 0; j < 4; ++j) { v[j] = xr[tid + 256 * j]; s += v[j].x * v[j].x + v[j].y * v[j].y + v[j].z * v[j].z + v[j].w * v[j].w; }
    for (int o = 32; o >= 1; o >>= 1) s += __shfl_xor(s, o);
    if ((tid & 63) == 0) red[tid >> 6] = s;
    __syncthreads();
    const float tot = red[0] + red[1] + red[2] + red[3];
    const float r = rsqrtf(tot * (1.0f / DM) + EPS);
    float4* hr = (float4*)(h + (size_t)row * DM);
    const float4* gr = (const float4*)g;
#pragma unroll
    for (int j = 0; j < 4; ++j) { const float4 gg = gr[tid + 256 * j]; float4 o; o.x = v[j].x * r * gg.x; o.y = v[j].y * r * gg.y; o.z = v[j].z * r * gg.z; o.w = v[j].w * r * gg.w; hr[tid + 256 * j] = o; }
}

template <typename T> __device__ __forceinline__ void load4(const T* p, float (&o)[4]);
template <> __device__ __forceinline__ void load4<float>(const float* p, float (&o)[4]) { const float4 v = *(const float4*)p; o[0] = v.x; o[1] = v.y; o[2] = v.z; o[3] = v.w; }
template <> __device__ __forceinline__ void load4<bf16_t>(const bf16_t* p, float (&o)[4]) { const uint2 v = *(const uint2*)p; o[0] = __uint_as_float(v.x << 16); o[1] = __uint_as_float(v.x & 0xffff0000u); o[2] = __uint_as_float(v.y << 16); o[3] = __uint_as_float(v.y & 0xffff0000u); }

template <class Epi, typename TA>
__global__ __launch_bounds__(256) void k_gemm(const TA* __restrict__ A, int lda, const float* __restrict__ W, int ldw, int N, int K, Epi epi) {
    __shared__ float As[8][128 + 4];
    __shared__ float Bs[8][128 + 4];
    const int tid = threadIdx.x, ty = tid >> 4, tx = tid & 15;
    const int row0 = blockIdx.y * 128, col0 = blockIdx.x * 128;
    float acc[8][8];
#pragma unroll
    for (int i = 0; i < 8; ++i)
#pragma unroll
        for (int j = 0; j < 8; ++j) acc[i][j] = 0.f;
    const int ar = tid >> 1, ak = (tid & 1) * 4;
    const int bk = tid >> 5, bc = (tid & 31) * 4;
    const bool bok = (col0 + bc) < N;
    for (int k0 = 0; k0 < K; k0 += 8) {
        float av[4]; load4<TA>(A + (size_t)(row0 + ar) * lda + k0 + ak, av);
        float4 bv = make_float4(0.f, 0.f, 0.f, 0.f);
        if (bok) bv = *(const float4*)(W + (size_t)(k0 + bk) * ldw + col0 + bc);
        __syncthreads();
#pragma unroll
        for (int j = 0; j < 4; ++j) As[ak + j][ar] = av[j];
        *(float4*)&Bs[bk][bc] = bv;
        __syncthreads();
#pragma unroll
        for (int k = 0; k < 8; ++k) {
            float a[8], b[8];
            *(float4*)&a[0] = *(const float4*)&As[k][ty * 8]; *(float4*)&a[4] = *(const float4*)&As[k][ty * 8 + 4];
            *(float4*)&b[0] = *(const float4*)&Bs[k][tx * 8]; *(float4*)&b[4] = *(const float4*)&Bs[k][tx * 8 + 4];
#pragma unroll
            for (int i = 0; i < 8; ++i)
#pragma unroll
                for (int j = 0; j < 8; ++j) acc[i][j] = fmaf(a[i], b[j], acc[i][j]);
        }
    }
#pragma unroll
    for (int i = 0; i < 8; ++i)
#pragma unroll
        for (int j = 0; j < 8; ++j) { const int c = col0 + tx * 8 + j; if (c < N) epi(row0 + ty * 8 + i, c, acc[i][j]); }
}

struct EpiStoreF32 { float* C; int ldc; __device__ __forceinline__ void operator()(int r, int c, float v) const { C[(size_t)r * ldc + c] = v; } };
struct EpiStoreBf16 { bf16_t* C; int ldc; __device__ __forceinline__ void operator()(int r, int c, float v) const { C[(size_t)r * ldc + c] = f2bf(v); } };
struct EpiGate { float* C; const float* proj; int goff; int accum;
    __device__ __forceinline__ void operator()(int r, int c, float v) const { const float g = sigmoidf_(proj[(size_t)r * NIN + goff + c]); float* p = C + (size_t)r * DM + c; const float o = g * v; *p = accum ? (*p + o) : o; } };
struct EpiResid { float* out; const float* base; __device__ __forceinline__ void operator()(int r, int c, float v) const { const size_t i = (size_t)r * DM + c; out[i] = base[i] + v; } };
struct EpiPle { float* out; const float* tmp; __device__ __forceinline__ void operator()(int r, int c, float v) const { const size_t i = (size_t)r * DM + c; out[i] = out[i] + sigmoidf_(v) * tmp[i]; } };

__global__ __launch_bounds__(256) void k_qknorm(float* __restrict__ proj, const float* __restrict__ gq, const float* __restrict__ gk) {
    const int w = blockIdx.x * 4 + (threadIdx.x >> 6), lane = threadIdx.x & 63;
    const int which = w & 1, head = (w >> 1) & 15, row = w >> 5;
    float* p = proj + (size_t)row * NIN + (which ? OKA : OQA) + head * HD;
    const float* g = which ? gk : gq;
    const float a = p[lane], b = p[lane + 64];
    float s = a * a + b * b;
    for (int o = 32; o >= 1; o >>= 1) s += __shfl_xor(s, o);
    const float r = rsqrtf(s * (1.0f / HD) + EPS);
    p[lane] = a * r * g[lane]; p[lane + 64] = b * r * g[lane + 64];
}
__global__ __launch_bounds__(256) void k_cumlogf(const float* __restrict__ proj, const float* __restrict__ bfv, float* __restrict__ c) {
    __shared__ float part[256];
    const int h = blockIdx.x, tid = threadIdx.x;
    const float b = bfv[h];
    float loc[32]; float s = 0.f;
#pragma unroll
    for (int i = 0; i < 32; ++i) { const int row = tid * 32 + i; s += log_sigmoidf_(proj[(size_t)row * NIN + OFA + h] + b); loc[i] = s; }
    part[tid] = s;
    __syncthreads();
    if (tid == 0) { float run = 0.f; for (int i = 0; i < 256; ++i) { const float t = part[i]; part[i] = run; run += t; } }
    __syncthreads();
    const float base = part[tid];
#pragma unroll
    for (int i = 0; i < 32; ++i) c[(size_t)(tid * 32 + i) * NH + h] = base + loc[i];
}

constexpr int ATT_LDS = (64 * 129 * 2 + 64 * 65) * 4;
__global__ __launch_bounds__(256) void k_fox(const float* __restrict__ proj, const float* __restrict__ c, float* __restrict__ y) {
    extern __shared__ float sm[];
    float* Qs = sm; float* Ks = sm + 64 * 129; float* Ss = sm + 2 * 64 * 129;
    const int qt = (gridDim.x - 1) - blockIdx.x, h = blockIdx.y, tid = threadIdx.x, ty = tid >> 4, tx = tid & 15;
    const int r0 = qt * 64;
    for (int i = tid; i < 64 * 128; i += 256) { const int r = i >> 7, d = i & 127; Qs[r * 129 + d] = proj[(size_t)(r0 + r) * NIN + OQA + h * HD + d] * SCALE; }
    float m[4], l[4], cq[4], o[4][8];
#pragma unroll
    for (int i = 0; i < 4; ++i) { m[i] = -1e30f; l[i] = 0.f; cq[i] = c[(size_t)(r0 + ty * 4 + i) * NH + h];
#pragma unroll
        for (int j = 0; j < 8; ++j) o[i][j] = 0.f; }
    for (int kt = 0; kt <= qt; ++kt) {
        const int k0 = kt * 64;
        __syncthreads();
        for (int i = tid; i < 64 * 128; i += 256) { const int r = i >> 7, d = i & 127; Ks[r * 129 + d] = proj[(size_t)(k0 + r) * NIN + OKA + h * HD + d]; }
        __syncthreads();
        float s[4][4];
#pragma unroll
        for (int i = 0; i < 4; ++i)
#pragma unroll
            for (int j = 0; j < 4; ++j) s[i][j] = 0.f;
        for (int d = 0; d < 128; ++d) {
            float q[4], k[4];
#pragma unroll
            for (int i = 0; i < 4; ++i) { q[i] = Qs[(ty * 4 + i) * 129 + d]; k[i] = Ks[(tx * 4 + i) * 129 + d]; }
#pragma unroll
            for (int i = 0; i < 4; ++i)
#pragma unroll
                for (int j = 0; j < 4; ++j) s[i][j] = fmaf(q[i], k[j], s[i][j]);
        }
        float ck[4];
#pragma unroll
        for (int j = 0; j < 4; ++j) ck[j] = c[(size_t)(k0 + tx * 4 + j) * NH + h];
        float alpha[4];
#pragma unroll
        for (int i = 0; i < 4; ++i) {
            const int row = r0 + ty * 4 + i;
            float mx = -1e30f;
#pragma unroll
            for (int j = 0; j < 4; ++j) { const int key = k0 + tx * 4 + j; s[i][j] = (key <= row) ? (s[i][j] + cq[i] - ck[j]) : -__builtin_inff(); mx = fmaxf(mx, s[i][j]); }
            for (int of = 8; of >= 1; of >>= 1) mx = fmaxf(mx, __shfl_xor(mx, of));
            const float mn = fmaxf(m[i], mx);
            alpha[i] = __expf(m[i] - mn); m[i] = mn;
            float ps = 0.f;
#pragma unroll
            for (int j = 0; j < 4; ++j) { const float p = __expf(s[i][j] - mn); ps += p; Ss[(ty * 4 + i) * 65 + tx * 4 + j] = p; }
            for (int of = 8; of >= 1; of >>= 1) ps += __shfl_xor(ps, of);
            l[i] = l[i] * alpha[i] + ps;
#pragma unroll
            for (int j = 0; j < 8; ++j) o[i][j] *= alpha[i];
        }
        __syncthreads();
        for (int k = 0; k < 64; ++k) {
            const float4 v0 = *(const float4*)(proj + (size_t)(k0 + k) * NIN + OVA + h * HD + tx * 8);
            const float4 v1 = *(const float4*)(proj + (size_t)(k0 + k) * NIN + OVA + h * HD + tx * 8 + 4);
#pragma unroll
            for (int i = 0; i < 4; ++i) { const float p = Ss[(ty * 4 + i) * 65 + k];
                o[i][0] = fmaf(p, v0.x, o[i][0]); o[i][1] = fmaf(p, v0.y, o[i][1]); o[i][2] = fmaf(p, v0.z, o[i][2]); o[i][3] = fmaf(p, v0.w, o[i][3]);
                o[i][4] = fmaf(p, v1.x, o[i][4]); o[i][5] = fmaf(p, v1.y, o[i][5]); o[i][6] = fmaf(p, v1.z, o[i][6]); o[i][7] = fmaf(p, v1.w, o[i][7]); }
        }
    }
#pragma unroll
    for (int i = 0; i < 4; ++i) { const float inv = 1.0f / l[i]; float* yp = y + (size_t)(r0 + ty * 4 + i) * DM + h * HD + tx * 8;
#pragma unroll
        for (int j = 0; j < 8; ++j) yp[j] = o[i][j] * inv; }
}

__global__ __launch_bounds__(256) void k_sb(const float* __restrict__ proj, float* __restrict__ y) {
    extern __shared__ float sm[];
    float* Qs = sm; float* Ks = sm + 64 * 129; float* Ss = sm + 2 * 64 * 129;
    __shared__ float Rs[64]; __shared__ int flag;
    const int qt = (gridDim.x - 1) - blockIdx.x, h = blockIdx.y, tid = threadIdx.x, ty = tid >> 4, tx = tid & 15;
    const int r0 = qt * 64;
    for (int i = tid; i < 64 * 128; i += 256) { const int r = i >> 7, d = i & 127; Qs[r * 129 + d] = proj[(size_t)(r0 + r) * NIN + OQB + h * HD + d] * SCALE; }
    if (tid < 64) Rs[tid] = 0.f;
    float o[4][8];
#pragma unroll
    for (int i = 0; i < 4; ++i)
#pragma unroll
        for (int j = 0; j < 8; ++j) o[i][j] = 0.f;
    for (int kt = qt; kt >= 0; --kt) {
        const int k0 = kt * 64;
        __syncthreads();
        for (int i = tid; i < 64 * 128; i += 256) { const int r = i >> 7, d = i & 127; Ks[r * 129 + d] = proj[(size_t)(k0 + r) * NIN + OKB + h * HD + d]; }
        if (tid == 0) flag = 1;
        __syncthreads();
        float z[4][4];
#pragma unroll
        for (int i = 0; i < 4; ++i)
#pragma unroll
            for (int j = 0; j < 4; ++j) z[i][j] = 0.f;
        for (int d = 0; d < 128; ++d) {
            float q[4], k[4];
#pragma unroll
            for (int i = 0; i < 4; ++i) { q[i] = Qs[(ty * 4 + i) * 129 + d]; k[i] = Ks[(tx * 4 + i) * 129 + d]; }
#pragma unroll
            for (int i = 0; i < 4; ++i)
#pragma unroll
                for (int j = 0; j < 4; ++j) z[i][j] = fmaf(q[i], k[j], z[i][j]);
        }
        float lom[4][4];
#pragma unroll
        for (int i = 0; i < 4; ++i)
#pragma unroll
            for (int j = 0; j < 4; ++j) { const int row = r0 + ty * 4 + i, key = k0 + tx * 4 + j; lom[i][j] = (key < row) ? -softplusf_(z[i][j]) : 0.f; Ss[(ty * 4 + i) * 65 + tx * 4 + j] = lom[i][j]; }
        __syncthreads();
        if (tid < 64) {
            float run = Rs[tid];
            for (int k = 63; k >= 0; --k) { const float t = Ss[tid * 65 + k]; Ss[tid * 65 + k] = run; run += t; }
            Rs[tid] = run;
            if (!(run < -105.f)) flag = 0;
        }
        __syncthreads();
#pragma unroll
        for (int i = 0; i < 4; ++i)
#pragma unroll
            for (int j = 0; j < 4; ++j) { const int row = r0 + ty * 4 + i, key = k0 + tx * 4 + j; const float tail = Ss[(ty * 4 + i) * 65 + tx * 4 + j];
                z[i][j] = (key < row) ? __expf(lom[i][j] + z[i][j] + tail) : 0.f; }
        const int stop = flag;
        __syncthreads();
#pragma unroll
        for (int i = 0; i < 4; ++i)
#pragma unroll
            for (int j = 0; j < 4; ++j) Ss[(ty * 4 + i) * 65 + tx * 4 + j] = z[i][j];
        __syncthreads();
        for (int k = 0; k < 64; ++k) {
            const float4 v0 = *(const float4*)(proj + (size_t)(k0 + k) * NIN + OVB + h * HD + tx * 8);
            const float4 v1 = *(const float4*)(proj + (size_t)(k0 + k) * NIN + OVB + h * HD + tx * 8 + 4);
#pragma unroll
            for (int i = 0; i < 4; ++i) { const float p = Ss[(ty * 4 + i) * 65 + k];
                o[i][0] = fmaf(p, v0.x, o[i][0]); o[i][1] = fmaf(p, v0.y, o[i][1]); o[i][2] = fmaf(p, v0.z, o[i][2]); o[i][3] = fmaf(p, v0.w, o[i][3]);
                o[i][4] = fmaf(p, v1.x, o[i][4]); o[i][5] = fmaf(p, v1.y, o[i][5]); o[i][6] = fmaf(p, v1.z, o[i][6]); o[i][7] = fmaf(p, v1.w, o[i][7]); }
        }
        if (stop) break;
    }
#pragma unroll
    for (int i = 0; i < 4; ++i) { float* yp = y + (size_t)(r0 + ty * 4 + i) * DM + WF + h * HD + tx * 8;
#pragma unroll
        for (int j = 0; j < 8; ++j) yp[j] = o[i][j]; }
}

__global__ __launch_bounds__(256) void k_convglu(const bf16_t* __restrict__ up, const float* __restrict__ cw, const float* __restrict__ cb, float* __restrict__ act) {
    const int t = blockIdx.y, j = blockIdx.x * 256 + threadIdx.x;
    if (j >= DFF) return;
    float ug = cb[j], uv = cb[DFF + j];
#pragma unroll
    for (int i = 0; i < 3; ++i) { const int tt = t - 2 + i; if (tt >= 0) { ug = fmaf(cw[(size_t)i * 2 * DFF + j], bf2f(up[(size_t)tt * 2 * DFF + j]), ug); uv = fmaf(cw[(size_t)i * 2 * DFF + DFF + j], bf2f(up[(size_t)tt * 2 * DFF + DFF + j]), uv); } }
    act[(size_t)t * DFF + j] = ug * sigmoidf_(ug) * uv;
}

template <class Epi, typename TA> static void gemm(const TA* A, int lda, const float* W, int ldw, int N, int K, const Epi& e, hipStream_t st) {
    dim3 grid((N + 127) / 128, S / 128);
    hipLaunchKernelGGL((k_gemm<Epi, TA>), grid, dim3(256), 0, st, A, lda, W, ldw, N, K, e);
}

extern "C" void kernel_launch(void* const* d_in, const int* in_sizes, int n_in, void* d_out, int out_size, void* d_ws, size_t ws_size, hipStream_t stream) {
    const float* x = (const float*)d_in[0]; const float* p = (const float*)d_in[1]; const float* g_mix = (const float*)d_in[2]; const float* w_in = (const float*)d_in[3];
    const float* b_f = (const float*)d_in[4]; const float* g_q = (const float*)d_in[5]; const float* g_k = (const float*)d_in[6]; const float* w_bf = (const float*)d_in[7];
    const float* w_bs = (const float*)d_in[8]; const float* w_out = (const float*)d_in[9]; const float* g_ffn = (const float*)d_in[10]; const float* w_up = (const float*)d_in[11];
    const float* conv_w = (const float*)d_in[12]; const float* conv_b = (const float*)d_in[13]; const float* w_down = (const float*)d_in[14]; const float* g_ple = (const float*)d_in[15];
    const float* w_pg = (const float*)d_in[16]; const float* w_pp = (const float*)d_in[17];
    float* out = (float*)d_out;
    char* ws = (char*)d_ws;
    constexpr size_t MB = 1u << 20;
    float* cbuf = (float*)(ws);
    float* h = (float*)(ws + 1 * MB);
    float* proj = (float*)(ws + 129 * MB);
    float* y = (float*)(ws + 770 * MB);
    float* merged = (float*)(ws + 898 * MB);
    bf16_t* up = (bf16_t*)(ws + 129 * MB);
    float* act = (float*)(ws + 474 * MB);
    if (ws_size < 1026 * MB) { fprintf(stderr, "workspace too small\n"); return; }
    static bool attr = false;
    if (!attr) { attr = true; hipFuncSetAttribute((const void*)k_fox, hipFuncAttributeMaxDynamicSharedMemorySize, ATT_LDS); hipFuncSetAttribute((const void*)k_sb, hipFuncAttributeMaxDynamicSharedMemorySize, ATT_LDS); }

    hipLaunchKernelGGL(k_rmsnorm, dim3(S), dim3(256), 0, stream, x, g_mix, h);
    gemm<EpiStoreF32, float>(h, DM, w_in, NIN, NIN, DM, EpiStoreF32{proj, NIN}, stream);
    hipLaunchKernelGGL(k_qknorm, dim3(S * 32 / 4), dim3(256), 0, stream, proj, g_q, g_k);
    hipLaunchKernelGGL(k_cumlogf, dim3(NH), dim3(256), 0, stream, (const float*)proj, b_f, cbuf);
    hipLaunchKernelGGL(k_fox, dim3(S / 64, NH), dim3(256), ATT_LDS, stream, (const float*)proj, (const float*)cbuf, y);
    hipLaunchKernelGGL(k_sb, dim3(S / 64, NH), dim3(256), ATT_LDS, stream, (const float*)proj, y);
    gemm<EpiGate, float>(y, DM, w_bf, DM, DM, WF, EpiGate{merged, proj, OGA, 0}, stream);
    gemm<EpiGate, float>(y + WF, DM, w_bs, DM, DM, WF, EpiGate{merged, proj, OGB, 1}, stream);
    gemm<EpiResid, float>(merged, DM, w_out, DM, DM, DM, EpiResid{out, x}, stream);
    hipLaunchKernelGGL(k_rmsnorm, dim3(S), dim3(256), 0, stream, (const float*)out, g_ffn, h);
    gemm<EpiStoreBf16, float>(h, DM, w_up, 2 * DFF, 2 * DFF, DM, EpiStoreBf16{up, 2 * DFF}, stream);
    hipLaunchKernelGGL(k_convglu, dim3((DFF + 255) / 256, S), dim3(256), 0, stream, (const bf16_t*)up, conv_w, conv_b, act);
    gemm<EpiResid, float>(act, DFF, w_down, DM, DM, DFF, EpiResid{out, out}, stream);
    hipLaunchKernelGGL(k_rmsnorm, dim3(S), dim3(256), 0, stream, (const float*)out, g_ple, h);
    gemm<EpiStoreF32, float>(p, PLE, w_pp, DM, DM, PLE, EpiStoreF32{merged, DM}, stream);
    gemm<EpiPle, float>(h, DM, w_pg, DM, DM, DM, EpiPle{out, merged}, stream);
}
```

```cpp
#include <hip/hip_runtime.h>
#include <cstdio>
#include <cstdint>
namespace pg8 {
#define PG8_LAS __attribute__((address_space(3)))
typedef unsigned short bf16_t;
typedef short bf16x8 __attribute__((ext_vector_type(8)));
typedef float f32x4 __attribute__((ext_vector_type(4)));
typedef unsigned u32x4 __attribute__((ext_vector_type(4)));
constexpr int BM = 256, BK = 64, HALF = 128, HTB = HALF * BK * 2  , STAGE_BYTES = 8 * HTB, NXCD = 8, WGM = 8;

__host__ __device__ __forceinline__ int lds_byte(int r, int c) { const int st = (r >> 4) * 2 + (c >> 5), rr = r & 15, cc = c & 31, ob = rr * 64 + cc * 2; return st * 1024 + (ob ^ (((ob >> 9) & 1) << 5)); }
__host__ __device__ __forceinline__ void stage_rc(int b, int& R, int& C) { const int st = b / 1024, sb = b % 1024, swz = sb ^ (((sb >> 9) & 1) << 5); R = (st >> 1) * 16 + swz / 64; C = (st & 1) * 32 + (swz % 64) / 2; }
__host__ __device__ __forceinline__ int perm32(int rho) { const int n = rho >> 4, i = rho & 15; return 8 * (i >> 2) + 4 * n + (i & 3); }

struct Unit { int pm, pn; };
struct Gemm { const bf16_t* A; const bf16_t* Bt; int M, N, K; };

struct StaticOrder {
    int nM, nN, nwg, G, c;
    __host__ __device__ void init(int M, int N, int G_, int c_) { nM = M / BM; nN = N / BM; nwg = nM * nN; G = G_; c = c_; }
    __host__ __device__ bool next(int i, Unit& u) const {
        const long L = (long)i * G + c; if (L >= nwg) return false;
        int wgid = (int)L; { const int q = nwg / NXCD, r = nwg % NXCD, xcd = wgid % NXCD, off = wgid / NXCD; wgid = (xcd < r ? xcd * (q + 1) : r * (q + 1) + (xcd - r) * q) + off; }
        const int nig = WGM * nN, gid = wgid / nig, fm = gid * WGM, gsz = (nM - fm) < WGM ? (nM - fm) : WGM;
        u.pm = fm + ((wgid % nig) % gsz); u.pn = (wgid % nig) / gsz; return true;
    }
    __device__ __forceinline__ void a_ready(const Unit&) const {}
    __device__ __forceinline__ void done(const Unit&) const {}
};

__device__ __forceinline__ unsigned cvt_pk_bf16(float lo, float hi) { unsigned r; asm volatile("v_cvt_pk_bf16_f32 %0, %1, %2" : "=v"(r) : "v"(lo), "v"(hi)); return r; }
typedef float f32x2 __attribute__((ext_vector_type(2)));
constexpr int SEQ_ = 8192, DM_ = 4096;
constexpr float EPS_ = 1e-6f;
__device__ __forceinline__ float sigm(float v) { return __builtin_amdgcn_rcpf(1.0f + __builtin_amdgcn_exp2f(-1.4426950408889634f * v)); }
__device__ __forceinline__ float rs_of(float ss) { return __builtin_amdgcn_rsqf(ss * (1.0f / DM_) + EPS_); }
typedef unsigned u32x2 __attribute__((ext_vector_type(2)));
__device__ __forceinline__ f32x4 bf4_to_f32(u32x2 w) { return (f32x4){__uint_as_float(w.x << 16), __uint_as_float(w.x & 0xffff0000u), __uint_as_float(w.y << 16), __uint_as_float(w.y & 0xffff0000u)}; }

struct EpiProj {
    static constexpr bool PERM = true, AFTER_DRAIN = false;
    bf16_t* qkv; bf16_t* gates; const float* ss;
    __device__ __forceinline__ void operator()(const f32x4 (&acc)[2][2][4][2], const Unit& u, int wr, int wc, int fr, int fq) const {
        const int row0 = u.pm * BM + wr * 64 + fr;
        bf16_t* base; int ldc, colt; const bool gate = u.pn >= 48;
        if (!gate) { base = qkv + (size_t)(u.pn >> 3) * ((size_t)SEQ_ * 2048); ldc = 2048; colt = (u.pn & 7) * 256; }
        else { const int t = u.pn - 48; base = gates + (size_t)(t >> 4) * ((size_t)SEQ_ * 4096); ldc = 4096; colt = (t & 15) * 256; }
        const int col0 = colt + wc * 32 + 8 * fq;
#pragma unroll
        for (int ai = 0; ai < 2; ++ai)
#pragma unroll
            for (int m = 0; m < 4; ++m) { const int r = row0 + ai * HALF + m * 16; const float rs = rs_of(ss[r]); bf16_t* rowp = base + (size_t)r * ldc + col0;
#pragma unroll
                for (int bj = 0; bj < 2; ++bj) { f32x4 v0 = acc[ai][bj][m][0] * rs, v1 = acc[ai][bj][m][1] * rs;
                    if (gate) {
#pragma unroll
                        for (int j = 0; j < 4; ++j) { v0[j] = sigm(v0[j]); v1[j] = sigm(v1[j]); } }
                    u32x4 w; w.x = cvt_pk_bf16(v0[0], v0[1]); w.y = cvt_pk_bf16(v0[2], v0[3]); w.z = cvt_pk_bf16(v1[0], v1[1]); w.w = cvt_pk_bf16(v1[2], v1[3]);
                    *(u32x4*)(rowp + bj * HALF) = w; } }
    }
};
struct EpiGateA {
    static constexpr bool PERM = false, AFTER_DRAIN = false;
    float* tmp; const bf16_t* sg;
    __device__ __forceinline__ void operator()(const f32x4 (&acc)[2][2][4][2], const Unit& u, int wr, int wc, int fr, int fq) const {
        const int row0 = u.pm * BM + wr * 64 + fr, col0 = u.pn * BM + wc * 32 + 4 * fq;
#pragma unroll
        for (int ai = 0; ai < 2; ++ai)
#pragma unroll
            for (int m = 0; m < 4; ++m) { const size_t off = (size_t)(row0 + ai * HALF + m * 16) * DM_ + col0;
#pragma unroll
                for (int bj = 0; bj < 2; ++bj)
#pragma unroll
                    for (int n = 0; n < 2; ++n) { const f32x4 g = bf4_to_f32(*(const u32x2*)(sg + off + bj * HALF + n * 16)); *(f32x4*)(tmp + off + bj * HALF + n * 16) = acc[ai][bj][m][n] * g; }
                asm volatile("" ::: "memory"); }
    }
};
struct EpiGateB {
    static constexpr bool PERM = true, AFTER_DRAIN = false;
    bf16_t* merged; const float* tmp; const bf16_t* sg;
    __device__ __forceinline__ void operator()(const f32x4 (&acc)[2][2][4][2], const Unit& u, int wr, int wc, int fr, int fq) const {
        const int row0 = u.pm * BM + wr * 64 + fr, col0 = u.pn * BM + wc * 32 + 8 * fq;
#pragma unroll
        for (int ai = 0; ai < 2; ++ai)
#pragma unroll
            for (int m = 0; m < 4; ++m) { const size_t off = (size_t)(row0 + ai * HALF + m * 16) * DM_ + col0;
#pragma unroll
                for (int bj = 0; bj < 2; ++bj) { const u32x4 gw = *(const u32x4*)(sg + off + bj * HALF); const f32x4 t0 = *(const f32x4*)(tmp + off + bj * HALF), t1 = *(const f32x4*)(tmp + off + bj * HALF + 4);
                    const f32x4 g0 = bf4_to_f32((u32x2){gw.x, gw.y}), g1 = bf4_to_f32((u32x2){gw.z, gw.w});
                    const f32x4 v0 = t0 + acc[ai][bj][m][0] * g0, v1 = t1 + acc[ai][bj][m][1] * g1;
                    u32x4 w; w.x = cvt_pk_bf16(v0[0], v0[1]); w.y = cvt_pk_bf16(v0[2], v0[3]); w.z = cvt_pk_bf16(v1[0], v1[1]); w.w = cvt_pk_bf16(v1[2], v1[3]);
                    *(u32x4*)(merged + off + bj * HALF) = w; }
                asm volatile("" ::: "memory"); }
    }
};
struct EpiResStat {
    static constexpr bool PERM = false, AFTER_DRAIN = false;
    const float* base; float* out; bf16_t* xb; float* ss;
    __device__ __forceinline__ void operator()(const f32x4 (&acc)[2][2][4][2], const Unit& u, int wr, int wc, int fr, int fq) const {
        const int row0 = u.pm * BM + wr * 64 + fr, col0 = u.pn * BM + wc * 32 + 4 * fq;
#pragma unroll
        for (int ai = 0; ai < 2; ++ai)
#pragma unroll
            for (int m = 0; m < 4; ++m) { const int r = row0 + ai * HALF + m * 16; const size_t off = (size_t)r * DM_ + col0; float s = 0.f;
#pragma unroll
                for (int bj = 0; bj < 2; ++bj)
#pragma unroll
                    for (int n = 0; n < 2; ++n) { const f32x4 b = *(const f32x4*)(base + off + bj * HALF + n * 16); const f32x4 o = b + acc[ai][bj][m][n];
                        *(f32x4*)(out + off + bj * HALF + n * 16) = o; s += (o[0] * o[0] + o[1] * o[1]) + (o[2] * o[2] + o[3] * o[3]);
                        u32x2 w; w.x = cvt_pk_bf16(o[0], o[1]); w.y = cvt_pk_bf16(o[2], o[3]); *(u32x2*)(xb + off + bj * HALF + n * 16) = w; }
                s += __shfl_xor(s, 16); s += __shfl_xor(s, 32);
                if (fq == 0) __hip_atomic_fetch_add(ss + r, s, __ATOMIC_RELAXED, __HIP_MEMORY_SCOPE_AGENT);
                asm volatile("" ::: "memory"); }
    }
};
struct EpiUp {
    static constexpr bool PERM = true, AFTER_DRAIN = false;
    bf16_t* O; int ldc; const float* ss;
    __device__ __forceinline__ void operator()(const f32x4 (&acc)[2][2][4][2], const Unit& u, int wr, int wc, int fr, int fq) const {
        const int row0 = u.pm * BM + wr * 64 + fr, col0 = u.pn * BM + wc * 32 + 8 * fq;
#pragma unroll
        for (int ai = 0; ai < 2; ++ai)
#pragma unroll
            for (int m = 0; m < 4; ++m) { const int r = row0 + ai * HALF + m * 16; const float rs = rs_of(ss[r]); bf16_t* rowp = O + (size_t)r * ldc + col0;
#pragma unroll
                for (int bj = 0; bj < 2; ++bj) { const f32x4 v0 = acc[ai][bj][m][0] * rs, v1 = acc[ai][bj][m][1] * rs;
                    u32x4 w; w.x = cvt_pk_bf16(v0[0], v0[1]); w.y = cvt_pk_bf16(v0[2], v0[3]); w.z = cvt_pk_bf16(v1[0], v1[1]); w.w = cvt_pk_bf16(v1[2], v1[3]);
                    *(u32x4*)(rowp + bj * HALF) = w; } }
    }
};
struct EpiStoreF32 {
    static constexpr bool PERM = false, AFTER_DRAIN = false;
    float* C;
    __device__ __forceinline__ void operator()(const f32x4 (&acc)[2][2][4][2], const Unit& u, int wr, int wc, int fr, int fq) const {
        const int row0 = u.pm * BM + wr * 64 + fr, col0 = u.pn * BM + wc * 32 + 4 * fq;
#pragma unroll
        for (int ai = 0; ai < 2; ++ai)
#pragma unroll
            for (int m = 0; m < 4; ++m) { float* rowp = C + (size_t)(row0 + ai * HALF + m * 16) * DM_ + col0;
#pragma unroll
                for (int bj = 0; bj < 2; ++bj)
#pragma unroll
                    for (int n = 0; n < 2; ++n) *(f32x4*)(rowp + bj * HALF + n * 16) = acc[ai][bj][m][n]; }
    }
};
struct EpiPle {
    static constexpr bool PERM = false, AFTER_DRAIN = false;
    float* out; const float* pp; const float* ss;
    __device__ __forceinline__ void operator()(const f32x4 (&acc)[2][2][4][2], const Unit& u, int wr, int wc, int fr, int fq) const {
        const int row0 = u.pm * BM + wr * 64 + fr, col0 = u.pn * BM + wc * 32 + 4 * fq;
#pragma unroll
        for (int ai = 0; ai < 2; ++ai)
#pragma unroll
            for (int m = 0; m < 4; ++m) { const int r = row0 + ai * HALF + m * 16; const size_t off = (size_t)r * DM_ + col0; const float rs = rs_of(ss[r]);
#pragma unroll
                for (int bj = 0; bj < 2; ++bj)
#pragma unroll
                    for (int n = 0; n < 2; ++n) { const f32x4 b = *(const f32x4*)(out + off + bj * HALF + n * 16), q = *(const f32x4*)(pp + off + bj * HALF + n * 16); const f32x4 a = acc[ai][bj][m][n] * rs;
                        f32x4 o; o[0] = b[0] + sigm(a[0]) * q[0]; o[1] = b[1] + sigm(a[1]) * q[1]; o[2] = b[2] + sigm(a[2]) * q[2]; o[3] = b[3] + sigm(a[3]) * q[3];
                        *(f32x4*)(out + off + bj * HALF + n * 16) = o; }
                asm volatile("" ::: "memory"); }
    }
};
template <class Epi, class Sched, bool ALIGN_EPI = false, bool SP2 = false>
__device__ __forceinline__ void gemm_phase(PG8_LAS unsigned char* lds, const Gemm g, const Sched& S, const Epi& E) {
    const int tid = threadIdx.x, wid = __builtin_amdgcn_readfirstlane(tid >> 6), lane = tid & 63, wr = wid >> 2, wc = wid & 3, fr = lane & 15, fq = lane >> 4;
    const int K = g.K, nt = K / BK;
    unsigned voffA[2], voffB[2];
#pragma unroll
    for (int i = 0; i < 2; ++i) { int R, C; stage_rc(tid * 16 + i * 8192, R, C); const int Rb = Epi::PERM ? ((R & ~31) + perm32(R & 31)) : R;
        voffA[i] = (unsigned)(R * K + C) * 2u; voffB[i] = (unsigned)(Rb * K + C) * 2u; }
    const size_t kstep = (size_t)(BK * 2);
    const size_t hstep = (size_t)HALF * K * 2;
    const size_t tstep = 2 * hstep;
    const unsigned ldsw = (unsigned)wid * 1024u;
    const int aoff = lds_byte(wr * 64 + fr, fq * 8), boff = lds_byte(wc * 32 + fr, fq * 8);
#define PG8_SA(b, h) (((b) * 2 + (h)) * HTB)
#define PG8_SB(b, h) ((4 + (b) * 2 + (h)) * HTB)
#define PG8_STAGE(bufoff, gbase, voff) do { _Pragma("unroll") for (int _i = 0; _i < 2; ++_i) \
        __builtin_amdgcn_global_load_lds((const unsigned*)((const char*)(gbase) + (voff)[_i]), (PG8_LAS unsigned*)(lds + (bufoff) + ldsw + _i * 8192), 16, 0, 0); } while (0)
#define PG8_LDA(dst, b, h) do { _Pragma("unroll") for (int m = 0; m < 4; ++m) _Pragma("unroll") for (int k = 0; k < 2; ++k) dst[m][k] = *(const PG8_LAS bf16x8*)(lds + PG8_SA(b, h) + aoff + m * 2048 + k * 1024); } while (0)
#define PG8_LDB(dst, b, h) do { _Pragma("unroll") for (int n = 0; n < 2; ++n) _Pragma("unroll") for (int k = 0; k < 2; ++k) dst[n][k] = *(const PG8_LAS bf16x8*)(lds + PG8_SB(b, h) + boff + n * 2048 + k * 1024); } while (0)
#define PG8_MMA(ai, bj, At, Bt) do { __builtin_amdgcn_s_setprio(1); _Pragma("unroll") for (int m = 0; m < 4; ++m) _Pragma("unroll") for (int n = 0; n < 2; ++n) _Pragma("unroll") for (int k = 0; k < 2; ++k) \
        acc[ai][bj][m][n] = __builtin_amdgcn_mfma_f32_16x16x32_bf16(Bt[n][k], At[m][k], acc[ai][bj][m][n], 0, 0, 0); __builtin_amdgcn_s_setprio(0); } while (0)
#define PG8_WAIT_V(n) asm volatile("s_waitcnt vmcnt(" #n ")" ::: "memory")
#define PG8_WAIT_L(n) asm volatile("s_waitcnt lgkmcnt(" #n ")" ::: "memory")
#define PG8_BAR __builtin_amdgcn_s_barrier()
#define PG8_SCHED __builtin_amdgcn_sched_barrier(0)
    Unit cur, nxt; int ui = 0;
    if (!S.next(0, cur)) return;
    f32x4 acc[2][2][4][2];
#pragma unroll
    for (int a = 0; a < 2; ++a)
#pragma unroll
        for (int b = 0; b < 2; ++b)
#pragma unroll
            for (int m = 0; m < 4; ++m)
#pragma unroll
                for (int n = 0; n < 2; ++n) acc[a][b][m][n] = (f32x4){0.f, 0.f, 0.f, 0.f};
    bf16x8 At[4][2], B0[2][2], B1[2][2];
    const char* cA = (const char*)g.A + (size_t)cur.pm * tstep; const char* cB = (const char*)g.Bt + (size_t)cur.pn * tstep;
    S.a_ready(cur);
    if constexpr (SP2) {
        PG8_STAGE(PG8_SB(0, 0), cB, voffB); PG8_STAGE(PG8_SB(0, 1), cB + hstep, voffB); PG8_STAGE(PG8_SA(0, 0), cA, voffA); PG8_STAGE(PG8_SA(0, 1), cA + hstep, voffA);
        if (wr == 1) PG8_BAR;
        PG8_WAIT_V(2); PG8_BAR;
        PG8_STAGE(PG8_SB(1, 0), cB + kstep, voffB); PG8_STAGE(PG8_SA(1, 0), cA + kstep, voffA); PG8_STAGE(PG8_SB(1, 1), cB + hstep + kstep, voffB);
        PG8_WAIT_V(6); PG8_BAR;
    } else {
        PG8_STAGE(PG8_SB(0, 0), cB, voffB); PG8_STAGE(PG8_SA(0, 0), cA, voffA); PG8_STAGE(PG8_SB(0, 1), cB + hstep, voffB); PG8_STAGE(PG8_SA(0, 1), cA + hstep, voffA);
        if (wr == 1) PG8_BAR;
        PG8_WAIT_V(4); PG8_BAR;
        PG8_STAGE(PG8_SB(1, 0), cB + kstep, voffB); PG8_STAGE(PG8_SA(1, 0), cA + kstep, voffA); PG8_STAGE(PG8_SB(1, 1), cB + hstep + kstep, voffB);
        PG8_WAIT_V(6); PG8_BAR;
    }
    for (;;) {
        const bool has_next = S.next(ui + 1, nxt);
        const char* nA = has_next ? (const char*)g.A + (size_t)nxt.pm * tstep : cA; const char* nB = has_next ? (const char*)g.Bt + (size_t)nxt.pn * tstep : cB;
        for (int t = 0; t < nt; t += 2) {
            const bool last = (t == nt - 2);
            const char* a1 = cA + (size_t)(t + 1) * kstep;
            const char* a2 = last ? nA : cA + (size_t)(t + 2) * kstep; const char* b2 = last ? nB : cB + (size_t)(t + 2) * kstep;
            const char* a3 = a2 + kstep; const char* b3 = b2 + kstep;
            if (last && has_next) S.a_ready(nxt);
            if constexpr (SP2) {
            PG8_LDB(B0, 0, 0); PG8_LDB(B1, 0, 1); PG8_SCHED; PG8_LDA(At, 0, 0); PG8_STAGE(PG8_SA(1, 1), a1 + hstep, voffA);
            PG8_WAIT_V(8); PG8_WAIT_L(0); PG8_BAR; PG8_MMA(0, 0, At, B0); PG8_MMA(0, 1, At, B1); PG8_BAR; PG8_SCHED;
            PG8_LDA(At, 0, 1); PG8_STAGE(PG8_SB(0, 0), b2, voffB); PG8_STAGE(PG8_SB(0, 1), b2 + hstep, voffB); PG8_STAGE(PG8_SA(0, 0), a2, voffA);
            PG8_WAIT_V(8); PG8_WAIT_L(0); PG8_BAR; PG8_MMA(1, 0, At, B0); PG8_MMA(1, 1, At, B1); PG8_BAR; PG8_SCHED;
            PG8_LDB(B0, 1, 0); PG8_LDB(B1, 1, 1); PG8_SCHED; PG8_LDA(At, 1, 0); PG8_STAGE(PG8_SA(0, 1), a2 + hstep, voffA);
            PG8_WAIT_V(8); PG8_WAIT_L(0); PG8_BAR; PG8_MMA(0, 0, At, B0); PG8_MMA(0, 1, At, B1); PG8_BAR; PG8_SCHED;
            PG8_LDA(At, 1, 1); PG8_STAGE(PG8_SB(1, 0), b3, voffB); PG8_STAGE(PG8_SB(1, 1), b3 + hstep, voffB); PG8_STAGE(PG8_SA(1, 0), a3, voffA);
            PG8_WAIT_V(8); PG8_WAIT_L(0); PG8_BAR; PG8_MMA(1, 0, At, B0); PG8_MMA(1, 1, At, B1); PG8_BAR; PG8_SCHED;
            } else {
            PG8_LDB(B0, 0, 0); PG8_SCHED; PG8_LDA(At, 0, 0); PG8_STAGE(PG8_SA(1, 1), a1 + hstep, voffA);
            PG8_WAIT_L(8); PG8_BAR; PG8_WAIT_L(0); PG8_MMA(0, 0, At, B0); PG8_BAR; PG8_SCHED;
            PG8_LDB(B1, 0, 1); PG8_STAGE(PG8_SB(0, 0), b2, voffB);
            PG8_BAR; PG8_WAIT_L(0); PG8_MMA(0, 1, At, B1); PG8_BAR;
            PG8_LDA(At, 0, 1); PG8_STAGE(PG8_SA(0, 0), a2, voffA);
            PG8_BAR; PG8_WAIT_L(0); PG8_MMA(1, 0, At, B0); PG8_BAR; PG8_SCHED;
            PG8_STAGE(PG8_SB(0, 1), b2 + hstep, voffB);
            PG8_WAIT_V(6); PG8_BAR; PG8_MMA(1, 1, At, B1); PG8_BAR;
            PG8_LDB(B0, 1, 0); PG8_SCHED; PG8_LDA(At, 1, 0); PG8_STAGE(PG8_SA(0, 1), a2 + hstep, voffA);
            PG8_WAIT_L(8); PG8_BAR; PG8_WAIT_L(0); PG8_MMA(0, 0, At, B0); PG8_BAR; PG8_SCHED;
            PG8_LDB(B1, 1, 1); PG8_STAGE(PG8_SB(1, 0), b3, voffB);
            PG8_BAR; PG8_WAIT_L(0); PG8_MMA(0, 1, At, B1); PG8_BAR;
            PG8_LDA(At, 1, 1); PG8_STAGE(PG8_SA(1, 0), a3, voffA);
            PG8_BAR; PG8_WAIT_L(0); PG8_MMA(1, 0, At, B0); PG8_BAR; PG8_SCHED;
            PG8_STAGE(PG8_SB(1, 1), b3 + hstep, voffB);
            PG8_WAIT_V(6); PG8_BAR; PG8_MMA(1, 1, At, B1); PG8_BAR;
            }
        }
        if constexpr (ALIGN_EPI) { if (wr == 0) PG8_BAR; }
        if constexpr (!Epi::AFTER_DRAIN) { E(acc, cur, wr, wc, fr, fq); S.done(cur); }
        if (!has_next) break;
#pragma unroll
        for (int a = 0; a < 2; ++a)
#pragma unroll
            for (int b = 0; b < 2; ++b)
#pragma unroll
                for (int m = 0; m < 4; ++m)
#pragma unroll
                    for (int n = 0; n < 2; ++n) acc[a][b][m][n] = (f32x4){0.f, 0.f, 0.f, 0.f};
        cur = nxt; cA = nA; cB = nB; ++ui;
        if constexpr (ALIGN_EPI) { if (wr == 1) PG8_BAR; }
    }
    PG8_WAIT_V(0);
    if constexpr (!ALIGN_EPI) { if (wr == 0) PG8_BAR; }
    PG8_BAR;
    if constexpr (Epi::AFTER_DRAIN) { E.fused(acc, cur, wr, wc, fr, fq, lds, wid, lane); S.done(cur); }
#undef PG8_SA
#undef PG8_SB
#undef PG8_STAGE
#undef PG8_LDA
#undef PG8_LDB
#undef PG8_MMA
#undef PG8_WAIT_V
#undef PG8_WAIT_L
#undef PG8_BAR
#undef PG8_SCHED
}
}
constexpr int NWAVES = 8;
constexpr int S = 8192, DM = 4096, HD = 128, NH = 16, WF = 2048, DFF = 11008, PLE = 256, NIN = 20496, NPROJ = 20480;
constexpr float EPS = 1e-6f;
constexpr float SCALE = 0.08838834764831845f;
constexpr size_t MiB = 1u << 20;
constexpr size_t WS_CTL = 0, CTL_ZERO_BYTES = 1 * MiB;
constexpr size_t WS_SS1 = 1 * MiB;
constexpr size_t WS_LOGF = WS_SS1 + 64 * 1024;
constexpr size_t WS_C = WS_LOGF + 512 * 1024;
constexpr size_t WS_WIN = 4 * MiB;
constexpr size_t WS_WBF = WS_WIN + 160 * MiB;
constexpr size_t WS_WBS = WS_WBF + 16 * MiB;
constexpr size_t WS_WOUT = WS_WBS + 16 * MiB;
constexpr size_t WS_WUP = WS_WOUT + 32 * MiB;
constexpr size_t WS_WDN = WS_WUP + 172 * MiB;
constexpr size_t WS_WPG = WS_WDN + 86 * MiB;
constexpr size_t WS_WPP = WS_WPG + 32 * MiB;
constexpr size_t WS_XB = WS_WPP + 2 * MiB;
constexpr size_t WS_PB = WS_XB + 64 * MiB;
constexpr size_t WS_QKV = WS_PB + 4 * MiB;
constexpr size_t WS_GATES = WS_QKV + 192 * MiB;
constexpr size_t WS_Y = WS_GATES + 128 * MiB;
constexpr size_t WS_UP = WS_QKV;
constexpr size_t WS_MERGED = WS_Y + 64 * MiB;
constexpr size_t WS_ACT = WS_MERGED + 64 * MiB;
constexpr size_t WS_PP = WS_QKV;
constexpr size_t WS_END = WS_ACT + 172 * MiB;
static_assert(WS_UP + (size_t)S * 2 * DFF * 2 <= WS_MERGED, "up overlay");
constexpr int CW_BAR = 4096;
constexpr int CW_SS2 = 32768, CW_SS3 = 32768 + 8192;
constexpr int N_BAR_REGIONS = 4;
constexpr int RING_OFF = 0, RING_BYTES = 131072;
constexpr int LDSCTL_OFF = RING_BYTES, MISC_OFF = LDSCTL_OFF + 320;
constexpr int LDS_BYTES = 147456;

#define GAS __attribute__((address_space(1)))
#define LAS __attribute__((address_space(3)))
typedef unsigned short bf16;
typedef unsigned v4u __attribute__((ext_vector_type(4)));
typedef unsigned v2u __attribute__((ext_vector_type(2)));
typedef float f32x4 __attribute__((ext_vector_type(4)));
typedef float f32x16 __attribute__((ext_vector_type(16)));
typedef short bf16x8 __attribute__((ext_vector_type(8)));
typedef GAS unsigned gu32;
#define RLX_AGENT __ATOMIC_RELAXED, __HIP_MEMORY_SCOPE_AGENT
#define LDS_WAIT() asm volatile("s_waitcnt lgkmcnt(0)" ::: "memory")
#define VM_WAIT() asm volatile("s_waitcnt vmcnt(0)" ::: "memory")
__device__ __forceinline__ unsigned pk2(float lo, float hi) { unsigned r; asm volatile("v_cvt_pk_bf16_f32 %0, %1, %2" : "=v"(r) : "v"(lo), "v"(hi)); return r; }
__device__ __forceinline__ float bf2f(bf16 b) { return __uint_as_float(((unsigned)b) << 16); }
__device__ __forceinline__ float bflo(unsigned w) { return __uint_as_float(w << 16); }
__device__ __forceinline__ float bfhi(unsigned w) { return __uint_as_float(w & 0xffff0000u); }
__device__ __forceinline__ float sigmoidf_(float v) { return 1.0f / (1.0f + __expf(-v)); }
__device__ __forceinline__ float log_sigmoidf_(float v) { return fminf(v, 0.f) - log1pf(__expf(-fabsf(v))); }
__device__ __forceinline__ float softplusf_(float v) { return fmaxf(v, 0.f) + log1pf(__expf(-fabsf(v))); }
__device__ __forceinline__ float wave_sum(float v) {
#pragma unroll
    for (int o = 1; o < 64; o <<= 1) v += __shfl_xor(v, o);
    return v;
}

#define XB_TMO      128
#define XB_XCNT(j)  (256  + 64 * (j))
#define XB_XSUB(j)  (1280 + 64 * (j))
#define XB_XGEN(j)  (2304 + 64 * (j))
#define XB_TOP      3328
#define XB_TOPGEN   3392
#define XCD_BAR_WORDS 3456
#define XB_SPIN_CAP (1u << 18)

__device__ __forceinline__ unsigned xb_ld(unsigned* p)              { return __hip_atomic_load(p, __ATOMIC_RELAXED, __HIP_MEMORY_SCOPE_AGENT); }
__device__ __forceinline__ unsigned xb_add(unsigned* p, unsigned v) { return __hip_atomic_fetch_add(p, v, __ATOMIC_RELAXED, __HIP_MEMORY_SCOPE_AGENT); }
__device__ __forceinline__ unsigned xb_xcc_id() { return (unsigned)__builtin_amdgcn_s_getreg((3 << 11) | 20) & 0xFu; }
#define XB_SPIN(cond, bar) do { unsigned _sp = 0; while (cond) { __builtin_amdgcn_s_sleep(1); \
    if ((++_sp & 255u) == 0u) { if (xb_ld(&(bar)[XB_TMO])) break; if (_sp > XB_SPIN_CAP) { atomicAdd(&(bar)[XB_TMO], 1u); break; } } } } while (0)

struct XcdBarrier {
    unsigned* bar; unsigned x;
    volatile LAS unsigned* st;
};

__device__ __forceinline__ XcdBarrier xcd_barrier_post(unsigned* bar, volatile LAS unsigned* st) {
    XcdBarrier b; b.bar = bar; b.x = xb_xcc_id(); b.st = st;
    if (threadIdx.x == 0) (void)xb_add(&bar[XB_XCNT(b.x)], 1u);
    return b;
}
__device__ __forceinline__ void xcd_barrier_complete(unsigned* bar, unsigned x, unsigned& nloc, unsigned& nx) {
    const unsigned G = gridDim.x * gridDim.y * gridDim.z;
    unsigned sum, cnt, mine, sp = 0u;
    for (;;) {
        sum = 0u; cnt = 0u; mine = 0u;
#pragma unroll
        for (unsigned j = 0; j < 16; ++j) { const unsigned c = xb_ld(&bar[XB_XCNT(j)]); sum += c; cnt += (c > 0u) ? 1u : 0u; mine = (j == x) ? c : mine; }
        if (sum == G) break;
        __builtin_amdgcn_s_sleep(1);
        if ((++sp & 255u) == 0u) { if (xb_ld(&bar[XB_TMO])) break; if (sp > XB_SPIN_CAP) { atomicAdd(&bar[XB_TMO], 1u); break; } }
    }
    nloc = mine > 0u ? mine : 1u; nx = cnt > 0u ? cnt : 1u;
}

__device__ __forceinline__ void xcd_barrier(const XcdBarrier& b) {
    asm volatile("s_waitcnt vmcnt(0)" ::: "memory");
    __syncthreads();
    if (threadIdx.x == 0) {
        unsigned* bar = b.bar;
        __builtin_amdgcn_s_waitcnt(0);
        unsigned nloc = b.st[0], nx = b.st[1];
        if (nloc == 0u) { xcd_barrier_complete(bar, b.x, nloc, nx); b.st[0] = nloc; b.st[1] = nx; }
        const unsigned old = xb_add(&bar[XB_XSUB(b.x)], 1u);
        const unsigned gen = old / nloc;
        if (old + 1u == (gen + 1u) * nloc) {
            __builtin_amdgcn_fence(__ATOMIC_RELEASE, "agent");
            asm volatile("s_waitcnt vmcnt(0)" ::: "memory");
            const unsigned og = xb_add(&bar[XB_TOP], 1u);
            const unsigned tg = og / nx;
            if (og + 1u == (tg + 1u) * nx) xb_add(&bar[XB_TOPGEN], 1u);
            else XB_SPIN(xb_ld(&bar[XB_TOPGEN]) == tg, bar);
            __builtin_amdgcn_fence(__ATOMIC_ACQUIRE, "agent");
            xb_add(&bar[XB_XGEN(b.x)], 1u);
            asm volatile("s_waitcnt vmcnt(0)" ::: "memory");
        } else {
            XB_SPIN(xb_ld(&bar[XB_XGEN(b.x)]) == gen, bar);
            __builtin_amdgcn_fence(__ATOMIC_ACQUIRE, "agent");
            asm volatile("s_waitcnt vmcnt(0)" ::: "memory");
        }
    }
    __syncthreads();
}


struct Params {
    const float* in[18]; float* out; unsigned char* ws;
    int ph_lo, ph_hi, li, pad;
};
struct Frame {
    LAS unsigned char* lds; volatile LAS unsigned* MISC; gu32* ctl;
    int tid, lane, wave, vcu, G;
};

__device__ __forceinline__ void cvt_tile(const float* __restrict__ W, int ldw, int srccol0, const float* __restrict__ g, bf16* __restrict__ Wt, int K, int nrow0, int k0, int lane) {
    const int nq = lane & 15, q = lane >> 4;
    const float* src = W + (size_t)(k0 + 8 * q) * ldw + srccol0 + 4 * nq;
    f32x4 v[2][8];
#pragma unroll
    for (int p = 0; p < 2; ++p)
#pragma unroll
        for (int t = 0; t < 8; ++t) v[p][t] = __builtin_nontemporal_load((const f32x4*)(src + (size_t)(32 * p + t) * ldw));
#pragma unroll
    for (int p = 0; p < 2; ++p) {
        f32x4 g0 = (f32x4){1.f, 1.f, 1.f, 1.f}, g1 = g0;
        if (g) { g0 = *(const f32x4*)(g + k0 + 32 * p + 8 * q); g1 = *(const f32x4*)(g + k0 + 32 * p + 8 * q + 4); }
#pragma unroll
        for (int i = 0; i < 4; ++i) {
            v4u w; w.x = pk2(v[p][0][i] * g0[0], v[p][1][i] * g0[1]); w.y = pk2(v[p][2][i] * g0[2], v[p][3][i] * g0[3]);
            w.z = pk2(v[p][4][i] * g1[0], v[p][5][i] * g1[1]); w.w = pk2(v[p][6][i] * g1[2], v[p][7][i] * g1[3]);
            *(v4u*)(Wt + (size_t)(nrow0 + 4 * nq + i) * K + k0 + 32 * p + 8 * q) = w;
        }
    }
}
__device__ __forceinline__ void cvt_job(const float* W, int ldw, int srccol0, const float* g, bf16* Wt, int K, int nrow0, int NT, int r, int lane) {
    const int nt = r % NT, kt = r / NT;
    cvt_tile(W, ldw, srccol0 + 64 * nt, g, Wt, K, nrow0 + 64 * nt, 64 * kt, lane);
}
__device__ __forceinline__ void p0_weights(const Frame& F, const Params& P) {
    const int gw = F.vcu * NWAVES + F.wave, NGW = F.G * NWAVES, lane = F.lane;
    unsigned char* ws = P.ws;
    const float* w_in = P.in[3]; const float* g_mix = P.in[2]; const float* g_ffn = P.in[10]; const float* g_ple = P.in[15];
    constexpr int T0 = 64 * 96, T1 = 64 * 224, T2 = 32 * 64, T3 = 32 * 64, T4 = 64 * 64, T5 = 64 * 344, T6 = 172 * 64, T7 = 64 * 64, T8 = 4 * 64;
    constexpr int NITEMS = T0 + T1 + T2 + T3 + T4 + T5 + T6 + T7 + T8;
    for (int it = gw; it < NITEMS; it += NGW) {
        int r = it;
        if (r < T0) { cvt_job(w_in, NIN, 0, g_mix, (bf16*)(ws + WS_WIN), DM, 0, 96, r, lane); continue; } r -= T0;
        if (r < T1) { cvt_job(w_in, NIN, 6160, g_mix, (bf16*)(ws + WS_WIN), DM, 6144, 224, r, lane); continue; } r -= T1;
        if (r < T2) { cvt_job(P.in[7], DM, 0, nullptr, (bf16*)(ws + WS_WBF), WF, 0, 64, r, lane); continue; } r -= T2;
        if (r < T3) { cvt_job(P.in[8], DM, 0, nullptr, (bf16*)(ws + WS_WBS), WF, 0, 64, r, lane); continue; } r -= T3;
        if (r < T4) { cvt_job(P.in[9], DM, 0, nullptr, (bf16*)(ws + WS_WOUT), DM, 0, 64, r, lane); continue; } r -= T4;
        if (r < T5) { cvt_job(P.in[11], 2 * DFF, 0, g_ffn, (bf16*)(ws + WS_WUP), DM, 0, 344, r, lane); continue; } r -= T5;
        if (r < T6) { cvt_job(P.in[14], DM, 0, nullptr, (bf16*)(ws + WS_WDN), DFF, 0, 64, r, lane); continue; } r -= T6;
        if (r < T7) { cvt_job(P.in[16], DM, 0, g_ple, (bf16*)(ws + WS_WPG), DM, 0, 64, r, lane); continue; } r -= T7;
        cvt_job(P.in[17], DM, 0, nullptr, (bf16*)(ws + WS_WPP), PLE, 0, 64, r, lane);
    }
    const float* p = P.in[1]; bf16* pb = (bf16*)(ws + WS_PB);
    for (int i = blockIdx.x * 512 + F.tid; i < S * PLE / 8; i += F.G * 512) {
        const f32x4 a = *(const f32x4*)(p + (size_t)i * 8), b = *(const f32x4*)(p + (size_t)i * 8 + 4);
        v4u w; w.x = pk2(a[0], a[1]); w.y = pk2(a[2], a[3]); w.z = pk2(b[0], b[1]); w.w = pk2(b[2], b[3]);
        *(v4u*)(pb + (size_t)i * 8) = w;
    }
}
__device__ __forceinline__ void p0_rows(const Frame& F, const Params& P) {
    const float* x = P.in[0]; const float* g_mix = P.in[2]; const float* w_in = P.in[3]; const float* b_f = P.in[4];
    unsigned char* ws = P.ws;
    float* ss1 = (float*)(ws + WS_SS1); float* logf = (float*)(ws + WS_LOGF); bf16* xb = (bf16*)(ws + WS_XB);
    LAS float* fbuf = (LAS float*)(F.lds + RING_OFF);
    LAS float* rsb = (LAS float*)(F.lds + RING_OFF + 16384);
    const int lane = F.lane, wave = F.wave;
    for (int grp = blockIdx.x; grp < S / 32; grp += F.G) {
        const int r0 = grp * 32;
#pragma unroll 1
        for (int i = 0; i < 4; ++i) {
            const int row = r0 + 4 * wave + i;
            const f32x4* xr = (const f32x4*)(x + (size_t)row * DM) + lane;
            f32x4 v[16]; float s = 0.f;
#pragma unroll
            for (int j = 0; j < 16; ++j) { v[j] = xr[64 * j]; s += (v[j][0] * v[j][0] + v[j][1] * v[j][1]) + (v[j][2] * v[j][2] + v[j][3] * v[j][3]); }
            s = wave_sum(s);
            if (lane == 0) { ss1[row] = s; rsb[4 * wave + i] = rsqrtf(s * (1.0f / DM) + EPS); }
            v2u* xo = (v2u*)(xb + (size_t)row * DM) + lane;
#pragma unroll
            for (int j = 0; j < 16; ++j) { v2u w; w.x = pk2(v[j][0], v[j][1]); w.y = pk2(v[j][2], v[j][3]); xo[64 * j] = w; }
        }
        f32x16 acc = {};
        const int rl = lane & 31, kg = lane >> 5;
        const float* xa = x + (size_t)(r0 + rl) * DM + 512 * wave + 8 * kg;
        const float* wb = w_in + (size_t)(512 * wave + 8 * kg) * NIN + 6144 + (rl & 15);
        const float* gp = g_mix + 512 * wave + 8 * kg;
#pragma unroll 2
        for (int ks = 0; ks < 32; ++ks) {
            const f32x4 a0 = *(const f32x4*)(xa + 16 * ks), a1 = *(const f32x4*)(xa + 16 * ks + 4);
            v4u aw; aw.x = pk2(a0[0], a0[1]); aw.y = pk2(a0[2], a0[3]); aw.z = pk2(a1[0], a1[1]); aw.w = pk2(a1[2], a1[3]);
            v4u bw = (v4u){0u, 0u, 0u, 0u};
            if (rl < 16) {
                const f32x4 g0 = *(const f32x4*)(gp + 16 * ks), g1 = *(const f32x4*)(gp + 16 * ks + 4);
                float b[8];
#pragma unroll
                for (int t = 0; t < 8; ++t) b[t] = wb[(size_t)(16 * ks + t) * NIN];
                bw.x = pk2(b[0] * g0[0], b[1] * g0[1]); bw.y = pk2(b[2] * g0[2], b[3] * g0[3]); bw.z = pk2(b[4] * g1[0], b[5] * g1[1]); bw.w = pk2(b[6] * g1[2], b[7] * g1[3]);
            }
            acc = __builtin_amdgcn_mfma_f32_32x32x16_bf16(__builtin_bit_cast(bf16x8, aw), __builtin_bit_cast(bf16x8, bw), acc, 0, 0, 0);
        }
        if (rl < 16) {
#pragma unroll
            for (int r = 0; r < 16; ++r) { const int tok = (r & 3) + 8 * (r >> 2) + 4 * kg; fbuf[(wave * 32 + tok) * 16 + rl] = acc[r]; }
        }
        __syncthreads();
        {
            const int tok = F.tid >> 4, h = F.tid & 15; float f = 0.f;
#pragma unroll
            for (int w = 0; w < 8; ++w) f += fbuf[(w * 32 + tok) * 16 + h];
            f = f * rsb[tok] + b_f[h];
            logf[(size_t)h * S + r0 + tok] = log_sigmoidf_(f);
        }
        __syncthreads();
    }
}

__device__ __forceinline__ void p1b_qknorm_cumsum(const Frame& F, const Params& P) {
    unsigned char* ws = P.ws;
    bf16* qkv = (bf16*)(ws + WS_QKV);
    const float* gq = P.in[5]; const float* gk = P.in[6];
    const int gw = F.vcu * NWAVES + F.wave, NGW = F.G * NWAVES, lane = F.lane, sub = lane >> 4, l16 = lane & 15;
    constexpr int NIT = 2 * S * NH / 4;
    for (int it = gw; it < NIT; it += NGW) {
        const int item = it * 4 + sub;
        const int t = item / (S * NH);
        bf16* ptr = qkv + (size_t)t * ((size_t)S * WF) + (size_t)(item - t * (S * NH)) * HD + l16 * 8;
        const float* g = (t ? gk : gq) + l16 * 8;
        const v4u w = *(const v4u*)ptr;
        float v[8] = {bflo(w.x), bfhi(w.x), bflo(w.y), bfhi(w.y), bflo(w.z), bfhi(w.z), bflo(w.w), bfhi(w.w)};
        float s = 0.f;
#pragma unroll
        for (int j = 0; j < 8; ++j) s += v[j] * v[j];
        s += __shfl_xor(s, 1); s += __shfl_xor(s, 2); s += __shfl_xor(s, 4); s += __shfl_xor(s, 8);
        const float r = rsqrtf(s * (1.0f / HD) + EPS);
        const f32x4 g0 = *(const f32x4*)g, g1 = *(const f32x4*)(g + 4);
        v4u o; o.x = pk2(v[0] * r * g0[0], v[1] * r * g0[1]); o.y = pk2(v[2] * r * g0[2], v[3] * r * g0[3]); o.z = pk2(v[4] * r * g1[0], v[5] * r * g1[1]); o.w = pk2(v[6] * r * g1[2], v[7] * r * g1[3]);
        *(v4u*)ptr = o;
    }
    const float* logf = (const float*)(ws + WS_LOGF); float* cc = (float*)(ws + WS_C);
    LAS float* wtot = (LAS float*)(F.lds + RING_OFF);
    for (int h = blockIdx.x; h < NH; h += F.G) {
        const float* src = logf + (size_t)h * S + F.tid * 16;
        float loc[16]; float s = 0.f;
        const f32x4 a = *(const f32x4*)src, b = *(const f32x4*)(src + 4), c = *(const f32x4*)(src + 8), d = *(const f32x4*)(src + 12);
        const float in[16] = {a[0], a[1], a[2], a[3], b[0], b[1], b[2], b[3], c[0], c[1], c[2], c[3], d[0], d[1], d[2], d[3]};
#pragma unroll
        for (int j = 0; j < 16; ++j) { s += in[j]; loc[j] = s; }
        float incl = s;
#pragma unroll
        for (int o = 1; o < 64; o <<= 1) { const float t = __shfl_up(incl, o); if (lane >= o) incl += t; }
        if (lane == 63) wtot[F.wave] = incl;
        __syncthreads();
        float base = incl - s;
        for (int w = 0; w < F.wave; ++w) base += wtot[w];
        float* dst = cc + (size_t)h * S + F.tid * 16;
#pragma unroll
        for (int j = 0; j < 16; j += 4) *(f32x4*)(dst + j) = (f32x4){base + loc[j], base + loc[j + 1], base + loc[j + 2], base + loc[j + 3]};
        __syncthreads();
    }
}

__device__ __forceinline__ void p5b_convglu(const Frame& F, const Params& P) {
    unsigned char* ws = P.ws;
    const bf16* up = (const bf16*)(ws + WS_UP); bf16* act = (bf16*)(ws + WS_ACT);
    const float* cw = P.in[12]; const float* cb = P.in[13];
    const int gw = F.vcu * NWAVES + F.wave, NGW = F.G * NWAVES, lane = F.lane;
    constexpr int NCG = (DFF + 511) / 512, RB = 16, NITEMS = NCG * (S / RB);
    for (int it = gw; it < NITEMS; it += NGW) {
        const int cg = it % NCG, rb = it / NCG, j0 = cg * 512 + lane * 8, t0 = rb * RB;
        if (j0 >= DFF) continue;
        float wg[3][8], wv[3][8], bg[8], bv[8];
#pragma unroll
        for (int i = 0; i < 3; ++i) { const f32x4 a = *(const f32x4*)(cw + (size_t)i * 2 * DFF + j0), b = *(const f32x4*)(cw + (size_t)i * 2 * DFF + j0 + 4), c = *(const f32x4*)(cw + (size_t)i * 2 * DFF + DFF + j0), d = *(const f32x4*)(cw + (size_t)i * 2 * DFF + DFF + j0 + 4);
#pragma unroll
            for (int e = 0; e < 4; ++e) { wg[i][e] = a[e]; wg[i][4 + e] = b[e]; wv[i][e] = c[e]; wv[i][4 + e] = d[e]; } }
        { const f32x4 a = *(const f32x4*)(cb + j0), b = *(const f32x4*)(cb + j0 + 4), c = *(const f32x4*)(cb + DFF + j0), d = *(const f32x4*)(cb + DFF + j0 + 4);
#pragma unroll
          for (int e = 0; e < 4; ++e) { bg[e] = a[e]; bg[4 + e] = b[e]; bv[e] = c[e]; bv[4 + e] = d[e]; } }
        v4u g0 = (v4u){0u, 0u, 0u, 0u}, g1 = g0, v0 = g0, v1 = g0;
        if (t0 >= 2) { g0 = *(const v4u*)(up + (size_t)(t0 - 2) * 2 * DFF + j0); v0 = *(const v4u*)(up + (size_t)(t0 - 2) * 2 * DFF + DFF + j0);
                       g1 = *(const v4u*)(up + (size_t)(t0 - 1) * 2 * DFF + j0); v1 = *(const v4u*)(up + (size_t)(t0 - 1) * 2 * DFF + DFF + j0); }
#pragma unroll 4
        for (int r = 0; r < RB; ++r) {
            const int t = t0 + r;
            const v4u g2 = *(const v4u*)(up + (size_t)t * 2 * DFF + j0), v2 = *(const v4u*)(up + (size_t)t * 2 * DFF + DFF + j0);
            float o[8];
#pragma unroll
            for (int e = 0; e < 4; ++e) {
                const unsigned a0 = g0[e], a1 = g1[e], a2 = g2[e], c0 = v0[e], c1 = v1[e], c2 = v2[e];
                const float ugl = bg[2 * e] + wg[0][2 * e] * bflo(a0) + wg[1][2 * e] * bflo(a1) + wg[2][2 * e] * bflo(a2);
                const float ugh = bg[2 * e + 1] + wg[0][2 * e + 1] * bfhi(a0) + wg[1][2 * e + 1] * bfhi(a1) + wg[2][2 * e + 1] * bfhi(a2);
                const float uvl = bv[2 * e] + wv[0][2 * e] * bflo(c0) + wv[1][2 * e] * bflo(c1) + wv[2][2 * e] * bflo(c2);
                const float uvh = bv[2 * e + 1] + wv[0][2 * e + 1] * bfhi(c0) + wv[1][2 * e + 1] * bfhi(c1) + wv[2][2 * e + 1] * bfhi(c2);
                o[2 * e] = ugl * sigmoidf_(ugl) * uvl; o[2 * e + 1] = ugh * sigmoidf_(ugh) * uvh;
            }
            v4u w; w.x = pk2(o[0], o[1]); w.y = pk2(o[2], o[3]); w.z = pk2(o[4], o[5]); w.w = pk2(o[6], o[7]);
            *(v4u*)(act + (size_t)t * DFF + j0) = w;
            g0 = g1; g1 = g2; v0 = v1; v1 = v2;
        }
    }
}

enum { PH_P0 = 0, PH_P1, PH_P1B, PH_ATT, PH_P3A, PH_P3B, PH_P4, PH_P5, PH_P5B, PH_P6, PH_P7A, PH_P7, PH_N };
__global__ void __launch_bounds__(NWAVES * 64, 2) mega_fwd(Params P) {
    extern __shared__ __attribute__((aligned(16))) unsigned char lds[];
    Frame F;
    F.lds = (LAS unsigned char*)lds;
    F.MISC = (volatile LAS unsigned*)(F.lds + MISC_OFF);
    F.tid = threadIdx.x; F.lane = F.tid & 63; F.wave = __builtin_amdgcn_readfirstlane(F.tid >> 6);
    F.G = gridDim.x; { const int bx = blockIdx.x; F.vcu = (F.G % 8 == 0) ? (bx % 8) * (F.G / 8) + bx / 8 : bx; }
    unsigned char* ws = P.ws;
    F.ctl = (gu32*)(ws + WS_CTL);
    for (int u = F.tid; u < (LDS_BYTES - LDSCTL_OFF) / 4; u += NWAVES * 64) ((LAS unsigned*)(F.lds + LDSCTL_OFF))[u] = 0u;
    __syncthreads();
    XcdBarrier bar = xcd_barrier_post((unsigned*)(F.ctl + CW_BAR) + P.li * XCD_BAR_WORDS, F.MISC + 8);
    const int lo = P.ph_lo, hi = P.ph_hi;
#define IN(k) (lo <= (k) && (k) < hi)
#define SEAM(k) do { if (IN(k) && IN((k) + 1)) xcd_barrier(bar); } while (0)
    bf16* W_in = (bf16*)(ws + WS_WIN); bf16* XB = (bf16*)(ws + WS_XB);
    float* ss1 = (float*)(ws + WS_SS1); float* ss2 = (float*)(F.ctl + CW_SS2); float* ss3 = (float*)(F.ctl + CW_SS3);
    bf16* QKV = (bf16*)(ws + WS_QKV); bf16* GATES = (bf16*)(ws + WS_GATES); bf16* Y = (bf16*)(ws + WS_Y); bf16* MERGED = (bf16*)(ws + WS_MERGED);
    LAS unsigned char* ring = F.lds + RING_OFF;

    if (IN(PH_P0)) { p0_weights(F, P); p0_rows(F, P); }
    SEAM(PH_P0);
    if (IN(PH_P1)) {
        pg8::Gemm g{XB, W_in, S, NPROJ, DM}; pg8::StaticOrder So; So.init(S, NPROJ, F.G, (int)blockIdx.x);
        pg8::EpiProj E{QKV, GATES, ss1};
        pg8::gemm_phase<pg8::EpiProj, pg8::StaticOrder, true, true>(ring, g, So, E);
    }
    SEAM(PH_P1);
    if (IN(PH_P1B)) { p1b_qknorm_cumsum(F, P); }
    SEAM(PH_P1B);
    SEAM(PH_ATT);
    if (IN(PH_P3A)) {
        pg8::Gemm g{Y, (bf16*)(ws + WS_WBF), S, DM, WF}; pg8::StaticOrder So; So.init(S, DM, F.G, (int)blockIdx.x);
        pg8::EpiGateA E{P.out, GATES};
        pg8::gemm_phase<pg8::EpiGateA, pg8::StaticOrder, true, true>(ring, g, So, E);
    }
    SEAM(PH_P3A);
    if (IN(PH_P3B)) {
        pg8::Gemm g{Y + (size_t)S * WF, (bf16*)(ws + WS_WBS), S, DM, WF}; pg8::StaticOrder So; So.init(S, DM, F.G, (int)blockIdx.x);
        pg8::EpiGateB E{MERGED, P.out, GATES + (size_t)S * DM};
        pg8::gemm_phase<pg8::EpiGateB, pg8::StaticOrder, true, true>(ring, g, So, E);
    }
    SEAM(PH_P3B);
    if (IN(PH_P4)) {
        pg8::Gemm g{MERGED, (bf16*)(ws + WS_WOUT), S, DM, DM}; pg8::StaticOrder So; So.init(S, DM, F.G, (int)blockIdx.x);
        pg8::EpiResStat E{P.in[0], P.out, XB, ss2};
        pg8::gemm_phase<pg8::EpiResStat, pg8::StaticOrder, true, true>(ring, g, So, E);
    }
    SEAM(PH_P4);
    if (IN(PH_P5)) {
        pg8::Gemm g{XB, (bf16*)(ws + WS_WUP), S, 2 * DFF, DM}; pg8::StaticOrder So; So.init(S, 2 * DFF, F.G, (int)blockIdx.x);
        pg8::EpiUp E{(bf16*)(ws + WS_UP), 2 * DFF, ss2};
        pg8::gemm_phase<pg8::EpiUp, pg8::StaticOrder, true, true>(ring, g, So, E);
    }
    SEAM(PH_P5);
    if (IN(PH_P5B)) { p5b_convglu(F, P); }
    SEAM(PH_P5B);
    if (IN(PH_P6)) {
        pg8::Gemm g{(bf16*)(ws + WS_ACT), (bf16*)(ws + WS_WDN), S, DM, DFF}; pg8::StaticOrder So; So.init(S, DM, F.G, (int)blockIdx.x);
        pg8::EpiResStat E{P.out, P.out, XB, ss3};
        pg8::gemm_phase<pg8::EpiResStat, pg8::StaticOrder, true, true>(ring, g, So, E);
    }
    SEAM(PH_P6);
    if (IN(PH_P7A)) {
        pg8::Gemm g{(bf16*)(ws + WS_PB), (bf16*)(ws + WS_WPP), S, DM, PLE}; pg8::StaticOrder So; So.init(S, DM, F.G, (int)blockIdx.x);
        pg8::EpiStoreF32 E{(float*)(ws + WS_PP)};
        pg8::gemm_phase<pg8::EpiStoreF32, pg8::StaticOrder, true, true>(ring, g, So, E);
    }
    SEAM(PH_P7A);
    if (IN(PH_P7)) {
        pg8::Gemm g{XB, (bf16*)(ws + WS_WPG), S, DM, DM}; pg8::StaticOrder So; So.init(S, DM, F.G, (int)blockIdx.x);
        pg8::EpiPle E{P.out, (const float*)(ws + WS_PP), ss3};
        pg8::gemm_phase<pg8::EpiPle, pg8::StaticOrder, true, true>(ring, g, So, E);
    }
#undef IN
#undef SEAM
}

constexpr int ATT_LDS = (64 * 129 * 2 + 64 * 65) * 4;
__global__ __launch_bounds__(256) void k_fox(const bf16* __restrict__ Q, const bf16* __restrict__ Kt, const bf16* __restrict__ V, const float* __restrict__ c, bf16* __restrict__ y) {
    extern __shared__ float sm[];
    float* Qs = sm; float* Ks = sm + 64 * 129; float* Ss = sm + 2 * 64 * 129;
    const int qt = (gridDim.x - 1) - blockIdx.x, h = blockIdx.y, tid = threadIdx.x, ty = tid >> 4, tx = tid & 15;
    const int r0 = qt * 64;
    for (int i = tid; i < 64 * 128; i += 256) { const int r = i >> 7, d = i & 127; Qs[r * 129 + d] = bf2f(Q[(size_t)(r0 + r) * WF + h * HD + d]) * SCALE; }
    float m[4], l[4], cq[4], o[4][8];
#pragma unroll
    for (int i = 0; i < 4; ++i) { m[i] = -1e30f; l[i] = 0.f; cq[i] = c[(size_t)h * S + r0 + ty * 4 + i];
#pragma unroll
        for (int j = 0; j < 8; ++j) o[i][j] = 0.f; }
    for (int kt = 0; kt <= qt; ++kt) {
        const int k0 = kt * 64;
        __syncthreads();
        for (int i = tid; i < 64 * 128; i += 256) { const int r = i >> 7, d = i & 127; Ks[r * 129 + d] = bf2f(Kt[(size_t)(k0 + r) * WF + h * HD + d]); }
        __syncthreads();
        float s[4][4];
#pragma unroll
        for (int i = 0; i < 4; ++i)
#pragma unroll
            for (int j = 0; j < 4; ++j) s[i][j] = 0.f;
        for (int d = 0; d < 128; ++d) {
            float q[4], k[4];
#pragma unroll
            for (int i = 0; i < 4; ++i) { q[i] = Qs[(ty * 4 + i) * 129 + d]; k[i] = Ks[(tx * 4 + i) * 129 + d]; }
#pragma unroll
            for (int i = 0; i < 4; ++i)
#pragma unroll
                for (int j = 0; j < 4; ++j) s[i][j] = fmaf(q[i], k[j], s[i][j]);
        }
        float ck[4];
#pragma unroll
        for (int j = 0; j < 4; ++j) ck[j] = c[(size_t)h * S + k0 + tx * 4 + j];
        float alpha[4];
#pragma unroll
        for (int i = 0; i < 4; ++i) {
            const int row = r0 + ty * 4 + i;
            float mx = -1e30f;
#pragma unroll
            for (int j = 0; j < 4; ++j) { const int key = k0 + tx * 4 + j; s[i][j] = (key <= row) ? (s[i][j] + cq[i] - ck[j]) : -__builtin_inff(); mx = fmaxf(mx, s[i][j]); }
            for (int of = 8; of >= 1; of >>= 1) mx = fmaxf(mx, __shfl_xor(mx, of));
            const float mn = fmaxf(m[i], mx);
            alpha[i] = __expf(m[i] - mn); m[i] = mn;
            float ps = 0.f;
#pragma unroll
            for (int j = 0; j < 4; ++j) { const float p = __expf(s[i][j] - mn); ps += p; Ss[(ty * 4 + i) * 65 + tx * 4 + j] = p; }
            for (int of = 8; of >= 1; of >>= 1) ps += __shfl_xor(ps, of);
            l[i] = l[i] * alpha[i] + ps;
#pragma unroll
            for (int j = 0; j < 8; ++j) o[i][j] *= alpha[i];
        }
        __syncthreads();
        for (int k = 0; k < 64; ++k) {
            const v4u vw = *(const v4u*)(V + (size_t)(k0 + k) * WF + h * HD + tx * 8);
            const float vv[8] = {bflo(vw.x), bfhi(vw.x), bflo(vw.y), bfhi(vw.y), bflo(vw.z), bfhi(vw.z), bflo(vw.w), bfhi(vw.w)};
#pragma unroll
            for (int i = 0; i < 4; ++i) { const float p = Ss[(ty * 4 + i) * 65 + k];
#pragma unroll
                for (int j = 0; j < 8; ++j) o[i][j] = fmaf(p, vv[j], o[i][j]); }
        }
    }
#pragma unroll
    for (int i = 0; i < 4; ++i) { const float inv = 1.0f / l[i]; bf16* yp = y + (size_t)(r0 + ty * 4 + i) * WF + h * HD + tx * 8;
        v4u w; w.x = pk2(o[i][0] * inv, o[i][1] * inv); w.y = pk2(o[i][2] * inv, o[i][3] * inv); w.z = pk2(o[i][4] * inv, o[i][5] * inv); w.w = pk2(o[i][6] * inv, o[i][7] * inv);
        *(v4u*)yp = w; }
}
__global__ __launch_bounds__(256) void k_sb(const bf16* __restrict__ Q, const bf16* __restrict__ Kt, const bf16* __restrict__ V, bf16* __restrict__ y) {
    extern __shared__ float sm[];
    float* Qs = sm; float* Ks = sm + 64 * 129; float* Ss = sm + 2 * 64 * 129;
    __shared__ float Rs[64]; __shared__ int flag;
    const int qt = (gridDim.x - 1) - blockIdx.x, h = blockIdx.y, tid = threadIdx.x, ty = tid >> 4, tx = tid & 15;
    const int r0 = qt * 64;
    for (int i = tid; i < 64 * 128; i += 256) { const int r = i >> 7, d = i & 127; Qs[r * 129 + d] = bf2f(Q[(size_t)(r0 + r) * WF + h * HD + d]) * SCALE; }
    if (tid < 64) Rs[tid] = 0.f;
    float o[4][8];
#pragma unroll
    for (int i = 0; i < 4; ++i)
#pragma unroll
        for (int j = 0; j < 8; ++j) o[i][j] = 0.f;
    for (int kt = qt; kt >= 0; --kt) {
        const int k0 = kt * 64;
        __syncthreads();
        for (int i = tid; i < 64 * 128; i += 256) { const int r = i >> 7, d = i & 127; Ks[r * 129 + d] = bf2f(Kt[(size_t)(k0 + r) * WF + h * HD + d]); }
        if (tid == 0) flag = 1;
        __syncthreads();
        float z[4][4];
#pragma unroll
        for (int i = 0; i < 4; ++i)
#pragma unroll
            for (int j = 0; j < 4; ++j) z[i][j] = 0.f;
        for (int d = 0; d < 128; ++d) {
            float q[4], k[4];
#pragma unroll
            for (int i = 0; i < 4; ++i) { q[i] = Qs[(ty * 4 + i) * 129 + d]; k[i] = Ks[(tx * 4 + i) * 129 + d]; }
#pragma unroll
            for (int i = 0; i < 4; ++i)
#pragma unroll
                for (int j = 0; j < 4; ++j) z[i][j] = fmaf(q[i], k[j], z[i][j]);
        }
        float lom[4][4];
#pragma unroll
        for (int i = 0; i < 4; ++i)
#pragma unroll
            for (int j = 0; j < 4; ++j) { const int row = r0 + ty * 4 + i, key = k0 + tx * 4 + j; lom[i][j] = (key < row) ? -softplusf_(z[i][j]) : 0.f; Ss[(ty * 4 + i) * 65 + tx * 4 + j] = lom[i][j]; }
        __syncthreads();
        if (tid < 64) {
            float run = Rs[tid];
            for (int k = 63; k >= 0; --k) { const float t = Ss[tid * 65 + k]; Ss[tid * 65 + k] = run; run += t; }
            Rs[tid] = run;
            if (!(run < -105.f)) flag = 0;
        }
        __syncthreads();
#pragma unroll
        for (int i = 0; i < 4; ++i)
#pragma unroll
            for (int j = 0; j < 4; ++j) { const int row = r0 + ty * 4 + i, key = k0 + tx * 4 + j; const float tail = Ss[(ty * 4 + i) * 65 + tx * 4 + j];
                z[i][j] = (key < row) ? __expf(lom[i][j] + z[i][j] + tail) : 0.f; }
        const int stop = flag;
        __syncthreads();
#pragma unroll
        for (int i = 0; i < 4; ++i)
#pragma unroll
            for (int j = 0; j < 4; ++j) Ss[(ty * 4 + i) * 65 + tx * 4 + j] = z[i][j];
        __syncthreads();
        for (int k = 0; k < 64; ++k) {
            const v4u vw = *(const v4u*)(V + (size_t)(k0 + k) * WF + h * HD + tx * 8);
            const float vv[8] = {bflo(vw.x), bfhi(vw.x), bflo(vw.y), bfhi(vw.y), bflo(vw.z), bfhi(vw.z), bflo(vw.w), bfhi(vw.w)};
#pragma unroll
            for (int i = 0; i < 4; ++i) { const float p = Ss[(ty * 4 + i) * 65 + k];
#pragma unroll
                for (int j = 0; j < 8; ++j) o[i][j] = fmaf(p, vv[j], o[i][j]); }
        }
        if (stop) break;
    }
#pragma unroll
    for (int i = 0; i < 4; ++i) { bf16* yp = y + (size_t)(r0 + ty * 4 + i) * WF + h * HD + tx * 8;
        v4u w; w.x = pk2(o[i][0], o[i][1]); w.y = pk2(o[i][2], o[i][3]); w.z = pk2(o[i][4], o[i][5]); w.w = pk2(o[i][6], o[i][7]);
        *(v4u*)yp = w; }
}

extern "C" void kernel_launch(void* const* d_in, const int* in_sizes, int n_in, void* d_out, int out_size, void* d_ws, size_t ws_size, hipStream_t stream) {
    static int grid = 0;
    if (grid == 0) {
        if (n_in != 18 || out_size != S * DM || ws_size < WS_END) { fprintf(stderr, "kernel_launch: unexpected shapes / workspace (%d inputs, out %d, ws %zu < %zu)\n", n_in, out_size, ws_size, (size_t)WS_END); grid = -1; return; }
        int dev = 0, cus = 0, per_cu = 0;
        if (hipGetDevice(&dev) != hipSuccess || hipDeviceGetAttribute(&cus, hipDeviceAttributeMultiprocessorCount, dev) != hipSuccess) { grid = -1; return; }
        if (hipFuncSetAttribute((const void*)mega_fwd, hipFuncAttributeMaxDynamicSharedMemorySize, LDS_BYTES) != hipSuccess) { fprintf(stderr, "kernel_launch: hipFuncSetAttribute failed\n"); grid = -1; return; }
        (void)hipFuncSetAttribute((const void*)k_fox, hipFuncAttributeMaxDynamicSharedMemorySize, ATT_LDS);
        (void)hipFuncSetAttribute((const void*)k_sb, hipFuncAttributeMaxDynamicSharedMemorySize, ATT_LDS);
        if (hipOccupancyMaxActiveBlocksPerMultiprocessor(&per_cu, (const void*)mega_fwd, NWAVES * 64, LDS_BYTES) != hipSuccess || per_cu < 1)
            fprintf(stderr, "kernel_launch: note: occupancy query reports %d workgroups per CU\n", per_cu);
        (void)hipGetLastError();
        grid = cus;
    }
    if (grid < 0) return;
    if (hipMemsetAsync((char*)d_ws + WS_CTL, 0, CTL_ZERO_BYTES, stream) != hipSuccess) return;
    Params a{};
    for (int i = 0; i < 18; ++i) a.in[i] = (const float*)d_in[i];
    a.out = (float*)d_out; a.ws = (unsigned char*)d_ws;
    unsigned char* ws = (unsigned char*)d_ws;
    bf16* QKV = (bf16*)(ws + WS_QKV); bf16* Y = (bf16*)(ws + WS_Y); const size_t T = (size_t)S * WF;
    a.ph_lo = PH_P0; a.ph_hi = PH_ATT; a.li = 0;
    hipLaunchKernelGGL(mega_fwd, dim3(grid), dim3(NWAVES * 64), LDS_BYTES, stream, a);
    hipLaunchKernelGGL(k_fox, dim3(S / 64, NH), dim3(256), ATT_LDS, stream, (const bf16*)QKV, (const bf16*)(QKV + T), (const bf16*)(QKV + 2 * T), (const float*)(ws + WS_C), Y);
    hipLaunchKernelGGL(k_sb, dim3(S / 64, NH), dim3(256), ATT_LDS, stream, (const bf16*)(QKV + 3 * T), (const bf16*)(QKV + 4 * T), (const bf16*)(QKV + 5 * T), Y + T);
    a.ph_lo = PH_P3A; a.ph_hi = PH_N; a.li = 1;
    hipLaunchKernelGGL(mega_fwd, dim3(grid), dim3(NWAVES * 64), LDS_BYTES, stream, a);
}
```

```cpp
#include <hip/hip_runtime.h>
#include <cstdio>
#include <cstdint>
__device__ __forceinline__ int lane_id() { int l = (int)__builtin_amdgcn_mbcnt_hi(~0u, __builtin_amdgcn_mbcnt_lo(~0u, 0u)); asm volatile("" : "+v"(l)); return l; }
#define TID() (WAVE_ * 64 + lane_id())
namespace pg8 {
#define PG8_LAS __attribute__((address_space(3)))
typedef unsigned short bf16_t;
typedef short bf16x8 __attribute__((ext_vector_type(8)));
typedef float f32x4 __attribute__((ext_vector_type(4)));
typedef unsigned u32x4 __attribute__((ext_vector_type(4)));
constexpr int BM = 256, BK = 64, HALF = 128, HTB = HALF * BK * 2  , STAGE_BYTES = 8 * HTB, NXCD = 8, WGM = 8;

__host__ __device__ __forceinline__ int lds_byte(int r, int c) { const int st = (r >> 4) * 2 + (c >> 5), rr = r & 15, cc = c & 31, ob = rr * 64 + cc * 2; return st * 1024 + (ob ^ (((ob >> 9) & 1) << 5)); }
__host__ __device__ __forceinline__ void stage_rc(int b, int& R, int& C) { const int st = b / 1024, sb = b % 1024, swz = sb ^ (((sb >> 9) & 1) << 5); R = (st >> 1) * 16 + swz / 64; C = (st & 1) * 32 + (swz % 64) / 2; }
__host__ __device__ __forceinline__ int perm32(int rho) { const int n = rho >> 4, i = rho & 15; return 8 * (i >> 2) + 4 * n + (i & 3); }

struct Unit { int pm, pn; };
struct Gemm { const bf16_t* A; const bf16_t* Bt; int M, N, K; };

struct StaticOrder {
    int nM, nN, nwg, G, c;
    __host__ __device__ void init(int M, int N, int G_, int c_) { nM = M / BM; nN = N / BM; nwg = nM * nN; G = G_; c = c_; }
    __host__ __device__ bool next(int i, Unit& u) const {
        const long L = (long)i * G + c; if (L >= nwg) return false;
        int wgid = (int)L; { const int q = nwg / NXCD, r = nwg % NXCD, xcd = wgid % NXCD, off = wgid / NXCD; wgid = (xcd < r ? xcd * (q + 1) : r * (q + 1) + (xcd - r) * q) + off; }
        const int nig = WGM * nN, gid = wgid / nig, fm = gid * WGM, gsz = (nM - fm) < WGM ? (nM - fm) : WGM;
        u.pm = fm + ((wgid % nig) % gsz); u.pn = (wgid % nig) / gsz; return true;
    }
    __device__ __forceinline__ void a_ready(const Unit&) const {}
    __device__ __forceinline__ void done(const Unit&) const {}
};

__device__ __forceinline__ unsigned cvt_pk_bf16(float lo, float hi) { unsigned r; asm volatile("v_cvt_pk_bf16_f32 %0, %1, %2" : "=v"(r) : "v"(lo), "v"(hi)); return r; }
typedef float f32x2 __attribute__((ext_vector_type(2)));
constexpr int SEQ_ = 8192, DM_ = 4096;
constexpr float EPS_ = 1e-6f;
__device__ __forceinline__ float sigm(float v) { return __builtin_amdgcn_rcpf(1.0f + __builtin_amdgcn_exp2f(-1.4426950408889634f * v)); }
__device__ __forceinline__ float rs_of(float ss) { return __builtin_amdgcn_rsqf(ss * (1.0f / DM_) + EPS_); }
typedef unsigned u32x2 __attribute__((ext_vector_type(2)));
__device__ __forceinline__ f32x4 bf4_to_f32(u32x2 w) { return (f32x4){__uint_as_float(w.x << 16), __uint_as_float(w.x & 0xffff0000u), __uint_as_float(w.y << 16), __uint_as_float(w.y & 0xffff0000u)}; }

struct EpiProj {
    static constexpr bool PERM = true, AFTER_DRAIN = false;
    bf16_t* qkv; bf16_t* gates; const float* ss;
    __device__ __forceinline__ void operator()(const f32x4 (&acc)[2][2][4][2], const Unit& u, int wr, int wc, int fr, int fq) const {
        const int row0 = u.pm * BM + wr * 64 + fr;
        bf16_t* base; int ldc, colt; const bool gate = u.pn >= 48;
        if (!gate) { base = qkv + (size_t)(u.pn >> 3) * ((size_t)SEQ_ * 2048); ldc = 2048; colt = (u.pn & 7) * 256; }
        else { const int t = u.pn - 48; base = gates + (size_t)(t >> 4) * ((size_t)SEQ_ * 4096); ldc = 4096; colt = (t & 15) * 256; }
        const int col0 = colt + wc * 32 + 8 * fq;
#pragma unroll
        for (int ai = 0; ai < 2; ++ai)
#pragma unroll
            for (int m = 0; m < 4; ++m) { const int r = row0 + ai * HALF + m * 16; const float rs = rs_of(ss[r]); bf16_t* rowp = base + (size_t)r * ldc + col0;
#pragma unroll
                for (int bj = 0; bj < 2; ++bj) { f32x4 v0 = acc[ai][bj][m][0] * rs, v1 = acc[ai][bj][m][1] * rs;
                    if (gate) {
#pragma unroll
                        for (int j = 0; j < 4; ++j) { v0[j] = sigm(v0[j]); v1[j] = sigm(v1[j]); } }
                    u32x4 w; w.x = cvt_pk_bf16(v0[0], v0[1]); w.y = cvt_pk_bf16(v0[2], v0[3]); w.z = cvt_pk_bf16(v1[0], v1[1]); w.w = cvt_pk_bf16(v1[2], v1[3]);
                    *(u32x4*)(rowp + bj * HALF) = w; } }
    }
};
struct EpiGateA {
    static constexpr bool PERM = false, AFTER_DRAIN = false;
    float* tmp; const bf16_t* sg;
    __device__ __forceinline__ void operator()(const f32x4 (&acc)[2][2][4][2], const Unit& u, int wr, int wc, int fr, int fq) const {
        const int row0 = u.pm * BM + wr * 64 + fr, col0 = u.pn * BM + wc * 32 + 4 * fq;
#pragma unroll
        for (int ai = 0; ai < 2; ++ai)
#pragma unroll
            for (int m = 0; m < 4; ++m) { const size_t off = (size_t)(row0 + ai * HALF + m * 16) * DM_ + col0;
#pragma unroll
                for (int bj = 0; bj < 2; ++bj)
#pragma unroll
                    for (int n = 0; n < 2; ++n) { const f32x4 g = bf4_to_f32(*(const u32x2*)(sg + off + bj * HALF + n * 16)); *(f32x4*)(tmp + off + bj * HALF + n * 16) = acc[ai][bj][m][n] * g; }
                asm volatile("" ::: "memory"); }
    }
};
struct EpiGateB {
    static constexpr bool PERM = true, AFTER_DRAIN = false;
    bf16_t* merged; const float* tmp; const bf16_t* sg;
    __device__ __forceinline__ void operator()(const f32x4 (&acc)[2][2][4][2], const Unit& u, int wr, int wc, int fr, int fq) const {
        const int row0 = u.pm * BM + wr * 64 + fr, col0 = u.pn * BM + wc * 32 + 8 * fq;
#pragma unroll
        for (int ai = 0; ai < 2; ++ai)
#pragma unroll
            for (int m = 0; m < 4; ++m) { const size_t off = (size_t)(row0 + ai * HALF + m * 16) * DM_ + col0;
#pragma unroll
                for (int bj = 0; bj < 2; ++bj) { const u32x4 gw = *(const u32x4*)(sg + off + bj * HALF); const f32x4 t0 = *(const f32x4*)(tmp + off + bj * HALF), t1 = *(const f32x4*)(tmp + off + bj * HALF + 4);
                    const f32x4 g0 = bf4_to_f32((u32x2){gw.x, gw.y}), g1 = bf4_to_f32((u32x2){gw.z, gw.w});
                    const f32x4 v0 = t0 + acc[ai][bj][m][0] * g0, v1 = t1 + acc[ai][bj][m][1] * g1;
                    u32x4 w; w.x = cvt_pk_bf16(v0[0], v0[1]); w.y = cvt_pk_bf16(v0[2], v0[3]); w.z = cvt_pk_bf16(v1[0], v1[1]); w.w = cvt_pk_bf16(v1[2], v1[3]);
                    *(u32x4*)(merged + off + bj * HALF) = w; }
                asm volatile("" ::: "memory"); }
    }
};
struct EpiResStat {
    static constexpr bool PERM = false, AFTER_DRAIN = false;
    const float* base; float* out; bf16_t* xb; float* ss;
    __device__ __forceinline__ void operator()(const f32x4 (&acc)[2][2][4][2], const Unit& u, int wr, int wc, int fr, int fq) const {
        const int row0 = u.pm * BM + wr * 64 + fr, col0 = u.pn * BM + wc * 32 + 4 * fq;
#pragma unroll
        for (int ai = 0; ai < 2; ++ai)
#pragma unroll
            for (int m = 0; m < 4; ++m) { const int r = row0 + ai * HALF + m * 16; const size_t off = (size_t)r * DM_ + col0; float s = 0.f;
#pragma unroll
                for (int bj = 0; bj < 2; ++bj)
#pragma unroll
                    for (int n = 0; n < 2; ++n) { const f32x4 b = *(const f32x4*)(base + off + bj * HALF + n * 16); const f32x4 o = b + acc[ai][bj][m][n];
                        *(f32x4*)(out + off + bj * HALF + n * 16) = o; s += (o[0] * o[0] + o[1] * o[1]) + (o[2] * o[2] + o[3] * o[3]);
                        u32x2 w; w.x = cvt_pk_bf16(o[0], o[1]); w.y = cvt_pk_bf16(o[2], o[3]); *(u32x2*)(xb + off + bj * HALF + n * 16) = w; }
                s += __shfl_xor(s, 16); s += __shfl_xor(s, 32);
                if (fq == 0) __hip_atomic_fetch_add(ss + r, s, __ATOMIC_RELAXED, __HIP_MEMORY_SCOPE_AGENT);
                asm volatile("" ::: "memory"); }
    }
};
struct EpiUp {
    static constexpr bool PERM = true, AFTER_DRAIN = false;
    bf16_t* O; int ldc; const float* ss;
    __device__ __forceinline__ void operator()(const f32x4 (&acc)[2][2][4][2], const Unit& u, int wr, int wc, int fr, int fq) const {
        const int row0 = u.pm * BM + wr * 64 + fr, col0 = u.pn * BM + wc * 32 + 8 * fq;
#pragma unroll
        for (int ai = 0; ai < 2; ++ai)
#pragma unroll
            for (int m = 0; m < 4; ++m) { const int r = row0 + ai * HALF + m * 16; const float rs = rs_of(ss[r]); bf16_t* rowp = O + (size_t)r * ldc + col0;
#pragma unroll
                for (int bj = 0; bj < 2; ++bj) { const f32x4 v0 = acc[ai][bj][m][0] * rs, v1 = acc[ai][bj][m][1] * rs;
                    u32x4 w; w.x = cvt_pk_bf16(v0[0], v0[1]); w.y = cvt_pk_bf16(v0[2], v0[3]); w.z = cvt_pk_bf16(v1[0], v1[1]); w.w = cvt_pk_bf16(v1[2], v1[3]);
                    *(u32x4*)(rowp + bj * HALF) = w; } }
    }
};
struct EpiStoreF32 {
    static constexpr bool PERM = false, AFTER_DRAIN = false;
    float* C;
    __device__ __forceinline__ void operator()(const f32x4 (&acc)[2][2][4][2], const Unit& u, int wr, int wc, int fr, int fq) const {
        const int row0 = u.pm * BM + wr * 64 + fr, col0 = u.pn * BM + wc * 32 + 4 * fq;
#pragma unroll
        for (int ai = 0; ai < 2; ++ai)
#pragma unroll
            for (int m = 0; m < 4; ++m) { float* rowp = C + (size_t)(row0 + ai * HALF + m * 16) * DM_ + col0;
#pragma unroll
                for (int bj = 0; bj < 2; ++bj)
#pragma unroll
                    for (int n = 0; n < 2; ++n) *(f32x4*)(rowp + bj * HALF + n * 16) = acc[ai][bj][m][n]; }
    }
};
struct EpiPle {
    static constexpr bool PERM = false, AFTER_DRAIN = false;
    float* out; const float* pp; const float* ss;
    __device__ __forceinline__ void operator()(const f32x4 (&acc)[2][2][4][2], const Unit& u, int wr, int wc, int fr, int fq) const {
        const int row0 = u.pm * BM + wr * 64 + fr, col0 = u.pn * BM + wc * 32 + 4 * fq;
#pragma unroll
        for (int ai = 0; ai < 2; ++ai)
#pragma unroll
            for (int m = 0; m < 4; ++m) { const int r = row0 + ai * HALF + m * 16; const size_t off = (size_t)r * DM_ + col0; const float rs = rs_of(ss[r]);
#pragma unroll
                for (int bj = 0; bj < 2; ++bj)
#pragma unroll
                    for (int n = 0; n < 2; ++n) { const f32x4 b = *(const f32x4*)(out + off + bj * HALF + n * 16), q = *(const f32x4*)(pp + off + bj * HALF + n * 16); const f32x4 a = acc[ai][bj][m][n] * rs;
                        f32x4 o; o[0] = b[0] + sigm(a[0]) * q[0]; o[1] = b[1] + sigm(a[1]) * q[1]; o[2] = b[2] + sigm(a[2]) * q[2]; o[3] = b[3] + sigm(a[3]) * q[3];
                        *(f32x4*)(out + off + bj * HALF + n * 16) = o; }
                asm volatile("" ::: "memory"); }
    }
};
template <class Epi, class Sched, bool ALIGN_EPI = false, bool SP2 = false>
__device__ __forceinline__ void gemm_phase(PG8_LAS unsigned char* lds, const Gemm g, const Sched& S, const Epi& E, const int WAVE_) {
    const int tid = TID(), wid = __builtin_amdgcn_readfirstlane(tid >> 6), lane = tid & 63, wr = wid >> 2, wc = wid & 3, fr = lane & 15, fq = lane >> 4;
    const int K = g.K, nt = K / BK;
    unsigned voffA[2], voffB[2];
#pragma unroll
    for (int i = 0; i < 2; ++i) { int R, C; stage_rc(tid * 16 + i * 8192, R, C); const int Rb = Epi::PERM ? ((R & ~31) + perm32(R & 31)) : R;
        voffA[i] = (unsigned)(R * K + C) * 2u; voffB[i] = (unsigned)(Rb * K + C) * 2u; }
    const size_t kstep = (size_t)(BK * 2);
    const size_t hstep = (size_t)HALF * K * 2;
    const size_t tstep = 2 * hstep;
    const unsigned ldsw = (unsigned)wid * 1024u;
    const int aoff = lds_byte(wr * 64 + fr, fq * 8), boff = lds_byte(wc * 32 + fr, fq * 8);
#define PG8_SA(b, h) (((b) * 2 + (h)) * HTB)
#define PG8_SB(b, h) ((4 + (b) * 2 + (h)) * HTB)
#define PG8_STAGE(bufoff, gbase, voff) do { _Pragma("unroll") for (int _i = 0; _i < 2; ++_i) \
        __builtin_amdgcn_global_load_lds((const unsigned*)((const char*)(gbase) + (voff)[_i]), (PG8_LAS unsigned*)(lds + (bufoff) + ldsw + _i * 8192), 16, 0, 0); } while (0)
#define PG8_LDA(dst, b, h) do { _Pragma("unroll") for (int m = 0; m < 4; ++m) _Pragma("unroll") for (int k = 0; k < 2; ++k) dst[m][k] = *(const PG8_LAS bf16x8*)(lds + PG8_SA(b, h) + aoff + m * 2048 + k * 1024); } while (0)
#define PG8_LDB(dst, b, h) do { _Pragma("unroll") for (int n = 0; n < 2; ++n) _Pragma("unroll") for (int k = 0; k < 2; ++k) dst[n][k] = *(const PG8_LAS bf16x8*)(lds + PG8_SB(b, h) + boff + n * 2048 + k * 1024); } while (0)
#define PG8_MMA(ai, bj, At, Bt) do { __builtin_amdgcn_s_setprio(1); _Pragma("unroll") for (int m = 0; m < 4; ++m) _Pragma("unroll") for (int n = 0; n < 2; ++n) _Pragma("unroll") for (int k = 0; k < 2; ++k) \
        acc[ai][bj][m][n] = __builtin_amdgcn_mfma_f32_16x16x32_bf16(Bt[n][k], At[m][k], acc[ai][bj][m][n], 0, 0, 0); __builtin_amdgcn_s_setprio(0); } while (0)
#define PG8_WAIT_V(n) asm volatile("s_waitcnt vmcnt(" #n ")" ::: "memory")
#define PG8_WAIT_L(n) asm volatile("s_waitcnt lgkmcnt(" #n ")" ::: "memory")
#define PG8_BAR __builtin_amdgcn_s_barrier()
#define PG8_SCHED __builtin_amdgcn_sched_barrier(0)
    Unit cur, nxt; int ui = 0;
    if (!S.next(0, cur)) return;
    f32x4 acc[2][2][4][2];
#pragma unroll
    for (int a = 0; a < 2; ++a)
#pragma unroll
        for (int b = 0; b < 2; ++b)
#pragma unroll
            for (int m = 0; m < 4; ++m)
#pragma unroll
                for (int n = 0; n < 2; ++n) acc[a][b][m][n] = (f32x4){0.f, 0.f, 0.f, 0.f};
    bf16x8 At[4][2], B0[2][2], B1[2][2];
    const char* cA = (const char*)g.A + (size_t)cur.pm * tstep; const char* cB = (const char*)g.Bt + (size_t)cur.pn * tstep;
    S.a_ready(cur);
    if constexpr (SP2) {
        PG8_STAGE(PG8_SB(0, 0), cB, voffB); PG8_STAGE(PG8_SB(0, 1), cB + hstep, voffB); PG8_STAGE(PG8_SA(0, 0), cA, voffA); PG8_STAGE(PG8_SA(0, 1), cA + hstep, voffA);
        if (wr == 1) PG8_BAR;
        PG8_WAIT_V(2); PG8_BAR;
        PG8_STAGE(PG8_SB(1, 0), cB + kstep, voffB); PG8_STAGE(PG8_SA(1, 0), cA + kstep, voffA); PG8_STAGE(PG8_SB(1, 1), cB + hstep + kstep, voffB);
        PG8_WAIT_V(6); PG8_BAR;
    } else {
        PG8_STAGE(PG8_SB(0, 0), cB, voffB); PG8_STAGE(PG8_SA(0, 0), cA, voffA); PG8_STAGE(PG8_SB(0, 1), cB + hstep, voffB); PG8_STAGE(PG8_SA(0, 1), cA + hstep, voffA);
        if (wr == 1) PG8_BAR;
        PG8_WAIT_V(4); PG8_BAR;
        PG8_STAGE(PG8_SB(1, 0), cB + kstep, voffB); PG8_STAGE(PG8_SA(1, 0), cA + kstep, voffA); PG8_STAGE(PG8_SB(1, 1), cB + hstep + kstep, voffB);
        PG8_WAIT_V(6); PG8_BAR;
    }
    for (;;) {
        const bool has_next = S.next(ui + 1, nxt);
        const char* nA = has_next ? (const char*)g.A + (size_t)nxt.pm * tstep : cA; const char* nB = has_next ? (const char*)g.Bt + (size_t)nxt.pn * tstep : cB;
        for (int t = 0; t < nt; t += 2) {
            const bool last = (t == nt - 2);
            const char* a1 = cA + (size_t)(t + 1) * kstep;
            const char* a2 = last ? nA : cA + (size_t)(t + 2) * kstep; const char* b2 = last ? nB : cB + (size_t)(t + 2) * kstep;
            const char* a3 = a2 + kstep; const char* b3 = b2 + kstep;
            if (last && has_next) S.a_ready(nxt);
            if constexpr (SP2) {
            PG8_LDB(B0, 0, 0); PG8_LDB(B1, 0, 1); PG8_SCHED; PG8_LDA(At, 0, 0); PG8_STAGE(PG8_SA(1, 1), a1 + hstep, voffA);
            PG8_WAIT_V(8); PG8_WAIT_L(0); PG8_BAR; PG8_MMA(0, 0, At, B0); PG8_MMA(0, 1, At, B1); PG8_BAR; PG8_SCHED;
            PG8_LDA(At, 0, 1); PG8_STAGE(PG8_SB(0, 0), b2, voffB); PG8_STAGE(PG8_SB(0, 1), b2 + hstep, voffB); PG8_STAGE(PG8_SA(0, 0), a2, voffA);
            PG8_WAIT_V(8); PG8_WAIT_L(0); PG8_BAR; PG8_MMA(1, 0, At, B0); PG8_MMA(1, 1, At, B1); PG8_BAR; PG8_SCHED;
            PG8_LDB(B0, 1, 0); PG8_LDB(B1, 1, 1); PG8_SCHED; PG8_LDA(At, 1, 0); PG8_STAGE(PG8_SA(0, 1), a2 + hstep, voffA);
            PG8_WAIT_V(8); PG8_WAIT_L(0); PG8_BAR; PG8_MMA(0, 0, At, B0); PG8_MMA(0, 1, At, B1); PG8_BAR; PG8_SCHED;
            PG8_LDA(At, 1, 1); PG8_STAGE(PG8_SB(1, 0), b3, voffB); PG8_STAGE(PG8_SB(1, 1), b3 + hstep, voffB); PG8_STAGE(PG8_SA(1, 0), a3, voffA);
            PG8_WAIT_V(8); PG8_WAIT_L(0); PG8_BAR; PG8_MMA(1, 0, At, B0); PG8_MMA(1, 1, At, B1); PG8_BAR; PG8_SCHED;
            } else {
            PG8_LDB(B0, 0, 0); PG8_SCHED; PG8_LDA(At, 0, 0); PG8_STAGE(PG8_SA(1, 1), a1 + hstep, voffA);
            PG8_WAIT_L(8); PG8_BAR; PG8_WAIT_L(0); PG8_MMA(0, 0, At, B0); PG8_BAR; PG8_SCHED;
            PG8_LDB(B1, 0, 1); PG8_STAGE(PG8_SB(0, 0), b2, voffB);
            PG8_BAR; PG8_WAIT_L(0); PG8_MMA(0, 1, At, B1); PG8_BAR;
            PG8_LDA(At, 0, 1); PG8_STAGE(PG8_SA(0, 0), a2, voffA);
            PG8_BAR; PG8_WAIT_L(0); PG8_MMA(1, 0, At, B0); PG8_BAR; PG8_SCHED;
            PG8_STAGE(PG8_SB(0, 1), b2 + hstep, voffB);
            PG8_WAIT_V(6); PG8_BAR; PG8_MMA(1, 1, At, B1); PG8_BAR;
            PG8_LDB(B0, 1, 0); PG8_SCHED; PG8_LDA(At, 1, 0); PG8_STAGE(PG8_SA(0, 1), a2 + hstep, voffA);
            PG8_WAIT_L(8); PG8_BAR; PG8_WAIT_L(0); PG8_MMA(0, 0, At, B0); PG8_BAR; PG8_SCHED;
            PG8_LDB(B1, 1, 1); PG8_STAGE(PG8_SB(1, 0), b3, voffB);
            PG8_BAR; PG8_WAIT_L(0); PG8_MMA(0, 1, At, B1); PG8_BAR;
            PG8_LDA(At, 1, 1); PG8_STAGE(PG8_SA(1, 0), a3, voffA);
            PG8_BAR; PG8_WAIT_L(0); PG8_MMA(1, 0, At, B0); PG8_BAR; PG8_SCHED;
            PG8_STAGE(PG8_SB(1, 1), b3 + hstep, voffB);
            PG8_WAIT_V(6); PG8_BAR; PG8_MMA(1, 1, At, B1); PG8_BAR;
            }
        }
        if constexpr (ALIGN_EPI) { if (wr == 0) PG8_BAR; }
        if constexpr (!Epi::AFTER_DRAIN) { E(acc, cur, wr, wc, fr, fq); S.done(cur); }
        if (!has_next) break;
#pragma unroll
        for (int a = 0; a < 2; ++a)
#pragma unroll
            for (int b = 0; b < 2; ++b)
#pragma unroll
                for (int m = 0; m < 4; ++m)
#pragma unroll
                    for (int n = 0; n < 2; ++n) acc[a][b][m][n] = (f32x4){0.f, 0.f, 0.f, 0.f};
        cur = nxt; cA = nA; cB = nB; ++ui;
        if constexpr (ALIGN_EPI) { if (wr == 1) PG8_BAR; }
    }
    PG8_WAIT_V(0);
    if constexpr (!ALIGN_EPI) { if (wr == 0) PG8_BAR; }
    PG8_BAR;
    if constexpr (Epi::AFTER_DRAIN) { E.fused(acc, cur, wr, wc, fr, fq, lds, wid, lane); S.done(cur); }
#undef PG8_SA
#undef PG8_SB
#undef PG8_STAGE
#undef PG8_LDA
#undef PG8_LDB
#undef PG8_MMA
#undef PG8_WAIT_V
#undef PG8_WAIT_L
#undef PG8_BAR
#undef PG8_SCHED
}
}
constexpr int NWAVES = 8;
constexpr int S = 8192, DM = 4096, HD = 128, NH = 16, WF = 2048, DFF = 11008, PLE = 256, NIN = 20496, NPROJ = 20480;
constexpr float EPS = 1e-6f;
constexpr float SCALE = 0.08838834764831845f;
constexpr size_t MiB = 1u << 20;
constexpr size_t WS_CTL = 0, CTL_ZERO_BYTES = 1 * MiB;
constexpr size_t WS_SS1 = 1 * MiB;
constexpr size_t WS_LOGF = WS_SS1 + 64 * 1024;
constexpr size_t WS_C = WS_LOGF + 512 * 1024;
constexpr size_t WS_WIN = 4 * MiB;
constexpr size_t WS_WBF = WS_WIN + 160 * MiB;
constexpr size_t WS_WBS = WS_WBF + 16 * MiB;
constexpr size_t WS_WOUT = WS_WBS + 16 * MiB;
constexpr size_t WS_WUP = WS_WOUT + 32 * MiB;
constexpr size_t WS_WDN = WS_WUP + 172 * MiB;
constexpr size_t WS_WPG = WS_WDN + 86 * MiB;
constexpr size_t WS_WPP = WS_WPG + 32 * MiB;
constexpr size_t WS_XB = WS_WPP + 2 * MiB;
constexpr size_t WS_PB = WS_XB + 64 * MiB;
constexpr size_t WS_QKV = WS_PB + 4 * MiB;
constexpr size_t WS_GATES = WS_QKV + 192 * MiB;
constexpr size_t WS_Y = WS_GATES + 128 * MiB;
constexpr size_t WS_UP = WS_QKV;
constexpr size_t WS_MERGED = WS_Y + 64 * MiB;
constexpr size_t WS_ACT = WS_MERGED + 64 * MiB;
constexpr size_t WS_PP = WS_QKV;
constexpr size_t WS_END = WS_ACT + 172 * MiB;
static_assert(WS_UP + (size_t)S * 2 * DFF * 2 <= WS_MERGED, "up overlay");
constexpr int CW_BAR = 4096;
constexpr int CW_SS2 = 32768, CW_SS3 = 32768 + 8192;
constexpr int N_BAR_REGIONS = 4;
constexpr int RING_OFF = 0, RING_BYTES = 131072;
constexpr int LDSCTL_OFF = RING_BYTES, MISC_OFF = LDSCTL_OFF + 320;
constexpr int LDS_BYTES = 147456;

#define GAS __attribute__((address_space(1)))
#define LAS __attribute__((address_space(3)))
typedef unsigned short bf16;
typedef unsigned v4u __attribute__((ext_vector_type(4)));
typedef unsigned v2u __attribute__((ext_vector_type(2)));
typedef float f32x4 __attribute__((ext_vector_type(4)));
typedef float f32x16 __attribute__((ext_vector_type(16)));
typedef short bf16x8 __attribute__((ext_vector_type(8)));
typedef GAS unsigned gu32;
#define RLX_AGENT __ATOMIC_RELAXED, __HIP_MEMORY_SCOPE_AGENT
#define LDS_WAIT() asm volatile("s_waitcnt lgkmcnt(0)" ::: "memory")
#define VM_WAIT() asm volatile("s_waitcnt vmcnt(0)" ::: "memory")
__device__ __forceinline__ unsigned pk2(float lo, float hi) { unsigned r; asm volatile("v_cvt_pk_bf16_f32 %0, %1, %2" : "=v"(r) : "v"(lo), "v"(hi)); return r; }
__device__ __forceinline__ float bf2f(bf16 b) { return __uint_as_float(((unsigned)b) << 16); }
__device__ __forceinline__ float bflo(unsigned w) { return __uint_as_float(w << 16); }
__device__ __forceinline__ float bfhi(unsigned w) { return __uint_as_float(w & 0xffff0000u); }
__device__ __forceinline__ float sigmoidf_(float v) { return 1.0f / (1.0f + __expf(-v)); }
__device__ __forceinline__ float log_sigmoidf_(float v) { return fminf(v, 0.f) - log1pf(__expf(-fabsf(v))); }
__device__ __forceinline__ float softplusf_(float v) { return fmaxf(v, 0.f) + log1pf(__expf(-fabsf(v))); }
__device__ __forceinline__ float wave_sum(float v) {
#pragma unroll
    for (int o = 1; o < 64; o <<= 1) v += __shfl_xor(v, o);
    return v;
}

#define XB_TMO      128
#define XB_XCNT(j)  (256  + 64 * (j))
#define XB_XSUB(j)  (1280 + 64 * (j))
#define XB_XGEN(j)  (2304 + 64 * (j))
#define XB_TOP      3328
#define XB_TOPGEN   3392
#define XCD_BAR_WORDS 3456
#define XB_SPIN_CAP (1u << 18)

__device__ __forceinline__ unsigned xb_ld(unsigned* p)              { return __hip_atomic_load(p, __ATOMIC_RELAXED, __HIP_MEMORY_SCOPE_AGENT); }
__device__ __forceinline__ unsigned xb_add(unsigned* p, unsigned v) { return __hip_atomic_fetch_add(p, v, __ATOMIC_RELAXED, __HIP_MEMORY_SCOPE_AGENT); }
__device__ __forceinline__ unsigned xb_xcc_id() { return (unsigned)__builtin_amdgcn_s_getreg((3 << 11) | 20) & 0xFu; }
#define XB_SPIN(cond, bar) do { unsigned _sp = 0; while (cond) { __builtin_amdgcn_s_sleep(1); \
    if ((++_sp & 255u) == 0u) { if (xb_ld(&(bar)[XB_TMO])) break; if (_sp > XB_SPIN_CAP) { atomicAdd(&(bar)[XB_TMO], 1u); break; } } } } while (0)

struct XcdBarrier {
    unsigned* bar; unsigned x; int wave;
    volatile LAS unsigned* st;
};

__device__ __forceinline__ XcdBarrier xcd_barrier_post(unsigned* bar, volatile LAS unsigned* st, const int WAVE_) {
    XcdBarrier b; b.wave = WAVE_; b.bar = bar; b.x = xb_xcc_id(); b.st = st;
    if (TID() == 0) (void)xb_add(&bar[XB_XCNT(b.x)], 1u);
    return b;
}
__device__ __forceinline__ void xcd_barrier_complete(unsigned* bar, unsigned x, unsigned& nloc, unsigned& nx) {
    const unsigned G = gridDim.x * gridDim.y * gridDim.z;
    unsigned sum, cnt, mine, sp = 0u;
    for (;;) {
        sum = 0u; cnt = 0u; mine = 0u;
#pragma unroll
        for (unsigned j = 0; j < 16; ++j) { const unsigned c = xb_ld(&bar[XB_XCNT(j)]); sum += c; cnt += (c > 0u) ? 1u : 0u; mine = (j == x) ? c : mine; }
        if (sum == G) break;
        __builtin_amdgcn_s_sleep(1);
        if ((++sp & 255u) == 0u) { if (xb_ld(&bar[XB_TMO])) break; if (sp > XB_SPIN_CAP) { atomicAdd(&bar[XB_TMO], 1u); break; } }
    }
    nloc = mine > 0u ? mine : 1u; nx = cnt > 0u ? cnt : 1u;
}

__device__ __forceinline__ void xcd_barrier(const XcdBarrier& b) {
    const int WAVE_ = b.wave;
    asm volatile("s_waitcnt vmcnt(0)" ::: "memory");
    __syncthreads();
    if (TID() == 0) {
        unsigned* bar = b.bar;
        __builtin_amdgcn_s_waitcnt(0);
        unsigned nloc = b.st[0], nx = b.st[1];
        if (nloc == 0u) { xcd_barrier_complete(bar, b.x, nloc, nx); b.st[0] = nloc; b.st[1] = nx; }
        const unsigned old = xb_add(&bar[XB_XSUB(b.x)], 1u);
        const unsigned gen = old / nloc;
        if (old + 1u == (gen + 1u) * nloc) {
            __builtin_amdgcn_fence(__ATOMIC_RELEASE, "agent");
            asm volatile("s_waitcnt vmcnt(0)" ::: "memory");
            const unsigned og = xb_add(&bar[XB_TOP], 1u);
            const unsigned tg = og / nx;
            if (og + 1u == (tg + 1u) * nx) xb_add(&bar[XB_TOPGEN], 1u);
            else XB_SPIN(xb_ld(&bar[XB_TOPGEN]) == tg, bar);
            __builtin_amdgcn_fence(__ATOMIC_ACQUIRE, "agent");
            xb_add(&bar[XB_XGEN(b.x)], 1u);
            asm volatile("s_waitcnt vmcnt(0)" ::: "memory");
        } else {
            XB_SPIN(xb_ld(&bar[XB_XGEN(b.x)]) == gen, bar);
            __builtin_amdgcn_fence(__ATOMIC_ACQUIRE, "agent");
            asm volatile("s_waitcnt vmcnt(0)" ::: "memory");
        }
    }
    __syncthreads();
}


struct Params {
    const float* in[18]; float* out; unsigned char* ws;
    int ph_lo, ph_hi, li, pad;
};
struct Frame {
    LAS unsigned char* lds; volatile LAS unsigned* MISC; gu32* ctl;
    int wave, vcu, G;
};

__device__ __forceinline__ void cvt_tile(const float* __restrict__ W, int ldw, int srccol0, const float* __restrict__ g, bf16* __restrict__ Wt, int K, int nrow0, int k0, int lane) {
    const int nq = lane & 15, q = lane >> 4;
    const float* src = W + (size_t)(k0 + 8 * q) * ldw + srccol0 + 4 * nq;
    f32x4 v[2][8];
#pragma unroll
    for (int p = 0; p < 2; ++p)
#pragma unroll
        for (int t = 0; t < 8; ++t) v[p][t] = __builtin_nontemporal_load((const f32x4*)(src + (size_t)(32 * p + t) * ldw));
#pragma unroll
    for (int p = 0; p < 2; ++p) {
        f32x4 g0 = (f32x4){1.f, 1.f, 1.f, 1.f}, g1 = g0;
        if (g) { g0 = *(const f32x4*)(g + k0 + 32 * p + 8 * q); g1 = *(const f32x4*)(g + k0 + 32 * p + 8 * q + 4); }
#pragma unroll
        for (int i = 0; i < 4; ++i) {
            v4u w; w.x = pk2(v[p][0][i] * g0[0], v[p][1][i] * g0[1]); w.y = pk2(v[p][2][i] * g0[2], v[p][3][i] * g0[3]);
            w.z = pk2(v[p][4][i] * g1[0], v[p][5][i] * g1[1]); w.w = pk2(v[p][6][i] * g1[2], v[p][7][i] * g1[3]);
            *(v4u*)(Wt + (size_t)(nrow0 + 4 * nq + i) * K + k0 + 32 * p + 8 * q) = w;
        }
    }
}
__device__ __forceinline__ void cvt_job(const float* W, int ldw, int srccol0, const float* g, bf16* Wt, int K, int nrow0, int NT, int r, int lane) {
    const int nt = r % NT, kt = r / NT;
    cvt_tile(W, ldw, srccol0 + 64 * nt, g, Wt, K, nrow0 + 64 * nt, 64 * kt, lane);
}
__device__ __forceinline__ void p0_weights(const Frame& F, const Params& P) {
    const int WAVE_ = F.wave; const int f_lane = lane_id(), f_tid = TID();
    const int gw = F.vcu * NWAVES + F.wave, NGW = F.G * NWAVES, lane = f_lane;
    unsigned char* ws = P.ws;
    const float* w_in = P.in[3]; const float* g_mix = P.in[2]; const float* g_ffn = P.in[10]; const float* g_ple = P.in[15];
    constexpr int T0 = 64 * 96, T1 = 64 * 224, T2 = 32 * 64, T3 = 32 * 64, T4 = 64 * 64, T5 = 64 * 344, T6 = 172 * 64, T7 = 64 * 64, T8 = 4 * 64;
    constexpr int NITEMS = T0 + T1 + T2 + T3 + T4 + T5 + T6 + T7 + T8;
    for (int it = gw; it < NITEMS; it += NGW) {
        int r = it;
        if (r < T0) { cvt_job(w_in, NIN, 0, g_mix, (bf16*)(ws + WS_WIN), DM, 0, 96, r, lane); continue; } r -= T0;
        if (r < T1) { cvt_job(w_in, NIN, 6160, g_mix, (bf16*)(ws + WS_WIN), DM, 6144, 224, r, lane); continue; } r -= T1;
        if (r < T2) { cvt_job(P.in[7], DM, 0, nullptr, (bf16*)(ws + WS_WBF), WF, 0, 64, r, lane); continue; } r -= T2;
        if (r < T3) { cvt_job(P.in[8], DM, 0, nullptr, (bf16*)(ws + WS_WBS), WF, 0, 64, r, lane); continue; } r -= T3;
        if (r < T4) { cvt_job(P.in[9], DM, 0, nullptr, (bf16*)(ws + WS_WOUT), DM, 0, 64, r, lane); continue; } r -= T4;
        if (r < T5) { cvt_job(P.in[11], 2 * DFF, 0, g_ffn, (bf16*)(ws + WS_WUP), DM, 0, 344, r, lane); continue; } r -= T5;
        if (r < T6) { cvt_job(P.in[14], DM, 0, nullptr, (bf16*)(ws + WS_WDN), DFF, 0, 64, r, lane); continue; } r -= T6;
        if (r < T7) { cvt_job(P.in[16], DM, 0, g_ple, (bf16*)(ws + WS_WPG), DM, 0, 64, r, lane); continue; } r -= T7;
        cvt_job(P.in[17], DM, 0, nullptr, (bf16*)(ws + WS_WPP), PLE, 0, 64, r, lane);
    }
    const float* p = P.in[1]; bf16* pb = (bf16*)(ws + WS_PB);
    for (int i = blockIdx.x * 512 + f_tid; i < S * PLE / 8; i += F.G * 512) {
        const f32x4 a = *(const f32x4*)(p + (size_t)i * 8), b = *(const f32x4*)(p + (size_t)i * 8 + 4);
        v4u w; w.x = pk2(a[0], a[1]); w.y = pk2(a[2], a[3]); w.z = pk2(b[0], b[1]); w.w = pk2(b[2], b[3]);
        *(v4u*)(pb + (size_t)i * 8) = w;
    }
}
__device__ __forceinline__ void p0_rows(const Frame& F, const Params& P) {
    const int WAVE_ = F.wave; const int f_lane = lane_id(), f_tid = TID();
    const float* x = P.in[0]; const float* g_mix = P.in[2]; const float* w_in = P.in[3]; const float* b_f = P.in[4];
    unsigned char* ws = P.ws;
    float* ss1 = (float*)(ws + WS_SS1); float* logf = (float*)(ws + WS_LOGF); bf16* xb = (bf16*)(ws + WS_XB);
    LAS float* fbuf = (LAS float*)(F.lds + RING_OFF);
    LAS float* rsb = (LAS float*)(F.lds + RING_OFF + 16384);
    const int lane = f_lane, wave = F.wave;
    for (int grp = blockIdx.x; grp < S / 32; grp += F.G) {
        const int r0 = grp * 32;
#pragma unroll 1
        for (int i = 0; i < 4; ++i) {
            const int row = r0 + 4 * wave + i;
            const f32x4* xr = (const f32x4*)(x + (size_t)row * DM) + lane;
            f32x4 v[16]; float s = 0.f;
#pragma unroll
            for (int j = 0; j < 16; ++j) { v[j] = xr[64 * j]; s += (v[j][0] * v[j][0] + v[j][1] * v[j][1]) + (v[j][2] * v[j][2] + v[j][3] * v[j][3]); }
            s = wave_sum(s);
            if (lane == 0) { ss1[row] = s; rsb[4 * wave + i] = rsqrtf(s * (1.0f / DM) + EPS); }
            v2u* xo = (v2u*)(xb + (size_t)row * DM) + lane;
#pragma unroll
            for (int j = 0; j < 16; ++j) { v2u w; w.x = pk2(v[j][0], v[j][1]); w.y = pk2(v[j][2], v[j][3]); xo[64 * j] = w; }
        }
        f32x16 acc = {};
        const int rl = lane & 31, kg = lane >> 5;
        const float* xa = x + (size_t)(r0 + rl) * DM + 512 * wave + 8 * kg;
        const float* wb = w_in + (size_t)(512 * wave + 8 * kg) * NIN + 6144 + (rl & 15);
        const float* gp = g_mix + 512 * wave + 8 * kg;
#pragma unroll 2
        for (int ks = 0; ks < 32; ++ks) {
            const f32x4 a0 = *(const f32x4*)(xa + 16 * ks), a1 = *(const f32x4*)(xa + 16 * ks + 4);
            v4u aw; aw.x = pk2(a0[0], a0[1]); aw.y = pk2(a0[2], a0[3]); aw.z = pk2(a1[0], a1[1]); aw.w = pk2(a1[2], a1[3]);
            v4u bw = (v4u){0u, 0u, 0u, 0u};
            if (rl < 16) {
                const f32x4 g0 = *(const f32x4*)(gp + 16 * ks), g1 = *(const f32x4*)(gp + 16 * ks + 4);
                float b[8];
#pragma unroll
                for (int t = 0; t < 8; ++t) b[t] = wb[(size_t)(16 * ks + t) * NIN];
                bw.x = pk2(b[0] * g0[0], b[1] * g0[1]); bw.y = pk2(b[2] * g0[2], b[3] * g0[3]); bw.z = pk2(b[4] * g1[0], b[5] * g1[1]); bw.w = pk2(b[6] * g1[2], b[7] * g1[3]);
            }
            acc = __builtin_amdgcn_mfma_f32_32x32x16_bf16(__builtin_bit_cast(bf16x8, aw), __builtin_bit_cast(bf16x8, bw), acc, 0, 0, 0);
        }
        if (rl < 16) {
#pragma unroll
            for (int r = 0; r < 16; ++r) { const int tok = (r & 3) + 8 * (r >> 2) + 4 * kg; fbuf[(wave * 32 + tok) * 16 + rl] = acc[r]; }
        }
        __syncthreads();
        {
            const int tok = f_tid >> 4, h = f_tid & 15; float f = 0.f;
#pragma unroll
            for (int w = 0; w < 8; ++w) f += fbuf[(w * 32 + tok) * 16 + h];
            f = f * rsb[tok] + b_f[h];
            logf[(size_t)h * S + r0 + tok] = log_sigmoidf_(f);
        }
        __syncthreads();
    }
}

__device__ __forceinline__ void p1b_qknorm_cumsum(const Frame& F, const Params& P) {
    const int WAVE_ = F.wave; const int f_lane = lane_id(), f_tid = TID();
    unsigned char* ws = P.ws;
    bf16* qkv = (bf16*)(ws + WS_QKV);
    const float* gq = P.in[5]; const float* gk = P.in[6];
    const int gw = F.vcu * NWAVES + F.wave, NGW = F.G * NWAVES, lane = f_lane, sub = lane >> 4, l16 = lane & 15;
    constexpr int NIT = 2 * S * NH / 4;
    for (int it = gw; it < NIT; it += NGW) {
        const int item = it * 4 + sub;
        const int t = item / (S * NH);
        bf16* ptr = qkv + (size_t)t * ((size_t)S * WF) + (size_t)(item - t * (S * NH)) * HD + l16 * 8;
        const float* g = (t ? gk : gq) + l16 * 8;
        const v4u w = *(const v4u*)ptr;
        float v[8] = {bflo(w.x), bfhi(w.x), bflo(w.y), bfhi(w.y), bflo(w.z), bfhi(w.z), bflo(w.w), bfhi(w.w)};
        float s = 0.f;
#pragma unroll
        for (int j = 0; j < 8; ++j) s += v[j] * v[j];
        s += __shfl_xor(s, 1); s += __shfl_xor(s, 2); s += __shfl_xor(s, 4); s += __shfl_xor(s, 8);
        const float r = rsqrtf(s * (1.0f / HD) + EPS);
        const f32x4 g0 = *(const f32x4*)g, g1 = *(const f32x4*)(g + 4);
        v4u o; o.x = pk2(v[0] * r * g0[0], v[1] * r * g0[1]); o.y = pk2(v[2] * r * g0[2], v[3] * r * g0[3]); o.z = pk2(v[4] * r * g1[0], v[5] * r * g1[1]); o.w = pk2(v[6] * r * g1[2], v[7] * r * g1[3]);
        *(v4u*)ptr = o;
    }
    const float* logf = (const float*)(ws + WS_LOGF); float* cc = (float*)(ws + WS_C);
    LAS float* wtot = (LAS float*)(F.lds + RING_OFF);
    for (int h = blockIdx.x; h < NH; h += F.G) {
        const float* src = logf + (size_t)h * S + f_tid * 16;
        float loc[16]; float s = 0.f;
        const f32x4 a = *(const f32x4*)src, b = *(const f32x4*)(src + 4), c = *(const f32x4*)(src + 8), d = *(const f32x4*)(src + 12);
        const float in[16] = {a[0], a[1], a[2], a[3], b[0], b[1], b[2], b[3], c[0], c[1], c[2], c[3], d[0], d[1], d[2], d[3]};
#pragma unroll
        for (int j = 0; j < 16; ++j) { s += in[j]; loc[j] = s; }
        float incl = s;
#pragma unroll
        for (int o = 1; o < 64; o <<= 1) { const float t = __shfl_up(incl, o); if (lane >= o) incl += t; }
        if (lane == 63) wtot[F.wave] = incl;
        __syncthreads();
        float base = incl - s;
        for (int w = 0; w < F.wave; ++w) base += wtot[w];
        float* dst = cc + (size_t)h * S + f_tid * 16;
#pragma unroll
        for (int j = 0; j < 16; j += 4) *(f32x4*)(dst + j) = (f32x4){base + loc[j], base + loc[j + 1], base + loc[j + 2], base + loc[j + 3]} * (1.0f / SCALE);
        __syncthreads();
    }
}

__device__ __forceinline__ void p5b_convglu(const Frame& F, const Params& P) {
    const int WAVE_ = F.wave; const int f_lane = lane_id(), f_tid = TID();
    unsigned char* ws = P.ws;
    const bf16* up = (const bf16*)(ws + WS_UP); bf16* act = (bf16*)(ws + WS_ACT);
    const float* cw = P.in[12]; const float* cb = P.in[13];
    const int gw = F.vcu * NWAVES + F.wave, NGW = F.G * NWAVES, lane = f_lane;
    constexpr int NCG = (DFF + 511) / 512, RB = 16, NITEMS = NCG * (S / RB);
    for (int it = gw; it < NITEMS; it += NGW) {
        const int cg = it % NCG, rb = it / NCG, j0 = cg * 512 + lane * 8, t0 = rb * RB;
        if (j0 >= DFF) continue;
        float wg[3][8], wv[3][8], bg[8], bv[8];
#pragma unroll
        for (int i = 0; i < 3; ++i) { const f32x4 a = *(const f32x4*)(cw + (size_t)i * 2 * DFF + j0), b = *(const f32x4*)(cw + (size_t)i * 2 * DFF + j0 + 4), c = *(const f32x4*)(cw + (size_t)i * 2 * DFF + DFF + j0), d = *(const f32x4*)(cw + (size_t)i * 2 * DFF + DFF + j0 + 4);
#pragma unroll
            for (int e = 0; e < 4; ++e) { wg[i][e] = a[e]; wg[i][4 + e] = b[e]; wv[i][e] = c[e]; wv[i][4 + e] = d[e]; } }
        { const f32x4 a = *(const f32x4*)(cb + j0), b = *(const f32x4*)(cb + j0 + 4), c = *(const f32x4*)(cb + DFF + j0), d = *(const f32x4*)(cb + DFF + j0 + 4);
#pragma unroll
          for (int e = 0; e < 4; ++e) { bg[e] = a[e]; bg[4 + e] = b[e]; bv[e] = c[e]; bv[4 + e] = d[e]; } }
        v4u g0 = (v4u){0u, 0u, 0u, 0u}, g1 = g0, v0 = g0, v1 = g0;
        if (t0 >= 2) { g0 = *(const v4u*)(up + (size_t)(t0 - 2) * 2 * DFF + j0); v0 = *(const v4u*)(up + (size_t)(t0 - 2) * 2 * DFF + DFF + j0);
                       g1 = *(const v4u*)(up + (size_t)(t0 - 1) * 2 * DFF + j0); v1 = *(const v4u*)(up + (size_t)(t0 - 1) * 2 * DFF + DFF + j0); }
#pragma unroll 4
        for (int r = 0; r < RB; ++r) {
            const int t = t0 + r;
            const v4u g2 = *(const v4u*)(up + (size_t)t * 2 * DFF + j0), v2 = *(const v4u*)(up + (size_t)t * 2 * DFF + DFF + j0);
            float o[8];
#pragma unroll
            for (int e = 0; e < 4; ++e) {
                const unsigned a0 = g0[e], a1 = g1[e], a2 = g2[e], c0 = v0[e], c1 = v1[e], c2 = v2[e];
                const float ugl = bg[2 * e] + wg[0][2 * e] * bflo(a0) + wg[1][2 * e] * bflo(a1) + wg[2][2 * e] * bflo(a2);
                const float ugh = bg[2 * e + 1] + wg[0][2 * e + 1] * bfhi(a0) + wg[1][2 * e + 1] * bfhi(a1) + wg[2][2 * e + 1] * bfhi(a2);
                const float uvl = bv[2 * e] + wv[0][2 * e] * bflo(c0) + wv[1][2 * e] * bflo(c1) + wv[2][2 * e] * bflo(c2);
                const float uvh = bv[2 * e + 1] + wv[0][2 * e + 1] * bfhi(c0) + wv[1][2 * e + 1] * bfhi(c1) + wv[2][2 * e + 1] * bfhi(c2);
                o[2 * e] = ugl * sigmoidf_(ugl) * uvl; o[2 * e + 1] = ugh * sigmoidf_(ugh) * uvh;
            }
            v4u w; w.x = pk2(o[0], o[1]); w.y = pk2(o[2], o[3]); w.z = pk2(o[4], o[5]); w.w = pk2(o[6], o[7]);
            *(v4u*)(act + (size_t)t * DFF + j0) = w;
            g0 = g1; g1 = g2; v0 = v1; v1 = v2;
        }
    }
}

namespace att {
constexpr int D = 128, PITCH = 2048, NW = 8, QBLK = 32, KVBLK = 64, QB = NW * QBLK;
constexpr int SHM_V = KVBLK * D * 2, SHM_K = KVBLK * D * 2;
constexpr int OFF_WS = 2 * SHM_V + 2 * SHM_K, OFF_KB = OFF_WS + NW * 64 * 4, OFF_FLAG = OFF_KB + 2 * 64 * 4, ATT_LDS_BYTES = OFF_FLAG + 64;
constexpr float SCALE = 0.08838834764831845f;
constexpr float THR = 8.f;
typedef short s16x4 __attribute__((ext_vector_type(4)));
typedef unsigned u32x4 __attribute__((ext_vector_type(4)));
#define KSWZ(row, colB) ((row) * 256 + ((colB) ^ (((row) & 7) << 4)))
#define SBAR() __builtin_amdgcn_sched_barrier(0)
__device__ __forceinline__ int v_st(int k, int c) { const int kk = (k & ~0xC) | ((k & 4) << 1) | ((k & 8) >> 1); return ((kk >> 3) * 4 + (c >> 5)) * 512 + ((kk & 7) * 32 + (c & 31)) * 2; }
__device__ __forceinline__ int v_rd_base(int lane) { return ((lane & 3) << 3) | (((lane >> 2) & 3) << 6) | (((lane >> 4) & 1) << 5) | (((lane >> 5) & 1) << 8); }
constexpr int v_rd_off(int d0, int ks, int half) { return d0 * 512 + ks * 4096 + half * 2048; }
__device__ __forceinline__ int crow(int r, int hi) { return (r & 3) + 8 * (r >> 2) + 4 * hi; }
__device__ __forceinline__ unsigned cvtpk(float lo, float hi) { unsigned r; asm volatile("v_cvt_pk_bf16_f32 %0, %1, %2" : "=v"(r) : "v"(lo), "v"(hi)); return r; }
__device__ __forceinline__ bf16x8 load8(const bf16* p) { return *reinterpret_cast<const bf16x8*>(p); }
__device__ __forceinline__ void mask_tile(f32x16& p0, f32x16& p1, int dq) {
    const float NEG = -__builtin_inff();
#pragma unroll
    for (int r = 0; r < 16; ++r) { const int c = (r & 3) + 8 * (r >> 2); if (dq - c < 0) p0[r] = NEG; if (dq - c - 32 < 0) p1[r] = NEG; }
}
__device__ __forceinline__ void partialSM(f32x16& p0, f32x16& p1, float& m_reg, float& mn, float& alpha) {
    float pmax = p0[0]; for (int r = 1; r < 16; ++r) pmax = fmaxf(pmax, p0[r]); for (int r = 0; r < 16; ++r) pmax = fmaxf(pmax, p1[r]);
    { auto rr = __builtin_amdgcn_permlane32_swap(__float_as_uint(pmax), __float_as_uint(pmax), false, false);
      pmax = fmaxf(__uint_as_float(rr[0]), __uint_as_float(rr[1])); }
    constexpr float C2 = 1.4426950408889634f * SCALE;
    if (__builtin_expect(__all((pmax - m_reg) * SCALE <= THR), 1)) { mn = m_reg; alpha = 1.f; }
    else { mn = fmaxf(m_reg, pmax); alpha = __builtin_amdgcn_exp2f((m_reg - mn) * C2); m_reg = mn; }
    const float mnL = -mn * C2;
    for (int r = 0; r < 16; ++r) p0[r] = fmaf(p0[r], C2, mnL); for (int r = 0; r < 16; ++r) p1[r] = fmaf(p1[r], C2, mnL);
    for (int r = 0; r < 16; ++r) p0[r] = __builtin_amdgcn_exp2f(p0[r]);
}
#define PK4(P, B_, OUT) do { unsigned a0 = cvtpk(P[B_+0], P[B_+1]), a1 = cvtpk(P[B_+2], P[B_+3]);                          \
        unsigned b0 = cvtpk(P[B_+4], P[B_+5]), b1 = cvtpk(P[B_+6], P[B_+7]);                                             \
        auto r0 = __builtin_amdgcn_permlane32_swap(a0, b0, false, false); auto r1 = __builtin_amdgcn_permlane32_swap(a1, b1, false, false); \
        u32x4 w = {r0[0], r1[0], r0[1], r1[1]}; OUT = *reinterpret_cast<bf16x8*>(&w); } while (0)
__device__ __forceinline__ void finishSM(f32x16& p0, f32x16& p1, float alpha, float& l_reg, bf16x8& pa0, bf16x8& pa1, bf16x8& pa2, bf16x8& pa3) {
    for (int r = 0; r < 16; ++r) p1[r] = __builtin_amdgcn_exp2f(p1[r]);
    float ps = 0; for (int r = 0; r < 16; ++r) ps += p0[r]; for (int r = 0; r < 16; ++r) ps += p1[r];
    { auto rr = __builtin_amdgcn_permlane32_swap(__float_as_uint(ps), __float_as_uint(ps), false, false);
      ps = __uint_as_float(rr[0]) + __uint_as_float(rr[1]); }
    l_reg = l_reg * alpha + ps;
    PK4(p0, 0, pa0); PK4(p0, 8, pa1); PK4(p1, 0, pa2); PK4(p1, 8, pa3);
}
template <int KB>
__device__ __forceinline__ void qkt(f32x16& p0, f32x16& p1, const char* K_lds, int r32, int hi, const bf16x8* qr) {
    p0 = f32x16{}; p1 = f32x16{};
    const char* kb[4];
#pragma unroll
    for (int dd = 0; dd < 4; ++dd) kb[dd] = K_lds + KB * SHM_K + KSWZ(r32, (dd * 16 + hi * 8) * 2);
#pragma unroll
    for (int d0 = 0; d0 < 8; ++d0) { const char* a = kb[d0 & 3] + (d0 >> 2) * 128;
        bf16x8 b0 = *reinterpret_cast<const bf16x8*>(a);
        bf16x8 b1 = *reinterpret_cast<const bf16x8*>(a + 32 * 256);
        p0 = __builtin_amdgcn_mfma_f32_32x32x16_bf16(b0, qr[d0], p0, 0, 0, 0);
        p1 = __builtin_amdgcn_mfma_f32_32x32x16_bf16(b1, qr[d0], p1, 0, 0, 0); }
}
template <int VB>
__device__ __forceinline__ void pv_tile(f32x16* o, int vb0, bf16x8 pa0, bf16x8 pa1, bf16x8 pa2, bf16x8 pa3) {
#define TRRD(dst, off) asm volatile("ds_read_b64_tr_b16 %0, %1 offset:%2" : "=&v"(dst) : "v"(vb0), "i"(off) : "memory")
#define PV_D0(d0) do { s16x4 l0, l1, l2, l3, h0, h1, h2, h3; constexpr int b_ = VB * SHM_V + v_rd_off(d0, 0, 0); \
        TRRD(l0, b_); TRRD(h0, b_ + 2048); TRRD(l1, b_ + 4096); TRRD(h1, b_ + 6144); TRRD(l2, b_ + 8192); TRRD(h2, b_ + 10240); TRRD(l3, b_ + 12288); TRRD(h3, b_ + 14336); \
        asm volatile("s_waitcnt lgkmcnt(0)" ::: "memory"); SBAR();   \
        o[d0] = __builtin_amdgcn_mfma_f32_32x32x16_bf16(pa0, (bf16x8){l0[0], l0[1], l0[2], l0[3], h0[0], h0[1], h0[2], h0[3]}, o[d0], 0, 0, 0);   \
        o[d0] = __builtin_amdgcn_mfma_f32_32x32x16_bf16(pa1, (bf16x8){l1[0], l1[1], l1[2], l1[3], h1[0], h1[1], h1[2], h1[3]}, o[d0], 0, 0, 0);   \
        o[d0] = __builtin_amdgcn_mfma_f32_32x32x16_bf16(pa2, (bf16x8){l2[0], l2[1], l2[2], l2[3], h2[0], h2[1], h2[2], h2[3]}, o[d0], 0, 0, 0);   \
        o[d0] = __builtin_amdgcn_mfma_f32_32x32x16_bf16(pa3, (bf16x8){l3[0], l3[1], l3[2], l3[3], h3[0], h3[1], h3[2], h3[3]}, o[d0], 0, 0, 0); } while (0)
    PV_D0(0); PV_D0(1); PV_D0(2); PV_D0(3);
#undef PV_D0
#undef TRRD
}
template <int KB>
__device__ __forceinline__ void key_bias(f32x16& p0, f32x16& p1, const char* lds, int hi) {
    const float* kbp = (const float*)(lds + OFF_KB) + KB * 64 + 4 * hi;
#pragma unroll
    for (int g = 0; g < 4; ++g) { const f32x4 b0 = *(const f32x4*)(kbp + 8 * g), b1 = *(const f32x4*)(kbp + 32 + 8 * g);
#pragma unroll
        for (int e = 0; e < 4; ++e) { p0[4 * g + e] -= b0[e]; p1[4 * g + e] -= b1[e]; } }
}

struct BlockRef { const bf16* Q; const bf16* K; const bf16* V; bf16* O; const float* C; int P0; };
struct Seam { bf16x8 qr[8]; bf16x8 st_v0, st_v1, st_k0, st_k1; float st_c; };
#define ROW(p, k0, rr) ((p) + (size_t)((k0) + (rr)) * PITCH + sc)
#define VMW() asm volatile("s_waitcnt vmcnt(0)" ::: "memory")
#define VMWN(n) asm volatile("s_waitcnt vmcnt(%0)" :: "i"(n) : "memory")
#define SLOAD_H(Kp, Vp, Cp, k0) do { S.st_v0 = load8(ROW(Vp, k0, sr)); S.st_v1 = load8(ROW(Vp, k0, 32 + sr));              \
                         S.st_k0 = load8(ROW(Kp, k0, sr)); S.st_k1 = load8(ROW(Kp, k0, 32 + sr)); S.st_c = (Cp)[(k0) + (tid & 63)]; } while (0)
#define SWRITE_HK(bf) do { *(bf16x8*)(K_lds + (bf) * SHM_K + kws) = S.st_k0; *(bf16x8*)(K_lds + (bf) * SHM_K + kws + 32 * 256) = S.st_k1; \
                           if (tid < 64) ((float*)(lds + OFF_KB))[(bf) * 64 + tid] = S.st_c; } while (0)
#define SWRITE_HV(bf) do { *(bf16x8*)(V_lds + (bf) * SHM_V + vst0) = S.st_v0; *(bf16x8*)(V_lds + (bf) * SHM_V + vst1) = S.st_v1; } while (0)
#define SWRITE_H(bf) do { SWRITE_HV(bf); SWRITE_HK(bf); } while (0)
__device__ __forceinline__ void fox_prime(const BlockRef& cur, char* lds, Seam& S, const int WAVE_) {
    const int tid = TID(), wid = __builtin_amdgcn_readfirstlane(tid >> 6), lane = tid & 63, r32 = lane & 31, hi = lane >> 5;
    const int sr = tid >> 4, sc = (tid & 15) * 8, kws = KSWZ(sr, sc * 2); char* K_lds = lds + 2 * SHM_V;
    for (int d0 = 0; d0 < 8; ++d0) S.qr[d0] = load8(cur.Q + (size_t)(wid * QBLK + r32) * PITCH + d0 * 16 + hi * 8);
    SLOAD_H(cur.K, cur.V, cur.C, 0); VMW(); SWRITE_HK(0);
    __syncthreads();
}
__device__ __forceinline__ void fox_block(const BlockRef& cur, const BlockRef& nxt, char* lds, Seam& S, const int WAVE_) {
    const int tid = TID(), wid = __builtin_amdgcn_readfirstlane(tid >> 6), lane = tid & 63, r32 = lane & 31, hi = lane >> 5;
    const int NT = (cur.P0 + QB - 1) / KVBLK + 1;
    const int qlo = cur.P0 + wid * QBLK, qm = qlo + r32 - 4 * hi;
    char* V_lds = lds; char* K_lds = lds + 2 * SHM_V;
    float* ws = (float*)(lds + OFF_WS) + wid * 64; float* li_l = ws, * al_l = ws + 32;
    float m_reg = -1e30f, l_reg = 0; f32x16 o[4] = {};
    const int sr = tid >> 4, sc = (tid & 15) * 8, vst0 = v_st(sr, sc), vst1 = v_st(32 + sr, sc), kws = KSWZ(sr, sc * 2);
    const int vb0 = (int)(uintptr_t)V_lds + v_rd_base(lane);
    const bf16* Kh = cur.K; const bf16* Vh = cur.V; const float* Ch = cur.C;
#define RESC(a) do { if (__any((a) < 1.f)) { if (hi == 0) al_l[r32] = (a); asm volatile("s_waitcnt lgkmcnt(0)" ::: "memory");              \
                     for (int d_ = 0; d_ < 4; ++d_) for (int r = 0; r < 16; ++r) o[d_][r] *= al_l[crow(r, hi)]; } } while (0)
#define KBASE(t) ((t) * KVBLK)
#define MASKT(P0_, P1_, t, KBUF) do { const int kb_ = KBASE(t); key_bias<KBUF>(P0_, P1_, lds, hi); if (kb_ + KVBLK - 1 > qlo) mask_tile(P0_, P1_, qm - kb_); } while (0)
#define SEAM_K0() do { VMWN(8); SWRITE_HK(0); SBAR(); } while (0)
    f32x16 pA0, pA1, pB0, pB1; float mnA, mnB, alA, alB; bf16x8 pa0, pa1, pa2, pa3;
    SWRITE_HV(0); SBAR();
    if (NT > 1) { SLOAD_H(Kh, Vh, Ch, KBASE(1)); }
    SBAR(); qkt<0>(pA0, pA1, K_lds, r32, hi, S.qr);
    MASKT(pA0, pA1, 0, 0); partialSM(pA0, pA1, m_reg, mnA, alA);
    if (NT > 1) { VMW(); SWRITE_H(1); }
    __syncthreads();
#define HALF_STEP(PX0, PX1, mnX, alX, PY0, PY1, alY, t, KB, VB, SB) do {                                                      \
        SBAR(); qkt<KB>(PX0, PX1, K_lds, r32, hi, S.qr);                                                                     \
        finishSM(PY0, PY1, alY, l_reg, pa0, pa1, pa2, pa3); SBAR();                                                           \
        if ((t) + 1 < NT) { SLOAD_H(Kh, Vh, Ch, KBASE((t) + 1)); SBAR(); }                                                    \
        pv_tile<VB>(o, vb0, pa0, pa1, pa2, pa3); MASKT(PX0, PX1, (t), KB); partialSM(PX0, PX1, m_reg, mnX, alX);             \
        __syncthreads();                                                                                                      \
        if ((t) + 1 < NT) { VMW(); SWRITE_H(SB); }                                                                            \
        RESC(alX); __syncthreads(); } while (0)
    for (int t = 1; t + 1 < NT; t += 2) {
        HALF_STEP(pB0, pB1, mnB, alB, pA0, pA1, alA, t, 1, 0, 0);
        HALF_STEP(pA0, pA1, mnA, alA, pB0, pB1, alB, t + 1, 0, 1, 1);
    }
    const bool even = (NT & 1) == 0;
    if (even) { SBAR(); qkt<1>(pB0, pB1, K_lds, r32, hi, S.qr); SBAR(); }
    SLOAD_H(nxt.K, nxt.V, nxt.C, 0); SBAR();
#pragma unroll
    for (int d0 = 0; d0 < 8; ++d0) S.qr[d0] = load8(nxt.Q + (size_t)(wid * QBLK + r32) * PITCH + d0 * 16 + hi * 8);
    SBAR();
    finishSM(pA0, pA1, alA, l_reg, pa0, pa1, pa2, pa3); SBAR();
    pv_tile<0>(o, vb0, pa0, pa1, pa2, pa3);
    if (even) { MASKT(pB0, pB1, NT - 1, 1); partialSM(pB0, pB1, m_reg, mnB, alB); __syncthreads(); RESC(alB);
        finishSM(pB0, pB1, alB, l_reg, pa0, pa1, pa2, pa3); SBAR(); pv_tile<1>(o, vb0, pa0, pa1, pa2, pa3); }
    SBAR(); SEAM_K0();
    if (hi == 0) li_l[r32] = l_reg; asm volatile("s_waitcnt lgkmcnt(0)" ::: "memory");
    float rli[16];
#pragma unroll
    for (int r = 0; r < 16; ++r) rli[r] = __builtin_amdgcn_rcpf(li_l[crow(r, hi)]);
    bf16* Ow = cur.O + (size_t)(wid * QBLK) * PITCH;
#pragma unroll
    for (int r = 0; r < 16; ++r) { const int orow = crow(r, hi);
#pragma unroll
        for (int d0 = 0; d0 < 4; ++d0) { const float v = o[d0][r] * rli[r];
            const float vn = __shfl_xor(v, 1);
            if ((r32 & 1) == 0) *(unsigned*)(Ow + (size_t)orow * PITCH + d0 * 32 + r32) = cvtpk(v, vn); } }
    __syncthreads();
#undef RESC
#undef MASKT
#undef SEAM_K0
#undef HALF_STEP
}

template <int BUF>
__device__ __forceinline__ void sb_tile(f32x16* o, float& R, const char* K_lds, int vb0, int r32, int hi, const bf16x8* qr, int dq) {
    f32x16 p0, p1;
    qkt<BUF>(p0, p1, K_lds, r32, hi, qr);
    constexpr float L2E = 1.4426950408889634f, LN2 = 0.6931471805599453f;
    f32x16 l0, l1;
    const float NEG = -__builtin_inff();
#pragma unroll
    for (int r = 0; r < 16; ++r) { const int c = (r & 3) + 8 * (r >> 2);
        { const float z = p0[r] * SCALE; const float sp = fmaxf(z, 0.f) + LN2 * __builtin_amdgcn_logf(1.0f + __builtin_amdgcn_exp2f(-fabsf(z) * L2E)); const bool st = (dq - c) >= 1; l0[r] = st ? -sp : 0.f; p0[r] = st ? (z - sp) : NEG; }
        { const float z = p1[r] * SCALE; const float sp = fmaxf(z, 0.f) + LN2 * __builtin_amdgcn_logf(1.0f + __builtin_amdgcn_exp2f(-fabsf(z) * L2E)); const bool st = (dq - c - 32) >= 1; l1[r] = st ? -sp : 0.f; p1[r] = st ? (z - sp) : NEG; } }
    float gs[8], pg[8], ps[8];
#pragma unroll
    for (int g = 0; g < 4; ++g) { gs[g] = (l0[4 * g] + l0[4 * g + 1]) + (l0[4 * g + 2] + l0[4 * g + 3]); gs[4 + g] = (l1[4 * g] + l1[4 * g + 1]) + (l1[4 * g + 2] + l1[4 * g + 3]); }
#pragma unroll
    for (int g = 0; g < 8; ++g) { auto rr = __builtin_amdgcn_permlane32_swap(__float_as_uint(gs[g]), __float_as_uint(gs[g]), false, false);
        const float lo = __uint_as_float(rr[0]), hv = __uint_as_float(rr[1]); ps[g] = lo + hv; pg[g] = hi ? lo : hv; }
    float acc = R;
#pragma unroll
    for (int g = 7; g >= 0; --g) {
        float run = hi ? acc : acc + pg[g];
        acc += ps[g];
        if (g >= 4) { const int b = 4 * (g - 4);
#pragma unroll
            for (int e = 3; e >= 0; --e) { const float t = l1[b + e]; p1[b + e] = __builtin_amdgcn_exp2f((p1[b + e] + run) * L2E); run += t; } }
        else { const int b = 4 * g;
#pragma unroll
            for (int e = 3; e >= 0; --e) { const float t = l0[b + e]; p0[b + e] = __builtin_amdgcn_exp2f((p0[b + e] + run) * L2E); run += t; } }
    }
    R = acc;
    bf16x8 pa0, pa1, pa2, pa3;
    PK4(p0, 0, pa0); PK4(p0, 8, pa1); PK4(p1, 0, pa2); PK4(p1, 8, pa3);
    pv_tile<BUF>(o, vb0, pa0, pa1, pa2, pa3);
}
__device__ __forceinline__ void sb_block(const BlockRef& cur, char* lds, const int WAVE_) {
    const int tid = TID(), wid = __builtin_amdgcn_readfirstlane(tid >> 6), lane = tid & 63, r32 = lane & 31, hi = lane >> 5;
    const int NT = (cur.P0 + QB - 1) / KVBLK + 1;
    const int qlo = cur.P0 + wid * QBLK, qm = qlo + r32 - 4 * hi;
    char* V_lds = lds; char* K_lds = lds + 2 * SHM_V;
    volatile LAS int* flg = (volatile LAS int*)(lds + OFF_FLAG);
    const int sr = tid >> 4, sc = (tid & 15) * 8, vst0 = v_st(sr, sc), vst1 = v_st(32 + sr, sc), kws = KSWZ(sr, sc * 2);
    const int vb0 = (int)(uintptr_t)V_lds + v_rd_base(lane);
    const bf16* Kh = cur.K; const bf16* Vh = cur.V;
    bf16x8 qr[8];
#pragma unroll
    for (int d0 = 0; d0 < 8; ++d0) qr[d0] = load8(cur.Q + (size_t)(wid * QBLK + r32) * PITCH + d0 * 16 + hi * 8);
    bf16x8 st_v0, st_v1, st_k0, st_k1;
#define SB_LOAD(k0) do { st_v0 = load8(ROW(Vh, k0, sr)); st_v1 = load8(ROW(Vh, k0, 32 + sr)); st_k0 = load8(ROW(Kh, k0, sr)); st_k1 = load8(ROW(Kh, k0, 32 + sr)); } while (0)
#define SB_WRITE(bf) do { *(bf16x8*)(V_lds + (bf) * SHM_V + vst0) = st_v0; *(bf16x8*)(V_lds + (bf) * SHM_V + vst1) = st_v1; \
                          *(bf16x8*)(K_lds + (bf) * SHM_K + kws) = st_k0; *(bf16x8*)(K_lds + (bf) * SHM_K + kws + 32 * 256) = st_k1; } while (0)
    f32x16 o[4] = {}; float R = 0.f; bool fin = false;
    SB_LOAD((NT - 1) * KVBLK); VMW(); SB_WRITE(0);
    if (NT > 1) SB_LOAD((NT - 2) * KVBLK);
    __syncthreads();
#define SB_STEP(t, BUF) do { const int kb_ = (NT - 1 - (t)) * KVBLK;                                                         \
        if (!fin && kb_ <= qlo + QBLK - 2) { sb_tile<BUF>(o, R, K_lds, vb0, r32, hi, qr, qm - kb_); fin = __all(R < -105.f); } \
        if ((t) + 1 < NT) { VMW(); SB_WRITE((BUF) ^ 1); if ((t) + 2 < NT) SB_LOAD((NT - 3 - (t)) * KVBLK); }                   \
        if (lane == 0) flg[(BUF) * 8 + wid] = fin ? 1 : 0;                                                                   \
        __syncthreads();                                                                                                      \
        { int all_ = 1; _Pragma("unroll") for (int w_ = 0; w_ < 8; ++w_) all_ &= flg[(BUF) * 8 + w_]; stop = all_ != 0; } } while (0)
    bool stop = false;
    for (int t = 0; t < NT; t += 2) {
        SB_STEP(t, 0);
        if (stop || t + 1 >= NT) break;
        SB_STEP(t + 1, 1);
        if (stop) break;
    }
    bf16* Ow = cur.O + (size_t)(wid * QBLK) * PITCH;
#pragma unroll
    for (int r = 0; r < 16; ++r) { const int orow = crow(r, hi);
#pragma unroll
        for (int d0 = 0; d0 < 4; ++d0) { const float v = o[d0][r];
            const float vn = __shfl_xor(v, 1);
            if ((r32 & 1) == 0) *(unsigned*)(Ow + (size_t)orow * PITCH + d0 * 32 + r32) = cvtpk(v, vn); } }
    __syncthreads();
#undef SB_LOAD
#undef SB_WRITE
#undef SB_STEP
}
#undef ROW
#undef VMW
#undef VMWN
#undef SLOAD_H
#undef SWRITE_HK
#undef SWRITE_HV
#undef SWRITE_H
#undef PK4
#undef KSWZ
}

enum { PH_P0 = 0, PH_P1, PH_P1B, PH_ATT, PH_P3A, PH_P3B, PH_P4, PH_P5, PH_P5B, PH_P6, PH_P7A, PH_P7, PH_N };
__global__ void __launch_bounds__(NWAVES * 64, 2) mega_fwd(Params P) {
    extern __shared__ __attribute__((aligned(16))) unsigned char lds[];
    Frame F;
    F.lds = (LAS unsigned char*)lds;
    F.MISC = (volatile LAS unsigned*)(F.lds + MISC_OFF);
    F.wave = __builtin_amdgcn_readfirstlane((int)(__builtin_amdgcn_workitem_id_x() >> 6));
    const int WAVE_ = F.wave; const int f_tid = TID();
    F.G = gridDim.x; { const int bx = blockIdx.x; F.vcu = (F.G % 8 == 0) ? (bx % 8) * (F.G / 8) + bx / 8 : bx; }
    unsigned char* ws = P.ws;
    F.ctl = (gu32*)(ws + WS_CTL);
    for (int u = f_tid; u < (LDS_BYTES - LDSCTL_OFF) / 4; u += NWAVES * 64) ((LAS unsigned*)(F.lds + LDSCTL_OFF))[u] = 0u;
    __syncthreads();
    XcdBarrier bar = xcd_barrier_post((unsigned*)(F.ctl + CW_BAR) + P.li * XCD_BAR_WORDS, F.MISC + 8, F.wave);
    const int lo = P.ph_lo, hi = P.ph_hi;
#define IN(k) (lo <= (k) && (k) < hi)
#define SEAM(k) do { if (IN(k) && IN((k) + 1)) xcd_barrier(bar); } while (0)
    bf16* W_in = (bf16*)(ws + WS_WIN); bf16* XB = (bf16*)(ws + WS_XB);
    float* ss1 = (float*)(ws + WS_SS1); float* ss2 = (float*)(F.ctl + CW_SS2); float* ss3 = (float*)(F.ctl + CW_SS3);
    bf16* QKV = (bf16*)(ws + WS_QKV); bf16* GATES = (bf16*)(ws + WS_GATES); bf16* Y = (bf16*)(ws + WS_Y); bf16* MERGED = (bf16*)(ws + WS_MERGED);
    LAS unsigned char* ring = F.lds + RING_OFF;

    if (IN(PH_P0)) { p0_weights(F, P); p0_rows(F, P); }
    SEAM(PH_P0);
    if (IN(PH_P1)) {
        pg8::Gemm g{XB, W_in, S, NPROJ, DM}; pg8::StaticOrder So; So.init(S, NPROJ, F.G, (int)blockIdx.x);
        pg8::EpiProj E{QKV, GATES, ss1};
        pg8::gemm_phase<pg8::EpiProj, pg8::StaticOrder, true, true>(ring, g, So, E, F.wave);
    }
    SEAM(PH_P1);
    if (IN(PH_P1B)) { p1b_qknorm_cumsum(F, P); }
    SEAM(PH_P1B);
    if (IN(PH_ATT)) {
        char* al = (char*)lds + RING_OFF;
        const size_t T = (size_t)S * WF; const float* Cs = (const float*)(ws + WS_C);
        for (int L = F.vcu; L < NH * 16; L += F.G) {
            const int h = L >> 4, x = L & 15;
            att::BlockRef b0, b1;
            b0.Q = QKV + (size_t)(x * 256) * WF + h * HD; b0.K = QKV + T + h * HD; b0.V = QKV + 2 * T + h * HD; b0.O = Y + (size_t)(x * 256) * WF + h * HD; b0.C = Cs + (size_t)h * S; b0.P0 = x * 256;
            b1 = b0; b1.Q = QKV + (size_t)((31 - x) * 256) * WF + h * HD; b1.O = Y + (size_t)((31 - x) * 256) * WF + h * HD; b1.P0 = (31 - x) * 256;
            att::Seam Sm;
            att::fox_prime(b0, al, Sm, F.wave);
            att::fox_block(b0, b1, al, Sm, F.wave);
            att::fox_block(b1, b1, al, Sm, F.wave);
        }
        for (int L = F.vcu; L < NH * 32; L += F.G) {
            const int h = L >> 5, qb = L & 31;
            att::BlockRef b;
            b.Q = QKV + 3 * T + (size_t)(qb * 256) * WF + h * HD; b.K = QKV + 4 * T + h * HD; b.V = QKV + 5 * T + h * HD; b.O = Y + T + (size_t)(qb * 256) * WF + h * HD; b.C = nullptr; b.P0 = qb * 256;
            att::sb_block(b, al, F.wave);
        }
    }
    SEAM(PH_ATT);
    if (IN(PH_P3A)) {
        pg8::Gemm g{Y, (bf16*)(ws + WS_WBF), S, DM, WF}; pg8::StaticOrder So; So.init(S, DM, F.G, (int)blockIdx.x);
        pg8::EpiGateA E{P.out, GATES};
        pg8::gemm_phase<pg8::EpiGateA, pg8::StaticOrder, true, true>(ring, g, So, E, F.wave);
    }
    SEAM(PH_P3A);
    if (IN(PH_P3B)) {
        pg8::Gemm g{Y + (size_t)S * WF, (bf16*)(ws + WS_WBS), S, DM, WF}; pg8::StaticOrder So; So.init(S, DM, F.G, (int)blockIdx.x);
        pg8::EpiGateB E{MERGED, P.out, GATES + (size_t)S * DM};
        pg8::gemm_phase<pg8::EpiGateB, pg8::StaticOrder, true, true>(ring, g, So, E, F.wave);
    }
    SEAM(PH_P3B);
    if (IN(PH_P4)) {
        pg8::Gemm g{MERGED, (bf16*)(ws + WS_WOUT), S, DM, DM}; pg8::StaticOrder So; So.init(S, DM, F.G, (int)blockIdx.x);
        pg8::EpiResStat E{P.in[0], P.out, XB, ss2};
        pg8::gemm_phase<pg8::EpiResStat, pg8::StaticOrder, true, true>(ring, g, So, E, F.wave);
    }
    SEAM(PH_P4);
    if (IN(PH_P5)) {
        pg8::Gemm g{XB, (bf16*)(ws + WS_WUP), S, 2 * DFF, DM}; pg8::StaticOrder So; So.init(S, 2 * DFF, F.G, (int)blockIdx.x);
        pg8::EpiUp E{(bf16*)(ws + WS_UP), 2 * DFF, ss2};
        pg8::gemm_phase<pg8::EpiUp, pg8::StaticOrder, true, true>(ring, g, So, E, F.wave);
    }
    SEAM(PH_P5);
    if (IN(PH_P5B)) { p5b_convglu(F, P); }
    SEAM(PH_P5B);
    if (IN(PH_P6)) {
        pg8::Gemm g{(bf16*)(ws + WS_ACT), (bf16*)(ws + WS_WDN), S, DM, DFF}; pg8::StaticOrder So; So.init(S, DM, F.G, (int)blockIdx.x);
        pg8::EpiResStat E{P.out, P.out, XB, ss3};
        pg8::gemm_phase<pg8::EpiResStat, pg8::StaticOrder, true, true>(ring, g, So, E, F.wave);
    }
    SEAM(PH_P6);
    if (IN(PH_P7A)) {
        pg8::Gemm g{(bf16*)(ws + WS_PB), (bf16*)(ws + WS_WPP), S, DM, PLE}; pg8::StaticOrder So; So.init(S, DM, F.G, (int)blockIdx.x);
        pg8::EpiStoreF32 E{(float*)(ws + WS_PP)};
        pg8::gemm_phase<pg8::EpiStoreF32, pg8::StaticOrder, true, true>(ring, g, So, E, F.wave);
    }
    SEAM(PH_P7A);
    if (IN(PH_P7)) {
        pg8::Gemm g{XB, (bf16*)(ws + WS_WPG), S, DM, DM}; pg8::StaticOrder So; So.init(S, DM, F.G, (int)blockIdx.x);
        pg8::EpiPle E{P.out, (const float*)(ws + WS_PP), ss3};
        pg8::gemm_phase<pg8::EpiPle, pg8::StaticOrder, true, true>(ring, g, So, E, F.wave);
    }
#undef IN
#undef SEAM
}

extern "C" void kernel_launch(void* const* d_in, const int* in_sizes, int n_in, void* d_out, int out_size, void* d_ws, size_t ws_size, hipStream_t stream) {
    static int grid = 0;
    if (grid == 0) {
        if (n_in != 18 || out_size != S * DM || ws_size < WS_END) { fprintf(stderr, "kernel_launch: unexpected shapes / workspace (%d inputs, out %d, ws %zu < %zu)\n", n_in, out_size, ws_size, (size_t)WS_END); grid = -1; return; }
        int dev = 0, cus = 0, per_cu = 0;
        if (hipGetDevice(&dev) != hipSuccess || hipDeviceGetAttribute(&cus, hipDeviceAttributeMultiprocessorCount, dev) != hipSuccess) { grid = -1; return; }
        if (hipFuncSetAttribute((const void*)mega_fwd, hipFuncAttributeMaxDynamicSharedMemorySize, LDS_BYTES) != hipSuccess) { fprintf(stderr, "kernel_launch: hipFuncSetAttribute failed\n"); grid = -1; return; }
        if (hipOccupancyMaxActiveBlocksPerMultiprocessor(&per_cu, (const void*)mega_fwd, NWAVES * 64, LDS_BYTES) != hipSuccess || per_cu < 1)
            fprintf(stderr, "kernel_launch: note: occupancy query reports %d workgroups per CU\n", per_cu);
        (void)hipGetLastError();
        grid = cus;
    }
    if (grid < 0) return;
    if (hipMemsetAsync((char*)d_ws + WS_CTL, 0, CTL_ZERO_BYTES, stream) != hipSuccess) return;
    Params a{};
    for (int i = 0; i < 18; ++i) a.in[i] = (const float*)d_in[i];
    a.out = (float*)d_out; a.ws = (unsigned char*)d_ws;
    a.ph_lo = PH_P0; a.ph_hi = PH_N; a.li = 0;
    hipLaunchKernelGGL(mega_fwd, dim3(grid), dim3(NWAVES * 64), LDS_BYTES, stream, a);
}
```

```cpp
#include <hip/hip_runtime.h>
#include <cstdio>
#include <cstdint>
__device__ __forceinline__ int lane_id() { int l; asm volatile("v_mbcnt_lo_u32_b32 %0, -1, 0\n\tv_mbcnt_hi_u32_b32 %0, -1, %0" : "=v"(l)); return l; }
#define TID() (WAVE_ * 64 + lane_id())
namespace pg8 {
#define PG8_LAS __attribute__((address_space(3)))
typedef unsigned short bf16_t;
typedef short bf16x8 __attribute__((ext_vector_type(8)));
typedef float f32x4 __attribute__((ext_vector_type(4)));
typedef unsigned u32x4 __attribute__((ext_vector_type(4)));
constexpr int BM = 256, BK = 64, HALF = 128, HTB = HALF * BK * 2  , STAGE_BYTES = 8 * HTB, NXCD = 8, WGM = 8;

__host__ __device__ __forceinline__ int lds_byte(int r, int c) { const int st = (r >> 4) * 2 + (c >> 5), rr = r & 15, cc = c & 31, ob = rr * 64 + cc * 2; return st * 1024 + (ob ^ (((ob >> 9) & 1) << 5)); }
__host__ __device__ __forceinline__ void stage_rc(int b, int& R, int& C) { const int st = b / 1024, sb = b % 1024, swz = sb ^ (((sb >> 9) & 1) << 5); R = (st >> 1) * 16 + swz / 64; C = (st & 1) * 32 + (swz % 64) / 2; }
__host__ __device__ __forceinline__ int perm32(int rho) { const int n = rho >> 4, i = rho & 15; return 8 * (i >> 2) + 4 * n + (i & 3); }

struct Unit { int pm, pn, part; };
struct Gemm { const bf16_t* A; const bf16_t* Bt; int M, N, K; };

struct StaticOrder {
    int nM, nN, nwg, G, c;
    __host__ __device__ void init(int M, int N, int G_, int c_) { nM = M / BM; nN = N / BM; nwg = nM * nN; G = G_; c = c_; }
    __host__ __device__ bool next(int i, Unit& u) const {
        const long L = (long)i * G + c; if (L >= nwg) return false;
        int wgid = (int)L; { const int q = nwg / NXCD, r = nwg % NXCD, xcd = wgid % NXCD, off = wgid / NXCD; wgid = (xcd < r ? xcd * (q + 1) : r * (q + 1) + (xcd - r) * q) + off; }
        const int nig = WGM * nN, gid = wgid / nig, fm = gid * WGM, gsz = (nM - fm) < WGM ? (nM - fm) : WGM;
        u.pm = fm + ((wgid % nig) % gsz); u.pn = (wgid % nig) / gsz; return true;
    }
    __device__ __forceinline__ void a_ready(const Unit&) const {}
    __device__ __forceinline__ void done(const Unit&) const {}
    __device__ __forceinline__ const bf16_t* baseA(const Gemm& g, const Unit&) const { return g.A; }
    __device__ __forceinline__ const bf16_t* baseB(const Gemm& g, const Unit&) const { return g.Bt; }
    __device__ __forceinline__ bool zero_after(const Unit&) const { return true; }
};

__device__ __forceinline__ unsigned cvt_pk_bf16(float lo, float hi) { unsigned r; asm volatile("v_cvt_pk_bf16_f32 %0, %1, %2" : "=v"(r) : "v"(lo), "v"(hi)); return r; }
typedef float f32x2 __attribute__((ext_vector_type(2)));
constexpr int SEQ_ = 8192, DM_ = 4096;
constexpr float EPS_ = 1e-6f;
__device__ __forceinline__ float sigm(float v) { return __builtin_amdgcn_rcpf(1.0f + __builtin_amdgcn_exp2f(-1.4426950408889634f * v)); }
__device__ __forceinline__ float rs_of(float ss) { return __builtin_amdgcn_rsqf(ss * (1.0f / DM_) + EPS_); }
typedef unsigned u32x2 __attribute__((ext_vector_type(2)));
__device__ __forceinline__ f32x4 bf4_to_f32(u32x2 w) { return (f32x4){__uint_as_float(w.x << 16), __uint_as_float(w.x & 0xffff0000u), __uint_as_float(w.y << 16), __uint_as_float(w.y & 0xffff0000u)}; }

struct EpiProj {
    static constexpr bool PERM = true, AFTER_DRAIN = false;
    bf16_t* qkv; bf16_t* gates; const float* ss;
    __device__ __forceinline__ void operator()(const f32x4 (&acc)[2][2][4][2], const Unit& u, int wr, int wc, int fr, int fq) const {
        const int row0 = u.pm * BM + wr * 64 + fr;
        bf16_t* base; int ldc, colt; const bool gate = u.pn >= 48;
        if (!gate) { base = qkv + (size_t)(u.pn >> 3) * ((size_t)SEQ_ * 2048); ldc = 2048; colt = (u.pn & 7) * 256; }
        else { const int t = u.pn - 48; base = gates + (size_t)(t >> 4) * ((size_t)SEQ_ * 4096); ldc = 4096; colt = (t & 15) * 256; }
        const int col0 = colt + wc * 32 + 8 * fq;
#pragma unroll
        for (int ai = 0; ai < 2; ++ai)
#pragma unroll
            for (int m = 0; m < 4; ++m) { const int r = row0 + ai * HALF + m * 16; const float rs = rs_of(ss[r]); bf16_t* rowp = base + (size_t)r * ldc + col0;
#pragma unroll
                for (int bj = 0; bj < 2; ++bj) { f32x4 v0 = acc[ai][bj][m][0] * rs, v1 = acc[ai][bj][m][1] * rs;
                    if (gate) {
#pragma unroll
                        for (int j = 0; j < 4; ++j) { v0[j] = sigm(v0[j]); v1[j] = sigm(v1[j]); } }
                    u32x4 w; w.x = cvt_pk_bf16(v0[0], v0[1]); w.y = cvt_pk_bf16(v0[2], v0[3]); w.z = cvt_pk_bf16(v1[0], v1[1]); w.w = cvt_pk_bf16(v1[2], v1[3]);
                    *(u32x4*)(rowp + bj * HALF) = w; } }
    }
};
struct EpiGateA {
    static constexpr bool PERM = false, AFTER_DRAIN = false;
    float* tmp; const bf16_t* sg;
    __device__ __forceinline__ void operator()(const f32x4 (&acc)[2][2][4][2], const Unit& u, int wr, int wc, int fr, int fq) const {
        const int row0 = u.pm * BM + wr * 64 + fr, col0 = u.pn * BM + wc * 32 + 4 * fq;
#pragma unroll
        for (int ai = 0; ai < 2; ++ai)
#pragma unroll
            for (int m = 0; m < 4; ++m) { const size_t off = (size_t)(row0 + ai * HALF + m * 16) * DM_ + col0;
#pragma unroll
                for (int bj = 0; bj < 2; ++bj)
#pragma unroll
                    for (int n = 0; n < 2; ++n) { const f32x4 g = bf4_to_f32(*(const u32x2*)(sg + off + bj * HALF + n * 16)); *(f32x4*)(tmp + off + bj * HALF + n * 16) = acc[ai][bj][m][n] * g; }
                asm volatile("" ::: "memory"); }
    }
};
struct EpiGateB {
    static constexpr bool PERM = true, AFTER_DRAIN = false;
    bf16_t* merged; const float* tmp; const bf16_t* sg;
    __device__ __forceinline__ void operator()(const f32x4 (&acc)[2][2][4][2], const Unit& u, int wr, int wc, int fr, int fq) const {
        const int row0 = u.pm * BM + wr * 64 + fr, col0 = u.pn * BM + wc * 32 + 8 * fq;
#pragma unroll
        for (int ai = 0; ai < 2; ++ai)
#pragma unroll
            for (int m = 0; m < 4; ++m) { const size_t off = (size_t)(row0 + ai * HALF + m * 16) * DM_ + col0;
#pragma unroll
                for (int bj = 0; bj < 2; ++bj) { const u32x4 gw = *(const u32x4*)(sg + off + bj * HALF); const f32x4 t0 = *(const f32x4*)(tmp + off + bj * HALF), t1 = *(const f32x4*)(tmp + off + bj * HALF + 4);
                    const f32x4 g0 = bf4_to_f32((u32x2){gw.x, gw.y}), g1 = bf4_to_f32((u32x2){gw.z, gw.w});
                    const f32x4 v0 = t0 + acc[ai][bj][m][0] * g0, v1 = t1 + acc[ai][bj][m][1] * g1;
                    u32x4 w; w.x = cvt_pk_bf16(v0[0], v0[1]); w.y = cvt_pk_bf16(v0[2], v0[3]); w.z = cvt_pk_bf16(v1[0], v1[1]); w.w = cvt_pk_bf16(v1[2], v1[3]);
                    *(u32x4*)(merged + off + bj * HALF) = w; }
                asm volatile("" ::: "memory"); }
    }
};
struct EpiResStat {
    static constexpr bool PERM = false, AFTER_DRAIN = false;
    const float* base; float* out; bf16_t* xb; float* ss;
    __device__ __forceinline__ void operator()(const f32x4 (&acc)[2][2][4][2], const Unit& u, int wr, int wc, int fr, int fq) const {
        const int row0 = u.pm * BM + wr * 64 + fr, col0 = u.pn * BM + wc * 32 + 4 * fq;
#pragma unroll
        for (int ai = 0; ai < 2; ++ai)
#pragma unroll
            for (int m = 0; m < 4; ++m) { const int r = row0 + ai * HALF + m * 16; const size_t off = (size_t)r * DM_ + col0; float s = 0.f;
#pragma unroll
                for (int bj = 0; bj < 2; ++bj)
#pragma unroll
                    for (int n = 0; n < 2; ++n) { const f32x4 b = *(const f32x4*)(base + off + bj * HALF + n * 16); const f32x4 o = b + acc[ai][bj][m][n];
                        *(f32x4*)(out + off + bj * HALF + n * 16) = o; s += (o[0] * o[0] + o[1] * o[1]) + (o[2] * o[2] + o[3] * o[3]);
                        u32x2 w; w.x = cvt_pk_bf16(o[0], o[1]); w.y = cvt_pk_bf16(o[2], o[3]); *(u32x2*)(xb + off + bj * HALF + n * 16) = w; }
                s += __shfl_xor(s, 16); s += __shfl_xor(s, 32);
                if (fq == 0) __hip_atomic_fetch_add(ss + r, s, __ATOMIC_RELAXED, __HIP_MEMORY_SCOPE_AGENT);
                asm volatile("" ::: "memory"); }
    }
};
struct EpiUp {
    static constexpr bool PERM = true, AFTER_DRAIN = false;
    bf16_t* O; int ldc; const float* ss;
    __device__ __forceinline__ void operator()(const f32x4 (&acc)[2][2][4][2], const Unit& u, int wr, int wc, int fr, int fq) const {
        const int row0 = u.pm * BM + wr * 64 + fr, col0 = u.pn * BM + wc * 32 + 8 * fq;
#pragma unroll
        for (int ai = 0; ai < 2; ++ai)
#pragma unroll
            for (int m = 0; m < 4; ++m) { const int r = row0 + ai * HALF + m * 16; const float rs = rs_of(ss[r]); bf16_t* rowp = O + (size_t)r * ldc + col0;
#pragma unroll
                for (int bj = 0; bj < 2; ++bj) { const f32x4 v0 = acc[ai][bj][m][0] * rs, v1 = acc[ai][bj][m][1] * rs;
                    u32x4 w; w.x = cvt_pk_bf16(v0[0], v0[1]); w.y = cvt_pk_bf16(v0[2], v0[3]); w.z = cvt_pk_bf16(v1[0], v1[1]); w.w = cvt_pk_bf16(v1[2], v1[3]);
                    *(u32x4*)(rowp + bj * HALF) = w; } }
    }
};
struct EpiStoreF32 {
    static constexpr bool PERM = false, AFTER_DRAIN = false;
    float* C;
    __device__ __forceinline__ void operator()(const f32x4 (&acc)[2][2][4][2], const Unit& u, int wr, int wc, int fr, int fq) const {
        const int row0 = u.pm * BM + wr * 64 + fr, col0 = u.pn * BM + wc * 32 + 4 * fq;
#pragma unroll
        for (int ai = 0; ai < 2; ++ai)
#pragma unroll
            for (int m = 0; m < 4; ++m) { float* rowp = C + (size_t)(row0 + ai * HALF + m * 16) * DM_ + col0;
#pragma unroll
                for (int bj = 0; bj < 2; ++bj)
#pragma unroll
                    for (int n = 0; n < 2; ++n) *(f32x4*)(rowp + bj * HALF + n * 16) = acc[ai][bj][m][n]; }
    }
};
struct EpiPle {
    static constexpr bool PERM = false, AFTER_DRAIN = false;
    float* out; const bf16_t* pp; const float* ss;
    __device__ __forceinline__ void operator()(const f32x4 (&acc)[2][2][4][2], const Unit& u, int wr, int wc, int fr, int fq) const {
        const int row0 = u.pm * BM + wr * 64 + fr, col0 = u.pn * BM + wc * 32 + 4 * fq;
#pragma unroll
        for (int ai = 0; ai < 2; ++ai)
#pragma unroll
            for (int m = 0; m < 4; ++m) { const int r = row0 + ai * HALF + m * 16; const size_t off = (size_t)r * DM_ + col0; const float rs = rs_of(ss[r]);
#pragma unroll
                for (int bj = 0; bj < 2; ++bj)
#pragma unroll
                    for (int n = 0; n < 2; ++n) { const f32x4 b = *(const f32x4*)(out + off + bj * HALF + n * 16), q = bf4_to_f32(*(const u32x2*)(pp + off + bj * HALF + n * 16)); const f32x4 a = acc[ai][bj][m][n] * rs;
                        f32x4 o; o[0] = b[0] + sigm(a[0]) * q[0]; o[1] = b[1] + sigm(a[1]) * q[1]; o[2] = b[2] + sigm(a[2]) * q[2]; o[3] = b[3] + sigm(a[3]) * q[3];
                        *(f32x4*)(out + off + bj * HALF + n * 16) = o; }
                asm volatile("" ::: "memory"); }
    }
};
struct EpiNull {
    static constexpr bool PERM = true, AFTER_DRAIN = false;
    __device__ __forceinline__ void operator()(const f32x4 (&acc)[2][2][4][2], const Unit& u, int wr, int wc, int fr, int fq) const {
#pragma unroll
        for (int ai = 0; ai < 2; ++ai)
#pragma unroll
            for (int bj = 0; bj < 2; ++bj)
#pragma unroll
                for (int m = 0; m < 4; ++m)
#pragma unroll
                    for (int n = 0; n < 2; ++n) asm volatile("" :: "v"(acc[ai][bj][m][n]));
    }
};
struct EpiGate2 {
    static constexpr bool PERM = true, AFTER_DRAIN = false;
    bf16_t* merged; const bf16_t* sga; const bf16_t* sgb;
    __device__ __forceinline__ void operator()(f32x4 (&acc)[2][2][4][2], const Unit& u, int wr, int wc, int fr, int fq) const {
        const int row0 = u.pm * BM + wr * 64 + fr, col0 = u.pn * BM + wc * 32 + 8 * fq;
        if (u.part == 0) {
#pragma unroll
            for (int ai = 0; ai < 2; ++ai)
#pragma unroll
                for (int m = 0; m < 4; ++m) { const size_t off = (size_t)(row0 + ai * HALF + m * 16) * DM_ + col0;
                    const u32x4 a0 = *(const u32x4*)(sga + off), a1 = *(const u32x4*)(sga + off + HALF), b0 = *(const u32x4*)(sgb + off), b1 = *(const u32x4*)(sgb + off + HALF);
#pragma unroll
                    for (int bj = 0; bj < 2; ++bj) { const u32x4 aw = bj ? a1 : a0, bw = bj ? b1 : b0;
                        const f32x4 ga0 = bf4_to_f32((u32x2){aw.x, aw.y}), ga1 = bf4_to_f32((u32x2){aw.z, aw.w}), gb0 = bf4_to_f32((u32x2){bw.x, bw.y}), gb1 = bf4_to_f32((u32x2){bw.z, bw.w});
#pragma unroll
                        for (int j = 0; j < 4; ++j) { acc[ai][bj][m][0][j] *= ga0[j] * __builtin_amdgcn_rcpf(fmaxf(gb0[j], 1e-20f)); acc[ai][bj][m][1][j] *= ga1[j] * __builtin_amdgcn_rcpf(fmaxf(gb1[j], 1e-20f)); } }
                    asm volatile("" ::: "memory"); }
        } else {
#pragma unroll
            for (int ai = 0; ai < 2; ++ai)
#pragma unroll
                for (int m = 0; m < 4; ++m) { const size_t off = (size_t)(row0 + ai * HALF + m * 16) * DM_ + col0;
                    const u32x4 b0 = *(const u32x4*)(sgb + off), b1 = *(const u32x4*)(sgb + off + HALF);
#pragma unroll
                    for (int bj = 0; bj < 2; ++bj) { const u32x4 bw = bj ? b1 : b0; const f32x4 gb0 = bf4_to_f32((u32x2){bw.x, bw.y}), gb1 = bf4_to_f32((u32x2){bw.z, bw.w});
                        f32x4 v0, v1;
#pragma unroll
                        for (int j = 0; j < 4; ++j) { v0[j] = acc[ai][bj][m][0][j] * fmaxf(gb0[j], 1e-20f); v1[j] = acc[ai][bj][m][1][j] * fmaxf(gb1[j], 1e-20f); }
                        u32x4 w; w.x = cvt_pk_bf16(v0[0], v0[1]); w.y = cvt_pk_bf16(v0[2], v0[3]); w.z = cvt_pk_bf16(v1[0], v1[1]); w.w = cvt_pk_bf16(v1[2], v1[3]);
                        *(u32x4*)(merged + off + bj * HALF) = w; }
                    asm volatile("" ::: "memory"); }
        }
    }
};
struct TwoPartOrder : StaticOrder {
    const bf16_t* A1; const bf16_t* B1;
    __device__ bool next(int i, Unit& u) const { const bool ok = StaticOrder::next(i >> 1, u); u.part = i & 1; return ok; }
    __device__ __forceinline__ const bf16_t* baseA(const Gemm& g, const Unit& u) const { return u.part ? A1 : g.A; }
    __device__ __forceinline__ const bf16_t* baseB(const Gemm& g, const Unit& u) const { return u.part ? B1 : g.Bt; }
    __device__ __forceinline__ bool zero_after(const Unit& u) const { return u.part != 0; }
};
struct EpiStoreBf16x4 {
    static constexpr bool PERM = false, AFTER_DRAIN = false;
    bf16_t* C;
    __device__ __forceinline__ void operator()(const f32x4 (&acc)[2][2][4][2], const Unit& u, int wr, int wc, int fr, int fq) const {
        const int row0 = u.pm * BM + wr * 64 + fr, col0 = u.pn * BM + wc * 32 + 4 * fq;
#pragma unroll
        for (int ai = 0; ai < 2; ++ai)
#pragma unroll
            for (int m = 0; m < 4; ++m) { bf16_t* rowp = C + (size_t)(row0 + ai * HALF + m * 16) * DM_ + col0;
#pragma unroll
                for (int bj = 0; bj < 2; ++bj)
#pragma unroll
                    for (int n = 0; n < 2; ++n) { const f32x4 v = acc[ai][bj][m][n]; u32x2 w; w.x = cvt_pk_bf16(v[0], v[1]); w.y = cvt_pk_bf16(v[2], v[3]); *(u32x2*)(rowp + bj * HALF + n * 16) = w; } }
    }
};
template <class Epi, class Sched, bool ALIGN_EPI = false, bool SP2 = false>
__device__ __forceinline__ void gemm_phase(PG8_LAS unsigned char* lds, const Gemm g, const Sched& S, const Epi& E, const int WAVE_) {
    const int tid = TID(), wid = __builtin_amdgcn_readfirstlane(tid >> 6), lane = tid & 63, wr = wid >> 2, wc = wid & 3, fr = lane & 15, fq = lane >> 4;
    const int K = g.K, nt = K / BK;
    unsigned voffA[2], voffB[2];
#pragma unroll
    for (int i = 0; i < 2; ++i) { int R, C; stage_rc(tid * 16 + i * 8192, R, C); const int Rb = Epi::PERM ? ((R & ~31) + perm32(R & 31)) : R;
        voffA[i] = (unsigned)(R * K + C) * 2u; voffB[i] = (unsigned)(Rb * K + C) * 2u; }
    const size_t kstep = (size_t)(BK * 2);
    const size_t hstep = (size_t)HALF * K * 2;
    const size_t tstep = 2 * hstep;
    const unsigned ldsw = (unsigned)wid * 1024u;
    const int aoff = lds_byte(wr * 64 + fr, fq * 8), boff = lds_byte(wc * 32 + fr, fq * 8);
#define PG8_SA(b, h) (((b) * 2 + (h)) * HTB)
#define PG8_SB(b, h) ((4 + (b) * 2 + (h)) * HTB)
#define PG8_STAGE(bufoff, gbase, voff) do { _Pragma("unroll") for (int _i = 0; _i < 2; ++_i) \
        __builtin_amdgcn_global_load_lds((const unsigned*)((const char*)(gbase) + (voff)[_i]), (PG8_LAS unsigned*)(lds + (bufoff) + ldsw + _i * 8192), 16, 0, 0); } while (0)
#define PG8_LDA(dst, b, h) do { _Pragma("unroll") for (int m = 0; m < 4; ++m) _Pragma("unroll") for (int k = 0; k < 2; ++k) dst[m][k] = *(const PG8_LAS bf16x8*)(lds + PG8_SA(b, h) + aoff + m * 2048 + k * 1024); } while (0)
#define PG8_LDB(dst, b, h) do { _Pragma("unroll") for (int n = 0; n < 2; ++n) _Pragma("unroll") for (int k = 0; k < 2; ++k) dst[n][k] = *(const PG8_LAS bf16x8*)(lds + PG8_SB(b, h) + boff + n * 2048 + k * 1024); } while (0)
#define PG8_MMA(ai, bj, At, Bt) do { __builtin_amdgcn_s_setprio(1); _Pragma("unroll") for (int m = 0; m < 4; ++m) _Pragma("unroll") for (int n = 0; n < 2; ++n) _Pragma("unroll") for (int k = 0; k < 2; ++k) \
        acc[ai][bj][m][n] = __builtin_amdgcn_mfma_f32_16x16x32_bf16(Bt[n][k], At[m][k], acc[ai][bj][m][n], 0, 0, 0); __builtin_amdgcn_s_setprio(0); } while (0)
#define PG8_WAIT_V(n) asm volatile("s_waitcnt vmcnt(" #n ")" ::: "memory")
#define PG8_WAIT_L(n) asm volatile("s_waitcnt lgkmcnt(" #n ")" ::: "memory")
#define PG8_BAR __builtin_amdgcn_s_barrier()
#define PG8_SCHED __builtin_amdgcn_sched_barrier(0)
    Unit cur, nxt; int ui = 0;
    if (!S.next(0, cur)) return;
    f32x4 acc[2][2][4][2];
#pragma unroll
    for (int a = 0; a < 2; ++a)
#pragma unroll
        for (int b = 0; b < 2; ++b)
#pragma unroll
            for (int m = 0; m < 4; ++m)
#pragma unroll
                for (int n = 0; n < 2; ++n) acc[a][b][m][n] = (f32x4){0.f, 0.f, 0.f, 0.f};
    bf16x8 At[4][2], B0[2][2], B1[2][2];
    const char* cA = (const char*)S.baseA(g, cur) + (size_t)cur.pm * tstep; const char* cB = (const char*)S.baseB(g, cur) + (size_t)cur.pn * tstep;
    S.a_ready(cur);
    if constexpr (SP2) {
        PG8_STAGE(PG8_SB(0, 0), cB, voffB); PG8_STAGE(PG8_SB(0, 1), cB + hstep, voffB); PG8_STAGE(PG8_SA(0, 0), cA, voffA); PG8_STAGE(PG8_SA(0, 1), cA + hstep, voffA);
        if (wr == 1) PG8_BAR;
        PG8_WAIT_V(2); PG8_BAR;
        PG8_STAGE(PG8_SB(1, 0), cB + kstep, voffB); PG8_STAGE(PG8_SA(1, 0), cA + kstep, voffA); PG8_STAGE(PG8_SB(1, 1), cB + hstep + kstep, voffB);
        PG8_WAIT_V(6); PG8_BAR;
    } else {
        PG8_STAGE(PG8_SB(0, 0), cB, voffB); PG8_STAGE(PG8_SA(0, 0), cA, voffA); PG8_STAGE(PG8_SB(0, 1), cB + hstep, voffB); PG8_STAGE(PG8_SA(0, 1), cA + hstep, voffA);
        if (wr == 1) PG8_BAR;
        PG8_WAIT_V(4); PG8_BAR;
        PG8_STAGE(PG8_SB(1, 0), cB + kstep, voffB); PG8_STAGE(PG8_SA(1, 0), cA + kstep, voffA); PG8_STAGE(PG8_SB(1, 1), cB + hstep + kstep, voffB);
        PG8_WAIT_V(6); PG8_BAR;
    }
    for (;;) {
        const bool has_next = S.next(ui + 1, nxt);
        const char* nA = has_next ? (const char*)S.baseA(g, nxt) + (size_t)nxt.pm * tstep : cA; const char* nB = has_next ? (const char*)S.baseB(g, nxt) + (size_t)nxt.pn * tstep : cB;
        for (int t = 0; t < nt; t += 2) {
            const bool last = (t == nt - 2);
            const char* a1 = cA + (size_t)(t + 1) * kstep;
            const char* a2 = last ? nA : cA + (size_t)(t + 2) * kstep; const char* b2 = last ? nB : cB + (size_t)(t + 2) * kstep;
            const char* a3 = a2 + kstep; const char* b3 = b2 + kstep;
            if (last && has_next) S.a_ready(nxt);
            if constexpr (SP2) {
            PG8_LDB(B0, 0, 0); PG8_LDB(B1, 0, 1); PG8_SCHED; PG8_LDA(At, 0, 0); PG8_STAGE(PG8_SA(1, 1), a1 + hstep, voffA);
            PG8_WAIT_V(8); PG8_WAIT_L(0); PG8_BAR; PG8_MMA(0, 0, At, B0); PG8_MMA(0, 1, At, B1); PG8_BAR; PG8_SCHED;
            PG8_LDA(At, 0, 1); PG8_STAGE(PG8_SB(0, 0), b2, voffB); PG8_STAGE(PG8_SB(0, 1), b2 + hstep, voffB); PG8_STAGE(PG8_SA(0, 0), a2, voffA);
            PG8_WAIT_V(8); PG8_WAIT_L(0); PG8_BAR; PG8_MMA(1, 0, At, B0); PG8_MMA(1, 1, At, B1); PG8_BAR; PG8_SCHED;
            PG8_LDB(B0, 1, 0); PG8_LDB(B1, 1, 1); PG8_SCHED; PG8_LDA(At, 1, 0); PG8_STAGE(PG8_SA(0, 1), a2 + hstep, voffA);
            PG8_WAIT_V(8); PG8_WAIT_L(0); PG8_BAR; PG8_MMA(0, 0, At, B0); PG8_MMA(0, 1, At, B1); PG8_BAR; PG8_SCHED;
            PG8_LDA(At, 1, 1); PG8_STAGE(PG8_SB(1, 0), b3, voffB); PG8_STAGE(PG8_SB(1, 1), b3 + hstep, voffB); PG8_STAGE(PG8_SA(1, 0), a3, voffA);
            PG8_WAIT_V(8); PG8_WAIT_L(0); PG8_BAR; PG8_MMA(1, 0, At, B0); PG8_MMA(1, 1, At, B1); PG8_BAR; PG8_SCHED;
            } else {
            PG8_LDB(B0, 0, 0); PG8_SCHED; PG8_LDA(At, 0, 0); PG8_STAGE(PG8_SA(1, 1), a1 + hstep, voffA);
            PG8_WAIT_L(8); PG8_BAR; PG8_WAIT_L(0); PG8_MMA(0, 0, At, B0); PG8_BAR; PG8_SCHED;
            PG8_LDB(B1, 0, 1); PG8_STAGE(PG8_SB(0, 0), b2, voffB);
            PG8_BAR; PG8_WAIT_L(0); PG8_MMA(0, 1, At, B1); PG8_BAR;
            PG8_LDA(At, 0, 1); PG8_STAGE(PG8_SA(0, 0), a2, voffA);
            PG8_BAR; PG8_WAIT_L(0); PG8_MMA(1, 0, At, B0); PG8_BAR; PG8_SCHED;
            PG8_STAGE(PG8_SB(0, 1), b2 + hstep, voffB);
            PG8_WAIT_V(6); PG8_BAR; PG8_MMA(1, 1, At, B1); PG8_BAR;
            PG8_LDB(B0, 1, 0); PG8_SCHED; PG8_LDA(At, 1, 0); PG8_STAGE(PG8_SA(0, 1), a2 + hstep, voffA);
            PG8_WAIT_L(8); PG8_BAR; PG8_WAIT_L(0); PG8_MMA(0, 0, At, B0); PG8_BAR; PG8_SCHED;
            PG8_LDB(B1, 1, 1); PG8_STAGE(PG8_SB(1, 0), b3, voffB);
            PG8_BAR; PG8_WAIT_L(0); PG8_MMA(0, 1, At, B1); PG8_BAR;
            PG8_LDA(At, 1, 1); PG8_STAGE(PG8_SA(1, 0), a3, voffA);
            PG8_BAR; PG8_WAIT_L(0); PG8_MMA(1, 0, At, B0); PG8_BAR; PG8_SCHED;
            PG8_STAGE(PG8_SB(1, 1), b3 + hstep, voffB);
            PG8_WAIT_V(6); PG8_BAR; PG8_MMA(1, 1, At, B1); PG8_BAR;
            }
        }
        if constexpr (ALIGN_EPI) { if (wr == 0) PG8_BAR; }
        if constexpr (!Epi::AFTER_DRAIN) { E(acc, cur, wr, wc, fr, fq); S.done(cur); }
        if (!has_next) break;
        if (S.zero_after(cur))
#pragma unroll
        for (int a = 0; a < 2; ++a)
#pragma unroll
            for (int b = 0; b < 2; ++b)
#pragma unroll
                for (int m = 0; m < 4; ++m)
#pragma unroll
                    for (int n = 0; n < 2; ++n) acc[a][b][m][n] = (f32x4){0.f, 0.f, 0.f, 0.f};
        cur = nxt; cA = nA; cB = nB; ++ui;
        if constexpr (ALIGN_EPI) { if (wr == 1) PG8_BAR; }
    }
    PG8_WAIT_V(0);
    if constexpr (!ALIGN_EPI) { if (wr == 0) PG8_BAR; }
    PG8_BAR;
    if constexpr (Epi::AFTER_DRAIN) { E.fused(acc, cur, wr, wc, fr, fq, lds, wid, lane); S.done(cur); }
#undef PG8_SA
#undef PG8_SB
#undef PG8_STAGE
#undef PG8_LDA
#undef PG8_LDB
#undef PG8_MMA
#undef PG8_WAIT_V
#undef PG8_WAIT_L
#undef PG8_BAR
#undef PG8_SCHED
}
}
constexpr int NWAVES = 8;
constexpr int S = 8192, DM = 4096, HD = 128, NH = 16, WF = 2048, DFF = 11008, PLE = 256, NIN = 20496, NPROJ = 20480;
constexpr float EPS = 1e-6f;
constexpr float SCALE = 0.08838834764831845f;
constexpr size_t MiB = 1u << 20;
constexpr size_t WS_CTL = 0, CTL_ZERO_BYTES = 1 * MiB;
constexpr size_t WS_SS1 = 1 * MiB;
constexpr size_t WS_LOGF = WS_SS1 + 64 * 1024;
constexpr size_t WS_C = WS_LOGF + 512 * 1024;
constexpr size_t WS_WTF = WS_C + 512 * 1024;
constexpr size_t WS_WIN = 4 * MiB;
constexpr size_t WS_WBF = WS_WIN + 160 * MiB;
constexpr size_t WS_WBS = WS_WBF + 16 * MiB;
constexpr size_t WS_WOUT = WS_WBS + 16 * MiB;
constexpr size_t WS_WUP = WS_WOUT + 32 * MiB;
constexpr size_t WS_WDN = WS_WUP + 172 * MiB;
constexpr size_t WS_WPG = WS_WDN + 86 * MiB;
constexpr size_t WS_WPP = WS_WPG + 32 * MiB;
constexpr size_t WS_XB = WS_WPP + 2 * MiB;
constexpr size_t WS_PB = WS_XB + 64 * MiB;
constexpr size_t WS_QKV = WS_PB + 4 * MiB;
constexpr size_t WS_GATES = WS_QKV + 192 * MiB;
constexpr size_t WS_Y = WS_GATES + 128 * MiB;
constexpr size_t WS_UP = WS_QKV;
constexpr size_t WS_MERGED = WS_Y + 64 * MiB;
constexpr size_t WS_ACT = WS_MERGED + 64 * MiB;
constexpr size_t WS_PP = WS_QKV;
constexpr size_t WS_END = WS_ACT + 172 * MiB;
static_assert(WS_UP + (size_t)S * 2 * DFF * 2 <= WS_MERGED, "up overlay");
constexpr int CW_BAR = 4096;
constexpr int CW_SS2 = 32768, CW_SS3 = 32768 + 8192;
constexpr int N_BAR_REGIONS = 4;
constexpr int RING_OFF = 0, RING_BYTES = 131072;
constexpr int LDSCTL_OFF = RING_BYTES, MISC_OFF = LDSCTL_OFF + 320;
constexpr int LDS_BYTES = 147456;

#define GAS __attribute__((address_space(1)))
#define LAS __attribute__((address_space(3)))
typedef unsigned short bf16;
typedef unsigned v4u __attribute__((ext_vector_type(4)));
typedef unsigned v2u __attribute__((ext_vector_type(2)));
typedef float f32x4 __attribute__((ext_vector_type(4)));
typedef float f32x16 __attribute__((ext_vector_type(16)));
typedef short bf16x8 __attribute__((ext_vector_type(8)));
typedef GAS unsigned gu32;
#define RLX_AGENT __ATOMIC_RELAXED, __HIP_MEMORY_SCOPE_AGENT
#define LDS_WAIT() asm volatile("s_waitcnt lgkmcnt(0)" ::: "memory")
#define VM_WAIT() asm volatile("s_waitcnt vmcnt(0)" ::: "memory")
__device__ __forceinline__ unsigned pk2(float lo, float hi) { unsigned r; asm volatile("v_cvt_pk_bf16_f32 %0, %1, %2" : "=v"(r) : "v"(lo), "v"(hi)); return r; }
__device__ __forceinline__ float bf2f(bf16 b) { return __uint_as_float(((unsigned)b) << 16); }
__device__ __forceinline__ float bflo(unsigned w) { return __uint_as_float(w << 16); }
__device__ __forceinline__ float bfhi(unsigned w) { return __uint_as_float(w & 0xffff0000u); }
__device__ __forceinline__ float sigmoidf_(float v) { return 1.0f / (1.0f + __expf(-v)); }
__device__ __forceinline__ float log_sigmoidf_(float v) { return fminf(v, 0.f) - log1pf(__expf(-fabsf(v))); }
__device__ __forceinline__ float softplusf_(float v) { return fmaxf(v, 0.f) + log1pf(__expf(-fabsf(v))); }
__device__ __forceinline__ float wave_sum(float v) {
#pragma unroll
    for (int o = 1; o < 64; o <<= 1) v += __shfl_xor(v, o);
    return v;
}

#define XB_TMO      128
#define XB_XCNT(j)  (256  + 64 * (j))
#define XB_XSUB(j)  (1280 + 64 * (j))
#define XB_XGEN(j)  (2304 + 64 * (j))
#define XB_TOP      3328
#define XB_TOPGEN   3392
#define XCD_BAR_WORDS 3456
#define XB_SPIN_CAP (1u << 18)

__device__ __forceinline__ unsigned xb_ld(unsigned* p)              { return __hip_atomic_load(p, __ATOMIC_RELAXED, __HIP_MEMORY_SCOPE_AGENT); }
__device__ __forceinline__ unsigned xb_add(unsigned* p, unsigned v) { return __hip_atomic_fetch_add(p, v, __ATOMIC_RELAXED, __HIP_MEMORY_SCOPE_AGENT); }
__device__ __forceinline__ unsigned xb_xcc_id() { return (unsigned)__builtin_amdgcn_s_getreg((3 << 11) | 20) & 0xFu; }
#define XB_SPIN(cond, bar) do { unsigned _sp = 0; while (cond) { __builtin_amdgcn_s_sleep(1); \
    if ((++_sp & 255u) == 0u) { if (xb_ld(&(bar)[XB_TMO])) break; if (_sp > XB_SPIN_CAP) { atomicAdd(&(bar)[XB_TMO], 1u); break; } } } } while (0)

struct XcdBarrier {
    unsigned* bar; unsigned x; int wave;
    volatile LAS unsigned* st;
};

__device__ __forceinline__ XcdBarrier xcd_barrier_post(unsigned* bar, volatile LAS unsigned* st, const int WAVE_) {
    XcdBarrier b; b.wave = WAVE_; b.bar = bar; b.x = xb_xcc_id(); b.st = st;
    if (TID() == 0) (void)xb_add(&bar[XB_XCNT(b.x)], 1u);
    return b;
}
__device__ __forceinline__ void xcd_barrier_complete(unsigned* bar, unsigned x, unsigned& nloc, unsigned& nx) {
    const unsigned G = gridDim.x * gridDim.y * gridDim.z;
    unsigned sum, cnt, mine, sp = 0u;
    for (;;) {
        sum = 0u; cnt = 0u; mine = 0u;
#pragma unroll
        for (unsigned j = 0; j < 16; ++j) { const unsigned c = xb_ld(&bar[XB_XCNT(j)]); sum += c; cnt += (c > 0u) ? 1u : 0u; mine = (j == x) ? c : mine; }
        if (sum == G) break;
        __builtin_amdgcn_s_sleep(1);
        if ((++sp & 255u) == 0u) { if (xb_ld(&bar[XB_TMO])) break; if (sp > XB_SPIN_CAP) { atomicAdd(&bar[XB_TMO], 1u); break; } }
    }
    nloc = mine > 0u ? mine : 1u; nx = cnt > 0u ? cnt : 1u;
}

__device__ __forceinline__ void xcd_barrier(const XcdBarrier& b) {
    const int WAVE_ = b.wave;
    asm volatile("s_waitcnt vmcnt(0)" ::: "memory");
    __syncthreads();
    if (TID() == 0) {
        unsigned* bar = b.bar;
        __builtin_amdgcn_s_waitcnt(0);
        unsigned nloc = b.st[0], nx = b.st[1];
        if (nloc == 0u) { xcd_barrier_complete(bar, b.x, nloc, nx); b.st[0] = nloc; b.st[1] = nx; }
        const unsigned old = xb_add(&bar[XB_XSUB(b.x)], 1u);
        const unsigned gen = old / nloc;
        if (old + 1u == (gen + 1u) * nloc) {
            __builtin_amdgcn_fence(__ATOMIC_RELEASE, "agent");
            asm volatile("s_waitcnt vmcnt(0)" ::: "memory");
            const unsigned og = xb_add(&bar[XB_TOP], 1u);
            const unsigned tg = og / nx;
            if (og + 1u == (tg + 1u) * nx) xb_add(&bar[XB_TOPGEN], 1u);
            else XB_SPIN(xb_ld(&bar[XB_TOPGEN]) == tg, bar);
            __builtin_amdgcn_fence(__ATOMIC_ACQUIRE, "agent");
            xb_add(&bar[XB_XGEN(b.x)], 1u);
            asm volatile("s_waitcnt vmcnt(0)" ::: "memory");
        } else {
            XB_SPIN(xb_ld(&bar[XB_XGEN(b.x)]) == gen, bar);
            __builtin_amdgcn_fence(__ATOMIC_ACQUIRE, "agent");
            asm volatile("s_waitcnt vmcnt(0)" ::: "memory");
        }
    }
    __syncthreads();
}


struct Params {
    const float* in[18]; float* out; unsigned char* ws;
    int ph_lo, ph_hi, li, pad;
};
struct Frame {
    LAS unsigned char* lds; volatile LAS unsigned* MISC; gu32* ctl;
    int wave, vcu, G;
};

struct CvtT { const float* src; const float* g; bf16* dst; int ldw, K; };
__device__ __forceinline__ CvtT cvt_decode(const Params& P, int it, int lane) {
    unsigned char* ws = P.ws;
    constexpr int T0 = 64 * 96, T1 = 64 * 224, T2 = 32 * 64, T3 = 32 * 64, T4 = 64 * 64, T5 = 64 * 344, T6 = 172 * 64, T7 = 64 * 64;
    const float* W; const float* g = nullptr; bf16* Wt; int ldw, srccol0 = 0, K, nrow0 = 0, NT; int r = it;
    if (r < T0) { W = P.in[3]; ldw = NIN; g = P.in[2]; Wt = (bf16*)(ws + WS_WIN); K = DM; NT = 96; }
    else if ((r -= T0) < T1) { W = P.in[3]; ldw = NIN; srccol0 = 6160; g = P.in[2]; Wt = (bf16*)(ws + WS_WIN); K = DM; nrow0 = 6144; NT = 224; }
    else if ((r -= T1) < T2) { W = P.in[7]; ldw = DM; Wt = (bf16*)(ws + WS_WBF); K = WF; NT = 64; }
    else if ((r -= T2) < T3) { W = P.in[8]; ldw = DM; Wt = (bf16*)(ws + WS_WBS); K = WF; NT = 64; }
    else if ((r -= T3) < T4) { W = P.in[9]; ldw = DM; Wt = (bf16*)(ws + WS_WOUT); K = DM; NT = 64; }
    else if ((r -= T4) < T5) { W = P.in[11]; ldw = 2 * DFF; g = P.in[10]; Wt = (bf16*)(ws + WS_WUP); K = DM; NT = 344; }
    else if ((r -= T5) < T6) { W = P.in[14]; ldw = DM; Wt = (bf16*)(ws + WS_WDN); K = DFF; NT = 64; }
    else if ((r -= T6) < T7) { W = P.in[16]; ldw = DM; g = P.in[15]; Wt = (bf16*)(ws + WS_WPG); K = DM; NT = 64; }
    else { r -= T7; W = P.in[17]; ldw = DM; Wt = (bf16*)(ws + WS_WPP); K = PLE; NT = 64; }
    const int nt = r % NT, kt = r / NT, nq = lane & 7, q = lane >> 3;
    CvtT T;
    T.src = W + (size_t)(64 * kt + 8 * q) * ldw + srccol0 + 64 * nt + 4 * nq;
    T.g = g ? g + 64 * kt + 8 * q : nullptr;
    T.dst = Wt + (size_t)(nrow0 + 64 * nt + 4 * nq) * K + 64 * kt + 8 * q;
    T.ldw = ldw; T.K = K;
    return T;
}
__device__ __forceinline__ void cvt_load(const CvtT& T, f32x4 (&v)[2][8]) {
#pragma unroll
    for (int p = 0; p < 2; ++p)
#pragma unroll
        for (int t = 0; t < 8; ++t) v[p][t] = __builtin_nontemporal_load((const f32x4*)(T.src + (size_t)t * T.ldw + 32 * p));
}
__device__ __forceinline__ void cvt_store(const CvtT& T, const f32x4 (&v)[2][8]) {
    f32x4 g0 = (f32x4){1.f, 1.f, 1.f, 1.f}, g1 = g0;
    if (T.g) { g0 = *(const f32x4*)T.g; g1 = *(const f32x4*)(T.g + 4); }
#pragma unroll
    for (int p = 0; p < 2; ++p)
#pragma unroll
        for (int i = 0; i < 4; ++i) {
            v4u w; w.x = pk2(v[p][0][i] * g0[0], v[p][1][i] * g0[1]); w.y = pk2(v[p][2][i] * g0[2], v[p][3][i] * g0[3]);
            w.z = pk2(v[p][4][i] * g1[0], v[p][5][i] * g1[1]); w.w = pk2(v[p][6][i] * g1[2], v[p][7][i] * g1[3]);
            *(v4u*)(T.dst + (size_t)(32 * p + i) * T.K) = w;
        }
}
__device__ __forceinline__ void p0_weights(const Frame& F, const Params& P) {
    const int WAVE_ = F.wave; const int f_lane = lane_id(), f_tid = TID();
    const int gw = F.vcu * NWAVES + F.wave, NGW = F.G * NWAVES, lane = f_lane;
    unsigned char* ws = P.ws;
    constexpr int NITEMS = 64 * 96 + 64 * 224 + 32 * 64 + 32 * 64 + 64 * 64 + 64 * 344 + 172 * 64 + 64 * 64 + 4 * 64;
    f32x4 va[2][8], vb[2][8];
    int it = gw;
    if (it < NITEMS) {
        CvtT Ta = cvt_decode(P, it, lane); cvt_load(Ta, va);
        for (;;) {
            const int i1 = it + NGW; CvtT Tb = Ta;
            if (i1 < NITEMS) { Tb = cvt_decode(P, i1, lane); cvt_load(Tb, vb); }
            cvt_store(Ta, va);
            if (i1 >= NITEMS) break;
            const int i2 = i1 + NGW;
            if (i2 < NITEMS) { Ta = cvt_decode(P, i2, lane); cvt_load(Ta, va); }
            cvt_store(Tb, vb);
            if (i2 >= NITEMS) break;
            it = i2;
        }
    }
    { const float* w_in = P.in[3]; const float* g_mix = P.in[2]; bf16* wtf = (bf16*)(ws + WS_WTF);
      for (int i = blockIdx.x * 512 + f_tid; i < NH * (DM / 8); i += F.G * 512) { const int n = i / (DM / 8), kc = i % (DM / 8);
          float b[8];
#pragma unroll
          for (int t = 0; t < 8; ++t) b[t] = w_in[(size_t)(8 * kc + t) * NIN + 6144 + n] * g_mix[8 * kc + t];
          v4u w; w.x = pk2(b[0], b[1]); w.y = pk2(b[2], b[3]); w.z = pk2(b[4], b[5]); w.w = pk2(b[6], b[7]);
          *(v4u*)(wtf + (size_t)n * DM + 8 * kc) = w; } }
    const float* p = P.in[1]; bf16* pb = (bf16*)(ws + WS_PB);
    for (int i = blockIdx.x * 512 + f_tid; i < S * PLE / 8; i += F.G * 512) {
        const f32x4 a = *(const f32x4*)(p + (size_t)i * 8), b = *(const f32x4*)(p + (size_t)i * 8 + 4);
        v4u w; w.x = pk2(a[0], a[1]); w.y = pk2(a[2], a[3]); w.z = pk2(b[0], b[1]); w.w = pk2(b[2], b[3]);
        *(v4u*)(pb + (size_t)i * 8) = w;
    }
}
__device__ __forceinline__ void p0_rows(const Frame& F, const Params& P) {
    const int WAVE_ = F.wave; const int f_lane = lane_id();
    const float* x = P.in[0]; unsigned char* ws = P.ws;
    float* ss1 = (float*)(ws + WS_SS1); bf16* xb = (bf16*)(ws + WS_XB);
    const int gw = F.vcu * NWAVES + F.wave, NGW = F.G * NWAVES, lane = f_lane;
    for (int base = gw; base < S; base += 2 * NGW) {
        const int rowA = base, rowB = (base + NGW < S) ? base + NGW : base;
        const f32x4* xa = (const f32x4*)(x + (size_t)rowA * DM) + lane; const f32x4* xbp = (const f32x4*)(x + (size_t)rowB * DM) + lane;
        f32x4 va[16], vb[16]; float sa = 0.f, sb = 0.f;
#pragma unroll
        for (int j = 0; j < 16; ++j) va[j] = __builtin_nontemporal_load(xa + 64 * j);
#pragma unroll
        for (int j = 0; j < 16; ++j) vb[j] = __builtin_nontemporal_load(xbp + 64 * j);
#pragma unroll
        for (int j = 0; j < 16; ++j) sa += (va[j][0] * va[j][0] + va[j][1] * va[j][1]) + (va[j][2] * va[j][2] + va[j][3] * va[j][3]);
#pragma unroll
        for (int j = 0; j < 16; ++j) sb += (vb[j][0] * vb[j][0] + vb[j][1] * vb[j][1]) + (vb[j][2] * vb[j][2] + vb[j][3] * vb[j][3]);
        sa = wave_sum(sa); sb = wave_sum(sb);
        if (lane == 0) { ss1[rowA] = sa; ss1[rowB] = sb; }
        v2u* oa = (v2u*)(xb + (size_t)rowA * DM) + lane; v2u* ob = (v2u*)(xb + (size_t)rowB * DM) + lane;
#pragma unroll
        for (int j = 0; j < 16; ++j) { v2u w; w.x = pk2(va[j][0], va[j][1]); w.y = pk2(va[j][2], va[j][3]); oa[64 * j] = w; }
#pragma unroll
        for (int j = 0; j < 16; ++j) { v2u w; w.x = pk2(vb[j][0], vb[j][1]); w.y = pk2(vb[j][2], vb[j][3]); ob[64 * j] = w; }
    }
}

__device__ __forceinline__ void p1b_qknorm_fgate(const Frame& F, const Params& P) {
    const int WAVE_ = F.wave; const int f_lane = lane_id(), f_tid = TID();
    unsigned char* ws = P.ws;
    bf16* qkv = (bf16*)(ws + WS_QKV);
    const float* gq = P.in[5]; const float* gk = P.in[6];
    const int gw = F.vcu * NWAVES + F.wave, NGW = F.G * NWAVES, lane = f_lane, sub = lane >> 4, l16 = lane & 15;
    constexpr int NIT = 2 * S * NH / 4;
    for (int it = gw; it < NIT; it += NGW) {
        const int item = it * 4 + sub;
        const int t = item / (S * NH);
        bf16* ptr = qkv + (size_t)t * ((size_t)S * WF) + (size_t)(item - t * (S * NH)) * HD + l16 * 8;
        const float* g = (t ? gk : gq) + l16 * 8;
        const v4u w = *(const v4u*)ptr;
        float v[8] = {bflo(w.x), bfhi(w.x), bflo(w.y), bfhi(w.y), bflo(w.z), bfhi(w.z), bflo(w.w), bfhi(w.w)};
        float s = 0.f;
#pragma unroll
        for (int j = 0; j < 8; ++j) s += v[j] * v[j];
        s += __shfl_xor(s, 1); s += __shfl_xor(s, 2); s += __shfl_xor(s, 4); s += __shfl_xor(s, 8);
        const float r = rsqrtf(s * (1.0f / HD) + EPS);
        const f32x4 g0 = *(const f32x4*)g, g1 = *(const f32x4*)(g + 4);
        v4u o; o.x = pk2(v[0] * r * g0[0], v[1] * r * g0[1]); o.y = pk2(v[2] * r * g0[2], v[3] * r * g0[3]); o.z = pk2(v[4] * r * g1[0], v[5] * r * g1[1]); o.w = pk2(v[6] * r * g1[2], v[7] * r * g1[3]);
        *(v4u*)ptr = o;
    }
    {
        const bf16* xb = (const bf16*)(ws + WS_XB); const bf16* wtf = (const bf16*)(ws + WS_WTF); const float* ss1 = (const float*)(ws + WS_SS1); const float* b_f = P.in[4];
        float* logf = (float*)(ws + WS_LOGF);
        LAS float* fbuf = (LAS float*)(F.lds + RING_OFF);
        const int wave = F.wave, rl = lane & 31, kg = lane >> 5;
        for (int grp = blockIdx.x; grp < S / 32; grp += F.G) {
            const int r0 = grp * 32;
            const bf16* pa = xb + (size_t)(r0 + rl) * DM + 512 * wave + 8 * kg;
            const bf16* pb = wtf + (size_t)(rl & 15) * DM + 512 * wave + 8 * kg;
            f32x16 acc = {};
#pragma unroll 8
            for (int ks = 0; ks < 32; ++ks) {
                const bf16x8 a = *(const bf16x8*)(pa + 16 * ks);
                bf16x8 b = *(const bf16x8*)(pb + 16 * ks);
                if (rl >= 16) b = (bf16x8){0, 0, 0, 0, 0, 0, 0, 0};
                acc = __builtin_amdgcn_mfma_f32_32x32x16_bf16(a, b, acc, 0, 0, 0);
            }
            if (rl < 16) {
#pragma unroll
                for (int r = 0; r < 16; ++r) { const int tok = (r & 3) + 8 * (r >> 2) + 4 * kg; fbuf[(wave * 32 + tok) * 16 + rl] = acc[r]; }
            }
            __syncthreads();
            {
                const int tok = f_tid >> 4, h = f_tid & 15; float fv = 0.f;
#pragma unroll
                for (int w = 0; w < 8; ++w) fv += fbuf[(w * 32 + tok) * 16 + h];
                fv = fv * rsqrtf(ss1[r0 + tok] * (1.0f / DM) + EPS) + b_f[h];
                logf[(size_t)h * S + r0 + tok] = log_sigmoidf_(fv);
            }
            __syncthreads();
        }
    }
}

__device__ __forceinline__ void p5b_convglu(const Frame& F, const Params& P) {
    const int WAVE_ = F.wave; const int f_lane = lane_id(), f_tid = TID();
    unsigned char* ws = P.ws;
    const bf16* up = (const bf16*)(ws + WS_UP); bf16* act = (bf16*)(ws + WS_ACT);
    const float* cw = P.in[12]; const float* cb = P.in[13];
    const int gw = F.vcu * NWAVES + F.wave, NGW = F.G * NWAVES, lane = f_lane;
    constexpr int NCG = (DFF + 511) / 512, RB = 16, NITEMS = NCG * (S / RB);
    for (int it = gw; it < NITEMS; it += NGW) {
        const int cg = it % NCG, rb = it / NCG, j0 = cg * 512 + lane * 8, t0 = rb * RB;
        if (j0 >= DFF) continue;
        float wg[3][8], wv[3][8], bg[8], bv[8];
#pragma unroll
        for (int i = 0; i < 3; ++i) { const f32x4 a = *(const f32x4*)(cw + (size_t)i * 2 * DFF + j0), b = *(const f32x4*)(cw + (size_t)i * 2 * DFF + j0 + 4), c = *(const f32x4*)(cw + (size_t)i * 2 * DFF + DFF + j0), d = *(const f32x4*)(cw + (size_t)i * 2 * DFF + DFF + j0 + 4);
#pragma unroll
            for (int e = 0; e < 4; ++e) { wg[i][e] = a[e]; wg[i][4 + e] = b[e]; wv[i][e] = c[e]; wv[i][4 + e] = d[e]; } }
        { const f32x4 a = *(const f32x4*)(cb + j0), b = *(const f32x4*)(cb + j0 + 4), c = *(const f32x4*)(cb + DFF + j0), d = *(const f32x4*)(cb + DFF + j0 + 4);
#pragma unroll
          for (int e = 0; e < 4; ++e) { bg[e] = a[e]; bg[4 + e] = b[e]; bv[e] = c[e]; bv[4 + e] = d[e]; } }
        v4u gr[RB + 2], vr[RB + 2];
#pragma unroll
        for (int r = 0; r < RB + 2; ++r) { const int t = t0 - 2 + r;
            if (t >= 0) { gr[r] = __builtin_nontemporal_load((const v4u*)(up + (size_t)t * 2 * DFF + j0)); vr[r] = __builtin_nontemporal_load((const v4u*)(up + (size_t)t * 2 * DFF + DFF + j0)); }
            else { gr[r] = (v4u){0u, 0u, 0u, 0u}; vr[r] = gr[r]; } }
#pragma unroll
        for (int r = 0; r < RB; ++r) {
            const int t = t0 + r;
            float o[8];
#pragma unroll
            for (int e = 0; e < 4; ++e) {
                const unsigned a0 = gr[r][e], a1 = gr[r + 1][e], a2 = gr[r + 2][e], c0 = vr[r][e], c1 = vr[r + 1][e], c2 = vr[r + 2][e];
                const float ugl = bg[2 * e] + wg[0][2 * e] * bflo(a0) + wg[1][2 * e] * bflo(a1) + wg[2][2 * e] * bflo(a2);
                const float ugh = bg[2 * e + 1] + wg[0][2 * e + 1] * bfhi(a0) + wg[1][2 * e + 1] * bfhi(a1) + wg[2][2 * e + 1] * bfhi(a2);
                const float uvl = bv[2 * e] + wv[0][2 * e] * bflo(c0) + wv[1][2 * e] * bflo(c1) + wv[2][2 * e] * bflo(c2);
                const float uvh = bv[2 * e + 1] + wv[0][2 * e + 1] * bfhi(c0) + wv[1][2 * e + 1] * bfhi(c1) + wv[2][2 * e + 1] * bfhi(c2);
                o[2 * e] = ugl * sigmoidf_(ugl) * uvl; o[2 * e + 1] = ugh * sigmoidf_(ugh) * uvh;
            }
            v4u w; w.x = pk2(o[0], o[1]); w.y = pk2(o[2], o[3]); w.z = pk2(o[4], o[5]); w.w = pk2(o[6], o[7]);
            *(v4u*)(act + (size_t)t * DFF + j0) = w;
        }
    }
}

namespace att {
constexpr int D = 128, PITCH = 2048, NW = 8, QBLK = 32, KVBLK = 64, QB = NW * QBLK;
constexpr int SHM_V = KVBLK * D * 2, SHM_K = KVBLK * D * 2;
constexpr int OFF_WS = 2 * SHM_V + 2 * SHM_K, OFF_FLAG = OFF_WS + NW * 64 * 4, OFF_WTOT = OFF_FLAG + 64, OFF_C = 73728  , ATT_LDS_BYTES = OFF_C + 32768;
constexpr float SCALE = 0.08838834764831845f;
constexpr float THR = 8.f;
typedef short s16x4 __attribute__((ext_vector_type(4)));
typedef unsigned u32x4 __attribute__((ext_vector_type(4)));
#define KSWZ(row, colB) ((row) * 256 + ((colB) ^ (((row) & 7) << 4)))
#define SBAR() __builtin_amdgcn_sched_barrier(0)
__device__ __forceinline__ int v_st(int k, int c) { const int kk = (k & ~0xC) | ((k & 4) << 1) | ((k & 8) >> 1); return ((kk >> 3) * 4 + (c >> 5)) * 512 + ((kk & 7) * 32 + (c & 31)) * 2; }
__device__ __forceinline__ int v_rd_base(int lane) { return ((lane & 3) << 3) | (((lane >> 2) & 3) << 6) | (((lane >> 4) & 1) << 5) | (((lane >> 5) & 1) << 8); }
constexpr int v_rd_off(int d0, int ks, int half) { return d0 * 512 + ks * 4096 + half * 2048; }
__device__ __forceinline__ int crow(int r, int hi) { return (r & 3) + 8 * (r >> 2) + 4 * hi; }
__device__ __forceinline__ unsigned cvtpk(float lo, float hi) { unsigned r; asm volatile("v_cvt_pk_bf16_f32 %0, %1, %2" : "=v"(r) : "v"(lo), "v"(hi)); return r; }
__device__ __forceinline__ bf16x8 load8(const bf16* p) { return *reinterpret_cast<const bf16x8*>(p); }
__device__ __forceinline__ void mask_tile(f32x16& p0, f32x16& p1, int dq) {
    const float NEG = -__builtin_inff();
#pragma unroll
    for (int r = 0; r < 16; ++r) { const int c = (r & 3) + 8 * (r >> 2); if (dq - c < 0) p0[r] = NEG; if (dq - c - 32 < 0) p1[r] = NEG; }
}
__device__ __forceinline__ void partialSM(f32x16& p0, f32x16& p1, float& m_reg, float& mn, float& alpha) {
    float pmax = p0[0]; for (int r = 1; r < 16; ++r) pmax = fmaxf(pmax, p0[r]); for (int r = 0; r < 16; ++r) pmax = fmaxf(pmax, p1[r]);
    { auto rr = __builtin_amdgcn_permlane32_swap(__float_as_uint(pmax), __float_as_uint(pmax), false, false);
      pmax = fmaxf(__uint_as_float(rr[0]), __uint_as_float(rr[1])); }
    constexpr float C2 = 1.4426950408889634f * SCALE;
    if (__builtin_expect(__all((pmax - m_reg) * SCALE <= THR), 1)) { mn = m_reg; alpha = 1.f; }
    else { mn = fmaxf(m_reg, pmax); alpha = __builtin_amdgcn_exp2f((m_reg - mn) * C2); m_reg = mn; }
    const float mnL = -mn * C2;
    for (int r = 0; r < 16; ++r) p0[r] = fmaf(p0[r], C2, mnL); for (int r = 0; r < 16; ++r) p1[r] = fmaf(p1[r], C2, mnL);
    for (int r = 0; r < 16; ++r) p0[r] = __builtin_amdgcn_exp2f(p0[r]);
}
#define PK4(P, B_, OUT) do { unsigned a0 = cvtpk(P[B_+0], P[B_+1]), a1 = cvtpk(P[B_+2], P[B_+3]);                          \
        unsigned b0 = cvtpk(P[B_+4], P[B_+5]), b1 = cvtpk(P[B_+6], P[B_+7]);                                             \
        auto r0 = __builtin_amdgcn_permlane32_swap(a0, b0, false, false); auto r1 = __builtin_amdgcn_permlane32_swap(a1, b1, false, false); \
        u32x4 w = {r0[0], r1[0], r0[1], r1[1]}; OUT = *reinterpret_cast<bf16x8*>(&w); } while (0)
__device__ __forceinline__ void finishSM(f32x16& p0, f32x16& p1, float alpha, float& l_reg, bf16x8& pa0, bf16x8& pa1, bf16x8& pa2, bf16x8& pa3) {
    for (int r = 0; r < 16; ++r) p1[r] = __builtin_amdgcn_exp2f(p1[r]);
    float ps = 0; for (int r = 0; r < 16; ++r) ps += p0[r]; for (int r = 0; r < 16; ++r) ps += p1[r];
    { auto rr = __builtin_amdgcn_permlane32_swap(__float_as_uint(ps), __float_as_uint(ps), false, false);
      ps = __uint_as_float(rr[0]) + __uint_as_float(rr[1]); }
    l_reg = l_reg * alpha + ps;
    PK4(p0, 0, pa0); PK4(p0, 8, pa1); PK4(p1, 0, pa2); PK4(p1, 8, pa3);
}
template <int KB>
__device__ __forceinline__ void qkt(f32x16& p0, f32x16& p1, const char* K_lds, int r32, int hi, const bf16x8* qr) {
    p0 = f32x16{}; p1 = f32x16{};
    const char* kb[4];
#pragma unroll
    for (int dd = 0; dd < 4; ++dd) kb[dd] = K_lds + KB * SHM_K + KSWZ(r32, (dd * 16 + hi * 8) * 2);
#pragma unroll
    for (int d0 = 0; d0 < 8; ++d0) { const char* a = kb[d0 & 3] + (d0 >> 2) * 128;
        bf16x8 b0 = *reinterpret_cast<const bf16x8*>(a);
        bf16x8 b1 = *reinterpret_cast<const bf16x8*>(a + 32 * 256);
        p0 = __builtin_amdgcn_mfma_f32_32x32x16_bf16(b0, qr[d0], p0, 0, 0, 0);
        p1 = __builtin_amdgcn_mfma_f32_32x32x16_bf16(b1, qr[d0], p1, 0, 0, 0); }
}
template <int VB>
__device__ __forceinline__ void pv_tile(f32x16* o, int vb0, bf16x8 pa0, bf16x8 pa1, bf16x8 pa2, bf16x8 pa3) {
#define TRRD(dst, off) asm volatile("ds_read_b64_tr_b16 %0, %1 offset:%2" : "=&v"(dst) : "v"(vb0), "i"(off) : "memory")
#define PV_D0(d0) do { s16x4 l0, l1, l2, l3, h0, h1, h2, h3; constexpr int b_ = VB * SHM_V + v_rd_off(d0, 0, 0); \
        TRRD(l0, b_); TRRD(h0, b_ + 2048); TRRD(l1, b_ + 4096); TRRD(h1, b_ + 6144); TRRD(l2, b_ + 8192); TRRD(h2, b_ + 10240); TRRD(l3, b_ + 12288); TRRD(h3, b_ + 14336); \
        asm volatile("s_waitcnt lgkmcnt(0)" ::: "memory"); SBAR();   \
        o[d0] = __builtin_amdgcn_mfma_f32_32x32x16_bf16(pa0, (bf16x8){l0[0], l0[1], l0[2], l0[3], h0[0], h0[1], h0[2], h0[3]}, o[d0], 0, 0, 0);   \
        o[d0] = __builtin_amdgcn_mfma_f32_32x32x16_bf16(pa1, (bf16x8){l1[0], l1[1], l1[2], l1[3], h1[0], h1[1], h1[2], h1[3]}, o[d0], 0, 0, 0);   \
        o[d0] = __builtin_amdgcn_mfma_f32_32x32x16_bf16(pa2, (bf16x8){l2[0], l2[1], l2[2], l2[3], h2[0], h2[1], h2[2], h2[3]}, o[d0], 0, 0, 0);   \
        o[d0] = __builtin_amdgcn_mfma_f32_32x32x16_bf16(pa3, (bf16x8){l3[0], l3[1], l3[2], l3[3], h3[0], h3[1], h3[2], h3[3]}, o[d0], 0, 0, 0); } while (0)
    PV_D0(0); PV_D0(1); PV_D0(2); PV_D0(3);
#undef PV_D0
#undef TRRD
}
__device__ __forceinline__ void key_bias(f32x16& p0, f32x16& p1, const char* lds, int kbase, int hi) {
    const float* kbp = (const float*)(lds + OFF_C) + kbase + 4 * hi;
#pragma unroll
    for (int g = 0; g < 4; ++g) { const f32x4 b0 = *(const f32x4*)(kbp + 8 * g), b1 = *(const f32x4*)(kbp + 32 + 8 * g);
#pragma unroll
        for (int e = 0; e < 4; ++e) { p0[4 * g + e] -= b0[e]; p1[4 * g + e] -= b1[e]; } }
}
__device__ __forceinline__ void cgate_scan(const float* logf_h, char* lds, const int WAVE_) {
    const int lane = lane_id(), tid = WAVE_ * 64 + lane;
    float* Cl = (float*)(lds + OFF_C); float* wtot = (float*)(lds + OFF_WTOT);
    const float* src = logf_h + tid * 16;
    const f32x4 a = *(const f32x4*)src, b = *(const f32x4*)(src + 4), c = *(const f32x4*)(src + 8), d = *(const f32x4*)(src + 12);
    const float in[16] = {a[0], a[1], a[2], a[3], b[0], b[1], b[2], b[3], c[0], c[1], c[2], c[3], d[0], d[1], d[2], d[3]};
    float loc[16]; float s = 0.f;
#pragma unroll
    for (int j = 0; j < 16; ++j) { s += in[j]; loc[j] = s; }
    float incl = s;
#pragma unroll
    for (int o = 1; o < 64; o <<= 1) { const float t = __shfl_up(incl, o); if (lane >= o) incl += t; }
    if (lane == 63) wtot[WAVE_] = incl;
    __syncthreads();
    float base = incl - s;
    for (int w = 0; w < WAVE_; ++w) base += wtot[w];
#pragma unroll
    for (int j = 0; j < 16; j += 4) *(f32x4*)(Cl + tid * 16 + j) = (f32x4){base + loc[j], base + loc[j + 1], base + loc[j + 2], base + loc[j + 3]} * (1.0f / SCALE);
    __syncthreads();
}

struct BlockRef { const bf16* Q; const bf16* K; const bf16* V; bf16* O; int P0; };
struct Seam { bf16x8 qr[8]; bf16x8 st_v0, st_v1, st_k0, st_k1; };
#define ROW(p, k0, rr) ((p) + (size_t)((k0) + (rr)) * PITCH + sc)
#define VMW() asm volatile("s_waitcnt vmcnt(0)" ::: "memory")
#define VMWN(n) asm volatile("s_waitcnt vmcnt(%0)" :: "i"(n) : "memory")
#define SLOAD_H(Kp, Vp, k0) do { S.st_v0 = load8(ROW(Vp, k0, sr)); S.st_v1 = load8(ROW(Vp, k0, 32 + sr));              \
                         S.st_k0 = load8(ROW(Kp, k0, sr)); S.st_k1 = load8(ROW(Kp, k0, 32 + sr)); } while (0)
#define SWRITE_HK(bf) do { *(bf16x8*)(K_lds + (bf) * SHM_K + kws) = S.st_k0; *(bf16x8*)(K_lds + (bf) * SHM_K + kws + 32 * 256) = S.st_k1; } while (0)
#define SWRITE_HV(bf) do { *(bf16x8*)(V_lds + (bf) * SHM_V + vst0) = S.st_v0; *(bf16x8*)(V_lds + (bf) * SHM_V + vst1) = S.st_v1; } while (0)
#define SWRITE_H(bf) do { SWRITE_HV(bf); SWRITE_HK(bf); } while (0)
__device__ __forceinline__ void fox_prime(const BlockRef& cur, char* lds, Seam& S, const int WAVE_) {
    const int tid = TID(), wid = __builtin_amdgcn_readfirstlane(tid >> 6), lane = tid & 63, r32 = lane & 31, hi = lane >> 5;
    const int sr = tid >> 4, sc = (tid & 15) * 8, kws = KSWZ(sr, sc * 2); char* K_lds = lds + 2 * SHM_V;
    for (int d0 = 0; d0 < 8; ++d0) S.qr[d0] = load8(cur.Q + (size_t)(wid * QBLK + r32) * PITCH + d0 * 16 + hi * 8);
    SLOAD_H(cur.K, cur.V, 0); VMW(); SWRITE_HK(0);
    __syncthreads();
}
__device__ __forceinline__ void fox_block(const BlockRef& cur, const BlockRef& nxt, char* lds, Seam& S, const int WAVE_) {
    const int tid = TID(), wid = __builtin_amdgcn_readfirstlane(tid >> 6), lane = tid & 63, r32 = lane & 31, hi = lane >> 5;
    const int NT = (cur.P0 + QB - 1) / KVBLK + 1;
    const int qlo = cur.P0 + wid * QBLK, qm = qlo + r32 - 4 * hi;
    char* V_lds = lds; char* K_lds = lds + 2 * SHM_V;
    float* ws = (float*)(lds + OFF_WS) + wid * 64; float* li_l = ws, * al_l = ws + 32;
    float m_reg = -1e30f, l_reg = 0; f32x16 o[4] = {};
    const int sr = tid >> 4, sc = (tid & 15) * 8, vst0 = v_st(sr, sc), vst1 = v_st(32 + sr, sc), kws = KSWZ(sr, sc * 2);
    const int vb0 = (int)(uintptr_t)V_lds + v_rd_base(lane);
    const bf16* Kh = cur.K; const bf16* Vh = cur.V;
#define RESC(a) do { if (__any((a) < 1.f)) { if (hi == 0) al_l[r32] = (a); asm volatile("s_waitcnt lgkmcnt(0)" ::: "memory");              \
                     for (int d_ = 0; d_ < 4; ++d_) for (int r = 0; r < 16; ++r) o[d_][r] *= al_l[crow(r, hi)]; } } while (0)
#define KBASE(t) ((t) * KVBLK)
#define MASKT(P0_, P1_, t, KBUF) do { const int kb_ = KBASE(t); key_bias(P0_, P1_, lds, kb_, hi); if (kb_ + KVBLK - 1 > qlo) mask_tile(P0_, P1_, qm - kb_); } while (0)
#define SEAM_K0() do { VMWN(8); SWRITE_HK(0); SBAR(); } while (0)
    f32x16 pA0, pA1, pB0, pB1; float mnA, mnB, alA, alB; bf16x8 pa0, pa1, pa2, pa3;
    SWRITE_HV(0); SBAR();
    if (NT > 1) { SLOAD_H(Kh, Vh, KBASE(1)); }
    SBAR(); qkt<0>(pA0, pA1, K_lds, r32, hi, S.qr);
    MASKT(pA0, pA1, 0, 0); partialSM(pA0, pA1, m_reg, mnA, alA);
    if (NT > 1) { VMW(); SWRITE_H(1); }
    __syncthreads();
#define HALF_STEP(PX0, PX1, mnX, alX, PY0, PY1, alY, t, KB, VB, SB) do {                                                      \
        SBAR(); qkt<KB>(PX0, PX1, K_lds, r32, hi, S.qr);                                                                     \
        finishSM(PY0, PY1, alY, l_reg, pa0, pa1, pa2, pa3); SBAR();                                                           \
        if ((t) + 1 < NT) { SLOAD_H(Kh, Vh, KBASE((t) + 1)); SBAR(); }                                                    \
        pv_tile<VB>(o, vb0, pa0, pa1, pa2, pa3); MASKT(PX0, PX1, (t), KB); partialSM(PX0, PX1, m_reg, mnX, alX);             \
        __syncthreads();                                                                                                      \
        if ((t) + 1 < NT) { VMW(); SWRITE_H(SB); }                                                                            \
        RESC(alX); __syncthreads(); } while (0)
    for (int t = 1; t + 1 < NT; t += 2) {
        HALF_STEP(pB0, pB1, mnB, alB, pA0, pA1, alA, t, 1, 0, 0);
        HALF_STEP(pA0, pA1, mnA, alA, pB0, pB1, alB, t + 1, 0, 1, 1);
    }
    const bool even = (NT & 1) == 0;
    if (even) { SBAR(); qkt<1>(pB0, pB1, K_lds, r32, hi, S.qr); SBAR(); }
    SLOAD_H(nxt.K, nxt.V, 0); SBAR();
#pragma unroll
    for (int d0 = 0; d0 < 8; ++d0) S.qr[d0] = load8(nxt.Q + (size_t)(wid * QBLK + r32) * PITCH + d0 * 16 + hi * 8);
    SBAR();
    finishSM(pA0, pA1, alA, l_reg, pa0, pa1, pa2, pa3); SBAR();
    pv_tile<0>(o, vb0, pa0, pa1, pa2, pa3);
    if (even) { MASKT(pB0, pB1, NT - 1, 1); partialSM(pB0, pB1, m_reg, mnB, alB); __syncthreads(); RESC(alB);
        finishSM(pB0, pB1, alB, l_reg, pa0, pa1, pa2, pa3); SBAR(); pv_tile<1>(o, vb0, pa0, pa1, pa2, pa3); }
    SBAR(); SEAM_K0();
    if (hi == 0) li_l[r32] = l_reg; asm volatile("s_waitcnt lgkmcnt(0)" ::: "memory");
    float rli[16];
#pragma unroll
    for (int r = 0; r < 16; ++r) rli[r] = __builtin_amdgcn_rcpf(li_l[crow(r, hi)]);
    bf16* Ow = cur.O + (size_t)(wid * QBLK) * PITCH;
#pragma unroll
    for (int r = 0; r < 16; ++r) { const int orow = crow(r, hi);
#pragma unroll
        for (int d0 = 0; d0 < 4; ++d0) { const float v = o[d0][r] * rli[r];
            const float vn = __shfl_xor(v, 1);
            if ((r32 & 1) == 0) *(unsigned*)(Ow + (size_t)orow * PITCH + d0 * 32 + r32) = cvtpk(v, vn); } }
    __syncthreads();
#undef RESC
#undef MASKT
#undef SEAM_K0
#undef HALF_STEP
}

template <int BUF>
__device__ __forceinline__ void sb_tile(f32x16* o, float& R, const char* K_lds, int vb0, int r32, int hi, const bf16x8* qr, int dq) {
    f32x16 p0, p1;
    qkt<BUF>(p0, p1, K_lds, r32, hi, qr);
    constexpr float L2E = 1.4426950408889634f, LN2 = 0.6931471805599453f;
    f32x16 l0, l1;
    const float NEG = -__builtin_inff();
#pragma unroll
    for (int r = 0; r < 16; ++r) { const int c = (r & 3) + 8 * (r >> 2);
        { const float z = p0[r] * SCALE; const float sp = fmaxf(z, 0.f) + LN2 * __builtin_amdgcn_logf(1.0f + __builtin_amdgcn_exp2f(-fabsf(z) * L2E)); const bool st = (dq - c) >= 1; l0[r] = st ? -sp : 0.f; p0[r] = st ? (z - sp) : NEG; }
        { const float z = p1[r] * SCALE; const float sp = fmaxf(z, 0.f) + LN2 * __builtin_amdgcn_logf(1.0f + __builtin_amdgcn_exp2f(-fabsf(z) * L2E)); const bool st = (dq - c - 32) >= 1; l1[r] = st ? -sp : 0.f; p1[r] = st ? (z - sp) : NEG; } }
    float gs[8], pg[8], ps[8];
#pragma unroll
    for (int g = 0; g < 4; ++g) { gs[g] = (l0[4 * g] + l0[4 * g + 1]) + (l0[4 * g + 2] + l0[4 * g + 3]); gs[4 + g] = (l1[4 * g] + l1[4 * g + 1]) + (l1[4 * g + 2] + l1[4 * g + 3]); }
#pragma unroll
    for (int g = 0; g < 8; ++g) { auto rr = __builtin_amdgcn_permlane32_swap(__float_as_uint(gs[g]), __float_as_uint(gs[g]), false, false);
        const float lo = __uint_as_float(rr[0]), hv = __uint_as_float(rr[1]); ps[g] = lo + hv; pg[g] = hi ? lo : hv; }
    float acc = R;
#pragma unroll
    for (int g = 7; g >= 0; --g) {
        float run = hi ? acc : acc + pg[g];
        acc += ps[g];
        if (g >= 4) { const int b = 4 * (g - 4);
#pragma unroll
            for (int e = 3; e >= 0; --e) { const float t = l1[b + e]; p1[b + e] = __builtin_amdgcn_exp2f((p1[b + e] + run) * L2E); run += t; } }
        else { const int b = 4 * g;
#pragma unroll
            for (int e = 3; e >= 0; --e) { const float t = l0[b + e]; p0[b + e] = __builtin_amdgcn_exp2f((p0[b + e] + run) * L2E); run += t; } }
    }
    R = acc;
    bf16x8 pa0, pa1, pa2, pa3;
    PK4(p0, 0, pa0); PK4(p0, 8, pa1); PK4(p1, 0, pa2); PK4(p1, 8, pa3);
    pv_tile<BUF>(o, vb0, pa0, pa1, pa2, pa3);
}
__device__ __forceinline__ void sb_block(const BlockRef& cur, char* lds, const int WAVE_) {
    const int tid = TID(), wid = __builtin_amdgcn_readfirstlane(tid >> 6), lane = tid & 63, r32 = lane & 31, hi = lane >> 5;
    const int NT = (cur.P0 + QB - 1) / KVBLK + 1;
    const int qlo = cur.P0 + wid * QBLK, qm = qlo + r32 - 4 * hi;
    char* V_lds = lds; char* K_lds = lds + 2 * SHM_V;
    volatile LAS int* flg = (volatile LAS int*)(lds + OFF_FLAG);
    const int sr = tid >> 4, sc = (tid & 15) * 8, vst0 = v_st(sr, sc), vst1 = v_st(32 + sr, sc), kws = KSWZ(sr, sc * 2);
    const int vb0 = (int)(uintptr_t)V_lds + v_rd_base(lane);
    const bf16* Kh = cur.K; const bf16* Vh = cur.V;
    bf16x8 qr[8];
#pragma unroll
    for (int d0 = 0; d0 < 8; ++d0) qr[d0] = load8(cur.Q + (size_t)(wid * QBLK + r32) * PITCH + d0 * 16 + hi * 8);
    bf16x8 st_v0, st_v1, st_k0, st_k1;
#define SB_LOAD(k0) do { st_v0 = load8(ROW(Vh, k0, sr)); st_v1 = load8(ROW(Vh, k0, 32 + sr)); st_k0 = load8(ROW(Kh, k0, sr)); st_k1 = load8(ROW(Kh, k0, 32 + sr)); } while (0)
#define SB_WRITE(bf) do { *(bf16x8*)(V_lds + (bf) * SHM_V + vst0) = st_v0; *(bf16x8*)(V_lds + (bf) * SHM_V + vst1) = st_v1; \
                          *(bf16x8*)(K_lds + (bf) * SHM_K + kws) = st_k0; *(bf16x8*)(K_lds + (bf) * SHM_K + kws + 32 * 256) = st_k1; } while (0)
    f32x16 o[4] = {}; float R = 0.f; bool fin = false;
    SB_LOAD((NT - 1) * KVBLK); VMW(); SB_WRITE(0);
    if (NT > 1) SB_LOAD((NT - 2) * KVBLK);
    __syncthreads();
#define SB_STEP(t, BUF) do { const int kb_ = (NT - 1 - (t)) * KVBLK;                                                         \
        if (!fin && kb_ <= qlo + QBLK - 2) { sb_tile<BUF>(o, R, K_lds, vb0, r32, hi, qr, qm - kb_); fin = __all(R < -105.f); } \
        if ((t) + 1 < NT) { VMW(); SB_WRITE((BUF) ^ 1); if ((t) + 2 < NT) SB_LOAD((NT - 3 - (t)) * KVBLK); }                   \
        if (lane == 0) flg[(BUF) * 8 + wid] = fin ? 1 : 0;                                                                   \
        __syncthreads();                                                                                                      \
        { int all_ = 1; _Pragma("unroll") for (int w_ = 0; w_ < 8; ++w_) all_ &= flg[(BUF) * 8 + w_]; stop = all_ != 0; } } while (0)
    bool stop = false;
    for (int t = 0; t < NT; t += 2) {
        SB_STEP(t, 0);
        if (stop || t + 1 >= NT) break;
        SB_STEP(t + 1, 1);
        if (stop) break;
    }
    bf16* Ow = cur.O + (size_t)(wid * QBLK) * PITCH;
#pragma unroll
    for (int r = 0; r < 16; ++r) { const int orow = crow(r, hi);
#pragma unroll
        for (int d0 = 0; d0 < 4; ++d0) { const float v = o[d0][r];
            const float vn = __shfl_xor(v, 1);
            if ((r32 & 1) == 0) *(unsigned*)(Ow + (size_t)orow * PITCH + d0 * 32 + r32) = cvtpk(v, vn); } }
    __syncthreads();
#undef SB_LOAD
#undef SB_WRITE
#undef SB_STEP
}
#undef ROW
#undef VMW
#undef VMWN
#undef SLOAD_H
#undef SWRITE_HK
#undef SWRITE_HV
#undef SWRITE_H
#undef PK4
#undef KSWZ
}

constexpr int REP_X3 = 0;
constexpr int REP_X2 = 0;
constexpr int X1_ALIGN = 1, X1_SP2 = 1;
constexpr int REP_X1 = 0, REP_X1N = 20480;
constexpr int REP_P0W = 1, REP_P0R = 1;
constexpr int REP_P0 = 1, REP_P1 = 1, REP_FOX = 1, REP_SB = 1, REP_P3A = 1, REP_P5 = 1, REP_P5B = 1, REP_P7A = 1;
enum { PH_P0 = 0, PH_P1, PH_P1B, PH_ATT, PH_P3A, PH_P3B, PH_P4, PH_P5, PH_P5B, PH_P6, PH_P7A, PH_P7, PH_N };
__global__ void __launch_bounds__(NWAVES * 64, 2) mega_fwd(Params P) {
    extern __shared__ __attribute__((aligned(16))) unsigned char lds[];
    Frame F;
    F.lds = (LAS unsigned char*)lds;
    F.MISC = (volatile LAS unsigned*)(F.lds + MISC_OFF);
    F.wave = __builtin_amdgcn_readfirstlane((int)(__builtin_amdgcn_workitem_id_x() >> 6));
    const int WAVE_ = F.wave; const int f_tid = TID();
    F.G = gridDim.x; { const int bx = blockIdx.x; F.vcu = (F.G % 8 == 0) ? (bx % 8) * (F.G / 8) + bx / 8 : bx; }
    unsigned char* ws = P.ws;
    F.ctl = (gu32*)(ws + WS_CTL);
    for (int u = f_tid; u < (LDS_BYTES - LDSCTL_OFF) / 4; u += NWAVES * 64) ((LAS unsigned*)(F.lds + LDSCTL_OFF))[u] = 0u;
    __syncthreads();
    XcdBarrier bar = xcd_barrier_post((unsigned*)(F.ctl + CW_BAR) + P.li * XCD_BAR_WORDS, F.MISC + 8, F.wave);
    const int lo = P.ph_lo, hi = P.ph_hi;
#define IN(k) (lo <= (k) && (k) < hi)
#define SEAM(k) do { if (IN(k) && IN((k) + 1)) xcd_barrier(bar); } while (0)
    bf16* W_in = (bf16*)(ws + WS_WIN); bf16* XB = (bf16*)(ws + WS_XB);
    float* ss1 = (float*)(ws + WS_SS1); float* ss2 = (float*)(F.ctl + CW_SS2); float* ss3 = (float*)(F.ctl + CW_SS3);
    bf16* QKV = (bf16*)(ws + WS_QKV); bf16* GATES = (bf16*)(ws + WS_GATES); bf16* Y = (bf16*)(ws + WS_Y); bf16* MERGED = (bf16*)(ws + WS_MERGED);
    LAS unsigned char* ring = F.lds + RING_OFF;

    if (IN(PH_P0)) { for (int rep = 0; rep < REP_P0; ++rep) { for (int r2 = 0; r2 < REP_P0W; ++r2) p0_weights(F, P); for (int r2 = 0; r2 < REP_P0R; ++r2) p0_rows(F, P); } }
    SEAM(PH_P0);
    if (IN(PH_P1)) { for (int rep = 0; rep < REP_P1; ++rep) {
        pg8::Gemm g{XB, W_in, S, NPROJ, DM}; pg8::StaticOrder So; So.init(S, NPROJ, F.G, (int)blockIdx.x);
        pg8::EpiProj E{QKV, GATES, ss1};
        pg8::gemm_phase<pg8::EpiProj, pg8::StaticOrder, true, true>(ring, g, So, E, F.wave);
    } }
    if (IN(PH_P1)) { for (int rep = 0; rep < REP_X1; ++rep) {
        pg8::Gemm g{XB, W_in, S, REP_X1N, DM}; pg8::StaticOrder So; So.init(S, REP_X1N, F.G, (int)blockIdx.x);
        pg8::EpiNull E{};
        pg8::gemm_phase<pg8::EpiNull, pg8::StaticOrder, true, true>(ring, g, So, E, F.wave);
    } }
    if (IN(PH_P1)) { for (int rep = 0; rep < REP_X2; ++rep) {
        struct SameOrder : pg8::StaticOrder { __device__ bool next(int i, pg8::Unit& u) const { const bool ok = pg8::StaticOrder::next(i, u); u.pm = 0; u.pn = 0; return ok; } };
        pg8::Gemm g{XB, W_in, S, NPROJ, DM}; SameOrder So; So.init(S, NPROJ, F.G, (int)blockIdx.x);
        pg8::EpiNull E{};
        pg8::gemm_phase<pg8::EpiNull, SameOrder, true, true>(ring, g, So, E, F.wave);
    } }
    if (IN(PH_P1)) { for (int rep = 0; rep < REP_X3; ++rep) {
        const long long c0 = clock64();
        pg8::Gemm g{XB, W_in, S, NPROJ, DM}; pg8::StaticOrder So; So.init(S, NPROJ, F.G, (int)blockIdx.x);
        pg8::EpiNull E{};
        pg8::gemm_phase<pg8::EpiNull, pg8::StaticOrder, true, true>(ring, g, So, E, F.wave);
        const long long extra = (clock64() - c0) >> 7; const long long t1 = wall_clock64();
        while (wall_clock64() - t1 < extra) __builtin_amdgcn_s_sleep(10);
    } }
    SEAM(PH_P1);
    if (IN(PH_P1B)) { p1b_qknorm_fgate(F, P); }
    SEAM(PH_P1B);
    if (IN(PH_ATT)) {
        char* al = (char*)lds + RING_OFF;
        const size_t T = (size_t)S * WF;
        for (int rep = 0; rep < REP_FOX; ++rep)
        for (int L = F.vcu; L < NH * 16; L += F.G) {
            const int h = L >> 4, x = L & 15;
            att::BlockRef b0, b1;
            b0.Q = QKV + (size_t)(x * 256) * WF + h * HD; b0.K = QKV + T + h * HD; b0.V = QKV + 2 * T + h * HD; b0.O = Y + (size_t)(x * 256) * WF + h * HD; b0.P0 = x * 256;
            b1 = b0; b1.Q = QKV + (size_t)((31 - x) * 256) * WF + h * HD; b1.O = Y + (size_t)((31 - x) * 256) * WF + h * HD; b1.P0 = (31 - x) * 256;
            att::cgate_scan((const float*)(ws + WS_LOGF) + (size_t)h * S, al, F.wave);
            att::Seam Sm;
            att::fox_prime(b0, al, Sm, F.wave);
            att::fox_block(b0, b1, al, Sm, F.wave);
            att::fox_block(b1, b1, al, Sm, F.wave);
        }
        for (int rep = 0; rep < REP_SB; ++rep)
        for (int L = F.vcu; L < NH * 32; L += F.G) {
            const int h = L >> 5, qb = L & 31;
            att::BlockRef b;
            b.Q = QKV + 3 * T + (size_t)(qb * 256) * WF + h * HD; b.K = QKV + 4 * T + h * HD; b.V = QKV + 5 * T + h * HD; b.O = Y + T + (size_t)(qb * 256) * WF + h * HD; b.P0 = qb * 256;
            att::sb_block(b, al, F.wave);
        }
    }
    SEAM(PH_ATT);
    if (IN(PH_P3A)) {
        pg8::Gemm g{Y, (bf16*)(ws + WS_WBF), S, DM, WF}; pg8::TwoPartOrder So; So.init(S, DM, F.G, (int)blockIdx.x); So.A1 = Y + (size_t)S * WF; So.B1 = (bf16*)(ws + WS_WBS);
        pg8::EpiGate2 E{MERGED, GATES, GATES + (size_t)S * DM};
        pg8::gemm_phase<pg8::EpiGate2, pg8::TwoPartOrder, true, true>(ring, g, So, E, F.wave);
    }
    SEAM(PH_P3B);
    if (IN(PH_P4)) {
        pg8::Gemm g{MERGED, (bf16*)(ws + WS_WOUT), S, DM, DM}; pg8::StaticOrder So; So.init(S, DM, F.G, (int)blockIdx.x);
        pg8::EpiResStat E{P.in[0], P.out, XB, ss2};
        pg8::gemm_phase<pg8::EpiResStat, pg8::StaticOrder, true, true>(ring, g, So, E, F.wave);
    }
    SEAM(PH_P4);
    if (IN(PH_P5)) { for (int rep = 0; rep < REP_P5; ++rep) {
        pg8::Gemm g{XB, (bf16*)(ws + WS_WUP), S, 2 * DFF, DM}; pg8::StaticOrder So; So.init(S, 2 * DFF, F.G, (int)blockIdx.x);
        pg8::EpiUp E{(bf16*)(ws + WS_UP), 2 * DFF, ss2};
        pg8::gemm_phase<pg8::EpiUp, pg8::StaticOrder, true, true>(ring, g, So, E, F.wave);
    } }
    SEAM(PH_P5);
    if (IN(PH_P5B)) { for (int rep = 0; rep < REP_P5B; ++rep) p5b_convglu(F, P); }
    SEAM(PH_P5B);
    if (IN(PH_P6)) {
        pg8::Gemm g{(bf16*)(ws + WS_ACT), (bf16*)(ws + WS_WDN), S, DM, DFF}; pg8::StaticOrder So; So.init(S, DM, F.G, (int)blockIdx.x);
        pg8::EpiResStat E{P.out, P.out, XB, ss3};
        pg8::gemm_phase<pg8::EpiResStat, pg8::StaticOrder, true, true>(ring, g, So, E, F.wave);
    }
    SEAM(PH_P6);
    if (IN(PH_P7A)) { for (int rep = 0; rep < REP_P7A; ++rep) {
        pg8::Gemm g{(bf16*)(ws + WS_PB), (bf16*)(ws + WS_WPP), S, DM, PLE}; pg8::StaticOrder So; So.init(S, DM, F.G, (int)blockIdx.x);
        pg8::EpiStoreBf16x4 E{(bf16*)(ws + WS_PP)};
        pg8::gemm_phase<pg8::EpiStoreBf16x4, pg8::StaticOrder, true, true>(ring, g, So, E, F.wave);
    } }
    if (IN(PH_P7)) {
        pg8::Gemm g{XB, (bf16*)(ws + WS_WPG), S, DM, DM}; pg8::StaticOrder So; So.init(S, DM, F.G, (int)blockIdx.x);
        pg8::EpiPle E{P.out, (const bf16*)(ws + WS_PP), ss3};
        pg8::gemm_phase<pg8::EpiPle, pg8::StaticOrder, true, true>(ring, g, So, E, F.wave);
    }
#undef IN
#undef SEAM
}

extern "C" void kernel_launch(void* const* d_in, const int* in_sizes, int n_in, void* d_out, int out_size, void* d_ws, size_t ws_size, hipStream_t stream) {
    static int grid = 0;
    if (grid == 0) {
        if (n_in != 18 || out_size != S * DM || ws_size < WS_END) { fprintf(stderr, "kernel_launch: unexpected shapes / workspace (%d inputs, out %d, ws %zu < %zu)\n", n_in, out_size, ws_size, (size_t)WS_END); grid = -1; return; }
        int dev = 0, cus = 0, per_cu = 0;
        if (hipGetDevice(&dev) != hipSuccess || hipDeviceGetAttribute(&cus, hipDeviceAttributeMultiprocessorCount, dev) != hipSuccess) { grid = -1; return; }
        if (hipFuncSetAttribute((const void*)mega_fwd, hipFuncAttributeMaxDynamicSharedMemorySize, LDS_BYTES) != hipSuccess) { fprintf(stderr, "kernel_launch: hipFuncSetAttribute failed\n"); grid = -1; return; }
        if (hipOccupancyMaxActiveBlocksPerMultiprocessor(&per_cu, (const void*)mega_fwd, NWAVES * 64, LDS_BYTES) != hipSuccess || per_cu < 1)
            fprintf(stderr, "kernel_launch: note: occupancy query reports %d workgroups per CU\n", per_cu);
        (void)hipGetLastError();
        grid = cus;
    }
    if (grid < 0) return;
    if (hipMemsetAsync((char*)d_ws + WS_CTL, 0, CTL_ZERO_BYTES, stream) != hipSuccess) return;
    Params a{};
    for (int i = 0; i < 18; ++i) a.in[i] = (const float*)d_in[i];
    a.out = (float*)d_out; a.ws = (unsigned char*)d_ws;
    a.ph_lo = PH_P0; a.ph_hi = PH_N; a.li = 0;
    hipLaunchKernelGGL(mega_fwd, dim3(grid), dim3(NWAVES * 64), LDS_BYTES, stream, a);
}
```

```cpp
#include <hip/hip_runtime.h>
#include <cstdio>
#include <cstdint>
__device__ __forceinline__ int lane_id() { int l; asm volatile("v_mbcnt_lo_u32_b32 %0, -1, 0\n\tv_mbcnt_hi_u32_b32 %0, -1, %0" : "=v"(l)); return l; }
#define TID() (WAVE_ * 64 + lane_id())
namespace pg8 {
#define PG8_LAS __attribute__((address_space(3)))
typedef unsigned short bf16_t;
typedef short bf16x8 __attribute__((ext_vector_type(8)));
typedef float f32x4 __attribute__((ext_vector_type(4)));
typedef unsigned u32x4 __attribute__((ext_vector_type(4)));
constexpr int BM = 256, BK = 64, HALF = 128, HTB = HALF * BK * 2  , STAGE_BYTES = 8 * HTB, NXCD = 8, WGM = 8;

__host__ __device__ __forceinline__ int lds_byte(int r, int c) { const int st = (r >> 4) * 2 + (c >> 5), rr = r & 15, cc = c & 31, ob = rr * 64 + cc * 2; return st * 1024 + (ob ^ (((ob >> 9) & 1) << 5)); }
__host__ __device__ __forceinline__ void stage_rc(int b, int& R, int& C) { const int st = b / 1024, sb = b % 1024, swz = sb ^ (((sb >> 9) & 1) << 5); R = (st >> 1) * 16 + swz / 64; C = (st & 1) * 32 + (swz % 64) / 2; }
__host__ __device__ __forceinline__ int perm32(int rho) { const int n = rho >> 4, i = rho & 15; return 8 * (i >> 2) + 4 * n + (i & 3); }

struct Unit { int pm, pn, part; };
struct Gemm { const bf16_t* A; const bf16_t* Bt; int M, N, K; };

struct StaticOrder {
    int nM, nN, nwg, G, c;
    __host__ __device__ void init(int M, int N, int G_, int c_) { nM = M / BM; nN = N / BM; nwg = nM * nN; G = G_; c = c_; }
    __host__ __device__ bool next(int i, Unit& u) const {
        const long L = (long)i * G + c; if (L >= nwg) return false;
        int wgid = (int)L; { const int q = nwg / NXCD, r = nwg % NXCD, xcd = wgid % NXCD, off = wgid / NXCD; wgid = (xcd < r ? xcd * (q + 1) : r * (q + 1) + (xcd - r) * q) + off; }
        const int nig = WGM * nN, gid = wgid / nig, fm = gid * WGM, gsz = (nM - fm) < WGM ? (nM - fm) : WGM;
        u.pm = fm + ((wgid % nig) % gsz); u.pn = (wgid % nig) / gsz; return true;
    }
    __device__ __forceinline__ void a_ready(const Unit&) const {}
    __device__ __forceinline__ void done(const Unit&) const {}
    __device__ __forceinline__ const bf16_t* baseA(const Gemm& g, const Unit&) const { return g.A; }
    __device__ __forceinline__ const bf16_t* baseB(const Gemm& g, const Unit&) const { return g.Bt; }
    __device__ __forceinline__ bool zero_after(const Unit&) const { return true; }
};

__device__ __forceinline__ unsigned cvt_pk_bf16(float lo, float hi) { unsigned r; asm volatile("v_cvt_pk_bf16_f32 %0, %1, %2" : "=v"(r) : "v"(lo), "v"(hi)); return r; }
typedef float f32x2 __attribute__((ext_vector_type(2)));
constexpr int SEQ_ = 8192, DM_ = 4096;
constexpr float EPS_ = 1e-6f;
__device__ __forceinline__ float sigm(float v) { return __builtin_amdgcn_rcpf(1.0f + __builtin_amdgcn_exp2f(-1.4426950408889634f * v)); }
__device__ __forceinline__ float rs_of(float ss) { return __builtin_amdgcn_rsqf(ss * (1.0f / DM_) + EPS_); }
typedef unsigned u32x2 __attribute__((ext_vector_type(2)));
__device__ __forceinline__ f32x4 bf4_to_f32(u32x2 w) { return (f32x4){__uint_as_float(w.x << 16), __uint_as_float(w.x & 0xffff0000u), __uint_as_float(w.y << 16), __uint_as_float(w.y & 0xffff0000u)}; }

struct EpiProj {
    static constexpr bool PERM = true, AFTER_DRAIN = false;
    bf16_t* qkv; bf16_t* gates; const float* ss;
    __device__ __forceinline__ void operator()(const f32x4 (&acc)[2][2][4][2], const Unit& u, int wr, int wc, int fr, int fq) const {
        const int row0 = u.pm * BM + wr * 64 + fr;
        bf16_t* base; int ldc, colt; const bool gate = u.pn >= 48;
        if (!gate) { base = qkv + (size_t)(u.pn >> 3) * ((size_t)SEQ_ * 2048); ldc = 2048; colt = (u.pn & 7) * 256; }
        else { const int t = u.pn - 48; base = gates + (size_t)(t >> 4) * ((size_t)SEQ_ * 4096); ldc = 4096; colt = (t & 15) * 256; }
        const int col0 = colt + wc * 32 + 8 * fq;
#pragma unroll
        for (int ai = 0; ai < 2; ++ai)
#pragma unroll
            for (int m = 0; m < 4; ++m) { const int r = row0 + ai * HALF + m * 16; const float rs = rs_of(ss[r]); bf16_t* rowp = base + (size_t)r * ldc + col0;
#pragma unroll
                for (int bj = 0; bj < 2; ++bj) { f32x4 v0 = acc[ai][bj][m][0] * rs, v1 = acc[ai][bj][m][1] * rs;
                    if (gate) {
#pragma unroll
                        for (int j = 0; j < 4; ++j) { v0[j] = sigm(v0[j]); v1[j] = sigm(v1[j]); } }
                    u32x4 w; w.x = cvt_pk_bf16(v0[0], v0[1]); w.y = cvt_pk_bf16(v0[2], v0[3]); w.z = cvt_pk_bf16(v1[0], v1[1]); w.w = cvt_pk_bf16(v1[2], v1[3]);
                    *(u32x4*)(rowp + bj * HALF) = w; } }
    }
};
struct EpiGateA {
    static constexpr bool PERM = false, AFTER_DRAIN = false;
    float* tmp; const bf16_t* sg;
    __device__ __forceinline__ void operator()(const f32x4 (&acc)[2][2][4][2], const Unit& u, int wr, int wc, int fr, int fq) const {
        const int row0 = u.pm * BM + wr * 64 + fr, col0 = u.pn * BM + wc * 32 + 4 * fq;
#pragma unroll
        for (int ai = 0; ai < 2; ++ai)
#pragma unroll
            for (int m = 0; m < 4; ++m) { const size_t off = (size_t)(row0 + ai * HALF + m * 16) * DM_ + col0;
#pragma unroll
                for (int bj = 0; bj < 2; ++bj)
#pragma unroll
                    for (int n = 0; n < 2; ++n) { const f32x4 g = bf4_to_f32(*(const u32x2*)(sg + off + bj * HALF + n * 16)); *(f32x4*)(tmp + off + bj * HALF + n * 16) = acc[ai][bj][m][n] * g; }
                asm volatile("" ::: "memory"); }
    }
};
struct EpiGateB {
    static constexpr bool PERM = true, AFTER_DRAIN = false;
    bf16_t* merged; const float* tmp; const bf16_t* sg;
    __device__ __forceinline__ void operator()(const f32x4 (&acc)[2][2][4][2], const Unit& u, int wr, int wc, int fr, int fq) const {
        const int row0 = u.pm * BM + wr * 64 + fr, col0 = u.pn * BM + wc * 32 + 8 * fq;
#pragma unroll
        for (int ai = 0; ai < 2; ++ai)
#pragma unroll
            for (int m = 0; m < 4; ++m) { const size_t off = (size_t)(row0 + ai * HALF + m * 16) * DM_ + col0;
#pragma unroll
                for (int bj = 0; bj < 2; ++bj) { const u32x4 gw = *(const u32x4*)(sg + off + bj * HALF); const f32x4 t0 = *(const f32x4*)(tmp + off + bj * HALF), t1 = *(const f32x4*)(tmp + off + bj * HALF + 4);
                    const f32x4 g0 = bf4_to_f32((u32x2){gw.x, gw.y}), g1 = bf4_to_f32((u32x2){gw.z, gw.w});
                    const f32x4 v0 = t0 + acc[ai][bj][m][0] * g0, v1 = t1 + acc[ai][bj][m][1] * g1;
                    u32x4 w; w.x = cvt_pk_bf16(v0[0], v0[1]); w.y = cvt_pk_bf16(v0[2], v0[3]); w.z = cvt_pk_bf16(v1[0], v1[1]); w.w = cvt_pk_bf16(v1[2], v1[3]);
                    *(u32x4*)(merged + off + bj * HALF) = w; }
                asm volatile("" ::: "memory"); }
    }
};
struct EpiResStat {
    static constexpr bool PERM = false, AFTER_DRAIN = false;
    const float* base; float* out; bf16_t* xb; float* ss;
    __device__ __forceinline__ void operator()(const f32x4 (&acc)[2][2][4][2], const Unit& u, int wr, int wc, int fr, int fq) const {
        const int row0 = u.pm * BM + wr * 64 + fr, col0 = u.pn * BM + wc * 32 + 4 * fq;
#pragma unroll
        for (int ai = 0; ai < 2; ++ai)
#pragma unroll
            for (int m = 0; m < 4; ++m) { const int r = row0 + ai * HALF + m * 16; const size_t off = (size_t)r * DM_ + col0; float s = 0.f;
#pragma unroll
                for (int bj = 0; bj < 2; ++bj)
#pragma unroll
                    for (int n = 0; n < 2; ++n) { const f32x4 b = *(const f32x4*)(base + off + bj * HALF + n * 16); const f32x4 o = b + acc[ai][bj][m][n];
                        *(f32x4*)(out + off + bj * HALF + n * 16) = o; s += (o[0] * o[0] + o[1] * o[1]) + (o[2] * o[2] + o[3] * o[3]);
                        u32x2 w; w.x = cvt_pk_bf16(o[0], o[1]); w.y = cvt_pk_bf16(o[2], o[3]); *(u32x2*)(xb + off + bj * HALF + n * 16) = w; }
                s += __shfl_xor(s, 16); s += __shfl_xor(s, 32);
                if (fq == 0) __hip_atomic_fetch_add(ss + r, s, __ATOMIC_RELAXED, __HIP_MEMORY_SCOPE_AGENT);
                asm volatile("" ::: "memory"); }
    }
};
struct EpiUp {
    static constexpr bool PERM = true, AFTER_DRAIN = false;
    bf16_t* O; int ldc; const float* ss;
    __device__ __forceinline__ void operator()(const f32x4 (&acc)[2][2][4][2], const Unit& u, int wr, int wc, int fr, int fq) const {
        const int row0 = u.pm * BM + wr * 64 + fr, col0 = u.pn * BM + wc * 32 + 8 * fq;
#pragma unroll
        for (int ai = 0; ai < 2; ++ai)
#pragma unroll
            for (int m = 0; m < 4; ++m) { const int r = row0 + ai * HALF + m * 16; const float rs = rs_of(ss[r]); bf16_t* rowp = O + (size_t)r * ldc + col0;
#pragma unroll
                for (int bj = 0; bj < 2; ++bj) { const f32x4 v0 = acc[ai][bj][m][0] * rs, v1 = acc[ai][bj][m][1] * rs;
                    u32x4 w; w.x = cvt_pk_bf16(v0[0], v0[1]); w.y = cvt_pk_bf16(v0[2], v0[3]); w.z = cvt_pk_bf16(v1[0], v1[1]); w.w = cvt_pk_bf16(v1[2], v1[3]);
                    *(u32x4*)(rowp + bj * HALF) = w; } }
    }
};
struct EpiStoreF32 {
    static constexpr bool PERM = false, AFTER_DRAIN = false;
    float* C;
    __device__ __forceinline__ void operator()(const f32x4 (&acc)[2][2][4][2], const Unit& u, int wr, int wc, int fr, int fq) const {
        const int row0 = u.pm * BM + wr * 64 + fr, col0 = u.pn * BM + wc * 32 + 4 * fq;
#pragma unroll
        for (int ai = 0; ai < 2; ++ai)
#pragma unroll
            for (int m = 0; m < 4; ++m) { float* rowp = C + (size_t)(row0 + ai * HALF + m * 16) * DM_ + col0;
#pragma unroll
                for (int bj = 0; bj < 2; ++bj)
#pragma unroll
                    for (int n = 0; n < 2; ++n) *(f32x4*)(rowp + bj * HALF + n * 16) = acc[ai][bj][m][n]; }
    }
};
struct EpiPle {
    static constexpr bool PERM = false, AFTER_DRAIN = false;
    float* out; const bf16_t* pp; const float* ss;
    __device__ __forceinline__ void operator()(const f32x4 (&acc)[2][2][4][2], const Unit& u, int wr, int wc, int fr, int fq) const {
        const int row0 = u.pm * BM + wr * 64 + fr, col0 = u.pn * BM + wc * 32 + 4 * fq;
#pragma unroll
        for (int ai = 0; ai < 2; ++ai)
#pragma unroll
            for (int m = 0; m < 4; ++m) { const int r = row0 + ai * HALF + m * 16; const size_t off = (size_t)r * DM_ + col0; const float rs = rs_of(ss[r]);
#pragma unroll
                for (int bj = 0; bj < 2; ++bj)
#pragma unroll
                    for (int n = 0; n < 2; ++n) { const f32x4 b = *(const f32x4*)(out + off + bj * HALF + n * 16), q = bf4_to_f32(*(const u32x2*)(pp + off + bj * HALF + n * 16)); const f32x4 a = acc[ai][bj][m][n] * rs;
                        f32x4 o; o[0] = b[0] + sigm(a[0]) * q[0]; o[1] = b[1] + sigm(a[1]) * q[1]; o[2] = b[2] + sigm(a[2]) * q[2]; o[3] = b[3] + sigm(a[3]) * q[3];
                        *(f32x4*)(out + off + bj * HALF + n * 16) = o; }
                asm volatile("" ::: "memory"); }
    }
};
struct EpiNull {
    static constexpr bool PERM = true, AFTER_DRAIN = false;
    __device__ __forceinline__ void operator()(const f32x4 (&acc)[2][2][4][2], const Unit& u, int wr, int wc, int fr, int fq) const {
#pragma unroll
        for (int ai = 0; ai < 2; ++ai)
#pragma unroll
            for (int bj = 0; bj < 2; ++bj)
#pragma unroll
                for (int m = 0; m < 4; ++m)
#pragma unroll
                    for (int n = 0; n < 2; ++n) asm volatile("" :: "v"(acc[ai][bj][m][n]));
    }
};
struct EpiGate2 {
    static constexpr bool PERM = true, AFTER_DRAIN = false;
    bf16_t* merged; const bf16_t* sga; const bf16_t* sgb;
    __device__ __forceinline__ void operator()(f32x4 (&acc)[2][2][4][2], const Unit& u, int wr, int wc, int fr, int fq) const {
        const int row0 = u.pm * BM + wr * 64 + fr, col0 = u.pn * BM + wc * 32 + 8 * fq;
        if (u.part == 0) {
#pragma unroll
            for (int ai = 0; ai < 2; ++ai)
#pragma unroll
                for (int m = 0; m < 4; ++m) { const size_t off = (size_t)(row0 + ai * HALF + m * 16) * DM_ + col0;
                    const u32x4 a0 = *(const u32x4*)(sga + off), a1 = *(const u32x4*)(sga + off + HALF), b0 = *(const u32x4*)(sgb + off), b1 = *(const u32x4*)(sgb + off + HALF);
#pragma unroll
                    for (int bj = 0; bj < 2; ++bj) { const u32x4 aw = bj ? a1 : a0, bw = bj ? b1 : b0;
                        const f32x4 ga0 = bf4_to_f32((u32x2){aw.x, aw.y}), ga1 = bf4_to_f32((u32x2){aw.z, aw.w}), gb0 = bf4_to_f32((u32x2){bw.x, bw.y}), gb1 = bf4_to_f32((u32x2){bw.z, bw.w});
#pragma unroll
                        for (int j = 0; j < 4; ++j) { acc[ai][bj][m][0][j] *= ga0[j] * __builtin_amdgcn_rcpf(fmaxf(gb0[j], 1e-20f)); acc[ai][bj][m][1][j] *= ga1[j] * __builtin_amdgcn_rcpf(fmaxf(gb1[j], 1e-20f)); } }
                    asm volatile("" ::: "memory"); }
        } else {
#pragma unroll
            for (int ai = 0; ai < 2; ++ai)
#pragma unroll
                for (int m = 0; m < 4; ++m) { const size_t off = (size_t)(row0 + ai * HALF + m * 16) * DM_ + col0;
                    const u32x4 b0 = *(const u32x4*)(sgb + off), b1 = *(const u32x4*)(sgb + off + HALF);
#pragma unroll
                    for (int bj = 0; bj < 2; ++bj) { const u32x4 bw = bj ? b1 : b0; const f32x4 gb0 = bf4_to_f32((u32x2){bw.x, bw.y}), gb1 = bf4_to_f32((u32x2){bw.z, bw.w});
                        f32x4 v0, v1;
#pragma unroll
                        for (int j = 0; j < 4; ++j) { v0[j] = acc[ai][bj][m][0][j] * fmaxf(gb0[j], 1e-20f); v1[j] = acc[ai][bj][m][1][j] * fmaxf(gb1[j], 1e-20f); }
                        u32x4 w; w.x = cvt_pk_bf16(v0[0], v0[1]); w.y = cvt_pk_bf16(v0[2], v0[3]); w.z = cvt_pk_bf16(v1[0], v1[1]); w.w = cvt_pk_bf16(v1[2], v1[3]);
                        *(u32x4*)(merged + off + bj * HALF) = w; }
                    asm volatile("" ::: "memory"); }
        }
    }
};
struct TwoPartOrder : StaticOrder {
    const bf16_t* A1; const bf16_t* B1;
    __device__ bool next(int i, Unit& u) const { const bool ok = StaticOrder::next(i >> 1, u); u.part = i & 1; return ok; }
    __device__ __forceinline__ const bf16_t* baseA(const Gemm& g, const Unit& u) const { return u.part ? A1 : g.A; }
    __device__ __forceinline__ const bf16_t* baseB(const Gemm& g, const Unit& u) const { return u.part ? B1 : g.Bt; }
    __device__ __forceinline__ bool zero_after(const Unit& u) const { return u.part != 0; }
};
struct EpiStoreBf16x4 {
    static constexpr bool PERM = false, AFTER_DRAIN = false;
    bf16_t* C;
    __device__ __forceinline__ void operator()(const f32x4 (&acc)[2][2][4][2], const Unit& u, int wr, int wc, int fr, int fq) const {
        const int row0 = u.pm * BM + wr * 64 + fr, col0 = u.pn * BM + wc * 32 + 4 * fq;
#pragma unroll
        for (int ai = 0; ai < 2; ++ai)
#pragma unroll
            for (int m = 0; m < 4; ++m) { bf16_t* rowp = C + (size_t)(row0 + ai * HALF + m * 16) * DM_ + col0;
#pragma unroll
                for (int bj = 0; bj < 2; ++bj)
#pragma unroll
                    for (int n = 0; n < 2; ++n) { const f32x4 v = acc[ai][bj][m][n]; u32x2 w; w.x = cvt_pk_bf16(v[0], v[1]); w.y = cvt_pk_bf16(v[2], v[3]); *(u32x2*)(rowp + bj * HALF + n * 16) = w; } }
    }
};
template <class Epi, class Sched, bool ALIGN_EPI = false, bool SP2 = false>
__device__ __forceinline__ void gemm_phase(PG8_LAS unsigned char* lds, const Gemm g, const Sched& S, const Epi& E, const int WAVE_) {
    const int tid = TID(), wid = __builtin_amdgcn_readfirstlane(tid >> 6), lane = tid & 63, wr = wid >> 2, wc = wid & 3, fr = lane & 15, fq = lane >> 4;
    const int K = g.K, nt = K / BK;
    unsigned voffA[2], voffB[2];
#pragma unroll
    for (int i = 0; i < 2; ++i) { int R, C; stage_rc(tid * 16 + i * 8192, R, C); const int Rb = Epi::PERM ? ((R & ~31) + perm32(R & 31)) : R;
        voffA[i] = (unsigned)(R * K + C) * 2u; voffB[i] = (unsigned)(Rb * K + C) * 2u; }
    const size_t kstep = (size_t)(BK * 2);
    const size_t hstep = (size_t)HALF * K * 2;
    const size_t tstep = 2 * hstep;
    const unsigned ldsw = (unsigned)wid * 1024u;
    const int aoff = lds_byte(wr * 64 + fr, fq * 8), boff = lds_byte(wc * 32 + fr, fq * 8);
#define PG8_SA(b, h) (((b) * 2 + (h)) * HTB)
#define PG8_SB(b, h) ((4 + (b) * 2 + (h)) * HTB)
#define PG8_STAGE(bufoff, gbase, voff) do { _Pragma("unroll") for (int _i = 0; _i < 2; ++_i) \
        __builtin_amdgcn_global_load_lds((const unsigned*)((const char*)(gbase) + (voff)[_i]), (PG8_LAS unsigned*)(lds + (bufoff) + ldsw + _i * 8192), 16, 0, 0); } while (0)
#define PG8_LDA(dst, b, h) do { _Pragma("unroll") for (int m = 0; m < 4; ++m) _Pragma("unroll") for (int k = 0; k < 2; ++k) dst[m][k] = *(const PG8_LAS bf16x8*)(lds + PG8_SA(b, h) + aoff + m * 2048 + k * 1024); } while (0)
#define PG8_LDB(dst, b, h) do { _Pragma("unroll") for (int n = 0; n < 2; ++n) _Pragma("unroll") for (int k = 0; k < 2; ++k) dst[n][k] = *(const PG8_LAS bf16x8*)(lds + PG8_SB(b, h) + boff + n * 2048 + k * 1024); } while (0)
#define PG8_MMA(ai, bj, At, Bt) do { __builtin_amdgcn_s_setprio(1); _Pragma("unroll") for (int m = 0; m < 4; ++m) _Pragma("unroll") for (int n = 0; n < 2; ++n) _Pragma("unroll") for (int k = 0; k < 2; ++k) \
        acc[ai][bj][m][n] = __builtin_amdgcn_mfma_f32_16x16x32_bf16(Bt[n][k], At[m][k], acc[ai][bj][m][n], 0, 0, 0); __builtin_amdgcn_s_setprio(0); } while (0)
#define PG8_WAIT_V(n) asm volatile("s_waitcnt vmcnt(" #n ")" ::: "memory")
#define PG8_WAIT_L(n) asm volatile("s_waitcnt lgkmcnt(" #n ")" ::: "memory")
#define PG8_BAR __builtin_amdgcn_s_barrier()
#define PG8_SCHED __builtin_amdgcn_sched_barrier(0)
    Unit cur, nxt; int ui = 0;
    if (!S.next(0, cur)) return;
    f32x4 acc[2][2][4][2];
#pragma unroll
    for (int a = 0; a < 2; ++a)
#pragma unroll
        for (int b = 0; b < 2; ++b)
#pragma unroll
            for (int m = 0; m < 4; ++m)
#pragma unroll
                for (int n = 0; n < 2; ++n) acc[a][b][m][n] = (f32x4){0.f, 0.f, 0.f, 0.f};
    bf16x8 At[4][2], B0[2][2], B1[2][2];
    const char* cA = (const char*)S.baseA(g, cur) + (size_t)cur.pm * tstep; const char* cB = (const char*)S.baseB(g, cur) + (size_t)cur.pn * tstep;
    S.a_ready(cur);
    if constexpr (SP2) {
        PG8_STAGE(PG8_SB(0, 0), cB, voffB); PG8_STAGE(PG8_SB(0, 1), cB + hstep, voffB); PG8_STAGE(PG8_SA(0, 0), cA, voffA); PG8_STAGE(PG8_SA(0, 1), cA + hstep, voffA);
        if (wr == 1) PG8_BAR;
        PG8_WAIT_V(2); PG8_BAR;
        PG8_STAGE(PG8_SB(1, 0), cB + kstep, voffB); PG8_STAGE(PG8_SA(1, 0), cA + kstep, voffA); PG8_STAGE(PG8_SB(1, 1), cB + hstep + kstep, voffB);
        PG8_WAIT_V(6); PG8_BAR;
    } else {
        PG8_STAGE(PG8_SB(0, 0), cB, voffB); PG8_STAGE(PG8_SA(0, 0), cA, voffA); PG8_STAGE(PG8_SB(0, 1), cB + hstep, voffB); PG8_STAGE(PG8_SA(0, 1), cA + hstep, voffA);
        if (wr == 1) PG8_BAR;
        PG8_WAIT_V(4); PG8_BAR;
        PG8_STAGE(PG8_SB(1, 0), cB + kstep, voffB); PG8_STAGE(PG8_SA(1, 0), cA + kstep, voffA); PG8_STAGE(PG8_SB(1, 1), cB + hstep + kstep, voffB);
        PG8_WAIT_V(6); PG8_BAR;
    }
    for (;;) {
        const bool has_next = S.next(ui + 1, nxt);
        const char* nA = has_next ? (const char*)S.baseA(g, nxt) + (size_t)nxt.pm * tstep : cA; const char* nB = has_next ? (const char*)S.baseB(g, nxt) + (size_t)nxt.pn * tstep : cB;
        for (int t = 0; t < nt; t += 2) {
            const bool last = (t == nt - 2);
            const char* a1 = cA + (size_t)(t + 1) * kstep;
            const char* a2 = last ? nA : cA + (size_t)(t + 2) * kstep; const char* b2 = last ? nB : cB + (size_t)(t + 2) * kstep;
            const char* a3 = a2 + kstep; const char* b3 = b2 + kstep;
            if (last && has_next) S.a_ready(nxt);
            if constexpr (SP2) {
            PG8_LDB(B0, 0, 0); PG8_LDB(B1, 0, 1); PG8_SCHED; PG8_LDA(At, 0, 0); PG8_STAGE(PG8_SA(1, 1), a1 + hstep, voffA);
            PG8_WAIT_V(8); PG8_WAIT_L(0); PG8_BAR; PG8_MMA(0, 0, At, B0); PG8_MMA(0, 1, At, B1); PG8_BAR; PG8_SCHED;
            PG8_LDA(At, 0, 1); PG8_STAGE(PG8_SB(0, 0), b2, voffB); PG8_STAGE(PG8_SB(0, 1), b2 + hstep, voffB); PG8_STAGE(PG8_SA(0, 0), a2, voffA);
            PG8_WAIT_V(8); PG8_WAIT_L(0); PG8_BAR; PG8_MMA(1, 0, At, B0); PG8_MMA(1, 1, At, B1); PG8_BAR; PG8_SCHED;
            PG8_LDB(B0, 1, 0); PG8_LDB(B1, 1, 1); PG8_SCHED; PG8_LDA(At, 1, 0); PG8_STAGE(PG8_SA(0, 1), a2 + hstep, voffA);
            PG8_WAIT_V(8); PG8_WAIT_L(0); PG8_BAR; PG8_MMA(0, 0, At, B0); PG8_MMA(0, 1, At, B1); PG8_BAR; PG8_SCHED;
            PG8_LDA(At, 1, 1); PG8_STAGE(PG8_SB(1, 0), b3, voffB); PG8_STAGE(PG8_SB(1, 1), b3 + hstep, voffB); PG8_STAGE(PG8_SA(1, 0), a3, voffA);
            PG8_WAIT_V(8); PG8_WAIT_L(0); PG8_BAR; PG8_MMA(1, 0, At, B0); PG8_MMA(1, 1, At, B1); PG8_BAR; PG8_SCHED;
            } else {
            PG8_LDB(B0, 0, 0); PG8_SCHED; PG8_LDA(At, 0, 0); PG8_STAGE(PG8_SA(1, 1), a1 + hstep, voffA);
            PG8_WAIT_L(8); PG8_BAR; PG8_WAIT_L(0); PG8_MMA(0, 0, At, B0); PG8_BAR; PG8_SCHED;
            PG8_LDB(B1, 0, 1); PG8_STAGE(PG8_SB(0, 0), b2, voffB);
            PG8_BAR; PG8_WAIT_L(0); PG8_MMA(0, 1, At, B1); PG8_BAR;
            PG8_LDA(At, 0, 1); PG8_STAGE(PG8_SA(0, 0), a2, voffA);
            PG8_BAR; PG8_WAIT_L(0); PG8_MMA(1, 0, At, B0); PG8_BAR; PG8_SCHED;
            PG8_STAGE(PG8_SB(0, 1), b2 + hstep, voffB);
            PG8_WAIT_V(6); PG8_BAR; PG8_MMA(1, 1, At, B1); PG8_BAR;
            PG8_LDB(B0, 1, 0); PG8_SCHED; PG8_LDA(At, 1, 0); PG8_STAGE(PG8_SA(0, 1), a2 + hstep, voffA);
            PG8_WAIT_L(8); PG8_BAR; PG8_WAIT_L(0); PG8_MMA(0, 0, At, B0); PG8_BAR; PG8_SCHED;
            PG8_LDB(B1, 1, 1); PG8_STAGE(PG8_SB(1, 0), b3, voffB);
            PG8_BAR; PG8_WAIT_L(0); PG8_MMA(0, 1, At, B1); PG8_BAR;
            PG8_LDA(At, 1, 1); PG8_STAGE(PG8_SA(1, 0), a3, voffA);
            PG8_BAR; PG8_WAIT_L(0); PG8_MMA(1, 0, At, B0); PG8_BAR; PG8_SCHED;
            PG8_STAGE(PG8_SB(1, 1), b3 + hstep, voffB);
            PG8_WAIT_V(6); PG8_BAR; PG8_MMA(1, 1, At, B1); PG8_BAR;
            }
        }
        if constexpr (ALIGN_EPI) { if (wr == 0) PG8_BAR; }
        if constexpr (!Epi::AFTER_DRAIN) { E(acc, cur, wr, wc, fr, fq); S.done(cur); }
        if (!has_next) break;
        if (S.zero_after(cur))
#pragma unroll
        for (int a = 0; a < 2; ++a)
#pragma unroll
            for (int b = 0; b < 2; ++b)
#pragma unroll
                for (int m = 0; m < 4; ++m)
#pragma unroll
                    for (int n = 0; n < 2; ++n) acc[a][b][m][n] = (f32x4){0.f, 0.f, 0.f, 0.f};
        cur = nxt; cA = nA; cB = nB; ++ui;
        if constexpr (ALIGN_EPI) { if (wr == 1) PG8_BAR; }
    }
    PG8_WAIT_V(0);
    if constexpr (!ALIGN_EPI) { if (wr == 0) PG8_BAR; }
    PG8_BAR;
    if constexpr (Epi::AFTER_DRAIN) { E.fused(acc, cur, wr, wc, fr, fq, lds, wid, lane); S.done(cur); }
#undef PG8_SA
#undef PG8_SB
#undef PG8_STAGE
#undef PG8_LDA
#undef PG8_LDB
#undef PG8_MMA
#undef PG8_WAIT_V
#undef PG8_WAIT_L
#undef PG8_BAR
#undef PG8_SCHED
}
}
constexpr int NWAVES = 8;
constexpr int S = 8192, DM = 4096, HD = 128, NH = 16, WF = 2048, DFF = 11008, PLE = 256, NIN = 20496, NPROJ = 20480;
constexpr float EPS = 1e-6f;
constexpr float SCALE = 0.08838834764831845f;
constexpr size_t MiB = 1u << 20;
constexpr size_t WS_CTL = 0, CTL_ZERO_BYTES = 1 * MiB;
constexpr size_t WS_SS1 = 1 * MiB;
constexpr size_t WS_LOGF = WS_SS1 + 64 * 1024;
constexpr size_t WS_C = WS_LOGF + 512 * 1024;
constexpr size_t WS_WTF = WS_C + 512 * 1024;
constexpr size_t WS_WIN = 4 * MiB;
constexpr size_t WS_WBF = WS_WIN + 160 * MiB;
constexpr size_t WS_WBS = WS_WBF + 16 * MiB;
constexpr size_t WS_WOUT = WS_WBS + 16 * MiB;
constexpr size_t WS_WUP = WS_WOUT + 32 * MiB;
constexpr size_t WS_WDN = WS_WUP + 172 * MiB;
constexpr size_t WS_WPG = WS_WDN + 86 * MiB;
constexpr size_t WS_WPP = WS_WPG + 32 * MiB;
constexpr size_t WS_XB = WS_WPP + 2 * MiB;
constexpr size_t WS_PB = WS_XB + 64 * MiB;
constexpr size_t WS_QKV = WS_PB + 4 * MiB;
constexpr size_t WS_GATES = WS_QKV + 192 * MiB;
constexpr size_t WS_Y = WS_GATES + 128 * MiB;
constexpr size_t WS_UP = WS_QKV;
constexpr size_t WS_MERGED = WS_Y + 64 * MiB;
constexpr size_t WS_ACT = WS_MERGED + 64 * MiB;
constexpr size_t WS_PP = WS_QKV;
constexpr size_t WS_END = WS_ACT + 172 * MiB;
static_assert(WS_UP + (size_t)S * 2 * DFF * 2 <= WS_MERGED, "up overlay");
constexpr int CW_BAR = 4096;
constexpr int CW_QATT = 2048;
constexpr int CW_SS2 = 32768, CW_SS3 = 32768 + 8192;
constexpr int N_BAR_REGIONS = 4;
constexpr int RING_OFF = 0, RING_BYTES = 131072;
constexpr int LDSCTL_OFF = RING_BYTES, MISC_OFF = LDSCTL_OFF + 320;
constexpr int LDS_BYTES = 147456;

#define GAS __attribute__((address_space(1)))
#define LAS __attribute__((address_space(3)))
typedef unsigned short bf16;
typedef unsigned v4u __attribute__((ext_vector_type(4)));
typedef unsigned v2u __attribute__((ext_vector_type(2)));
typedef float f32x4 __attribute__((ext_vector_type(4)));
typedef float f32x16 __attribute__((ext_vector_type(16)));
typedef short bf16x8 __attribute__((ext_vector_type(8)));
typedef GAS unsigned gu32;
#define RLX_AGENT __ATOMIC_RELAXED, __HIP_MEMORY_SCOPE_AGENT
#define LDS_WAIT() asm volatile("s_waitcnt lgkmcnt(0)" ::: "memory")
#define VM_WAIT() asm volatile("s_waitcnt vmcnt(0)" ::: "memory")
__device__ __forceinline__ unsigned pk2(float lo, float hi) { unsigned r; asm volatile("v_cvt_pk_bf16_f32 %0, %1, %2" : "=v"(r) : "v"(lo), "v"(hi)); return r; }
__device__ __forceinline__ float bf2f(bf16 b) { return __uint_as_float(((unsigned)b) << 16); }
__device__ __forceinline__ float bflo(unsigned w) { return __uint_as_float(w << 16); }
__device__ __forceinline__ float bfhi(unsigned w) { return __uint_as_float(w & 0xffff0000u); }
__device__ __forceinline__ float sigmoidf_(float v) { return 1.0f / (1.0f + __expf(-v)); }
__device__ __forceinline__ float log_sigmoidf_(float v) { return fminf(v, 0.f) - log1pf(__expf(-fabsf(v))); }
__device__ __forceinline__ float softplusf_(float v) { return fmaxf(v, 0.f) + log1pf(__expf(-fabsf(v))); }
__device__ __forceinline__ float wave_sum(float v) {
#pragma unroll
    for (int o = 1; o < 64; o <<= 1) v += __shfl_xor(v, o);
    return v;
}

#define XB_TMO      128
#define XB_XCNT(j)  (256  + 64 * (j))
#define XB_XSUB(j)  (1280 + 64 * (j))
#define XB_XGEN(j)  (2304 + 64 * (j))
#define XB_TOP      3328
#define XB_TOPGEN   3392
#define XCD_BAR_WORDS 3456
#define XB_SPIN_CAP (1u << 18)

__device__ __forceinline__ unsigned xb_ld(unsigned* p)              { return __hip_atomic_load(p, __ATOMIC_RELAXED, __HIP_MEMORY_SCOPE_AGENT); }
__device__ __forceinline__ unsigned xb_add(unsigned* p, unsigned v) { return __hip_atomic_fetch_add(p, v, __ATOMIC_RELAXED, __HIP_MEMORY_SCOPE_AGENT); }
__device__ __forceinline__ unsigned xb_xcc_id() { return (unsigned)__builtin_amdgcn_s_getreg((3 << 11) | 20) & 0xFu; }
#define XB_SPIN(cond, bar) do { unsigned _sp = 0; while (cond) { __builtin_amdgcn_s_sleep(1); \
    if ((++_sp & 255u) == 0u) { if (xb_ld(&(bar)[XB_TMO])) break; if (_sp > XB_SPIN_CAP) { atomicAdd(&(bar)[XB_TMO], 1u); break; } } } } while (0)

struct XcdBarrier {
    unsigned* bar; unsigned x; int wave;
    volatile LAS unsigned* st;
};

__device__ __forceinline__ XcdBarrier xcd_barrier_post(unsigned* bar, volatile LAS unsigned* st, const int WAVE_) {
    XcdBarrier b; b.wave = WAVE_; b.bar = bar; b.x = xb_xcc_id(); b.st = st;
    if (TID() == 0) (void)xb_add(&bar[XB_XCNT(b.x)], 1u);
    return b;
}
__device__ __forceinline__ void xcd_barrier_complete(unsigned* bar, unsigned x, unsigned& nloc, unsigned& nx) {
    const unsigned G = gridDim.x * gridDim.y * gridDim.z;
    unsigned sum, cnt, mine, sp = 0u;
    for (;;) {
        sum = 0u; cnt = 0u; mine = 0u;
#pragma unroll
        for (unsigned j = 0; j < 16; ++j) { const unsigned c = xb_ld(&bar[XB_XCNT(j)]); sum += c; cnt += (c > 0u) ? 1u : 0u; mine = (j == x) ? c : mine; }
        if (sum == G) break;
        __builtin_amdgcn_s_sleep(1);
        if ((++sp & 255u) == 0u) { if (xb_ld(&bar[XB_TMO])) break; if (sp > XB_SPIN_CAP) { atomicAdd(&bar[XB_TMO], 1u); break; } }
    }
    nloc = mine > 0u ? mine : 1u; nx = cnt > 0u ? cnt : 1u;
}

__device__ __forceinline__ void xcd_barrier(const XcdBarrier& b) {
    const int WAVE_ = b.wave;
    asm volatile("s_waitcnt vmcnt(0)" ::: "memory");
    __syncthreads();
    if (TID() == 0) {
        unsigned* bar = b.bar;
        __builtin_amdgcn_s_waitcnt(0);
        unsigned nloc = b.st[0], nx = b.st[1];
        if (nloc == 0u) { xcd_barrier_complete(bar, b.x, nloc, nx); b.st[0] = nloc; b.st[1] = nx; }
        const unsigned old = xb_add(&bar[XB_XSUB(b.x)], 1u);
        const unsigned gen = old / nloc;
        if (old + 1u == (gen + 1u) * nloc) {
            __builtin_amdgcn_fence(__ATOMIC_RELEASE, "agent");
            asm volatile("s_waitcnt vmcnt(0)" ::: "memory");
            const unsigned og = xb_add(&bar[XB_TOP], 1u);
            const unsigned tg = og / nx;
            if (og + 1u == (tg + 1u) * nx) xb_add(&bar[XB_TOPGEN], 1u);
            else XB_SPIN(xb_ld(&bar[XB_TOPGEN]) == tg, bar);
            __builtin_amdgcn_fence(__ATOMIC_ACQUIRE, "agent");
            xb_add(&bar[XB_XGEN(b.x)], 1u);
            asm volatile("s_waitcnt vmcnt(0)" ::: "memory");
        } else {
            XB_SPIN(xb_ld(&bar[XB_XGEN(b.x)]) == gen, bar);
            __builtin_amdgcn_fence(__ATOMIC_ACQUIRE, "agent");
            asm volatile("s_waitcnt vmcnt(0)" ::: "memory");
        }
    }
    __syncthreads();
}


struct Params {
    const float* in[18]; float* out; unsigned char* ws;
    int ph_lo, ph_hi, li, pad;
};
struct Frame {
    LAS unsigned char* lds; volatile LAS unsigned* MISC; gu32* ctl;
    int wave, vcu, G;
};

struct CvtT { const float* src; const float* g; bf16* dst; int ldw, K; };
__device__ __forceinline__ CvtT cvt_decode(const Params& P, int it, int lane) {
    unsigned char* ws = P.ws;
    constexpr int T0 = 64 * 96, T1 = 64 * 224, T2 = 32 * 64, T3 = 32 * 64, T4 = 64 * 64, T5 = 64 * 344, T6 = 172 * 64, T7 = 64 * 64;
    const float* W; const float* g = nullptr; bf16* Wt; int ldw, srccol0 = 0, K, nrow0 = 0, NT; int r = it;
    if (r < T0) { W = P.in[3]; ldw = NIN; g = P.in[2]; Wt = (bf16*)(ws + WS_WIN); K = DM; NT = 96; }
    else if ((r -= T0) < T1) { W = P.in[3]; ldw = NIN; srccol0 = 6160; g = P.in[2]; Wt = (bf16*)(ws + WS_WIN); K = DM; nrow0 = 6144; NT = 224; }
    else if ((r -= T1) < T2) { W = P.in[7]; ldw = DM; Wt = (bf16*)(ws + WS_WBF); K = WF; NT = 64; }
    else if ((r -= T2) < T3) { W = P.in[8]; ldw = DM; Wt = (bf16*)(ws + WS_WBS); K = WF; NT = 64; }
    else if ((r -= T3) < T4) { W = P.in[9]; ldw = DM; Wt = (bf16*)(ws + WS_WOUT); K = DM; NT = 64; }
    else if ((r -= T4) < T5) { W = P.in[11]; ldw = 2 * DFF; g = P.in[10]; Wt = (bf16*)(ws + WS_WUP); K = DM; NT = 344; }
    else if ((r -= T5) < T6) { W = P.in[14]; ldw = DM; Wt = (bf16*)(ws + WS_WDN); K = DFF; NT = 64; }
    else if ((r -= T6) < T7) { W = P.in[16]; ldw = DM; g = P.in[15]; Wt = (bf16*)(ws + WS_WPG); K = DM; NT = 64; }
    else { r -= T7; W = P.in[17]; ldw = DM; Wt = (bf16*)(ws + WS_WPP); K = PLE; NT = 64; }
    const int nt = r % NT, kt = r / NT, nq = lane & 7, q = lane >> 3;
    CvtT T;
    T.src = W + (size_t)(64 * kt + 8 * q) * ldw + srccol0 + 64 * nt + 4 * nq;
    T.g = g ? g + 64 * kt + 8 * q : nullptr;
    T.dst = Wt + (size_t)(nrow0 + 64 * nt + 4 * nq) * K + 64 * kt + 8 * q;
    T.ldw = ldw; T.K = K;
    return T;
}
__device__ __forceinline__ void cvt_load(const CvtT& T, f32x4 (&v)[2][8]) {
#pragma unroll
    for (int p = 0; p < 2; ++p)
#pragma unroll
        for (int t = 0; t < 8; ++t) v[p][t] = __builtin_nontemporal_load((const f32x4*)(T.src + (size_t)t * T.ldw + 32 * p));
}
__device__ __forceinline__ void cvt_store(const CvtT& T, const f32x4 (&v)[2][8]) {
    f32x4 g0 = (f32x4){1.f, 1.f, 1.f, 1.f}, g1 = g0;
    if (T.g) { g0 = *(const f32x4*)T.g; g1 = *(const f32x4*)(T.g + 4); }
#pragma unroll
    for (int p = 0; p < 2; ++p)
#pragma unroll
        for (int i = 0; i < 4; ++i) {
            v4u w; w.x = pk2(v[p][0][i] * g0[0], v[p][1][i] * g0[1]); w.y = pk2(v[p][2][i] * g0[2], v[p][3][i] * g0[3]);
            w.z = pk2(v[p][4][i] * g1[0], v[p][5][i] * g1[1]); w.w = pk2(v[p][6][i] * g1[2], v[p][7][i] * g1[3]);
            *(v4u*)(T.dst + (size_t)(32 * p + i) * T.K) = w;
        }
}
__device__ __forceinline__ void p0_weights(const Frame& F, const Params& P) {
    const int WAVE_ = F.wave; const int f_lane = lane_id(), f_tid = TID();
    const int gw = F.vcu * NWAVES + F.wave, NGW = F.G * NWAVES, lane = f_lane;
    unsigned char* ws = P.ws;
    constexpr int NITEMS = 64 * 96 + 64 * 224 + 32 * 64 + 32 * 64 + 64 * 64 + 64 * 344 + 172 * 64 + 64 * 64 + 4 * 64;
    f32x4 va[2][8], vb[2][8];
    int it = gw;
    if (it < NITEMS) {
        CvtT Ta = cvt_decode(P, it, lane); cvt_load(Ta, va);
        for (;;) {
            const int i1 = it + NGW; CvtT Tb = Ta;
            if (i1 < NITEMS) { Tb = cvt_decode(P, i1, lane); cvt_load(Tb, vb); }
            cvt_store(Ta, va);
            if (i1 >= NITEMS) break;
            const int i2 = i1 + NGW;
            if (i2 < NITEMS) { Ta = cvt_decode(P, i2, lane); cvt_load(Ta, va); }
            cvt_store(Tb, vb);
            if (i2 >= NITEMS) break;
            it = i2;
        }
    }
    { const float* w_in = P.in[3]; const float* g_mix = P.in[2]; bf16* wtf = (bf16*)(ws + WS_WTF);
      for (int i = blockIdx.x * 512 + f_tid; i < NH * (DM / 8); i += F.G * 512) { const int n = i / (DM / 8), kc = i % (DM / 8);
          float b[8];
#pragma unroll
          for (int t = 0; t < 8; ++t) b[t] = w_in[(size_t)(8 * kc + t) * NIN + 6144 + n] * g_mix[8 * kc + t];
          v4u w; w.x = pk2(b[0], b[1]); w.y = pk2(b[2], b[3]); w.z = pk2(b[4], b[5]); w.w = pk2(b[6], b[7]);
          *(v4u*)(wtf + (size_t)n * DM + 8 * kc) = w; } }
    const float* p = P.in[1]; bf16* pb = (bf16*)(ws + WS_PB);
    for (int i = blockIdx.x * 512 + f_tid; i < S * PLE / 8; i += F.G * 512) {
        const f32x4 a = *(const f32x4*)(p + (size_t)i * 8), b = *(const f32x4*)(p + (size_t)i * 8 + 4);
        v4u w; w.x = pk2(a[0], a[1]); w.y = pk2(a[2], a[3]); w.z = pk2(b[0], b[1]); w.w = pk2(b[2], b[3]);
        *(v4u*)(pb + (size_t)i * 8) = w;
    }
}
__device__ __forceinline__ void p0_rows(const Frame& F, const Params& P) {
    const int WAVE_ = F.wave; const int f_lane = lane_id();
    const float* x = P.in[0]; unsigned char* ws = P.ws;
    float* ss1 = (float*)(ws + WS_SS1); bf16* xb = (bf16*)(ws + WS_XB);
    const int gw = F.vcu * NWAVES + F.wave, NGW = F.G * NWAVES, lane = f_lane;
    for (int base = gw; base < S; base += 2 * NGW) {
        const int rowA = base, rowB = (base + NGW < S) ? base + NGW : base;
        const f32x4* xa = (const f32x4*)(x + (size_t)rowA * DM) + lane; const f32x4* xbp = (const f32x4*)(x + (size_t)rowB * DM) + lane;
        f32x4 va[16], vb[16]; float sa = 0.f, sb = 0.f;
#pragma unroll
        for (int j = 0; j < 16; ++j) va[j] = __builtin_nontemporal_load(xa + 64 * j);
#pragma unroll
        for (int j = 0; j < 16; ++j) vb[j] = __builtin_nontemporal_load(xbp + 64 * j);
#pragma unroll
        for (int j = 0; j < 16; ++j) sa += (va[j][0] * va[j][0] + va[j][1] * va[j][1]) + (va[j][2] * va[j][2] + va[j][3] * va[j][3]);
#pragma unroll
        for (int j = 0; j < 16; ++j) sb += (vb[j][0] * vb[j][0] + vb[j][1] * vb[j][1]) + (vb[j][2] * vb[j][2] + vb[j][3] * vb[j][3]);
        sa = wave_sum(sa); sb = wave_sum(sb);
        if (lane == 0) { ss1[rowA] = sa; ss1[rowB] = sb; }
        v2u* oa = (v2u*)(xb + (size_t)rowA * DM) + lane; v2u* ob = (v2u*)(xb + (size_t)rowB * DM) + lane;
#pragma unroll
        for (int j = 0; j < 16; ++j) { v2u w; w.x = pk2(va[j][0], va[j][1]); w.y = pk2(va[j][2], va[j][3]); oa[64 * j] = w; }
#pragma unroll
        for (int j = 0; j < 16; ++j) { v2u w; w.x = pk2(vb[j][0], vb[j][1]); w.y = pk2(vb[j][2], vb[j][3]); ob[64 * j] = w; }
    }
}

__device__ __forceinline__ void p1b_qknorm_fgate(const Frame& F, const Params& P) {
    const int WAVE_ = F.wave; const int f_lane = lane_id(), f_tid = TID();
    unsigned char* ws = P.ws;
    bf16* qkv = (bf16*)(ws + WS_QKV);
    const float* gq = P.in[5]; const float* gk = P.in[6];
    const int gw = F.vcu * NWAVES + F.wave, NGW = F.G * NWAVES, lane = f_lane, sub = lane >> 4, l16 = lane & 15;
    constexpr int NIT = 2 * S * NH / 4;
    for (int it = gw; it < NIT; it += NGW) {
        const int item = it * 4 + sub;
        const int t = item / (S * NH);
        bf16* ptr = qkv + (size_t)t * ((size_t)S * WF) + (size_t)(item - t * (S * NH)) * HD + l16 * 8;
        const float* g = (t ? gk : gq) + l16 * 8;
        const v4u w = *(const v4u*)ptr;
        float v[8] = {bflo(w.x), bfhi(w.x), bflo(w.y), bfhi(w.y), bflo(w.z), bfhi(w.z), bflo(w.w), bfhi(w.w)};
        float s = 0.f;
#pragma unroll
        for (int j = 0; j < 8; ++j) s += v[j] * v[j];
        s += __shfl_xor(s, 1); s += __shfl_xor(s, 2); s += __shfl_xor(s, 4); s += __shfl_xor(s, 8);
        const float r = rsqrtf(s * (1.0f / HD) + EPS);
        const f32x4 g0 = *(const f32x4*)g, g1 = *(const f32x4*)(g + 4);
        v4u o; o.x = pk2(v[0] * r * g0[0], v[1] * r * g0[1]); o.y = pk2(v[2] * r * g0[2], v[3] * r * g0[3]); o.z = pk2(v[4] * r * g1[0], v[5] * r * g1[1]); o.w = pk2(v[6] * r * g1[2], v[7] * r * g1[3]);
        *(v4u*)ptr = o;
    }
    {
        const bf16* xb = (const bf16*)(ws + WS_XB); const bf16* wtf = (const bf16*)(ws + WS_WTF); const float* ss1 = (const float*)(ws + WS_SS1); const float* b_f = P.in[4];
        float* logf = (float*)(ws + WS_LOGF);
        LAS float* fbuf = (LAS float*)(F.lds + RING_OFF);
        const int wave = F.wave, rl = lane & 31, kg = lane >> 5;
        for (int grp = blockIdx.x; grp < S / 32; grp += F.G) {
            const int r0 = grp * 32;
            const bf16* pa = xb + (size_t)(r0 + rl) * DM + 512 * wave + 8 * kg;
            const bf16* pb = wtf + (size_t)(rl & 15) * DM + 512 * wave + 8 * kg;
            f32x16 acc = {};
#pragma unroll 8
            for (int ks = 0; ks < 32; ++ks) {
                const bf16x8 a = *(const bf16x8*)(pa + 16 * ks);
                bf16x8 b = *(const bf16x8*)(pb + 16 * ks);
                if (rl >= 16) b = (bf16x8){0, 0, 0, 0, 0, 0, 0, 0};
                acc = __builtin_amdgcn_mfma_f32_32x32x16_bf16(a, b, acc, 0, 0, 0);
            }
            if (rl < 16) {
#pragma unroll
                for (int r = 0; r < 16; ++r) { const int tok = (r & 3) + 8 * (r >> 2) + 4 * kg; fbuf[(wave * 32 + tok) * 16 + rl] = acc[r]; }
            }
            __syncthreads();
            {
                const int tok = f_tid >> 4, h = f_tid & 15; float fv = 0.f;
#pragma unroll
                for (int w = 0; w < 8; ++w) fv += fbuf[(w * 32 + tok) * 16 + h];
                fv = fv * rsqrtf(ss1[r0 + tok] * (1.0f / DM) + EPS) + b_f[h];
                logf[(size_t)h * S + r0 + tok] = log_sigmoidf_(fv);
            }
            __syncthreads();
        }
    }
}

__device__ __forceinline__ void p5b_convglu(const Frame& F, const Params& P) {
    const int WAVE_ = F.wave; const int f_lane = lane_id(), f_tid = TID();
    unsigned char* ws = P.ws;
    const bf16* up = (const bf16*)(ws + WS_UP); bf16* act = (bf16*)(ws + WS_ACT);
    const float* cw = P.in[12]; const float* cb = P.in[13];
    const int gw = F.vcu * NWAVES + F.wave, NGW = F.G * NWAVES, lane = f_lane;
    constexpr int NCG = (DFF + 511) / 512, RB = 16, NITEMS = NCG * (S / RB);
    for (int it = gw; it < NITEMS; it += NGW) {
        const int cg = it % NCG, rb = it / NCG, j0 = cg * 512 + lane * 8, t0 = rb * RB;
        if (j0 >= DFF) continue;
        float wg[3][8], wv[3][8], bg[8], bv[8];
#pragma unroll
        for (int i = 0; i < 3; ++i) { const f32x4 a = *(const f32x4*)(cw + (size_t)i * 2 * DFF + j0), b = *(const f32x4*)(cw + (size_t)i * 2 * DFF + j0 + 4), c = *(const f32x4*)(cw + (size_t)i * 2 * DFF + DFF + j0), d = *(const f32x4*)(cw + (size_t)i * 2 * DFF + DFF + j0 + 4);
#pragma unroll
            for (int e = 0; e < 4; ++e) { wg[i][e] = a[e]; wg[i][4 + e] = b[e]; wv[i][e] = c[e]; wv[i][4 + e] = d[e]; } }
        { const f32x4 a = *(const f32x4*)(cb + j0), b = *(const f32x4*)(cb + j0 + 4), c = *(const f32x4*)(cb + DFF + j0), d = *(const f32x4*)(cb + DFF + j0 + 4);
#pragma unroll
          for (int e = 0; e < 4; ++e) { bg[e] = a[e]; bg[4 + e] = b[e]; bv[e] = c[e]; bv[4 + e] = d[e]; } }
        v4u gr[RB + 2], vr[RB + 2];
#pragma unroll
        for (int r = 0; r < RB + 2; ++r) { const int t = t0 - 2 + r;
            if (t >= 0) { gr[r] = __builtin_nontemporal_load((const v4u*)(up + (size_t)t * 2 * DFF + j0)); vr[r] = __builtin_nontemporal_load((const v4u*)(up + (size_t)t * 2 * DFF + DFF + j0)); }
            else { gr[r] = (v4u){0u, 0u, 0u, 0u}; vr[r] = gr[r]; } }
#pragma unroll
        for (int r = 0; r < RB; ++r) {
            const int t = t0 + r;
            float o[8];
#pragma unroll
            for (int e = 0; e < 4; ++e) {
                const unsigned a0 = gr[r][e], a1 = gr[r + 1][e], a2 = gr[r + 2][e], c0 = vr[r][e], c1 = vr[r + 1][e], c2 = vr[r + 2][e];
                const float ugl = bg[2 * e] + wg[0][2 * e] * bflo(a0) + wg[1][2 * e] * bflo(a1) + wg[2][2 * e] * bflo(a2);
                const float ugh = bg[2 * e + 1] + wg[0][2 * e + 1] * bfhi(a0) + wg[1][2 * e + 1] * bfhi(a1) + wg[2][2 * e + 1] * bfhi(a2);
                const float uvl = bv[2 * e] + wv[0][2 * e] * bflo(c0) + wv[1][2 * e] * bflo(c1) + wv[2][2 * e] * bflo(c2);
                const float uvh = bv[2 * e + 1] + wv[0][2 * e + 1] * bfhi(c0) + wv[1][2 * e + 1] * bfhi(c1) + wv[2][2 * e + 1] * bfhi(c2);
                o[2 * e] = ugl * sigmoidf_(ugl) * uvl; o[2 * e + 1] = ugh * sigmoidf_(ugh) * uvh;
            }
            v4u w; w.x = pk2(o[0], o[1]); w.y = pk2(o[2], o[3]); w.z = pk2(o[4], o[5]); w.w = pk2(o[6], o[7]);
            *(v4u*)(act + (size_t)t * DFF + j0) = w;
        }
    }
}

namespace att {
constexpr int D = 128, PITCH = 2048, NW = 8, QBLK = 32, KVBLK = 64, QB = NW * QBLK;
constexpr int SHM_V = KVBLK * D * 2, SHM_K = KVBLK * D * 2;
constexpr int OFF_WS = 2 * SHM_V + 2 * SHM_K, OFF_FLAG = OFF_WS + NW * 64 * 4, OFF_WTOT = OFF_FLAG + 64, OFF_NEXT = OFF_WTOT + 64, OFF_C = 73728  , ATT_LDS_BYTES = OFF_C + 32768;
constexpr float SCALE = 0.08838834764831845f;
constexpr float THR = 8.f;
typedef short s16x4 __attribute__((ext_vector_type(4)));
typedef unsigned u32x4 __attribute__((ext_vector_type(4)));
#define KSWZ(row, colB) ((row) * 256 + ((colB) ^ (((row) & 7) << 4)))
#define SBAR() __builtin_amdgcn_sched_barrier(0)
__device__ __forceinline__ int v_st(int k, int c) { const int kk = (k & ~0xC) | ((k & 4) << 1) | ((k & 8) >> 1); return ((kk >> 3) * 4 + (c >> 5)) * 512 + ((kk & 7) * 32 + (c & 31)) * 2; }
__device__ __forceinline__ int v_rd_base(int lane) { return ((lane & 3) << 3) | (((lane >> 2) & 3) << 6) | (((lane >> 4) & 1) << 5) | (((lane >> 5) & 1) << 8); }
constexpr int v_rd_off(int d0, int ks, int half) { return d0 * 512 + ks * 4096 + half * 2048; }
__device__ __forceinline__ int crow(int r, int hi) { return (r & 3) + 8 * (r >> 2) + 4 * hi; }
__device__ __forceinline__ unsigned cvtpk(float lo, float hi) { unsigned r; asm volatile("v_cvt_pk_bf16_f32 %0, %1, %2" : "=v"(r) : "v"(lo), "v"(hi)); return r; }
__device__ __forceinline__ bf16x8 load8(const bf16* p) { return *reinterpret_cast<const bf16x8*>(p); }
__device__ __forceinline__ void mask_tile(f32x16& p0, f32x16& p1, int dq) {
    const float NEG = -__builtin_inff();
#pragma unroll
    for (int r = 0; r < 16; ++r) { const int c = (r & 3) + 8 * (r >> 2); if (dq - c < 0) p0[r] = NEG; if (dq - c - 32 < 0) p1[r] = NEG; }
}
__device__ __forceinline__ void partialSM(f32x16& p0, f32x16& p1, float& m_reg, float& mn, float& alpha) {
    float pmax = p0[0]; for (int r = 1; r < 16; ++r) pmax = fmaxf(pmax, p0[r]); for (int r = 0; r < 16; ++r) pmax = fmaxf(pmax, p1[r]);
    { auto rr = __builtin_amdgcn_permlane32_swap(__float_as_uint(pmax), __float_as_uint(pmax), false, false);
      pmax = fmaxf(__uint_as_float(rr[0]), __uint_as_float(rr[1])); }
    constexpr float C2 = 1.4426950408889634f * SCALE;
    if (__builtin_expect(__all((pmax - m_reg) * SCALE <= THR), 1)) { mn = m_reg; alpha = 1.f; }
    else { mn = fmaxf(m_reg, pmax); alpha = __builtin_amdgcn_exp2f((m_reg - mn) * C2); m_reg = mn; }
    const float mnL = -mn * C2;
    for (int r = 0; r < 16; ++r) p0[r] = fmaf(p0[r], C2, mnL); for (int r = 0; r < 16; ++r) p1[r] = fmaf(p1[r], C2, mnL);
    for (int r = 0; r < 16; ++r) p0[r] = __builtin_amdgcn_exp2f(p0[r]);
}
#define PK4(P, B_, OUT) do { unsigned a0 = cvtpk(P[B_+0], P[B_+1]), a1 = cvtpk(P[B_+2], P[B_+3]);                          \
        unsigned b0 = cvtpk(P[B_+4], P[B_+5]), b1 = cvtpk(P[B_+6], P[B_+7]);                                             \
        auto r0 = __builtin_amdgcn_permlane32_swap(a0, b0, false, false); auto r1 = __builtin_amdgcn_permlane32_swap(a1, b1, false, false); \
        u32x4 w = {r0[0], r1[0], r0[1], r1[1]}; OUT = *reinterpret_cast<bf16x8*>(&w); } while (0)
__device__ __forceinline__ void finishSM(f32x16& p0, f32x16& p1, float alpha, float& l_reg, bf16x8& pa0, bf16x8& pa1, bf16x8& pa2, bf16x8& pa3) {
    for (int r = 0; r < 16; ++r) p1[r] = __builtin_amdgcn_exp2f(p1[r]);
    float ps = 0; for (int r = 0; r < 16; ++r) ps += p0[r]; for (int r = 0; r < 16; ++r) ps += p1[r];
    { auto rr = __builtin_amdgcn_permlane32_swap(__float_as_uint(ps), __float_as_uint(ps), false, false);
      ps = __uint_as_float(rr[0]) + __uint_as_float(rr[1]); }
    l_reg = l_reg * alpha + ps;
    PK4(p0, 0, pa0); PK4(p0, 8, pa1); PK4(p1, 0, pa2); PK4(p1, 8, pa3);
}
template <int KB>
__device__ __forceinline__ void qkt(f32x16& p0, f32x16& p1, const char* K_lds, int r32, int hi, const bf16x8* qr) {
    p0 = f32x16{}; p1 = f32x16{};
    const char* kb[4];
#pragma unroll
    for (int dd = 0; dd < 4; ++dd) kb[dd] = K_lds + KB * SHM_K + KSWZ(r32, (dd * 16 + hi * 8) * 2);
#pragma unroll
    for (int d0 = 0; d0 < 8; ++d0) { const char* a = kb[d0 & 3] + (d0 >> 2) * 128;
        bf16x8 b0 = *reinterpret_cast<const bf16x8*>(a);
        bf16x8 b1 = *reinterpret_cast<const bf16x8*>(a + 32 * 256);
        p0 = __builtin_amdgcn_mfma_f32_32x32x16_bf16(b0, qr[d0], p0, 0, 0, 0);
        p1 = __builtin_amdgcn_mfma_f32_32x32x16_bf16(b1, qr[d0], p1, 0, 0, 0); }
}
template <int VB>
__device__ __forceinline__ void pv_tile(f32x16* o, int vb0, bf16x8 pa0, bf16x8 pa1, bf16x8 pa2, bf16x8 pa3) {
#define TRRD(dst, off) asm volatile("ds_read_b64_tr_b16 %0, %1 offset:%2" : "=&v"(dst) : "v"(vb0), "i"(off) : "memory")
#define PV_D0(d0) do { s16x4 l0, l1, l2, l3, h0, h1, h2, h3; constexpr int b_ = VB * SHM_V + v_rd_off(d0, 0, 0); \
        TRRD(l0, b_); TRRD(h0, b_ + 2048); TRRD(l1, b_ + 4096); TRRD(h1, b_ + 6144); TRRD(l2, b_ + 8192); TRRD(h2, b_ + 10240); TRRD(l3, b_ + 12288); TRRD(h3, b_ + 14336); \
        asm volatile("s_waitcnt lgkmcnt(0)" ::: "memory"); SBAR();   \
        o[d0] = __builtin_amdgcn_mfma_f32_32x32x16_bf16(pa0, (bf16x8){l0[0], l0[1], l0[2], l0[3], h0[0], h0[1], h0[2], h0[3]}, o[d0], 0, 0, 0);   \
        o[d0] = __builtin_amdgcn_mfma_f32_32x32x16_bf16(pa1, (bf16x8){l1[0], l1[1], l1[2], l1[3], h1[0], h1[1], h1[2], h1[3]}, o[d0], 0, 0, 0);   \
        o[d0] = __builtin_amdgcn_mfma_f32_32x32x16_bf16(pa2, (bf16x8){l2[0], l2[1], l2[2], l2[3], h2[0], h2[1], h2[2], h2[3]}, o[d0], 0, 0, 0);   \
        o[d0] = __builtin_amdgcn_mfma_f32_32x32x16_bf16(pa3, (bf16x8){l3[0], l3[1], l3[2], l3[3], h3[0], h3[1], h3[2], h3[3]}, o[d0], 0, 0, 0); } while (0)
    PV_D0(0); PV_D0(1); PV_D0(2); PV_D0(3);
#undef PV_D0
#undef TRRD
}
__device__ __forceinline__ void key_bias(f32x16& p0, f32x16& p1, const char* lds, int kbase, int hi) {
    const float* kbp = (const float*)(lds + OFF_C) + kbase + 4 * hi;
#pragma unroll
    for (int g = 0; g < 4; ++g) { const f32x4 b0 = *(const f32x4*)(kbp + 8 * g), b1 = *(const f32x4*)(kbp + 32 + 8 * g);
#pragma unroll
        for (int e = 0; e < 4; ++e) { p0[4 * g + e] -= b0[e]; p1[4 * g + e] -= b1[e]; } }
}
__device__ __forceinline__ void cgate_scan(const float* logf_h, char* lds, const int WAVE_) {
    const int lane = lane_id(), tid = WAVE_ * 64 + lane;
    float* Cl = (float*)(lds + OFF_C); float* wtot = (float*)(lds + OFF_WTOT);
    const float* src = logf_h + tid * 16;
    const f32x4 a = *(const f32x4*)src, b = *(const f32x4*)(src + 4), c = *(const f32x4*)(src + 8), d = *(const f32x4*)(src + 12);
    const float in[16] = {a[0], a[1], a[2], a[3], b[0], b[1], b[2], b[3], c[0], c[1], c[2], c[3], d[0], d[1], d[2], d[3]};
    float loc[16]; float s = 0.f;
#pragma unroll
    for (int j = 0; j < 16; ++j) { s += in[j]; loc[j] = s; }
    float incl = s;
#pragma unroll
    for (int o = 1; o < 64; o <<= 1) { const float t = __builtin_bit_cast(float, __builtin_amdgcn_ds_bpermute((lane - o) << 2, __builtin_bit_cast(int, incl))); if (lane >= o) incl += t; }
    if (lane == 63) wtot[WAVE_] = incl;
    __syncthreads();
    float base = incl - s;
    for (int w = 0; w < WAVE_; ++w) base += wtot[w];
#pragma unroll
    for (int j = 0; j < 16; j += 4) *(f32x4*)(Cl + tid * 16 + j) = (f32x4){base + loc[j], base + loc[j + 1], base + loc[j + 2], base + loc[j + 3]} * (1.0f / SCALE);
    __syncthreads();
}

struct BlockRef { const bf16* Q; const bf16* K; const bf16* V; bf16* O; int P0; };
struct Seam { bf16x8 qr[8]; bf16x8 st_v0, st_v1, st_k0, st_k1; };
#define ROW(p, k0, rr) ((p) + (size_t)((k0) + (rr)) * PITCH + sc)
#define VMW() asm volatile("s_waitcnt vmcnt(0)" ::: "memory")
#define VMWN(n) asm volatile("s_waitcnt vmcnt(%0)" :: "i"(n) : "memory")
#define SLOAD_H(Kp, Vp, k0) do { S.st_v0 = load8(ROW(Vp, k0, sr)); S.st_v1 = load8(ROW(Vp, k0, 32 + sr));              \
                         S.st_k0 = load8(ROW(Kp, k0, sr)); S.st_k1 = load8(ROW(Kp, k0, 32 + sr)); } while (0)
#define SWRITE_HK(bf) do { *(bf16x8*)(K_lds + (bf) * SHM_K + kws) = S.st_k0; *(bf16x8*)(K_lds + (bf) * SHM_K + kws + 32 * 256) = S.st_k1; } while (0)
#define SWRITE_HV(bf) do { *(bf16x8*)(V_lds + (bf) * SHM_V + vst0) = S.st_v0; *(bf16x8*)(V_lds + (bf) * SHM_V + vst1) = S.st_v1; } while (0)
#define SWRITE_H(bf) do { SWRITE_HV(bf); SWRITE_HK(bf); } while (0)
__device__ __forceinline__ void fox_prime(const BlockRef& cur, char* lds, Seam& S, const int WAVE_) {
    const int tid = TID(), wid = __builtin_amdgcn_readfirstlane(tid >> 6), lane = tid & 63, r32 = lane & 31, hi = lane >> 5;
    const int sr = tid >> 4, sc = (tid & 15) * 8, kws = KSWZ(sr, sc * 2); char* K_lds = lds + 2 * SHM_V;
    for (int d0 = 0; d0 < 8; ++d0) S.qr[d0] = load8(cur.Q + (size_t)(wid * QBLK + r32) * PITCH + d0 * 16 + hi * 8);
    SLOAD_H(cur.K, cur.V, ((cur.P0 + QB - 1) / KVBLK) * KVBLK); VMW(); SWRITE_HK(0);
    __syncthreads();
}
__device__ __forceinline__ void fox_block(const BlockRef& cur, const BlockRef& nxt, const float Uq, char* lds, Seam& S, const int WAVE_) {
    const int tid = TID(), wid = __builtin_amdgcn_readfirstlane(tid >> 6), lane = tid & 63, r32 = lane & 31, hi = lane >> 5;
    const int NT0 = (cur.P0 + QB - 1) / KVBLK + 1;
    int NT = NT0;
    volatile LAS int* flg = (volatile LAS int*)(lds + OFF_FLAG);
    const int qlo = cur.P0 + wid * QBLK, qm = qlo + r32 - 4 * hi;
    char* V_lds = lds; char* K_lds = lds + 2 * SHM_V;
    float* ws = (float*)(lds + OFF_WS) + wid * 64; float* li_l = ws, * al_l = ws + 32;
    float m_reg = -1e30f, l_reg = 0; f32x16 o[4] = {};
    const int sr = tid >> 4, sc = (tid & 15) * 8, vst0 = v_st(sr, sc), vst1 = v_st(32 + sr, sc), kws = KSWZ(sr, sc * 2);
    const int vb0 = (int)(uintptr_t)V_lds + v_rd_base(lane);
    const bf16* Kh = cur.K; const bf16* Vh = cur.V;
#define RESC(a) do { if (__any((a) < 1.f)) { if (hi == 0) al_l[r32] = (a); asm volatile("s_waitcnt lgkmcnt(0)" ::: "memory");              \
                     for (int d_ = 0; d_ < 4; ++d_) for (int r = 0; r < 16; ++r) o[d_][r] *= al_l[crow(r, hi)]; } } while (0)
#define KBASE(t) ((NT0 - 1 - (t)) * KVBLK)
#define MASKT(P0_, P1_, t, KBUF) do { const int kb_ = KBASE(t); key_bias(P0_, P1_, lds, kb_, hi); if (kb_ + KVBLK - 1 > qlo) mask_tile(P0_, P1_, qm - kb_); } while (0)
#define SEAM_K0() do { VMWN(8); SWRITE_HK(0); SBAR(); } while (0)
    f32x16 pA0, pA1, pB0, pB1; float mnA, mnB, alA, alB; bf16x8 pa0, pa1, pa2, pa3;
    SWRITE_HV(0); SBAR();
    if (NT > 1) { SLOAD_H(Kh, Vh, KBASE(1)); }
    SBAR(); qkt<0>(pA0, pA1, K_lds, r32, hi, S.qr);
    MASKT(pA0, pA1, 0, 0); partialSM(pA0, pA1, m_reg, mnA, alA);
    if (NT > 1) { VMW(); SWRITE_H(1); }
    __syncthreads();
#define VOTE(t) do { bool can_ = false; if ((t) + 2 < NT) { const float negc_ = -((const float*)(lds + OFF_C))[KBASE((t) + 2) + KVBLK - 1]; can_ = __all((Uq + negc_ - m_reg) * SCALE <= -104.f) != 0; } \
                     if (lane == 0) flg[wid] = can_ ? 1 : 0; } while (0)
#define DECIDE(t) do { int all_ = 1; _Pragma("unroll") for (int w_ = 0; w_ < 8; ++w_) all_ &= flg[w_]; if (all_ && (t) + 2 < NT) NT = (t) + 2; } while (0)
#define HALF_STEP(PX0, PX1, mnX, alX, PY0, PY1, alY, t, KB, VB, SB) do {                                                      \
        SBAR(); qkt<KB>(PX0, PX1, K_lds, r32, hi, S.qr);                                                                     \
        finishSM(PY0, PY1, alY, l_reg, pa0, pa1, pa2, pa3); SBAR();                                                           \
        if ((t) + 1 < NT) { SLOAD_H(Kh, Vh, KBASE((t) + 1)); SBAR(); }                                                    \
        pv_tile<VB>(o, vb0, pa0, pa1, pa2, pa3); MASKT(PX0, PX1, (t), KB); partialSM(PX0, PX1, m_reg, mnX, alX); VOTE(t);    \
        __syncthreads(); DECIDE(t);                                                                                           \
        if ((t) + 1 < NT) { VMW(); SWRITE_H(SB); }                                                                            \
        RESC(alX); __syncthreads(); } while (0)
    for (int t = 1; t + 1 < NT; t += 2) {
        HALF_STEP(pB0, pB1, mnB, alB, pA0, pA1, alA, t, 1, 0, 0);
        HALF_STEP(pA0, pA1, mnA, alA, pB0, pB1, alB, t + 1, 0, 1, 1);
    }
    const bool even = (NT & 1) == 0;
    if (even) { SBAR(); qkt<1>(pB0, pB1, K_lds, r32, hi, S.qr); SBAR(); }
    SLOAD_H(nxt.K, nxt.V, ((nxt.P0 + QB - 1) / KVBLK) * KVBLK); SBAR();
#pragma unroll
    for (int d0 = 0; d0 < 8; ++d0) S.qr[d0] = load8(nxt.Q + (size_t)(wid * QBLK + r32) * PITCH + d0 * 16 + hi * 8);
    SBAR();
    finishSM(pA0, pA1, alA, l_reg, pa0, pa1, pa2, pa3); SBAR();
    pv_tile<0>(o, vb0, pa0, pa1, pa2, pa3);
    if (even) { MASKT(pB0, pB1, NT - 1, 1); partialSM(pB0, pB1, m_reg, mnB, alB); __syncthreads(); RESC(alB);
        finishSM(pB0, pB1, alB, l_reg, pa0, pa1, pa2, pa3); SBAR(); pv_tile<1>(o, vb0, pa0, pa1, pa2, pa3); }
    SBAR(); SEAM_K0();
    if (hi == 0) li_l[r32] = l_reg; asm volatile("s_waitcnt lgkmcnt(0)" ::: "memory");
    float rli[16];
#pragma unroll
    for (int r = 0; r < 16; ++r) rli[r] = __builtin_amdgcn_rcpf(li_l[crow(r, hi)]);
    bf16* Ow = cur.O + (size_t)(wid * QBLK) * PITCH;
#pragma unroll
    for (int r = 0; r < 16; ++r) { const int orow = crow(r, hi);
#pragma unroll
        for (int d0 = 0; d0 < 4; ++d0) { const float v = o[d0][r] * rli[r];
            const float vn = __shfl_xor(v, 1);
            if ((r32 & 1) == 0) *(unsigned*)(Ow + (size_t)orow * PITCH + d0 * 32 + r32) = cvtpk(v, vn); } }
    __syncthreads();
#undef RESC
#undef MASKT
#undef SEAM_K0
#undef HALF_STEP
#undef VOTE
#undef DECIDE
#undef KBASE
}

template <int BUF>
__device__ __forceinline__ void sb_tile(f32x16* o, float& R, const char* K_lds, int vb0, int r32, int hi, const bf16x8* qr, int dq) {
    f32x16 p0, p1;
    qkt<BUF>(p0, p1, K_lds, r32, hi, qr);
    constexpr float L2E = 1.4426950408889634f, LN2 = 0.6931471805599453f;
    f32x16 l0, l1;
    const float NEG = -__builtin_inff();
#pragma unroll
    for (int r = 0; r < 16; ++r) { const int c = (r & 3) + 8 * (r >> 2);
        { const float z = p0[r] * SCALE; const float sp = fmaxf(z, 0.f) + LN2 * __builtin_amdgcn_logf(1.0f + __builtin_amdgcn_exp2f(-fabsf(z) * L2E)); const bool st = (dq - c) >= 1; l0[r] = st ? -sp : 0.f; p0[r] = st ? (z - sp) : NEG; }
        { const float z = p1[r] * SCALE; const float sp = fmaxf(z, 0.f) + LN2 * __builtin_amdgcn_logf(1.0f + __builtin_amdgcn_exp2f(-fabsf(z) * L2E)); const bool st = (dq - c - 32) >= 1; l1[r] = st ? -sp : 0.f; p1[r] = st ? (z - sp) : NEG; } }
    float gs[8], pg[8], ps[8];
#pragma unroll
    for (int g = 0; g < 4; ++g) { gs[g] = (l0[4 * g] + l0[4 * g + 1]) + (l0[4 * g + 2] + l0[4 * g + 3]); gs[4 + g] = (l1[4 * g] + l1[4 * g + 1]) + (l1[4 * g + 2] + l1[4 * g + 3]); }
#pragma unroll
    for (int g = 0; g < 8; ++g) { auto rr = __builtin_amdgcn_permlane32_swap(__float_as_uint(gs[g]), __float_as_uint(gs[g]), false, false);
        const float lo = __uint_as_float(rr[0]), hv = __uint_as_float(rr[1]); ps[g] = lo + hv; pg[g] = hi ? lo : hv; }
    float acc = R;
#pragma unroll
    for (int g = 7; g >= 0; --g) {
        float run = hi ? acc : acc + pg[g];
        acc += ps[g];
        if (g >= 4) { const int b = 4 * (g - 4);
#pragma unroll
            for (int e = 3; e >= 0; --e) { const float t = l1[b + e]; p1[b + e] = __builtin_amdgcn_exp2f((p1[b + e] + run) * L2E); run += t; } }
        else { const int b = 4 * g;
#pragma unroll
            for (int e = 3; e >= 0; --e) { const float t = l0[b + e]; p0[b + e] = __builtin_amdgcn_exp2f((p0[b + e] + run) * L2E); run += t; } }
    }
    R = acc;
    bf16x8 pa0, pa1, pa2, pa3;
    PK4(p0, 0, pa0); PK4(p0, 8, pa1); PK4(p1, 0, pa2); PK4(p1, 8, pa3);
    pv_tile<BUF>(o, vb0, pa0, pa1, pa2, pa3);
}
__device__ __forceinline__ void sb_block(const BlockRef& cur, char* lds, const int WAVE_) {
    const int tid = TID(), wid = __builtin_amdgcn_readfirstlane(tid >> 6), lane = tid & 63, r32 = lane & 31, hi = lane >> 5;
    const int NT = (cur.P0 + QB - 1) / KVBLK + 1;
    const int qlo = cur.P0 + wid * QBLK, qm = qlo + r32 - 4 * hi;
    char* V_lds = lds; char* K_lds = lds + 2 * SHM_V;
    volatile LAS int* flg = (volatile LAS int*)(lds + OFF_FLAG);
    const int sr = tid >> 4, sc = (tid & 15) * 8, vst0 = v_st(sr, sc), vst1 = v_st(32 + sr, sc), kws = KSWZ(sr, sc * 2);
    const int vb0 = (int)(uintptr_t)V_lds + v_rd_base(lane);
    const bf16* Kh = cur.K; const bf16* Vh = cur.V;
    bf16x8 qr[8];
#pragma unroll
    for (int d0 = 0; d0 < 8; ++d0) qr[d0] = load8(cur.Q + (size_t)(wid * QBLK + r32) * PITCH + d0 * 16 + hi * 8);
    bf16x8 st_v0, st_v1, st_k0, st_k1;
#define SB_LOAD(k0) do { st_v0 = load8(ROW(Vh, k0, sr)); st_v1 = load8(ROW(Vh, k0, 32 + sr)); st_k0 = load8(ROW(Kh, k0, sr)); st_k1 = load8(ROW(Kh, k0, 32 + sr)); } while (0)
#define SB_WRITE(bf) do { *(bf16x8*)(V_lds + (bf) * SHM_V + vst0) = st_v0; *(bf16x8*)(V_lds + (bf) * SHM_V + vst1) = st_v1; \
                          *(bf16x8*)(K_lds + (bf) * SHM_K + kws) = st_k0; *(bf16x8*)(K_lds + (bf) * SHM_K + kws + 32 * 256) = st_k1; } while (0)
    f32x16 o[4] = {}; float R = 0.f; bool fin = false;
    SB_LOAD((NT - 1) * KVBLK); VMW(); SB_WRITE(0);
    if (NT > 1) SB_LOAD((NT - 2) * KVBLK);
    __syncthreads();
#define SB_STEP(t, BUF) do { const int kb_ = (NT - 1 - (t)) * KVBLK;                                                         \
        if (!fin && kb_ <= qlo + QBLK - 2) { sb_tile<BUF>(o, R, K_lds, vb0, r32, hi, qr, qm - kb_); fin = __all(R < -105.f); } \
        if ((t) + 1 < NT) { VMW(); SB_WRITE((BUF) ^ 1); if ((t) + 2 < NT) SB_LOAD((NT - 3 - (t)) * KVBLK); }                   \
        if (lane == 0) flg[(BUF) * 8 + wid] = fin ? 1 : 0;                                                                   \
        __syncthreads();                                                                                                      \
        { int all_ = 1; _Pragma("unroll") for (int w_ = 0; w_ < 8; ++w_) all_ &= flg[(BUF) * 8 + w_]; stop = all_ != 0; } } while (0)
    bool stop = false;
    for (int t = 0; t < NT; t += 2) {
        SB_STEP(t, 0);
        if (stop || t + 1 >= NT) break;
        SB_STEP(t + 1, 1);
        if (stop) break;
    }
    bf16* Ow = cur.O + (size_t)(wid * QBLK) * PITCH;
#pragma unroll
    for (int r = 0; r < 16; ++r) { const int orow = crow(r, hi);
#pragma unroll
        for (int d0 = 0; d0 < 4; ++d0) { const float v = o[d0][r];
            const float vn = __shfl_xor(v, 1);
            if ((r32 & 1) == 0) *(unsigned*)(Ow + (size_t)orow * PITCH + d0 * 32 + r32) = cvtpk(v, vn); } }
    __syncthreads();
#undef SB_LOAD
#undef SB_WRITE
#undef SB_STEP
}
#undef ROW
#undef VMW
#undef VMWN
#undef SLOAD_H
#undef SWRITE_HK
#undef SWRITE_HV
#undef SWRITE_H
#undef PK4
#undef KSWZ
}

constexpr int REP_X3 = 0;
constexpr int REP_X2 = 0;
constexpr int X1_ALIGN = 1, X1_SP2 = 1;
constexpr int REP_X1 = 0, REP_X1N = 20480;
constexpr int REP_P0W = 1, REP_P0R = 1;
constexpr int REP_P0 = 1, REP_P1 = 1, REP_FOX = 1, REP_SB = 1, REP_P3A = 1, REP_P5 = 1, REP_P5B = 1, REP_P7A = 1;
enum { PH_P0 = 0, PH_P1, PH_P1B, PH_ATT, PH_P3A, PH_P3B, PH_P4, PH_P5, PH_P5B, PH_P6, PH_P7A, PH_P7, PH_N };
__global__ void __launch_bounds__(NWAVES * 64, 2) mega_fwd(Params P) {
    extern __shared__ __attribute__((aligned(16))) unsigned char lds[];
    Frame F;
    F.lds = (LAS unsigned char*)lds;
    F.MISC = (volatile LAS unsigned*)(F.lds + MISC_OFF);
    F.wave = __builtin_amdgcn_readfirstlane((int)(__builtin_amdgcn_workitem_id_x() >> 6));
    const int WAVE_ = F.wave; const int f_tid = TID();
    F.G = gridDim.x; { const int bx = blockIdx.x; F.vcu = (F.G % 8 == 0) ? (bx % 8) * (F.G / 8) + bx / 8 : bx; }
    unsigned char* ws = P.ws;
    F.ctl = (gu32*)(ws + WS_CTL);
    for (int u = f_tid; u < (LDS_BYTES - LDSCTL_OFF) / 4; u += NWAVES * 64) ((LAS unsigned*)(F.lds + LDSCTL_OFF))[u] = 0u;
    __syncthreads();
    XcdBarrier bar = xcd_barrier_post((unsigned*)(F.ctl + CW_BAR) + P.li * XCD_BAR_WORDS, F.MISC + 8, F.wave);
    const int lo = P.ph_lo, hi = P.ph_hi;
#define IN(k) (lo <= (k) && (k) < hi)
#define SEAM(k) do { if (IN(k) && IN((k) + 1)) xcd_barrier(bar); } while (0)
    bf16* W_in = (bf16*)(ws + WS_WIN); bf16* XB = (bf16*)(ws + WS_XB);
    float* ss1 = (float*)(ws + WS_SS1); float* ss2 = (float*)(F.ctl + CW_SS2); float* ss3 = (float*)(F.ctl + CW_SS3);
    bf16* QKV = (bf16*)(ws + WS_QKV); bf16* GATES = (bf16*)(ws + WS_GATES); bf16* Y = (bf16*)(ws + WS_Y); bf16* MERGED = (bf16*)(ws + WS_MERGED);
    LAS unsigned char* ring = F.lds + RING_OFF;

    if (IN(PH_P0)) { for (int rep = 0; rep < REP_P0; ++rep) { for (int r2 = 0; r2 < REP_P0W; ++r2) p0_weights(F, P); for (int r2 = 0; r2 < REP_P0R; ++r2) p0_rows(F, P); } }
    SEAM(PH_P0);
    if (IN(PH_P1)) { for (int rep = 0; rep < REP_P1; ++rep) {
        pg8::Gemm g{XB, W_in, S, NPROJ, DM}; pg8::StaticOrder So; So.init(S, NPROJ, F.G, (int)blockIdx.x);
        pg8::EpiProj E{QKV, GATES, ss1};
        pg8::gemm_phase<pg8::EpiProj, pg8::StaticOrder, true, true>(ring, g, So, E, F.wave);
    } }
    if (IN(PH_P1)) { for (int rep = 0; rep < REP_X1; ++rep) {
        pg8::Gemm g{XB, W_in, S, REP_X1N, DM}; pg8::StaticOrder So; So.init(S, REP_X1N, F.G, (int)blockIdx.x);
        pg8::EpiNull E{};
        pg8::gemm_phase<pg8::EpiNull, pg8::StaticOrder, true, true>(ring, g, So, E, F.wave);
    } }
    if (IN(PH_P1)) { for (int rep = 0; rep < REP_X2; ++rep) {
        struct SameOrder : pg8::StaticOrder { __device__ bool next(int i, pg8::Unit& u) const { const bool ok = pg8::StaticOrder::next(i, u); u.pm = 0; u.pn = 0; return ok; } };
        pg8::Gemm g{XB, W_in, S, NPROJ, DM}; SameOrder So; So.init(S, NPROJ, F.G, (int)blockIdx.x);
        pg8::EpiNull E{};
        pg8::gemm_phase<pg8::EpiNull, SameOrder, true, true>(ring, g, So, E, F.wave);
    } }
    if (IN(PH_P1)) { for (int rep = 0; rep < REP_X3; ++rep) {
        const long long c0 = clock64();
        pg8::Gemm g{XB, W_in, S, NPROJ, DM}; pg8::StaticOrder So; So.init(S, NPROJ, F.G, (int)blockIdx.x);
        pg8::EpiNull E{};
        pg8::gemm_phase<pg8::EpiNull, pg8::StaticOrder, true, true>(ring, g, So, E, F.wave);
        const long long extra = (clock64() - c0) >> 7; const long long t1 = wall_clock64();
        while (wall_clock64() - t1 < extra) __builtin_amdgcn_s_sleep(10);
    } }
    SEAM(PH_P1);
    if (IN(PH_P1B)) { p1b_qknorm_fgate(F, P); }
    SEAM(PH_P1B);
    if (IN(PH_ATT)) {
        char* al = (char*)lds + RING_OFF;
        const size_t T = (size_t)S * WF;
        gu32* qctr = F.ctl + CW_QATT; volatile LAS int* nx = (volatile LAS int*)(F.lds + RING_OFF + att::OFF_NEXT);
        const int a_lane = lane_id(); const bool puller = (F.wave == 0 && a_lane == 0);
        float gqm = fmaxf(fabsf(P.in[5][a_lane]), fabsf(P.in[5][a_lane + 64])), gkm = fmaxf(fabsf(P.in[6][a_lane]), fabsf(P.in[6][a_lane + 64]));
#pragma unroll
        for (int o = 1; o < 64; o <<= 1) { gqm = fmaxf(gqm, __shfl_xor(gqm, o)); gkm = fmaxf(gkm, __shfl_xor(gkm, o)); }
        const float Uq = __builtin_bit_cast(float, __builtin_amdgcn_readfirstlane(__builtin_bit_cast(int, 128.0f * gqm * gkm * 1.02f)));
        if (puller) nx[0] = (int)__hip_atomic_fetch_add(qctr, 1u, RLX_AGENT);
        __syncthreads();
        int item = nx[0];
        __syncthreads();
        {
            bool primed = false; att::Seam Sm;
            while (item < NH * 32) {
                int pulled = 0;
                if (puller) pulled = (int)__hip_atomic_fetch_add(qctr, 1u, RLX_AGENT);
                const int h = item & 15, qb = 31 - (item >> 4);
                att::cgate_scan((const float*)(ws + WS_LOGF) + (size_t)h * S, al, F.wave);
                if (puller) nx[0] = pulled;
                att::BlockRef cur; cur.Q = QKV + (size_t)(qb * 256) * WF + h * HD; cur.K = QKV + T + h * HD; cur.V = QKV + 2 * T + h * HD; cur.O = Y + (size_t)(qb * 256) * WF + h * HD; cur.P0 = qb * 256;
                if (!primed) att::fox_prime(cur, al, Sm, F.wave); else __syncthreads();
                const int nitem = nx[0];
                att::BlockRef nxt = cur; primed = false;
                if (nitem < NH * 32) { const int h2 = nitem & 15, q2 = 31 - (nitem >> 4);
                    nxt.Q = QKV + (size_t)(q2 * 256) * WF + h2 * HD; nxt.K = QKV + T + h2 * HD; nxt.V = QKV + 2 * T + h2 * HD; nxt.O = Y + (size_t)(q2 * 256) * WF + h2 * HD; nxt.P0 = q2 * 256; primed = true; }
                att::fox_block(cur, nxt, Uq, al, Sm, F.wave);
                item = nitem;
            }
        }
        while (item < 2 * NH * 32) {
            int pulled = 0;
            if (puller) pulled = (int)__hip_atomic_fetch_add(qctr, 1u, RLX_AGENT);
            const int L = item - NH * 32, h = L & 15, qb = 31 - (L >> 4);
            att::BlockRef b; b.Q = QKV + 3 * T + (size_t)(qb * 256) * WF + h * HD; b.K = QKV + 4 * T + h * HD; b.V = QKV + 5 * T + h * HD; b.O = Y + T + (size_t)(qb * 256) * WF + h * HD; b.P0 = qb * 256;
            if (puller) nx[0] = pulled;
            att::sb_block(b, al, F.wave);
            item = nx[0];
            __syncthreads();
        }
    }
    SEAM(PH_ATT);
    if (IN(PH_P3A)) {
        pg8::Gemm g{Y, (bf16*)(ws + WS_WBF), S, DM, WF}; pg8::TwoPartOrder So; So.init(S, DM, F.G, (int)blockIdx.x); So.A1 = Y + (size_t)S * WF; So.B1 = (bf16*)(ws + WS_WBS);
        pg8::EpiGate2 E{MERGED, GATES, GATES + (size_t)S * DM};
        pg8::gemm_phase<pg8::EpiGate2, pg8::TwoPartOrder, true, true>(ring, g, So, E, F.wave);
    }
    SEAM(PH_P3B);
    if (IN(PH_P4)) {
        pg8::Gemm g{MERGED, (bf16*)(ws + WS_WOUT), S, DM, DM}; pg8::StaticOrder So; So.init(S, DM, F.G, (int)blockIdx.x);
        pg8::EpiResStat E{P.in[0], P.out, XB, ss2};
        pg8::gemm_phase<pg8::EpiResStat, pg8::StaticOrder, true, true>(ring, g, So, E, F.wave);
    }
    SEAM(PH_P4);
    if (IN(PH_P5)) { for (int rep = 0; rep < REP_P5; ++rep) {
        pg8::Gemm g{XB, (bf16*)(ws + WS_WUP), S, 2 * DFF, DM}; pg8::StaticOrder So; So.init(S, 2 * DFF, F.G, (int)blockIdx.x);
        pg8::EpiUp E{(bf16*)(ws + WS_UP), 2 * DFF, ss2};
        pg8::gemm_phase<pg8::EpiUp, pg8::StaticOrder, true, true>(ring, g, So, E, F.wave);
    } }
    SEAM(PH_P5);
    if (IN(PH_P5B)) { for (int rep = 0; rep < REP_P5B; ++rep) p5b_convglu(F, P); }
    SEAM(PH_P5B);
    if (IN(PH_P6)) {
        pg8::Gemm g{(bf16*)(ws + WS_ACT), (bf16*)(ws + WS_WDN), S, DM, DFF}; pg8::StaticOrder So; So.init(S, DM, F.G, (int)blockIdx.x);
        pg8::EpiResStat E{P.out, P.out, XB, ss3};
        pg8::gemm_phase<pg8::EpiResStat, pg8::StaticOrder, true, true>(ring, g, So, E, F.wave);
    }
    SEAM(PH_P6);
    if (IN(PH_P7A)) { for (int rep = 0; rep < REP_P7A; ++rep) {
        pg8::Gemm g{(bf16*)(ws + WS_PB), (bf16*)(ws + WS_WPP), S, DM, PLE}; pg8::StaticOrder So; So.init(S, DM, F.G, (int)blockIdx.x);
        pg8::EpiStoreBf16x4 E{(bf16*)(ws + WS_PP)};
        pg8::gemm_phase<pg8::EpiStoreBf16x4, pg8::StaticOrder, true, true>(ring, g, So, E, F.wave);
    } }
    if (IN(PH_P7)) {
        pg8::Gemm g{XB, (bf16*)(ws + WS_WPG), S, DM, DM}; pg8::StaticOrder So; So.init(S, DM, F.G, (int)blockIdx.x);
        pg8::EpiPle E{P.out, (const bf16*)(ws + WS_PP), ss3};
        pg8::gemm_phase<pg8::EpiPle, pg8::StaticOrder, true, true>(ring, g, So, E, F.wave);
    }
#undef IN
#undef SEAM
}

extern "C" void kernel_launch(void* const* d_in, const int* in_sizes, int n_in, void* d_out, int out_size, void* d_ws, size_t ws_size, hipStream_t stream) {
    static int grid = 0;
    if (grid == 0) {
        if (n_in != 18 || out_size != S * DM || ws_size < WS_END) { fprintf(stderr, "kernel_launch: unexpected shapes / workspace (%d inputs, out %d, ws %zu < %zu)\n", n_in, out_size, ws_size, (size_t)WS_END); grid = -1; return; }
        int dev = 0, cus = 0, per_cu = 0;
        if (hipGetDevice(&dev) != hipSuccess || hipDeviceGetAttribute(&cus, hipDeviceAttributeMultiprocessorCount, dev) != hipSuccess) { grid = -1; return; }
        if (hipFuncSetAttribute((const void*)mega_fwd, hipFuncAttributeMaxDynamicSharedMemorySize, LDS_BYTES) != hipSuccess) { fprintf(stderr, "kernel_launch: hipFuncSetAttribute failed\n"); grid = -1; return; }
        if (hipOccupancyMaxActiveBlocksPerMultiprocessor(&per_cu, (const void*)mega_fwd, NWAVES * 64, LDS_BYTES) != hipSuccess || per_cu < 1)
            fprintf(stderr, "kernel_launch: note: occupancy query reports %d workgroups per CU\n", per_cu);
        (void)hipGetLastError();
        grid = cus;
    }
    if (grid < 0) return;
    if (hipMemsetAsync((char*)d_ws + WS_CTL, 0, CTL_ZERO_BYTES, stream) != hipSuccess) return;
    Params a{};
    for (int i = 0; i < 18; ++i) a.in[i] = (const float*)d_in[i];
    a.out = (float*)d_out; a.ws = (unsigned char*)d_ws;
    a.ph_lo = PH_P0; a.ph_hi = PH_N; a.li = 0;
    hipLaunchKernelGGL(mega_fwd, dim3(grid), dim3(NWAVES * 64), LDS_BYTES, stream, a);
}
```

```cpp
#include <hip/hip_runtime.h>
#include <cstdio>
#include <cstdint>
__device__ __forceinline__ int lane_id() { int l; asm volatile("v_mbcnt_lo_u32_b32 %0, -1, 0\n\tv_mbcnt_hi_u32_b32 %0, -1, %0" : "=v"(l)); return l; }
#define TID() (WAVE_ * 64 + lane_id())
namespace pg8 {
#define PG8_LAS __attribute__((address_space(3)))
typedef unsigned short bf16_t;
typedef short bf16x8 __attribute__((ext_vector_type(8)));
typedef float f32x4 __attribute__((ext_vector_type(4)));
typedef unsigned u32x4 __attribute__((ext_vector_type(4)));
constexpr int BM = 256, BK = 64, HALF = 128, HTB = HALF * BK * 2  , STAGE_BYTES = 8 * HTB, NXCD = 8, WGM = 8;

__host__ __device__ __forceinline__ int lds_byte(int r, int c) { const int st = (r >> 4) * 2 + (c >> 5), rr = r & 15, cc = c & 31, ob = rr * 64 + cc * 2; return st * 1024 + (ob ^ (((ob >> 9) & 1) << 5)); }
__host__ __device__ __forceinline__ void stage_rc(int b, int& R, int& C) { const int st = b / 1024, sb = b % 1024, swz = sb ^ (((sb >> 9) & 1) << 5); R = (st >> 1) * 16 + swz / 64; C = (st & 1) * 32 + (swz % 64) / 2; }
__host__ __device__ __forceinline__ int perm32(int rho) { const int n = rho >> 4, i = rho & 15; return 8 * (i >> 2) + 4 * n + (i & 3); }

struct Unit { int pm, pn, part; };
struct Gemm { const bf16_t* A; const bf16_t* Bt; int M, N, K; };

struct StaticOrder {
    int nM, nN, nwg, G, c;
    __host__ __device__ void init(int M, int N, int G_, int c_) { nM = M / BM; nN = N / BM; nwg = nM * nN; G = G_; c = c_; }
    __host__ __device__ bool next(int i, Unit& u) const {
        const long L = (long)i * G + c; if (L >= nwg) return false;
        int wgid = (int)L; { const int q = nwg / NXCD, r = nwg % NXCD, xcd = wgid % NXCD, off = wgid / NXCD; wgid = (xcd < r ? xcd * (q + 1) : r * (q + 1) + (xcd - r) * q) + off; }
        const int nig = WGM * nN, gid = wgid / nig, fm = gid * WGM, gsz = (nM - fm) < WGM ? (nM - fm) : WGM;
        u.pm = fm + ((wgid % nig) % gsz); u.pn = (wgid % nig) / gsz; return true;
    }
    __device__ __forceinline__ void a_ready(const Unit&) const {}
    __device__ __forceinline__ void done(const Unit&) const {}
    __device__ __forceinline__ const bf16_t* baseA(const Gemm& g, const Unit&) const { return g.A; }
    __device__ __forceinline__ const bf16_t* baseB(const Gemm& g, const Unit&) const { return g.Bt; }
    __device__ __forceinline__ bool zero_after(const Unit&) const { return true; }
};

__device__ __forceinline__ unsigned cvt_pk_bf16(float lo, float hi) { unsigned r; asm volatile("v_cvt_pk_bf16_f32 %0, %1, %2" : "=v"(r) : "v"(lo), "v"(hi)); return r; }
typedef float f32x2 __attribute__((ext_vector_type(2)));
constexpr int SEQ_ = 8192, DM_ = 4096;
constexpr float EPS_ = 1e-6f;
__device__ __forceinline__ float sigm(float v) { return __builtin_amdgcn_rcpf(1.0f + __builtin_amdgcn_exp2f(-1.4426950408889634f * v)); }
__device__ __forceinline__ float rs_of(float ss) { return __builtin_amdgcn_rsqf(ss * (1.0f / DM_) + EPS_); }
typedef unsigned u32x2 __attribute__((ext_vector_type(2)));
__device__ __forceinline__ f32x4 bf4_to_f32(u32x2 w) { return (f32x4){__uint_as_float(w.x << 16), __uint_as_float(w.x & 0xffff0000u), __uint_as_float(w.y << 16), __uint_as_float(w.y & 0xffff0000u)}; }

#define EPI_ROWS(k) (row0 + ((k) >> 2) * HALF + ((k) & 3) * 16)
#define EPI_ACC(k, bj, n) acc[(k) >> 2][bj][(k) & 3][n]
__device__ __forceinline__ u32x4 pack8(const f32x4 v0, const f32x4 v1) { u32x4 w; w.x = cvt_pk_bf16(v0[0], v0[1]); w.y = cvt_pk_bf16(v0[2], v0[3]); w.z = cvt_pk_bf16(v1[0], v1[1]); w.w = cvt_pk_bf16(v1[2], v1[3]); return w; }

struct EpiProj {
    static constexpr bool PERM = true, AFTER_DRAIN = false;
    bf16_t* qkv; bf16_t* gates; const float* ss;
    __device__ __forceinline__ void operator()(const f32x4 (&acc)[2][2][4][2], const Unit& u, int wr, int wc, int fr, int fq) const {
        const int row0 = u.pm * BM + wr * 64 + fr;
        bf16_t* base; int ldc, colt; const bool gate = u.pn >= 48;
        if (!gate) { base = qkv + (size_t)(u.pn >> 3) * ((size_t)SEQ_ * 2048); ldc = 2048; colt = (u.pn & 7) * 256; }
        else { const int t = u.pn - 48; base = gates + (size_t)(t >> 4) * ((size_t)SEQ_ * 4096); ldc = 4096; colt = (t & 15) * 256; }
        const int col0 = colt + wc * 32 + 8 * fq;
        float rs[8];
#pragma unroll
        for (int k = 0; k < 8; ++k) rs[k] = ss[EPI_ROWS(k)];
#pragma unroll
        for (int k = 0; k < 8; ++k) { const float r = rs_of(rs[k]); bf16_t* rowp = base + (size_t)EPI_ROWS(k) * ldc + col0;
#pragma unroll
            for (int bj = 0; bj < 2; ++bj) { f32x4 v0 = EPI_ACC(k, bj, 0) * r, v1 = EPI_ACC(k, bj, 1) * r;
                if (gate) {
#pragma unroll
                    for (int j = 0; j < 4; ++j) { v0[j] = sigm(v0[j]); v1[j] = sigm(v1[j]); } }
                *(u32x4*)(rowp + bj * HALF) = pack8(v0, v1); } }
    }
};
struct EpiResStat {
    static constexpr bool PERM = false, AFTER_DRAIN = false;
    const float* base; float* out; bf16_t* xb; float* ss;
    __device__ __forceinline__ void operator()(const f32x4 (&acc)[2][2][4][2], const Unit& u, int wr, int wc, int fr, int fq) const {
        const int row0 = u.pm * BM + wr * 64 + fr, col0 = u.pn * BM + wc * 32 + 4 * fq;
        f32x4 b[2][4];
#define LD_(k) do { const size_t off_ = (size_t)EPI_ROWS(k) * DM_ + col0; _Pragma("unroll") for (int q_ = 0; q_ < 4; ++q_) b[(k) & 1][q_] = *(const f32x4*)(base + off_ + (q_ >> 1) * HALF + (q_ & 1) * 16); } while (0)
        LD_(0);
#pragma unroll
        for (int k = 0; k < 8; ++k) {
            if (k + 1 < 8) LD_(k + 1);
            const int r = EPI_ROWS(k); const size_t off = (size_t)r * DM_ + col0; float s = 0.f;
#pragma unroll
            for (int q = 0; q < 4; ++q) { const f32x4 o = b[k & 1][q] + EPI_ACC(k, q >> 1, q & 1);
                *(f32x4*)(out + off + (q >> 1) * HALF + (q & 1) * 16) = o; s += (o[0] * o[0] + o[1] * o[1]) + (o[2] * o[2] + o[3] * o[3]);
                u32x2 w; w.x = cvt_pk_bf16(o[0], o[1]); w.y = cvt_pk_bf16(o[2], o[3]); *(u32x2*)(xb + off + (q >> 1) * HALF + (q & 1) * 16) = w; }
            s += __shfl_xor(s, 16); s += __shfl_xor(s, 32);
            if (fq == 0) __hip_atomic_fetch_add(ss + r, s, __ATOMIC_RELAXED, __HIP_MEMORY_SCOPE_AGENT);
            asm volatile("" ::: "memory");
        }
#undef LD_
    }
};
struct EpiUp {
    static constexpr bool PERM = true, AFTER_DRAIN = false;
    bf16_t* O; int ldc; const float* ss;
    __device__ __forceinline__ void operator()(const f32x4 (&acc)[2][2][4][2], const Unit& u, int wr, int wc, int fr, int fq) const {
        const int row0 = u.pm * BM + wr * 64 + fr, col0 = u.pn * BM + wc * 32 + 8 * fq;
        float rs[8];
#pragma unroll
        for (int k = 0; k < 8; ++k) rs[k] = ss[EPI_ROWS(k)];
#pragma unroll
        for (int k = 0; k < 8; ++k) { const float r = rs_of(rs[k]); bf16_t* rowp = O + (size_t)EPI_ROWS(k) * ldc + col0;
#pragma unroll
            for (int bj = 0; bj < 2; ++bj) *(u32x4*)(rowp + bj * HALF) = pack8(EPI_ACC(k, bj, 0) * r, EPI_ACC(k, bj, 1) * r); }
    }
};
struct EpiPle {
    static constexpr bool PERM = false, AFTER_DRAIN = false;
    float* out; const bf16_t* pp; const float* ss;
    __device__ __forceinline__ void operator()(const f32x4 (&acc)[2][2][4][2], const Unit& u, int wr, int wc, int fr, int fq) const {
        const int row0 = u.pm * BM + wr * 64 + fr, col0 = u.pn * BM + wc * 32 + 4 * fq;
        float rs[8];
#pragma unroll
        for (int k = 0; k < 8; ++k) rs[k] = ss[EPI_ROWS(k)];
        f32x4 b[2][4]; u32x2 q2[2][4];
#define LD_(k) do { const size_t off_ = (size_t)EPI_ROWS(k) * DM_ + col0; _Pragma("unroll") for (int q_ = 0; q_ < 4; ++q_) { b[(k) & 1][q_] = *(const f32x4*)(out + off_ + (q_ >> 1) * HALF + (q_ & 1) * 16); \
            q2[(k) & 1][q_] = *(const u32x2*)(pp + off_ + (q_ >> 1) * HALF + (q_ & 1) * 16); } } while (0)
        LD_(0);
#pragma unroll
        for (int k = 0; k < 8; ++k) {
            if (k + 1 < 8) LD_(k + 1);
            const size_t off = (size_t)EPI_ROWS(k) * DM_ + col0; const float r = rs_of(rs[k]);
#pragma unroll
            for (int q = 0; q < 4; ++q) { const f32x4 a = EPI_ACC(k, q >> 1, q & 1) * r, pv = bf4_to_f32(q2[k & 1][q]), bb = b[k & 1][q];
                f32x4 o; o[0] = bb[0] + sigm(a[0]) * pv[0]; o[1] = bb[1] + sigm(a[1]) * pv[1]; o[2] = bb[2] + sigm(a[2]) * pv[2]; o[3] = bb[3] + sigm(a[3]) * pv[3];
                *(f32x4*)(out + off + (q >> 1) * HALF + (q & 1) * 16) = o; }
            asm volatile("" ::: "memory");
        }
#undef LD_
    }
};
struct EpiGate2 {
    static constexpr bool PERM = true, AFTER_DRAIN = false;
    bf16_t* merged; const bf16_t* sga; const bf16_t* sgb;
    __device__ __forceinline__ void operator()(f32x4 (&acc)[2][2][4][2], const Unit& u, int wr, int wc, int fr, int fq) const {
        const int row0 = u.pm * BM + wr * 64 + fr, col0 = u.pn * BM + wc * 32 + 8 * fq;
        if (u.part == 0) {
            u32x4 ga[2][2], gb[2][2];
#define LD_(k) do { const size_t off_ = (size_t)EPI_ROWS(k) * DM_ + col0; ga[(k) & 1][0] = *(const u32x4*)(sga + off_); ga[(k) & 1][1] = *(const u32x4*)(sga + off_ + HALF); gb[(k) & 1][0] = *(const u32x4*)(sgb + off_); gb[(k) & 1][1] = *(const u32x4*)(sgb + off_ + HALF); } while (0)
            LD_(0);
#pragma unroll
            for (int k = 0; k < 8; ++k) {
                if (k + 1 < 8) LD_(k + 1);
#pragma unroll
                for (int bj = 0; bj < 2; ++bj) { const u32x4 aw = ga[k & 1][bj], bw = gb[k & 1][bj];
                    const f32x4 ga0 = bf4_to_f32((u32x2){aw.x, aw.y}), ga1 = bf4_to_f32((u32x2){aw.z, aw.w}), gb0 = bf4_to_f32((u32x2){bw.x, bw.y}), gb1 = bf4_to_f32((u32x2){bw.z, bw.w});
#pragma unroll
                    for (int j = 0; j < 4; ++j) { EPI_ACC(k, bj, 0)[j] *= ga0[j] * __builtin_amdgcn_rcpf(fmaxf(gb0[j], 1e-20f)); EPI_ACC(k, bj, 1)[j] *= ga1[j] * __builtin_amdgcn_rcpf(fmaxf(gb1[j], 1e-20f)); } }
                asm volatile("" ::: "memory");
            }
#undef LD_
        } else {
            u32x4 gb[2][2];
#define LD_(k) do { const size_t off_ = (size_t)EPI_ROWS(k) * DM_ + col0; gb[(k) & 1][0] = *(const u32x4*)(sgb + off_); gb[(k) & 1][1] = *(const u32x4*)(sgb + off_ + HALF); } while (0)
            LD_(0);
#pragma unroll
            for (int k = 0; k < 8; ++k) {
                if (k + 1 < 8) LD_(k + 1);
                const size_t off = (size_t)EPI_ROWS(k) * DM_ + col0;
#pragma unroll
                for (int bj = 0; bj < 2; ++bj) { const u32x4 bw = gb[k & 1][bj]; const f32x4 gb0 = bf4_to_f32((u32x2){bw.x, bw.y}), gb1 = bf4_to_f32((u32x2){bw.z, bw.w});
                    f32x4 v0, v1;
#pragma unroll
                    for (int j = 0; j < 4; ++j) { v0[j] = EPI_ACC(k, bj, 0)[j] * fmaxf(gb0[j], 1e-20f); v1[j] = EPI_ACC(k, bj, 1)[j] * fmaxf(gb1[j], 1e-20f); }
                    *(u32x4*)(merged + off + bj * HALF) = pack8(v0, v1); }
                asm volatile("" ::: "memory");
            }
#undef LD_
        }
    }
};
struct TwoPartOrder : StaticOrder {
    const bf16_t* A1; const bf16_t* B1;
    __device__ bool next(int i, Unit& u) const { const bool ok = StaticOrder::next(i >> 1, u); u.part = i & 1; return ok; }
    __device__ __forceinline__ const bf16_t* baseA(const Gemm& g, const Unit& u) const { return u.part ? A1 : g.A; }
    __device__ __forceinline__ const bf16_t* baseB(const Gemm& g, const Unit& u) const { return u.part ? B1 : g.Bt; }
    __device__ __forceinline__ bool zero_after(const Unit& u) const { return u.part != 0; }
};
struct EpiStoreBf16x4 {
    static constexpr bool PERM = false, AFTER_DRAIN = false;
    bf16_t* C;
    __device__ __forceinline__ void operator()(const f32x4 (&acc)[2][2][4][2], const Unit& u, int wr, int wc, int fr, int fq) const {
        const int row0 = u.pm * BM + wr * 64 + fr, col0 = u.pn * BM + wc * 32 + 4 * fq;
#pragma unroll
        for (int ai = 0; ai < 2; ++ai)
#pragma unroll
            for (int m = 0; m < 4; ++m) { bf16_t* rowp = C + (size_t)(row0 + ai * HALF + m * 16) * DM_ + col0;
#pragma unroll
                for (int bj = 0; bj < 2; ++bj)
#pragma unroll
                    for (int n = 0; n < 2; ++n) { const f32x4 v = acc[ai][bj][m][n]; u32x2 w; w.x = cvt_pk_bf16(v[0], v[1]); w.y = cvt_pk_bf16(v[2], v[3]); *(u32x2*)(rowp + bj * HALF + n * 16) = w; } }
    }
};
struct EpiNull {
    static constexpr bool PERM = true, AFTER_DRAIN = false;
    __device__ __forceinline__ void operator()(const f32x4 (&acc)[2][2][4][2], const Unit& u, int wr, int wc, int fr, int fq) const {
#pragma unroll
        for (int ai = 0; ai < 2; ++ai)
#pragma unroll
            for (int bj = 0; bj < 2; ++bj)
#pragma unroll
                for (int m = 0; m < 4; ++m)
#pragma unroll
                    for (int n = 0; n < 2; ++n) asm volatile("" :: "v"(acc[ai][bj][m][n]));
    }
};
#undef EPI_ROWS
#undef EPI_ACC
template <class Epi, class Sched, bool ALIGN_EPI = false, bool SP2 = false>
__device__ __forceinline__ void gemm_phase(PG8_LAS unsigned char* lds, const Gemm g, const Sched& S, const Epi& E, const int WAVE_) {
    const int tid = TID(), wid = __builtin_amdgcn_readfirstlane(tid >> 6), lane = tid & 63, wr = wid >> 2, wc = wid & 3, fr = lane & 15, fq = lane >> 4;
    const int K = g.K, nt = K / BK;
    unsigned voffA[2], voffB[2];
#pragma unroll
    for (int i = 0; i < 2; ++i) { int R, C; stage_rc(tid * 16 + i * 8192, R, C); const int Rb = Epi::PERM ? ((R & ~31) + perm32(R & 31)) : R;
        voffA[i] = (unsigned)(R * K + C) * 2u; voffB[i] = (unsigned)(Rb * K + C) * 2u; }
    const size_t kstep = (size_t)(BK * 2);
    const size_t hstep = (size_t)HALF * K * 2;
    const size_t tstep = 2 * hstep;
    const unsigned ldsw = (unsigned)wid * 1024u;
    const int aoff = lds_byte(wr * 64 + fr, fq * 8), boff = lds_byte(wc * 32 + fr, fq * 8);
#define PG8_SA(b, h) (((b) * 2 + (h)) * HTB)
#define PG8_SB(b, h) ((4 + (b) * 2 + (h)) * HTB)
#define PG8_STAGE(bufoff, gbase, voff) do { _Pragma("unroll") for (int _i = 0; _i < 2; ++_i) \
        __builtin_amdgcn_global_load_lds((const unsigned*)((const char*)(gbase) + (voff)[_i]), (PG8_LAS unsigned*)(lds + (bufoff) + ldsw + _i * 8192), 16, 0, 0); } while (0)
#define PG8_LDA(dst, b, h) do { _Pragma("unroll") for (int m = 0; m < 4; ++m) _Pragma("unroll") for (int k = 0; k < 2; ++k) dst[m][k] = *(const PG8_LAS bf16x8*)(lds + PG8_SA(b, h) + aoff + m * 2048 + k * 1024); } while (0)
#define PG8_LDB(dst, b, h) do { _Pragma("unroll") for (int n = 0; n < 2; ++n) _Pragma("unroll") for (int k = 0; k < 2; ++k) dst[n][k] = *(const PG8_LAS bf16x8*)(lds + PG8_SB(b, h) + boff + n * 2048 + k * 1024); } while (0)
#define PG8_MMA(ai, bj, At, Bt) do { __builtin_amdgcn_s_setprio(1); _Pragma("unroll") for (int m = 0; m < 4; ++m) _Pragma("unroll") for (int n = 0; n < 2; ++n) _Pragma("unroll") for (int k = 0; k < 2; ++k) \
        acc[ai][bj][m][n] = __builtin_amdgcn_mfma_f32_16x16x32_bf16(Bt[n][k], At[m][k], acc[ai][bj][m][n], 0, 0, 0); __builtin_amdgcn_s_setprio(0); } while (0)
#define PG8_WAIT_V(n) asm volatile("s_waitcnt vmcnt(" #n ")" ::: "memory")
#define PG8_WAIT_L(n) asm volatile("s_waitcnt lgkmcnt(" #n ")" ::: "memory")
#define PG8_BAR __builtin_amdgcn_s_barrier()
#define PG8_SCHED __builtin_amdgcn_sched_barrier(0)
    Unit cur, nxt; int ui = 0;
    if (!S.next(0, cur)) return;
    f32x4 acc[2][2][4][2];
#pragma unroll
    for (int a = 0; a < 2; ++a)
#pragma unroll
        for (int b = 0; b < 2; ++b)
#pragma unroll
            for (int m = 0; m < 4; ++m)
#pragma unroll
                for (int n = 0; n < 2; ++n) acc[a][b][m][n] = (f32x4){0.f, 0.f, 0.f, 0.f};
    bf16x8 At[4][2], B0[2][2], B1[2][2];
    const char* cA = (const char*)S.baseA(g, cur) + (size_t)cur.pm * tstep; const char* cB = (const char*)S.baseB(g, cur) + (size_t)cur.pn * tstep;
    S.a_ready(cur);
    if constexpr (SP2) {
        PG8_STAGE(PG8_SB(0, 0), cB, voffB); PG8_STAGE(PG8_SB(0, 1), cB + hstep, voffB); PG8_STAGE(PG8_SA(0, 0), cA, voffA); PG8_STAGE(PG8_SA(0, 1), cA + hstep, voffA);
        if (wr == 1) PG8_BAR;
        PG8_WAIT_V(2); PG8_BAR;
        PG8_STAGE(PG8_SB(1, 0), cB + kstep, voffB); PG8_STAGE(PG8_SA(1, 0), cA + kstep, voffA); PG8_STAGE(PG8_SB(1, 1), cB + hstep + kstep, voffB);
        PG8_WAIT_V(6); PG8_BAR;
    } else {
        PG8_STAGE(PG8_SB(0, 0), cB, voffB); PG8_STAGE(PG8_SA(0, 0), cA, voffA); PG8_STAGE(PG8_SB(0, 1), cB + hstep, voffB); PG8_STAGE(PG8_SA(0, 1), cA + hstep, voffA);
        if (wr == 1) PG8_BAR;
        PG8_WAIT_V(4); PG8_BAR;
        PG8_STAGE(PG8_SB(1, 0), cB + kstep, voffB); PG8_STAGE(PG8_SA(1, 0), cA + kstep, voffA); PG8_STAGE(PG8_SB(1, 1), cB + hstep + kstep, voffB);
        PG8_WAIT_V(6); PG8_BAR;
    }
    for (;;) {
        const bool has_next = S.next(ui + 1, nxt);
        const char* nA = has_next ? (const char*)S.baseA(g, nxt) + (size_t)nxt.pm * tstep : cA; const char* nB = has_next ? (const char*)S.baseB(g, nxt) + (size_t)nxt.pn * tstep : cB;
        for (int t = 0; t < nt; t += 2) {
            const bool last = (t == nt - 2);
            const char* a1 = cA + (size_t)(t + 1) * kstep;
            const char* a2 = last ? nA : cA + (size_t)(t + 2) * kstep; const char* b2 = last ? nB : cB + (size_t)(t + 2) * kstep;
            const char* a3 = a2 + kstep; const char* b3 = b2 + kstep;
            if (last && has_next) S.a_ready(nxt);
            if constexpr (SP2) {
            PG8_LDB(B0, 0, 0); PG8_LDB(B1, 0, 1); PG8_SCHED; PG8_LDA(At, 0, 0); PG8_STAGE(PG8_SA(1, 1), a1 + hstep, voffA);
            PG8_WAIT_V(8); PG8_WAIT_L(0); PG8_BAR; PG8_MMA(0, 0, At, B0); PG8_MMA(0, 1, At, B1); PG8_BAR; PG8_SCHED;
            PG8_LDA(At, 0, 1); PG8_STAGE(PG8_SB(0, 0), b2, voffB); PG8_STAGE(PG8_SB(0, 1), b2 + hstep, voffB); PG8_STAGE(PG8_SA(0, 0), a2, voffA);
            PG8_WAIT_V(8); PG8_WAIT_L(0); PG8_BAR; PG8_MMA(1, 0, At, B0); PG8_MMA(1, 1, At, B1); PG8_BAR; PG8_SCHED;
            PG8_LDB(B0, 1, 0); PG8_LDB(B1, 1, 1); PG8_SCHED; PG8_LDA(At, 1, 0); PG8_STAGE(PG8_SA(0, 1), a2 + hstep, voffA);
            PG8_WAIT_V(8); PG8_WAIT_L(0); PG8_BAR; PG8_MMA(0, 0, At, B0); PG8_MMA(0, 1, At, B1); PG8_BAR; PG8_SCHED;
            PG8_LDA(At, 1, 1); PG8_STAGE(PG8_SB(1, 0), b3, voffB); PG8_STAGE(PG8_SB(1, 1), b3 + hstep, voffB); PG8_STAGE(PG8_SA(1, 0), a3, voffA);
            PG8_WAIT_V(8); PG8_WAIT_L(0); PG8_BAR; PG8_MMA(1, 0, At, B0); PG8_MMA(1, 1, At, B1); PG8_BAR; PG8_SCHED;
            } else {
            PG8_LDB(B0, 0, 0); PG8_SCHED; PG8_LDA(At, 0, 0); PG8_STAGE(PG8_SA(1, 1), a1 + hstep, voffA);
            PG8_WAIT_L(8); PG8_BAR; PG8_WAIT_L(0); PG8_MMA(0, 0, At, B0); PG8_BAR; PG8_SCHED;
            PG8_LDB(B1, 0, 1); PG8_STAGE(PG8_SB(0, 0), b2, voffB);
            PG8_BAR; PG8_WAIT_L(0); PG8_MMA(0, 1, At, B1); PG8_BAR;
            PG8_LDA(At, 0, 1); PG8_STAGE(PG8_SA(0, 0), a2, voffA);
            PG8_BAR; PG8_WAIT_L(0); PG8_MMA(1, 0, At, B0); PG8_BAR; PG8_SCHED;
            PG8_STAGE(PG8_SB(0, 1), b2 + hstep, voffB);
            PG8_WAIT_V(6); PG8_BAR; PG8_MMA(1, 1, At, B1); PG8_BAR;
            PG8_LDB(B0, 1, 0); PG8_SCHED; PG8_LDA(At, 1, 0); PG8_STAGE(PG8_SA(0, 1), a2 + hstep, voffA);
            PG8_WAIT_L(8); PG8_BAR; PG8_WAIT_L(0); PG8_MMA(0, 0, At, B0); PG8_BAR; PG8_SCHED;
            PG8_LDB(B1, 1, 1); PG8_STAGE(PG8_SB(1, 0), b3, voffB);
            PG8_BAR; PG8_WAIT_L(0); PG8_MMA(0, 1, At, B1); PG8_BAR;
            PG8_LDA(At, 1, 1); PG8_STAGE(PG8_SA(1, 0), a3, voffA);
            PG8_BAR; PG8_WAIT_L(0); PG8_MMA(1, 0, At, B0); PG8_BAR; PG8_SCHED;
            PG8_STAGE(PG8_SB(1, 1), b3 + hstep, voffB);
            PG8_WAIT_V(6); PG8_BAR; PG8_MMA(1, 1, At, B1); PG8_BAR;
            }
        }
        if constexpr (ALIGN_EPI) { if (wr == 0) PG8_BAR; }
        if constexpr (!Epi::AFTER_DRAIN) { E(acc, cur, wr, wc, fr, fq); S.done(cur); }
        if (!has_next) break;
        if (S.zero_after(cur))
#pragma unroll
        for (int a = 0; a < 2; ++a)
#pragma unroll
            for (int b = 0; b < 2; ++b)
#pragma unroll
                for (int m = 0; m < 4; ++m)
#pragma unroll
                    for (int n = 0; n < 2; ++n) acc[a][b][m][n] = (f32x4){0.f, 0.f, 0.f, 0.f};
        cur = nxt; cA = nA; cB = nB; ++ui;
        if constexpr (ALIGN_EPI) { if (wr == 1) PG8_BAR; }
    }
    PG8_WAIT_V(0);
    if constexpr (!ALIGN_EPI) { if (wr == 0) PG8_BAR; }
    PG8_BAR;
    if constexpr (Epi::AFTER_DRAIN) { E.fused(acc, cur, wr, wc, fr, fq, lds, wid, lane); S.done(cur); }
#undef PG8_SA
#undef PG8_SB
#undef PG8_STAGE
#undef PG8_LDA
#undef PG8_LDB
#undef PG8_MMA
#undef PG8_WAIT_V
#undef PG8_WAIT_L
#undef PG8_BAR
#undef PG8_SCHED
}
}
constexpr int NWAVES = 8;
constexpr int S = 8192, DM = 4096, HD = 128, NH = 16, WF = 2048, DFF = 11008, PLE = 256, NIN = 20496, NPROJ = 20480;
constexpr float EPS = 1e-6f;
constexpr float SCALE = 0.08838834764831845f;
constexpr size_t MiB = 1u << 20;
constexpr size_t WS_CTL = 0, CTL_ZERO_BYTES = 1 * MiB;
constexpr size_t WS_SS1 = 1 * MiB;
constexpr size_t WS_LOGF = WS_SS1 + 64 * 1024;
constexpr size_t WS_C = WS_LOGF + 512 * 1024;
constexpr size_t WS_WTF = WS_C + 512 * 1024;
constexpr size_t WS_WIN = 4 * MiB;
constexpr size_t WS_WBF = WS_WIN + 160 * MiB;
constexpr size_t WS_WBS = WS_WBF + 16 * MiB;
constexpr size_t WS_WOUT = WS_WBS + 16 * MiB;
constexpr size_t WS_WUP = WS_WOUT + 32 * MiB;
constexpr size_t WS_WDN = WS_WUP + 172 * MiB;
constexpr size_t WS_WPG = WS_WDN + 86 * MiB;
constexpr size_t WS_WPP = WS_WPG + 32 * MiB;
constexpr size_t WS_XB = WS_WPP + 2 * MiB;
constexpr size_t WS_PB = WS_XB + 64 * MiB;
constexpr size_t WS_QKV = WS_PB + 4 * MiB;
constexpr size_t WS_GATES = WS_QKV + 192 * MiB;
constexpr size_t WS_Y = WS_GATES + 128 * MiB;
constexpr size_t WS_UP = WS_QKV;
constexpr size_t WS_MERGED = WS_Y + 64 * MiB;
constexpr size_t WS_ACT = WS_MERGED + 64 * MiB;
constexpr size_t WS_PP = WS_QKV;
constexpr size_t WS_END = WS_ACT + 172 * MiB;
static_assert(WS_UP + (size_t)S * 2 * DFF * 2 <= WS_MERGED, "up overlay");
constexpr int CW_BAR = 4096;
constexpr int CW_QATT = 2048;
constexpr int CW_SS2 = 32768, CW_SS3 = 32768 + 8192;
constexpr int N_BAR_REGIONS = 4;
constexpr int RING_OFF = 0, RING_BYTES = 131072;
constexpr int LDSCTL_OFF = RING_BYTES, MISC_OFF = LDSCTL_OFF + 320;
constexpr int LDS_BYTES = 147456;

#define GAS __attribute__((address_space(1)))
#define LAS __attribute__((address_space(3)))
typedef unsigned short bf16;
typedef unsigned v4u __attribute__((ext_vector_type(4)));
typedef unsigned v2u __attribute__((ext_vector_type(2)));
typedef float f32x4 __attribute__((ext_vector_type(4)));
typedef float f32x16 __attribute__((ext_vector_type(16)));
typedef short bf16x8 __attribute__((ext_vector_type(8)));
typedef GAS unsigned gu32;
#define RLX_AGENT __ATOMIC_RELAXED, __HIP_MEMORY_SCOPE_AGENT
#define LDS_WAIT() asm volatile("s_waitcnt lgkmcnt(0)" ::: "memory")
#define VM_WAIT() asm volatile("s_waitcnt vmcnt(0)" ::: "memory")
__device__ __forceinline__ unsigned pk2(float lo, float hi) { unsigned r; asm volatile("v_cvt_pk_bf16_f32 %0, %1, %2" : "=v"(r) : "v"(lo), "v"(hi)); return r; }
__device__ __forceinline__ float bf2f(bf16 b) { return __uint_as_float(((unsigned)b) << 16); }
__device__ __forceinline__ float bflo(unsigned w) { return __uint_as_float(w << 16); }
__device__ __forceinline__ float bfhi(unsigned w) { return __uint_as_float(w & 0xffff0000u); }
__device__ __forceinline__ float sigmoidf_(float v) { return 1.0f / (1.0f + __expf(-v)); }
__device__ __forceinline__ float log_sigmoidf_(float v) { return fminf(v, 0.f) - log1pf(__expf(-fabsf(v))); }
__device__ __forceinline__ float softplusf_(float v) { return fmaxf(v, 0.f) + log1pf(__expf(-fabsf(v))); }
__device__ __forceinline__ float wave_sum(float v) {
#pragma unroll
    for (int o = 1; o < 64; o <<= 1) v += __shfl_xor(v, o);
    return v;
}

#define XB_TMO      128
#define XB_XCNT(j)  (256  + 64 * (j))
#define XB_XSUB(j)  (1280 + 64 * (j))
#define XB_XGEN(j)  (2304 + 64 * (j))
#define XB_TOP      3328
#define XB_TOPGEN   3392
#define XCD_BAR_WORDS 3456
#define XB_SPIN_CAP (1u << 18)

__device__ __forceinline__ unsigned xb_ld(unsigned* p)              { return __hip_atomic_load(p, __ATOMIC_RELAXED, __HIP_MEMORY_SCOPE_AGENT); }
__device__ __forceinline__ unsigned xb_add(unsigned* p, unsigned v) { return __hip_atomic_fetch_add(p, v, __ATOMIC_RELAXED, __HIP_MEMORY_SCOPE_AGENT); }
__device__ __forceinline__ unsigned xb_xcc_id() { return (unsigned)__builtin_amdgcn_s_getreg((3 << 11) | 20) & 0xFu; }
#define XB_SPIN(cond, bar) do { unsigned _sp = 0; while (cond) { __builtin_amdgcn_s_sleep(1); \
    if ((++_sp & 255u) == 0u) { if (xb_ld(&(bar)[XB_TMO])) break; if (_sp > XB_SPIN_CAP) { atomicAdd(&(bar)[XB_TMO], 1u); break; } } } } while (0)

struct XcdBarrier {
    unsigned* bar; unsigned x; int wave;
    volatile LAS unsigned* st;
};

__device__ __forceinline__ XcdBarrier xcd_barrier_post(unsigned* bar, volatile LAS unsigned* st, const int WAVE_) {
    XcdBarrier b; b.wave = WAVE_; b.bar = bar; b.x = xb_xcc_id(); b.st = st;
    if (TID() == 0) (void)xb_add(&bar[XB_XCNT(b.x)], 1u);
    return b;
}
__device__ __forceinline__ void xcd_barrier_complete(unsigned* bar, unsigned x, unsigned& nloc, unsigned& nx) {
    const unsigned G = gridDim.x * gridDim.y * gridDim.z;
    unsigned sum, cnt, mine, sp = 0u;
    for (;;) {
        sum = 0u; cnt = 0u; mine = 0u;
#pragma unroll
        for (unsigned j = 0; j < 16; ++j) { const unsigned c = xb_ld(&bar[XB_XCNT(j)]); sum += c; cnt += (c > 0u) ? 1u : 0u; mine = (j == x) ? c : mine; }
        if (sum == G) break;
        __builtin_amdgcn_s_sleep(1);
        if ((++sp & 255u) == 0u) { if (xb_ld(&bar[XB_TMO])) break; if (sp > XB_SPIN_CAP) { atomicAdd(&bar[XB_TMO], 1u); break; } }
    }
    nloc = mine > 0u ? mine : 1u; nx = cnt > 0u ? cnt : 1u;
}

__device__ __forceinline__ void xcd_barrier(const XcdBarrier& b) {
    const int WAVE_ = b.wave;
    asm volatile("s_waitcnt vmcnt(0)" ::: "memory");
    __syncthreads();
    if (TID() == 0) {
        unsigned* bar = b.bar;
        __builtin_amdgcn_s_waitcnt(0);
        unsigned nloc = b.st[0], nx = b.st[1];
        if (nloc == 0u) { xcd_barrier_complete(bar, b.x, nloc, nx); b.st[0] = nloc; b.st[1] = nx; }
        const unsigned old = xb_add(&bar[XB_XSUB(b.x)], 1u);
        const unsigned gen = old / nloc;
        if (old + 1u == (gen + 1u) * nloc) {
            __builtin_amdgcn_fence(__ATOMIC_RELEASE, "agent");
            asm volatile("s_waitcnt vmcnt(0)" ::: "memory");
            const unsigned og = xb_add(&bar[XB_TOP], 1u);
            const unsigned tg = og / nx;
            if (og + 1u == (tg + 1u) * nx) xb_add(&bar[XB_TOPGEN], 1u);
            else XB_SPIN(xb_ld(&bar[XB_TOPGEN]) == tg, bar);
            __builtin_amdgcn_fence(__ATOMIC_ACQUIRE, "agent");
            xb_add(&bar[XB_XGEN(b.x)], 1u);
            asm volatile("s_waitcnt vmcnt(0)" ::: "memory");
        } else {
            XB_SPIN(xb_ld(&bar[XB_XGEN(b.x)]) == gen, bar);
            __builtin_amdgcn_fence(__ATOMIC_ACQUIRE, "agent");
            asm volatile("s_waitcnt vmcnt(0)" ::: "memory");
        }
    }
    __syncthreads();
}


struct Params {
    const float* in[18]; float* out; unsigned char* ws;
    int ph_lo, ph_hi, li, pad;
};
struct Frame {
    LAS unsigned char* lds; volatile LAS unsigned* MISC; gu32* ctl;
    int wave, vcu, G;
};

constexpr int CVT_WIN_TILES = 64 * 96 + 64 * 224;
constexpr int CVT_REST_TILES = 32 * 64 + 32 * 64 + 64 * 64 + 64 * 344 + 172 * 64 + 64 * 64 + 4 * 64;
struct CvtT { const float* src; const float* g; bf16* dst; int ldw, K; };
__device__ __forceinline__ CvtT cvt_decode(const Params& P, int it, int lane) {
    unsigned char* ws = P.ws;
    constexpr int T0 = 64 * 96, T1 = 64 * 224, T2 = 32 * 64, T3 = 32 * 64, T4 = 64 * 64, T5 = 64 * 344, T6 = 172 * 64, T7 = 64 * 64;
    const float* W; const float* g = nullptr; bf16* Wt; int ldw, srccol0 = 0, K, nrow0 = 0, NT; int r = it;
    if (r < T0) { W = P.in[3]; ldw = NIN; g = P.in[2]; Wt = (bf16*)(ws + WS_WIN); K = DM; NT = 96; }
    else if ((r -= T0) < T1) { W = P.in[3]; ldw = NIN; srccol0 = 6160; g = P.in[2]; Wt = (bf16*)(ws + WS_WIN); K = DM; nrow0 = 6144; NT = 224; }
    else if ((r -= T1) < T2) { W = P.in[7]; ldw = DM; Wt = (bf16*)(ws + WS_WBF); K = WF; NT = 64; }
    else if ((r -= T2) < T3) { W = P.in[8]; ldw = DM; Wt = (bf16*)(ws + WS_WBS); K = WF; NT = 64; }
    else if ((r -= T3) < T4) { W = P.in[9]; ldw = DM; Wt = (bf16*)(ws + WS_WOUT); K = DM; NT = 64; }
    else if ((r -= T4) < T5) { W = P.in[11]; ldw = 2 * DFF; g = P.in[10]; Wt = (bf16*)(ws + WS_WUP); K = DM; NT = 344; }
    else if ((r -= T5) < T6) { W = P.in[14]; ldw = DM; Wt = (bf16*)(ws + WS_WDN); K = DFF; NT = 64; }
    else if ((r -= T6) < T7) { W = P.in[16]; ldw = DM; g = P.in[15]; Wt = (bf16*)(ws + WS_WPG); K = DM; NT = 64; }
    else { r -= T7; W = P.in[17]; ldw = DM; Wt = (bf16*)(ws + WS_WPP); K = PLE; NT = 64; }
    const int nt = r % NT, kt = r / NT, nq = lane & 7, q = lane >> 3;
    CvtT T;
    T.src = W + (size_t)(64 * kt + 8 * q) * ldw + srccol0 + 64 * nt + 4 * nq;
    T.g = g ? g + 64 * kt + 8 * q : nullptr;
    T.dst = Wt + (size_t)(nrow0 + 64 * nt + 4 * nq) * K + 64 * kt + 8 * q;
    T.ldw = ldw; T.K = K;
    return T;
}
__device__ __forceinline__ void cvt_load(const CvtT& T, f32x4 (&v)[2][8]) {
#pragma unroll
    for (int p = 0; p < 2; ++p)
#pragma unroll
        for (int t = 0; t < 8; ++t) v[p][t] = __builtin_nontemporal_load((const f32x4*)(T.src + (size_t)t * T.ldw + 32 * p));
}
__device__ __forceinline__ void cvt_store(const CvtT& T, const f32x4 (&v)[2][8]) {
    f32x4 g0 = (f32x4){1.f, 1.f, 1.f, 1.f}, g1 = g0;
    if (T.g) { g0 = *(const f32x4*)T.g; g1 = *(const f32x4*)(T.g + 4); }
#pragma unroll
    for (int p = 0; p < 2; ++p)
#pragma unroll
        for (int i = 0; i < 4; ++i) {
            v4u w; w.x = pk2(v[p][0][i] * g0[0], v[p][1][i] * g0[1]); w.y = pk2(v[p][2][i] * g0[2], v[p][3][i] * g0[3]);
            w.z = pk2(v[p][4][i] * g1[0], v[p][5][i] * g1[1]); w.w = pk2(v[p][6][i] * g1[2], v[p][7][i] * g1[3]);
            *(v4u*)(T.dst + (size_t)(32 * p + i) * T.K) = w;
        }
}
__device__ __forceinline__ void p0_weights(const Frame& F, const Params& P) {
    const int WAVE_ = F.wave; const int f_lane = lane_id(), f_tid = TID();
    const int gw = F.vcu * NWAVES + F.wave, NGW = F.G * NWAVES, lane = f_lane;
    unsigned char* ws = P.ws;
    constexpr int NITEMS = CVT_WIN_TILES;
    f32x4 va[2][8], vb[2][8];
    int it = gw;
    if (it < NITEMS) {
        CvtT Ta = cvt_decode(P, it, lane); cvt_load(Ta, va);
        for (;;) {
            const int i1 = it + NGW; CvtT Tb = Ta;
            if (i1 < NITEMS) { Tb = cvt_decode(P, i1, lane); cvt_load(Tb, vb); }
            cvt_store(Ta, va);
            if (i1 >= NITEMS) break;
            const int i2 = i1 + NGW;
            if (i2 < NITEMS) { Ta = cvt_decode(P, i2, lane); cvt_load(Ta, va); }
            cvt_store(Tb, vb);
            if (i2 >= NITEMS) break;
            it = i2;
        }
    }
    { const float* w_in = P.in[3]; const float* g_mix = P.in[2]; bf16* wtf = (bf16*)(ws + WS_WTF);
      for (int i = blockIdx.x * 512 + f_tid; i < NH * (DM / 8); i += F.G * 512) { const int n = i / (DM / 8), kc = i % (DM / 8);
          float b[8];
#pragma unroll
          for (int t = 0; t < 8; ++t) b[t] = w_in[(size_t)(8 * kc + t) * NIN + 6144 + n] * g_mix[8 * kc + t];
          v4u w; w.x = pk2(b[0], b[1]); w.y = pk2(b[2], b[3]); w.z = pk2(b[4], b[5]); w.w = pk2(b[6], b[7]);
          *(v4u*)(wtf + (size_t)n * DM + 8 * kc) = w; } }
    const float* p = P.in[1]; bf16* pb = (bf16*)(ws + WS_PB);
    for (int i = blockIdx.x * 512 + f_tid; i < S * PLE / 8; i += F.G * 512) {
        const f32x4 a = *(const f32x4*)(p + (size_t)i * 8), b = *(const f32x4*)(p + (size_t)i * 8 + 4);
        v4u w; w.x = pk2(a[0], a[1]); w.y = pk2(a[2], a[3]); w.z = pk2(b[0], b[1]); w.w = pk2(b[2], b[3]);
        *(v4u*)(pb + (size_t)i * 8) = w;
    }
}
constexpr int CVT_SLOT = 18;
static_assert(2560 * CVT_SLOT >= CVT_REST_TILES, "conversion slots cover every tile");
struct ConvOrder : pg8::StaticOrder {
    const Params* P; int wave; mutable int slot;
    __device__ __forceinline__ void done(const pg8::Unit&) const {
        const int lane = lane_id();
        const int base = (slot * G + c) * CVT_SLOT; ++slot;
        const int i0 = base + wave, i1 = i0 + 8, i2 = i0 + 16;
        const int lim = (base + CVT_SLOT < CVT_REST_TILES) ? base + CVT_SLOT : CVT_REST_TILES;
        f32x4 va[2][8], vb[2][8];
        if (i0 < lim) {
            CvtT Ta = cvt_decode(*P, CVT_WIN_TILES + i0, lane); cvt_load(Ta, va);
            if (i1 < lim) {
                CvtT Tb = cvt_decode(*P, CVT_WIN_TILES + i1, lane); cvt_load(Tb, vb);
                cvt_store(Ta, va);
                if (i2 < lim) { Ta = cvt_decode(*P, CVT_WIN_TILES + i2, lane); cvt_load(Ta, va); cvt_store(Tb, vb); cvt_store(Ta, va); }
                else cvt_store(Tb, vb);
            } else cvt_store(Ta, va);
        }
    }
};
__device__ __forceinline__ void p0_rows(const Frame& F, const Params& P) {
    const int WAVE_ = F.wave; const int f_lane = lane_id();
    const float* x = P.in[0]; unsigned char* ws = P.ws;
    float* ss1 = (float*)(ws + WS_SS1); bf16* xb = (bf16*)(ws + WS_XB);
    const int gw = F.vcu * NWAVES + F.wave, NGW = F.G * NWAVES, lane = f_lane;
    for (int base = gw; base < S; base += 2 * NGW) {
        const int rowA = base, rowB = (base + NGW < S) ? base + NGW : base;
        const f32x4* xa = (const f32x4*)(x + (size_t)rowA * DM) + lane; const f32x4* xbp = (const f32x4*)(x + (size_t)rowB * DM) + lane;
        f32x4 va[16], vb[16]; float sa = 0.f, sb = 0.f;
#pragma unroll
        for (int j = 0; j < 16; ++j) va[j] = __builtin_nontemporal_load(xa + 64 * j);
#pragma unroll
        for (int j = 0; j < 16; ++j) vb[j] = __builtin_nontemporal_load(xbp + 64 * j);
#pragma unroll
        for (int j = 0; j < 16; ++j) sa += (va[j][0] * va[j][0] + va[j][1] * va[j][1]) + (va[j][2] * va[j][2] + va[j][3] * va[j][3]);
#pragma unroll
        for (int j = 0; j < 16; ++j) sb += (vb[j][0] * vb[j][0] + vb[j][1] * vb[j][1]) + (vb[j][2] * vb[j][2] + vb[j][3] * vb[j][3]);
        sa = wave_sum(sa); sb = wave_sum(sb);
        if (lane == 0) { ss1[rowA] = sa; ss1[rowB] = sb; }
        v2u* oa = (v2u*)(xb + (size_t)rowA * DM) + lane; v2u* ob = (v2u*)(xb + (size_t)rowB * DM) + lane;
#pragma unroll
        for (int j = 0; j < 16; ++j) { v2u w; w.x = pk2(va[j][0], va[j][1]); w.y = pk2(va[j][2], va[j][3]); oa[64 * j] = w; }
#pragma unroll
        for (int j = 0; j < 16; ++j) { v2u w; w.x = pk2(vb[j][0], vb[j][1]); w.y = pk2(vb[j][2], vb[j][3]); ob[64 * j] = w; }
    }
}

__device__ __forceinline__ void p1b_qknorm_fgate(const Frame& F, const Params& P) {
    const int WAVE_ = F.wave; const int f_lane = lane_id(), f_tid = TID();
    unsigned char* ws = P.ws;
    bf16* qkv = (bf16*)(ws + WS_QKV);
    const float* gq = P.in[5]; const float* gk = P.in[6];
    const int gw = F.vcu * NWAVES + F.wave, NGW = F.G * NWAVES, lane = f_lane, sub = lane >> 4, l16 = lane & 15;
    constexpr int NIT = 2 * S * NH / 4;
    for (int it = gw; it < NIT; it += NGW) {
        const int item = it * 4 + sub;
        const int t = item / (S * NH);
        bf16* ptr = qkv + (size_t)t * ((size_t)S * WF) + (size_t)(item - t * (S * NH)) * HD + l16 * 8;
        const float* g = (t ? gk : gq) + l16 * 8;
        const v4u w = *(const v4u*)ptr;
        float v[8] = {bflo(w.x), bfhi(w.x), bflo(w.y), bfhi(w.y), bflo(w.z), bfhi(w.z), bflo(w.w), bfhi(w.w)};
        float s = 0.f;
#pragma unroll
        for (int j = 0; j < 8; ++j) s += v[j] * v[j];
        s += __shfl_xor(s, 1); s += __shfl_xor(s, 2); s += __shfl_xor(s, 4); s += __shfl_xor(s, 8);
        const float r = rsqrtf(s * (1.0f / HD) + EPS);
        const f32x4 g0 = *(const f32x4*)g, g1 = *(const f32x4*)(g + 4);
        v4u o; o.x = pk2(v[0] * r * g0[0], v[1] * r * g0[1]); o.y = pk2(v[2] * r * g0[2], v[3] * r * g0[3]); o.z = pk2(v[4] * r * g1[0], v[5] * r * g1[1]); o.w = pk2(v[6] * r * g1[2], v[7] * r * g1[3]);
        *(v4u*)ptr = o;
    }
    {
        const bf16* xb = (const bf16*)(ws + WS_XB); const bf16* wtf = (const bf16*)(ws + WS_WTF); const float* ss1 = (const float*)(ws + WS_SS1); const float* b_f = P.in[4];
        float* logf = (float*)(ws + WS_LOGF);
        LAS float* fbuf = (LAS float*)(F.lds + RING_OFF);
        const int wave = F.wave, rl = lane & 31, kg = lane >> 5;
        for (int grp = blockIdx.x; grp < S / 32; grp += F.G) {
            const int r0 = grp * 32;
            const bf16* pa = xb + (size_t)(r0 + rl) * DM + 512 * wave + 8 * kg;
            const bf16* pb = wtf + (size_t)(rl & 15) * DM + 512 * wave + 8 * kg;
            f32x16 acc = {};
#pragma unroll 8
            for (int ks = 0; ks < 32; ++ks) {
                const bf16x8 a = *(const bf16x8*)(pa + 16 * ks);
                bf16x8 b = *(const bf16x8*)(pb + 16 * ks);
                if (rl >= 16) b = (bf16x8){0, 0, 0, 0, 0, 0, 0, 0};
                acc = __builtin_amdgcn_mfma_f32_32x32x16_bf16(a, b, acc, 0, 0, 0);
            }
            if (rl < 16) {
#pragma unroll
                for (int r = 0; r < 16; ++r) { const int tok = (r & 3) + 8 * (r >> 2) + 4 * kg; fbuf[(wave * 32 + tok) * 16 + rl] = acc[r]; }
            }
            __syncthreads();
            {
                const int tok = f_tid >> 4, h = f_tid & 15; float fv = 0.f;
#pragma unroll
                for (int w = 0; w < 8; ++w) fv += fbuf[(w * 32 + tok) * 16 + h];
                fv = fv * rsqrtf(ss1[r0 + tok] * (1.0f / DM) + EPS) + b_f[h];
                logf[(size_t)h * S + r0 + tok] = log_sigmoidf_(fv);
            }
            __syncthreads();
        }
    }
}

__device__ __forceinline__ void p5b_convglu(const Frame& F, const Params& P) {
    const int WAVE_ = F.wave; const int f_lane = lane_id(), f_tid = TID();
    unsigned char* ws = P.ws;
    const bf16* up = (const bf16*)(ws + WS_UP); bf16* act = (bf16*)(ws + WS_ACT);
    const float* cw = P.in[12]; const float* cb = P.in[13];
    const int gw = F.vcu * NWAVES + F.wave, NGW = F.G * NWAVES, lane = f_lane;
    constexpr int NCG = (DFF + 511) / 512, RB = 16, NITEMS = NCG * (S / RB);
    for (int it = gw; it < NITEMS; it += NGW) {
        const int cg = it % NCG, rb = it / NCG, j0 = cg * 512 + lane * 8, t0 = rb * RB;
        if (j0 >= DFF) continue;
        float wg[3][8], wv[3][8], bg[8], bv[8];
#pragma unroll
        for (int i = 0; i < 3; ++i) { const f32x4 a = *(const f32x4*)(cw + (size_t)i * 2 * DFF + j0), b = *(const f32x4*)(cw + (size_t)i * 2 * DFF + j0 + 4), c = *(const f32x4*)(cw + (size_t)i * 2 * DFF + DFF + j0), d = *(const f32x4*)(cw + (size_t)i * 2 * DFF + DFF + j0 + 4);
#pragma unroll
            for (int e = 0; e < 4; ++e) { wg[i][e] = a[e]; wg[i][4 + e] = b[e]; wv[i][e] = c[e]; wv[i][4 + e] = d[e]; } }
        { const f32x4 a = *(const f32x4*)(cb + j0), b = *(const f32x4*)(cb + j0 + 4), c = *(const f32x4*)(cb + DFF + j0), d = *(const f32x4*)(cb + DFF + j0 + 4);
#pragma unroll
          for (int e = 0; e < 4; ++e) { bg[e] = a[e]; bg[4 + e] = b[e]; bv[e] = c[e]; bv[4 + e] = d[e]; } }
        v4u gr[RB + 2], vr[RB + 2];
#pragma unroll
        for (int r = 0; r < RB + 2; ++r) { const int t = t0 - 2 + r;
            if (t >= 0) { gr[r] = __builtin_nontemporal_load((const v4u*)(up + (size_t)t * 2 * DFF + j0)); vr[r] = __builtin_nontemporal_load((const v4u*)(up + (size_t)t * 2 * DFF + DFF + j0)); }
            else { gr[r] = (v4u){0u, 0u, 0u, 0u}; vr[r] = gr[r]; } }
#pragma unroll
        for (int r = 0; r < RB; ++r) {
            const int t = t0 + r;
            float o[8];
#pragma unroll
            for (int e = 0; e < 4; ++e) {
                const unsigned a0 = gr[r][e], a1 = gr[r + 1][e], a2 = gr[r + 2][e], c0 = vr[r][e], c1 = vr[r + 1][e], c2 = vr[r + 2][e];
                const float ugl = bg[2 * e] + wg[0][2 * e] * bflo(a0) + wg[1][2 * e] * bflo(a1) + wg[2][2 * e] * bflo(a2);
                const float ugh = bg[2 * e + 1] + wg[0][2 * e + 1] * bfhi(a0) + wg[1][2 * e + 1] * bfhi(a1) + wg[2][2 * e + 1] * bfhi(a2);
                const float uvl = bv[2 * e] + wv[0][2 * e] * bflo(c0) + wv[1][2 * e] * bflo(c1) + wv[2][2 * e] * bflo(c2);
                const float uvh = bv[2 * e + 1] + wv[0][2 * e + 1] * bfhi(c0) + wv[1][2 * e + 1] * bfhi(c1) + wv[2][2 * e + 1] * bfhi(c2);
                o[2 * e] = ugl * sigmoidf_(ugl) * uvl; o[2 * e + 1] = ugh * sigmoidf_(ugh) * uvh;
            }
            v4u w; w.x = pk2(o[0], o[1]); w.y = pk2(o[2], o[3]); w.z = pk2(o[4], o[5]); w.w = pk2(o[6], o[7]);
            *(v4u*)(act + (size_t)t * DFF + j0) = w;
        }
    }
}

namespace att {
constexpr int D = 128, PITCH = 2048, NW = 8, QBLK = 32, KVBLK = 64, QB = NW * QBLK;
constexpr int SHM_V = KVBLK * D * 2, SHM_K = KVBLK * D * 2;
constexpr int OFF_WS = 2 * SHM_V + 2 * SHM_K, OFF_FLAG = OFF_WS + NW * 64 * 4, OFF_WTOT = OFF_FLAG + 64, OFF_NEXT = OFF_WTOT + 64, OFF_C = 73728  , ATT_LDS_BYTES = OFF_C + 32768;
constexpr float SCALE = 0.08838834764831845f;
constexpr float THR = 8.f;
typedef short s16x4 __attribute__((ext_vector_type(4)));
typedef unsigned u32x4 __attribute__((ext_vector_type(4)));
#define KSWZ(row, colB) ((row) * 256 + ((colB) ^ (((row) & 7) << 4)))
#define SBAR() __builtin_amdgcn_sched_barrier(0)
__device__ __forceinline__ int v_st(int k, int c) { const int kk = (k & ~0xC) | ((k & 4) << 1) | ((k & 8) >> 1); return ((kk >> 3) * 4 + (c >> 5)) * 512 + ((kk & 7) * 32 + (c & 31)) * 2; }
__device__ __forceinline__ int v_rd_base(int lane) { return ((lane & 3) << 3) | (((lane >> 2) & 3) << 6) | (((lane >> 4) & 1) << 5) | (((lane >> 5) & 1) << 8); }
constexpr int v_rd_off(int d0, int ks, int half) { return d0 * 512 + ks * 4096 + half * 2048; }
__device__ __forceinline__ int crow(int r, int hi) { return (r & 3) + 8 * (r >> 2) + 4 * hi; }
__device__ __forceinline__ unsigned cvtpk(float lo, float hi) { unsigned r; asm volatile("v_cvt_pk_bf16_f32 %0, %1, %2" : "=v"(r) : "v"(lo), "v"(hi)); return r; }
__device__ __forceinline__ bf16x8 load8(const bf16* p) { return *reinterpret_cast<const bf16x8*>(p); }
__device__ __forceinline__ void mask_tile(f32x16& p0, f32x16& p1, int dq) {
    const float NEG = -__builtin_inff();
#pragma unroll
    for (int r = 0; r < 16; ++r) { const int c = (r & 3) + 8 * (r >> 2); if (dq - c < 0) p0[r] = NEG; if (dq - c - 32 < 0) p1[r] = NEG; }
}
__device__ __forceinline__ void partialSM(f32x16& p0, f32x16& p1, float& m_reg, float& mn, float& alpha) {
    float pmax = p0[0]; for (int r = 1; r < 16; ++r) pmax = fmaxf(pmax, p0[r]); for (int r = 0; r < 16; ++r) pmax = fmaxf(pmax, p1[r]);
    { auto rr = __builtin_amdgcn_permlane32_swap(__float_as_uint(pmax), __float_as_uint(pmax), false, false);
      pmax = fmaxf(__uint_as_float(rr[0]), __uint_as_float(rr[1])); }
    constexpr float C2 = 1.4426950408889634f * SCALE;
    if (__builtin_expect(__all((pmax - m_reg) * SCALE <= THR), 1)) { mn = m_reg; alpha = 1.f; }
    else { mn = fmaxf(m_reg, pmax); alpha = __builtin_amdgcn_exp2f((m_reg - mn) * C2); m_reg = mn; }
    const float mnL = -mn * C2;
    for (int r = 0; r < 16; ++r) p0[r] = fmaf(p0[r], C2, mnL); for (int r = 0; r < 16; ++r) p1[r] = fmaf(p1[r], C2, mnL);
    for (int r = 0; r < 16; ++r) p0[r] = __builtin_amdgcn_exp2f(p0[r]);
}
#define PK4(P, B_, OUT) do { unsigned a0 = cvtpk(P[B_+0], P[B_+1]), a1 = cvtpk(P[B_+2], P[B_+3]);                          \
        unsigned b0 = cvtpk(P[B_+4], P[B_+5]), b1 = cvtpk(P[B_+6], P[B_+7]);                                             \
        auto r0 = __builtin_amdgcn_permlane32_swap(a0, b0, false, false); auto r1 = __builtin_amdgcn_permlane32_swap(a1, b1, false, false); \
        u32x4 w = {r0[0], r1[0], r0[1], r1[1]}; OUT = *reinterpret_cast<bf16x8*>(&w); } while (0)
__device__ __forceinline__ void finishSM(f32x16& p0, f32x16& p1, float alpha, float& l_reg, bf16x8& pa0, bf16x8& pa1, bf16x8& pa2, bf16x8& pa3) {
    for (int r = 0; r < 16; ++r) p1[r] = __builtin_amdgcn_exp2f(p1[r]);
    float ps = 0; for (int r = 0; r < 16; ++r) ps += p0[r]; for (int r = 0; r < 16; ++r) ps += p1[r];
    { auto rr = __builtin_amdgcn_permlane32_swap(__float_as_uint(ps), __float_as_uint(ps), false, false);
      ps = __uint_as_float(rr[0]) + __uint_as_float(rr[1]); }
    l_reg = l_reg * alpha + ps;
    PK4(p0, 0, pa0); PK4(p0, 8, pa1); PK4(p1, 0, pa2); PK4(p1, 8, pa3);
}
template <int KB>
__device__ __forceinline__ void qkt(f32x16& p0, f32x16& p1, const char* K_lds, int r32, int hi, const bf16x8* qr) {
    p0 = f32x16{}; p1 = f32x16{};
    const char* kb[4];
#pragma unroll
    for (int dd = 0; dd < 4; ++dd) kb[dd] = K_lds + KB * SHM_K + KSWZ(r32, (dd * 16 + hi * 8) * 2);
#pragma unroll
    for (int d0 = 0; d0 < 8; ++d0) { const char* a = kb[d0 & 3] + (d0 >> 2) * 128;
        bf16x8 b0 = *reinterpret_cast<const bf16x8*>(a);
        bf16x8 b1 = *reinterpret_cast<const bf16x8*>(a + 32 * 256);
        p0 = __builtin_amdgcn_mfma_f32_32x32x16_bf16(b0, qr[d0], p0, 0, 0, 0);
        p1 = __builtin_amdgcn_mfma_f32_32x32x16_bf16(b1, qr[d0], p1, 0, 0, 0); }
}
template <int VB>
__device__ __forceinline__ void pv_tile(f32x16* o, int vb0, bf16x8 pa0, bf16x8 pa1, bf16x8 pa2, bf16x8 pa3) {
#define TRRD(dst, off) asm volatile("ds_read_b64_tr_b16 %0, %1 offset:%2" : "=&v"(dst) : "v"(vb0), "i"(off) : "memory")
#define PV_D0(d0) do { s16x4 l0, l1, l2, l3, h0, h1, h2, h3; constexpr int b_ = VB * SHM_V + v_rd_off(d0, 0, 0); \
        TRRD(l0, b_); TRRD(h0, b_ + 2048); TRRD(l1, b_ + 4096); TRRD(h1, b_ + 6144); TRRD(l2, b_ + 8192); TRRD(h2, b_ + 10240); TRRD(l3, b_ + 12288); TRRD(h3, b_ + 14336); \
        asm volatile("s_waitcnt lgkmcnt(0)" ::: "memory"); SBAR();   \
        o[d0] = __builtin_amdgcn_mfma_f32_32x32x16_bf16(pa0, (bf16x8){l0[0], l0[1], l0[2], l0[3], h0[0], h0[1], h0[2], h0[3]}, o[d0], 0, 0, 0);   \
        o[d0] = __builtin_amdgcn_mfma_f32_32x32x16_bf16(pa1, (bf16x8){l1[0], l1[1], l1[2], l1[3], h1[0], h1[1], h1[2], h1[3]}, o[d0], 0, 0, 0);   \
        o[d0] = __builtin_amdgcn_mfma_f32_32x32x16_bf16(pa2, (bf16x8){l2[0], l2[1], l2[2], l2[3], h2[0], h2[1], h2[2], h2[3]}, o[d0], 0, 0, 0);   \
        o[d0] = __builtin_amdgcn_mfma_f32_32x32x16_bf16(pa3, (bf16x8){l3[0], l3[1], l3[2], l3[3], h3[0], h3[1], h3[2], h3[3]}, o[d0], 0, 0, 0); } while (0)
    PV_D0(0); PV_D0(1); PV_D0(2); PV_D0(3);
#undef PV_D0
#undef TRRD
}
__device__ __forceinline__ void key_bias(f32x16& p0, f32x16& p1, const char* lds, int kbase, int hi) {
    const float* kbp = (const float*)(lds + OFF_C) + kbase + 4 * hi;
#pragma unroll
    for (int g = 0; g < 4; ++g) { const f32x4 b0 = *(const f32x4*)(kbp + 8 * g), b1 = *(const f32x4*)(kbp + 32 + 8 * g);
#pragma unroll
        for (int e = 0; e < 4; ++e) { p0[4 * g + e] -= b0[e]; p1[4 * g + e] -= b1[e]; } }
}
__device__ __forceinline__ void cgate_scan(const float* logf_h, char* lds, const int WAVE_) {
    const int lane = lane_id(), tid = WAVE_ * 64 + lane;
    float* Cl = (float*)(lds + OFF_C); float* wtot = (float*)(lds + OFF_WTOT);
    const float* src = logf_h + tid * 16;
    const f32x4 a = *(const f32x4*)src, b = *(const f32x4*)(src + 4), c = *(const f32x4*)(src + 8), d = *(const f32x4*)(src + 12);
    const float in[16] = {a[0], a[1], a[2], a[3], b[0], b[1], b[2], b[3], c[0], c[1], c[2], c[3], d[0], d[1], d[2], d[3]};
    float loc[16]; float s = 0.f;
#pragma unroll
    for (int j = 0; j < 16; ++j) { s += in[j]; loc[j] = s; }
    float incl = s;
#pragma unroll
    for (int o = 1; o < 64; o <<= 1) { const float t = __builtin_bit_cast(float, __builtin_amdgcn_ds_bpermute((lane - o) << 2, __builtin_bit_cast(int, incl))); if (lane >= o) incl += t; }
    if (lane == 63) wtot[WAVE_] = incl;
    __syncthreads();
    float base = incl - s;
    for (int w = 0; w < WAVE_; ++w) base += wtot[w];
#pragma unroll
    for (int j = 0; j < 16; j += 4) *(f32x4*)(Cl + tid * 16 + j) = (f32x4){base + loc[j], base + loc[j + 1], base + loc[j + 2], base + loc[j + 3]} * (1.0f / SCALE);
    __syncthreads();
}

struct BlockRef { const bf16* Q; const bf16* K; const bf16* V; bf16* O; int P0; };
struct Seam { bf16x8 qr[8]; bf16x8 st_v0, st_v1, st_k0, st_k1; };
#define ROW(p, k0, rr) ((p) + (size_t)((k0) + (rr)) * PITCH + sc)
#define VMW() asm volatile("s_waitcnt vmcnt(0)" ::: "memory")
#define VMWN(n) asm volatile("s_waitcnt vmcnt(%0)" :: "i"(n) : "memory")
#define SLOAD_H(Kp, Vp, k0) do { S.st_v0 = load8(ROW(Vp, k0, sr)); S.st_v1 = load8(ROW(Vp, k0, 32 + sr));              \
                         S.st_k0 = load8(ROW(Kp, k0, sr)); S.st_k1 = load8(ROW(Kp, k0, 32 + sr)); } while (0)
#define SWRITE_HK(bf) do { *(bf16x8*)(K_lds + (bf) * SHM_K + kws) = S.st_k0; *(bf16x8*)(K_lds + (bf) * SHM_K + kws + 32 * 256) = S.st_k1; } while (0)
#define SWRITE_HV(bf) do { *(bf16x8*)(V_lds + (bf) * SHM_V + vst0) = S.st_v0; *(bf16x8*)(V_lds + (bf) * SHM_V + vst1) = S.st_v1; } while (0)
#define SWRITE_H(bf) do { SWRITE_HV(bf); SWRITE_HK(bf); } while (0)
__device__ __forceinline__ void fox_prime(const BlockRef& cur, char* lds, Seam& S, const int WAVE_) {
    const int tid = TID(), wid = __builtin_amdgcn_readfirstlane(tid >> 6), lane = tid & 63, r32 = lane & 31, hi = lane >> 5;
    const int sr = tid >> 4, sc = (tid & 15) * 8, kws = KSWZ(sr, sc * 2); char* K_lds = lds + 2 * SHM_V;
    for (int d0 = 0; d0 < 8; ++d0) S.qr[d0] = load8(cur.Q + (size_t)(wid * QBLK + r32) * PITCH + d0 * 16 + hi * 8);
    SLOAD_H(cur.K, cur.V, ((cur.P0 + QB - 1) / KVBLK) * KVBLK); VMW(); SWRITE_HK(0);
    __syncthreads();
}
__device__ __forceinline__ void fox_block(const BlockRef& cur, const BlockRef& nxt, const float Uq, char* lds, Seam& S, const int WAVE_) {
    const int tid = TID(), wid = __builtin_amdgcn_readfirstlane(tid >> 6), lane = tid & 63, r32 = lane & 31, hi = lane >> 5;
    const int NT0 = (cur.P0 + QB - 1) / KVBLK + 1;
    int NT = NT0;
    volatile LAS int* flg = (volatile LAS int*)(lds + OFF_FLAG);
    const int qlo = cur.P0 + wid * QBLK, qm = qlo + r32 - 4 * hi;
    char* V_lds = lds; char* K_lds = lds + 2 * SHM_V;
    float* ws = (float*)(lds + OFF_WS) + wid * 64; float* li_l = ws, * al_l = ws + 32;
    float m_reg = -1e30f, l_reg = 0; f32x16 o[4] = {};
    const int sr = tid >> 4, sc = (tid & 15) * 8, vst0 = v_st(sr, sc), vst1 = v_st(32 + sr, sc), kws = KSWZ(sr, sc * 2);
    const int vb0 = (int)(uintptr_t)V_lds + v_rd_base(lane);
    const bf16* Kh = cur.K; const bf16* Vh = cur.V;
#define RESC(a) do { if (__any((a) < 1.f)) { if (hi == 0) al_l[r32] = (a); asm volatile("s_waitcnt lgkmcnt(0)" ::: "memory");              \
                     for (int d_ = 0; d_ < 4; ++d_) for (int r = 0; r < 16; ++r) o[d_][r] *= al_l[crow(r, hi)]; } } while (0)
#define KBASE(t) ((NT0 - 1 - (t)) * KVBLK)
#define MASKT(P0_, P1_, t, KBUF) do { const int kb_ = KBASE(t); key_bias(P0_, P1_, lds, kb_, hi); if (kb_ + KVBLK - 1 > qlo) mask_tile(P0_, P1_, qm - kb_); } while (0)
#define SEAM_K0() do { VMWN(8); SWRITE_HK(0); SBAR(); } while (0)
    f32x16 pA0, pA1, pB0, pB1; float mnA, mnB, alA, alB; bf16x8 pa0, pa1, pa2, pa3;
    SWRITE_HV(0); SBAR();
    if (NT > 1) { SLOAD_H(Kh, Vh, KBASE(1)); }
    SBAR(); qkt<0>(pA0, pA1, K_lds, r32, hi, S.qr);
    MASKT(pA0, pA1, 0, 0); partialSM(pA0, pA1, m_reg, mnA, alA);
    if (NT > 1) { VMW(); SWRITE_H(1); }
    __syncthreads();
#define VOTE(t) do { bool can_ = false; if ((t) + 2 < NT) { const float negc_ = -((const float*)(lds + OFF_C))[KBASE((t) + 2) + KVBLK - 1]; can_ = __all((Uq + negc_ - m_reg) * SCALE <= -104.f) != 0; } \
                     if (lane == 0) flg[wid] = can_ ? 1 : 0; } while (0)
#define DECIDE(t) do { int all_ = 1; _Pragma("unroll") for (int w_ = 0; w_ < 8; ++w_) all_ &= flg[w_]; if (all_ && (t) + 2 < NT) NT = (t) + 2; } while (0)
#define HALF_STEP(PX0, PX1, mnX, alX, PY0, PY1, alY, t, KB, VB, SB) do {                                                      \
        SBAR(); qkt<KB>(PX0, PX1, K_lds, r32, hi, S.qr);                                                                     \
        finishSM(PY0, PY1, alY, l_reg, pa0, pa1, pa2, pa3); SBAR();                                                           \
        if ((t) + 1 < NT) { SLOAD_H(Kh, Vh, KBASE((t) + 1)); SBAR(); }                                                    \
        pv_tile<VB>(o, vb0, pa0, pa1, pa2, pa3); MASKT(PX0, PX1, (t), KB); partialSM(PX0, PX1, m_reg, mnX, alX); VOTE(t);    \
        __syncthreads(); DECIDE(t);                                                                                           \
        if ((t) + 1 < NT) { VMW(); SWRITE_H(SB); }                                                                            \
        RESC(alX); __syncthreads(); } while (0)
    for (int t = 1; t + 1 < NT; t += 2) {
        HALF_STEP(pB0, pB1, mnB, alB, pA0, pA1, alA, t, 1, 0, 0);
        HALF_STEP(pA0, pA1, mnA, alA, pB0, pB1, alB, t + 1, 0, 1, 1);
    }
    const bool even = (NT & 1) == 0;
    if (even) { SBAR(); qkt<1>(pB0, pB1, K_lds, r32, hi, S.qr); SBAR(); }
    SLOAD_H(nxt.K, nxt.V, ((nxt.P0 + QB - 1) / KVBLK) * KVBLK); SBAR();
#pragma unroll
    for (int d0 = 0; d0 < 8; ++d0) S.qr[d0] = load8(nxt.Q + (size_t)(wid * QBLK + r32) * PITCH + d0 * 16 + hi * 8);
    SBAR();
    finishSM(pA0, pA1, alA, l_reg, pa0, pa1, pa2, pa3); SBAR();
    pv_tile<0>(o, vb0, pa0, pa1, pa2, pa3);
    if (even) { MASKT(pB0, pB1, NT - 1, 1); partialSM(pB0, pB1, m_reg, mnB, alB); __syncthreads(); RESC(alB);
        finishSM(pB0, pB1, alB, l_reg, pa0, pa1, pa2, pa3); SBAR(); pv_tile<1>(o, vb0, pa0, pa1, pa2, pa3); }
    SBAR(); SEAM_K0();
    if (hi == 0) li_l[r32] = l_reg; asm volatile("s_waitcnt lgkmcnt(0)" ::: "memory");
    float rli[16];
#pragma unroll
    for (int r = 0; r < 16; ++r) rli[r] = __builtin_amdgcn_rcpf(li_l[crow(r, hi)]);
    bf16* Ow = cur.O + (size_t)(wid * QBLK) * PITCH;
#pragma unroll
    for (int r = 0; r < 16; ++r) { const int orow = crow(r, hi);
#pragma unroll
        for (int d0 = 0; d0 < 4; ++d0) { const float v = o[d0][r] * rli[r];
            const float vn = __shfl_xor(v, 1);
            if ((r32 & 1) == 0) *(unsigned*)(Ow + (size_t)orow * PITCH + d0 * 32 + r32) = cvtpk(v, vn); } }
    __syncthreads();
#undef RESC
#undef MASKT
#undef SEAM_K0
#undef HALF_STEP
#undef VOTE
#undef DECIDE
#undef KBASE
}

template <int BUF>
__device__ __forceinline__ void sb_tile(f32x16* o, float& R, const char* K_lds, int vb0, int r32, int hi, const bf16x8* qr, int dq) {
    f32x16 p0, p1;
    qkt<BUF>(p0, p1, K_lds, r32, hi, qr);
    constexpr float L2E = 1.4426950408889634f, LN2 = 0.6931471805599453f;
    f32x16 l0, l1;
    const float NEG = -__builtin_inff();
#pragma unroll
    for (int r = 0; r < 16; ++r) { const int c = (r & 3) + 8 * (r >> 2);
        { const float z = p0[r] * SCALE; const float sp = fmaxf(z, 0.f) + LN2 * __builtin_amdgcn_logf(1.0f + __builtin_amdgcn_exp2f(-fabsf(z) * L2E)); const bool st = (dq - c) >= 1; l0[r] = st ? -sp : 0.f; p0[r] = st ? (z - sp) : NEG; }
        { const float z = p1[r] * SCALE; const float sp = fmaxf(z, 0.f) + LN2 * __builtin_amdgcn_logf(1.0f + __builtin_amdgcn_exp2f(-fabsf(z) * L2E)); const bool st = (dq - c - 32) >= 1; l1[r] = st ? -sp : 0.f; p1[r] = st ? (z - sp) : NEG; } }
    float gs[8], pg[8], ps[8];
#pragma unroll
    for (int g = 0; g < 4; ++g) { gs[g] = (l0[4 * g] + l0[4 * g + 1]) + (l0[4 * g + 2] + l0[4 * g + 3]); gs[4 + g] = (l1[4 * g] + l1[4 * g + 1]) + (l1[4 * g + 2] + l1[4 * g + 3]); }
#pragma unroll
    for (int g = 0; g < 8; ++g) { auto rr = __builtin_amdgcn_permlane32_swap(__float_as_uint(gs[g]), __float_as_uint(gs[g]), false, false);
        const float lo = __uint_as_float(rr[0]), hv = __uint_as_float(rr[1]); ps[g] = lo + hv; pg[g] = hi ? lo : hv; }
    float acc = R;
#pragma unroll
    for (int g = 7; g >= 0; --g) {
        float run = hi ? acc : acc + pg[g];
        acc += ps[g];
        if (g >= 4) { const int b = 4 * (g - 4);
#pragma unroll
            for (int e = 3; e >= 0; --e) { const float t = l1[b + e]; p1[b + e] = __builtin_amdgcn_exp2f((p1[b + e] + run) * L2E); run += t; } }
        else { const int b = 4 * g;
#pragma unroll
            for (int e = 3; e >= 0; --e) { const float t = l0[b + e]; p0[b + e] = __builtin_amdgcn_exp2f((p0[b + e] + run) * L2E); run += t; } }
    }
    R = acc;
    bf16x8 pa0, pa1, pa2, pa3;
    PK4(p0, 0, pa0); PK4(p0, 8, pa1); PK4(p1, 0, pa2); PK4(p1, 8, pa3);
    pv_tile<BUF>(o, vb0, pa0, pa1, pa2, pa3);
}
__device__ __forceinline__ void sb_block(const BlockRef& cur, char* lds, const int WAVE_) {
    const int tid = TID(), wid = __builtin_amdgcn_readfirstlane(tid >> 6), lane = tid & 63, r32 = lane & 31, hi = lane >> 5;
    const int NT = (cur.P0 + QB - 1) / KVBLK + 1;
    const int qlo = cur.P0 + wid * QBLK, qm = qlo + r32 - 4 * hi;
    char* V_lds = lds; char* K_lds = lds + 2 * SHM_V;
    volatile LAS int* flg = (volatile LAS int*)(lds + OFF_FLAG);
    const int sr = tid >> 4, sc = (tid & 15) * 8, vst0 = v_st(sr, sc), vst1 = v_st(32 + sr, sc), kws = KSWZ(sr, sc * 2);
    const int vb0 = (int)(uintptr_t)V_lds + v_rd_base(lane);
    const bf16* Kh = cur.K; const bf16* Vh = cur.V;
    bf16x8 qr[8];
#pragma unroll
    for (int d0 = 0; d0 < 8; ++d0) qr[d0] = load8(cur.Q + (size_t)(wid * QBLK + r32) * PITCH + d0 * 16 + hi * 8);
    bf16x8 st_v0, st_v1, st_k0, st_k1;
#define SB_LOAD(k0) do { st_v0 = load8(ROW(Vh, k0, sr)); st_v1 = load8(ROW(Vh, k0, 32 + sr)); st_k0 = load8(ROW(Kh, k0, sr)); st_k1 = load8(ROW(Kh, k0, 32 + sr)); } while (0)
#define SB_WRITE(bf) do { *(bf16x8*)(V_lds + (bf) * SHM_V + vst0) = st_v0; *(bf16x8*)(V_lds + (bf) * SHM_V + vst1) = st_v1; \
                          *(bf16x8*)(K_lds + (bf) * SHM_K + kws) = st_k0; *(bf16x8*)(K_lds + (bf) * SHM_K + kws + 32 * 256) = st_k1; } while (0)
    f32x16 o[4] = {}; float R = 0.f; bool fin = false;
    SB_LOAD((NT - 1) * KVBLK); VMW(); SB_WRITE(0);
    if (NT > 1) SB_LOAD((NT - 2) * KVBLK);
    __syncthreads();
#define SB_STEP(t, BUF) do { const int kb_ = (NT - 1 - (t)) * KVBLK;                                                         \
        if (!fin && kb_ <= qlo + QBLK - 2) { sb_tile<BUF>(o, R, K_lds, vb0, r32, hi, qr, qm - kb_); fin = __all(R < -105.f); } \
        if ((t) + 1 < NT) { VMW(); SB_WRITE((BUF) ^ 1); if ((t) + 2 < NT) SB_LOAD((NT - 3 - (t)) * KVBLK); }                   \
        if (lane == 0) flg[(BUF) * 8 + wid] = fin ? 1 : 0;                                                                   \
        __syncthreads();                                                                                                      \
        { int all_ = 1; _Pragma("unroll") for (int w_ = 0; w_ < 8; ++w_) all_ &= flg[(BUF) * 8 + w_]; stop = all_ != 0; } } while (0)
    bool stop = false;
    for (int t = 0; t < NT; t += 2) {
        SB_STEP(t, 0);
        if (stop || t + 1 >= NT) break;
        SB_STEP(t + 1, 1);
        if (stop) break;
    }
    bf16* Ow = cur.O + (size_t)(wid * QBLK) * PITCH;
#pragma unroll
    for (int r = 0; r < 16; ++r) { const int orow = crow(r, hi);
#pragma unroll
        for (int d0 = 0; d0 < 4; ++d0) { const float v = o[d0][r];
            const float vn = __shfl_xor(v, 1);
            if ((r32 & 1) == 0) *(unsigned*)(Ow + (size_t)orow * PITCH + d0 * 32 + r32) = cvtpk(v, vn); } }
    __syncthreads();
#undef SB_LOAD
#undef SB_WRITE
#undef SB_STEP
}
#undef ROW
#undef VMW
#undef VMWN
#undef SLOAD_H
#undef SWRITE_HK
#undef SWRITE_HV
#undef SWRITE_H
#undef PK4
#undef KSWZ
}

constexpr int REP_X3 = 0;
constexpr int REP_X2 = 0;
constexpr int X1_ALIGN = 1, X1_SP2 = 1, X1_CONSTA = 0;
constexpr int REP_X1 = 0, REP_X1N = 20480;
constexpr int REP_ATT = 1;
constexpr int REP_P0W = 1, REP_P0R = 1;
constexpr int REP_P0 = 1, REP_P1 = 1, REP_FOX = 1, REP_SB = 1, REP_P3A = 1, REP_P5 = 1, REP_P5B = 1, REP_P7A = 1;
enum { PH_P0 = 0, PH_P1, PH_P1B, PH_ATT, PH_P3A, PH_P3B, PH_P4, PH_P5, PH_P5B, PH_P6, PH_P7A, PH_P7, PH_N };
__global__ void __launch_bounds__(NWAVES * 64, 2) mega_fwd(Params P) {
    extern __shared__ __attribute__((aligned(16))) unsigned char lds[];
    Frame F;
    F.lds = (LAS unsigned char*)lds;
    F.MISC = (volatile LAS unsigned*)(F.lds + MISC_OFF);
    F.wave = __builtin_amdgcn_readfirstlane((int)(__builtin_amdgcn_workitem_id_x() >> 6));
    const int WAVE_ = F.wave; const int f_tid = TID();
    F.G = gridDim.x; { const int bx = blockIdx.x; F.vcu = (F.G % 8 == 0) ? (bx % 8) * (F.G / 8) + bx / 8 : bx; }
    unsigned char* ws = P.ws;
    F.ctl = (gu32*)(ws + WS_CTL);
    for (int u = f_tid; u < (LDS_BYTES - LDSCTL_OFF) / 4; u += NWAVES * 64) ((LAS unsigned*)(F.lds + LDSCTL_OFF))[u] = 0u;
    __syncthreads();
    XcdBarrier bar = xcd_barrier_post((unsigned*)(F.ctl + CW_BAR) + P.li * XCD_BAR_WORDS, F.MISC + 8, F.wave);
    const int lo = P.ph_lo, hi = P.ph_hi;
#define IN(k) (lo <= (k) && (k) < hi)
#define SEAM(k) do { if (IN(k) && IN((k) + 1)) xcd_barrier(bar); } while (0)
    bf16* W_in = (bf16*)(ws + WS_WIN); bf16* XB = (bf16*)(ws + WS_XB);
    float* ss1 = (float*)(ws + WS_SS1); float* ss2 = (float*)(F.ctl + CW_SS2); float* ss3 = (float*)(F.ctl + CW_SS3);
    bf16* QKV = (bf16*)(ws + WS_QKV); bf16* GATES = (bf16*)(ws + WS_GATES); bf16* Y = (bf16*)(ws + WS_Y); bf16* MERGED = (bf16*)(ws + WS_MERGED);
    LAS unsigned char* ring = F.lds + RING_OFF;

    if (IN(PH_P0)) { for (int rep = 0; rep < REP_P0; ++rep) { for (int r2 = 0; r2 < REP_P0W; ++r2) p0_weights(F, P); for (int r2 = 0; r2 < REP_P0R; ++r2) p0_rows(F, P); } }
    SEAM(PH_P0);
    if (IN(PH_P1)) { for (int rep = 0; rep < REP_P1; ++rep) {
        pg8::Gemm g{XB, W_in, S, NPROJ, DM}; ConvOrder So; So.init(S, NPROJ, F.G, (int)blockIdx.x); So.P = &P; So.wave = F.wave; So.slot = 0;
        pg8::EpiProj E{QKV, GATES, ss1};
        pg8::gemm_phase<pg8::EpiProj, ConvOrder, true, true>(ring, g, So, E, F.wave);
    } }
    if (IN(PH_P1)) { for (int rep = 0; rep < REP_X1; ++rep) {
        pg8::Gemm g{X1_CONSTA ? (bf16*)(ws + WS_ACT) : XB, W_in, S, REP_X1N, DM}; pg8::StaticOrder So; So.init(S, REP_X1N, F.G, (int)blockIdx.x);
        pg8::EpiNull E{};
        pg8::gemm_phase<pg8::EpiNull, pg8::StaticOrder, true, true>(ring, g, So, E, F.wave);
    } }
    if (IN(PH_P1)) { for (int rep = 0; rep < REP_X2; ++rep) {
        struct SameOrder : pg8::StaticOrder { __device__ bool next(int i, pg8::Unit& u) const { const bool ok = pg8::StaticOrder::next(i, u); u.pm = 0; u.pn = 0; return ok; } };
        pg8::Gemm g{XB, W_in, S, NPROJ, DM}; SameOrder So; So.init(S, NPROJ, F.G, (int)blockIdx.x);
        pg8::EpiNull E{};
        pg8::gemm_phase<pg8::EpiNull, SameOrder, true, true>(ring, g, So, E, F.wave);
    } }
    if (IN(PH_P1)) { for (int rep = 0; rep < REP_X3; ++rep) {
        const long long c0 = clock64();
        pg8::Gemm g{XB, W_in, S, NPROJ, DM}; pg8::StaticOrder So; So.init(S, NPROJ, F.G, (int)blockIdx.x);
        pg8::EpiNull E{};
        pg8::gemm_phase<pg8::EpiNull, pg8::StaticOrder, true, true>(ring, g, So, E, F.wave);
        const long long extra = (clock64() - c0) >> 7; const long long t1 = wall_clock64();
        while (wall_clock64() - t1 < extra) __builtin_amdgcn_s_sleep(10);
    } }
    SEAM(PH_P1);
    if (IN(PH_P1B)) { p1b_qknorm_fgate(F, P); }
    SEAM(PH_P1B);
    if (IN(PH_ATT)) {
        char* al = (char*)lds + RING_OFF;
        const size_t T = (size_t)S * WF;
        gu32* qctr = F.ctl + CW_QATT; volatile LAS int* nx = (volatile LAS int*)(F.lds + RING_OFF + att::OFF_NEXT);
        const int a_lane = lane_id(); const bool puller = (F.wave == 0 && a_lane == 0);
        float gqm = fmaxf(fabsf(P.in[5][a_lane]), fabsf(P.in[5][a_lane + 64])), gkm = fmaxf(fabsf(P.in[6][a_lane]), fabsf(P.in[6][a_lane + 64]));
#pragma unroll
        for (int o = 1; o < 64; o <<= 1) { gqm = fmaxf(gqm, __shfl_xor(gqm, o)); gkm = fmaxf(gkm, __shfl_xor(gkm, o)); }
        const float Uq = __builtin_bit_cast(float, __builtin_amdgcn_readfirstlane(__builtin_bit_cast(int, 128.0f * gqm * gkm * 1.02f)));
        for (int arep = 0; arep < REP_ATT; ++arep) {
        if (arep > 0) { xcd_barrier(bar); if (blockIdx.x == 0 && puller) __hip_atomic_store(qctr, 0u, RLX_AGENT); xcd_barrier(bar); }
        if (puller) nx[0] = (int)__hip_atomic_fetch_add(qctr, 1u, RLX_AGENT);
        __syncthreads();
        int item = nx[0];
        __syncthreads();
        {
            bool primed = false; att::Seam Sm;
            while (item < NH * 32) {
                int pulled = 0;
                if (puller) pulled = (int)__hip_atomic_fetch_add(qctr, 1u, RLX_AGENT);
                const int h = item & 15, qb = 31 - (item >> 4);
                att::cgate_scan((const float*)(ws + WS_LOGF) + (size_t)h * S, al, F.wave);
                if (puller) nx[0] = pulled;
                att::BlockRef cur; cur.Q = QKV + (size_t)(qb * 256) * WF + h * HD; cur.K = QKV + T + h * HD; cur.V = QKV + 2 * T + h * HD; cur.O = Y + (size_t)(qb * 256) * WF + h * HD; cur.P0 = qb * 256;
                if (!primed) att::fox_prime(cur, al, Sm, F.wave); else __syncthreads();
                const int nitem = nx[0];
                att::BlockRef nxt = cur; primed = false;
                if (nitem < NH * 32) { const int h2 = nitem & 15, q2 = 31 - (nitem >> 4);
                    nxt.Q = QKV + (size_t)(q2 * 256) * WF + h2 * HD; nxt.K = QKV + T + h2 * HD; nxt.V = QKV + 2 * T + h2 * HD; nxt.O = Y + (size_t)(q2 * 256) * WF + h2 * HD; nxt.P0 = q2 * 256; primed = true; }
                att::fox_block(cur, nxt, Uq, al, Sm, F.wave);
                item = nitem;
            }
        }
        while (item < 2 * NH * 32) {
            int pulled = 0;
            if (puller) pulled = (int)__hip_atomic_fetch_add(qctr, 1u, RLX_AGENT);
            const int L = item - NH * 32, h = L & 15, qb = 31 - (L >> 4);
            att::BlockRef b; b.Q = QKV + 3 * T + (size_t)(qb * 256) * WF + h * HD; b.K = QKV + 4 * T + h * HD; b.V = QKV + 5 * T + h * HD; b.O = Y + T + (size_t)(qb * 256) * WF + h * HD; b.P0 = qb * 256;
            if (puller) nx[0] = pulled;
            att::sb_block(b, al, F.wave);
            item = nx[0];
            __syncthreads();
        }
        }
    }
    SEAM(PH_ATT);
    if (IN(PH_P3A)) {
        pg8::Gemm g{Y, (bf16*)(ws + WS_WBF), S, DM, WF}; pg8::TwoPartOrder So; So.init(S, DM, F.G, (int)blockIdx.x); So.A1 = Y + (size_t)S * WF; So.B1 = (bf16*)(ws + WS_WBS);
        pg8::EpiGate2 E{MERGED, GATES, GATES + (size_t)S * DM};
        pg8::gemm_phase<pg8::EpiGate2, pg8::TwoPartOrder, true, true>(ring, g, So, E, F.wave);
    }
    SEAM(PH_P3B);
    if (IN(PH_P4)) {
        pg8::Gemm g{MERGED, (bf16*)(ws + WS_WOUT), S, DM, DM}; pg8::StaticOrder So; So.init(S, DM, F.G, (int)blockIdx.x);
        pg8::EpiResStat E{P.in[0], P.out, XB, ss2};
        pg8::gemm_phase<pg8::EpiResStat, pg8::StaticOrder, true, true>(ring, g, So, E, F.wave);
    }
    SEAM(PH_P4);
    if (IN(PH_P5)) { for (int rep = 0; rep < REP_P5; ++rep) {
        pg8::Gemm g{XB, (bf16*)(ws + WS_WUP), S, 2 * DFF, DM}; pg8::StaticOrder So; So.init(S, 2 * DFF, F.G, (int)blockIdx.x);
        pg8::EpiUp E{(bf16*)(ws + WS_UP), 2 * DFF, ss2};
        pg8::gemm_phase<pg8::EpiUp, pg8::StaticOrder, true, true>(ring, g, So, E, F.wave);
    } }
    SEAM(PH_P5);
    if (IN(PH_P5B)) { for (int rep = 0; rep < REP_P5B; ++rep) p5b_convglu(F, P); }
    SEAM(PH_P5B);
    if (IN(PH_P6)) {
        pg8::Gemm g{(bf16*)(ws + WS_ACT), (bf16*)(ws + WS_WDN), S, DM, DFF}; pg8::StaticOrder So; So.init(S, DM, F.G, (int)blockIdx.x);
        pg8::EpiResStat E{P.out, P.out, XB, ss3};
        pg8::gemm_phase<pg8::EpiResStat, pg8::StaticOrder, true, true>(ring, g, So, E, F.wave);
    }
    SEAM(PH_P6);
    if (IN(PH_P7A)) { for (int rep = 0; rep < REP_P7A; ++rep) {
        pg8::Gemm g{(bf16*)(ws + WS_PB), (bf16*)(ws + WS_WPP), S, DM, PLE}; pg8::StaticOrder So; So.init(S, DM, F.G, (int)blockIdx.x);
        pg8::EpiStoreBf16x4 E{(bf16*)(ws + WS_PP)};
        pg8::gemm_phase<pg8::EpiStoreBf16x4, pg8::StaticOrder, true, true>(ring, g, So, E, F.wave);
    } }
    if (IN(PH_P7)) {
        pg8::Gemm g{XB, (bf16*)(ws + WS_WPG), S, DM, DM}; pg8::StaticOrder So; So.init(S, DM, F.G, (int)blockIdx.x);
        pg8::EpiPle E{P.out, (const bf16*)(ws + WS_PP), ss3};
        pg8::gemm_phase<pg8::EpiPle, pg8::StaticOrder, true, true>(ring, g, So, E, F.wave);
    }
#undef IN
#undef SEAM
}

extern "C" void kernel_launch(void* const* d_in, const int* in_sizes, int n_in, void* d_out, int out_size, void* d_ws, size_t ws_size, hipStream_t stream) {
    static int grid = 0;
    if (grid == 0) {
        if (n_in != 18 || out_size != S * DM || ws_size < WS_END) { fprintf(stderr, "kernel_launch: unexpected shapes / workspace (%d inputs, out %d, ws %zu < %zu)\n", n_in, out_size, ws_size, (size_t)WS_END); grid = -1; return; }
        int dev = 0, cus = 0, per_cu = 0;
        if (hipGetDevice(&dev) != hipSuccess || hipDeviceGetAttribute(&cus, hipDeviceAttributeMultiprocessorCount, dev) != hipSuccess) { grid = -1; return; }
        if (hipFuncSetAttribute((const void*)mega_fwd, hipFuncAttributeMaxDynamicSharedMemorySize, LDS_BYTES) != hipSuccess) { fprintf(stderr, "kernel_launch: hipFuncSetAttribute failed\n"); grid = -1; return; }
        if (hipOccupancyMaxActiveBlocksPerMultiprocessor(&per_cu, (const void*)mega_fwd, NWAVES * 64, LDS_BYTES) != hipSuccess || per_cu < 1)
            fprintf(stderr, "kernel_launch: note: occupancy query reports %d workgroups per CU\n", per_cu);
        (void)hipGetLastError();
        grid = cus;
    }
    if (grid < 0) return;
    if (hipMemsetAsync((char*)d_ws + WS_CTL, 0, CTL_ZERO_BYTES, stream) != hipSuccess) return;
    Params a{};
    for (int i = 0; i < 18; ++i) a.in[i] = (const float*)d_in[i];
    a.out = (float*)d_out; a.ws = (unsigned char*)d_ws;
    a.ph_lo = PH_P0; a.ph_hi = PH_N; a.li = 0;
    hipLaunchKernelGGL(mega_fwd, dim3(grid), dim3(NWAVES * 64), LDS_BYTES, stream, a);
}
```

```cpp
#include <hip/hip_runtime.h>
#include <cstdio>
#include <cstdint>
__device__ __forceinline__ int lane_id() { int l; asm volatile("v_mbcnt_lo_u32_b32 %0, -1, 0\n\tv_mbcnt_hi_u32_b32 %0, -1, %0" : "=v"(l)); return l; }
#define TID() (WAVE_ * 64 + lane_id())
namespace pg8 {
#define PG8_LAS __attribute__((address_space(3)))
typedef unsigned short bf16_t;
typedef short bf16x8 __attribute__((ext_vector_type(8)));
typedef float f32x4 __attribute__((ext_vector_type(4)));
typedef unsigned u32x4 __attribute__((ext_vector_type(4)));
constexpr int BM = 256, BK = 64, HALF = 128, HTB = HALF * BK * 2  , STAGE_BYTES = 8 * HTB, NXCD = 8, WGM = 8;

__host__ __device__ __forceinline__ int lds_byte(int r, int c) { const int st = (r >> 4) * 2 + (c >> 5), rr = r & 15, cc = c & 31, ob = rr * 64 + cc * 2; return st * 1024 + (ob ^ (((ob >> 9) & 1) << 5)); }
__host__ __device__ __forceinline__ void stage_rc(int b, int& R, int& C) { const int st = b / 1024, sb = b % 1024, swz = sb ^ (((sb >> 9) & 1) << 5); R = (st >> 1) * 16 + swz / 64; C = (st & 1) * 32 + (swz % 64) / 2; }
__host__ __device__ __forceinline__ int perm32(int rho) { const int n = rho >> 4, i = rho & 15; return 8 * (i >> 2) + 4 * n + (i & 3); }

struct Unit { int pm, pn, part; };
struct Gemm { const bf16_t* A; const bf16_t* Bt; int M, N, K, lda, ldb; };

struct StaticOrder {
    int nM, nN, nwg, G, c;
    __host__ __device__ void init(int M, int N, int G_, int c_) { nM = M / BM; nN = N / BM; nwg = nM * nN; G = G_; c = c_; }
    __host__ __device__ bool next(int i, Unit& u) const {
        const long L = (long)i * G + c; if (L >= nwg) return false;
        int wgid = (int)L; { const int q = nwg / NXCD, r = nwg % NXCD, xcd = wgid % NXCD, off = wgid / NXCD; wgid = (xcd < r ? xcd * (q + 1) : r * (q + 1) + (xcd - r) * q) + off; }
        const int nig = WGM * nN, gid = wgid / nig, fm = gid * WGM, gsz = (nM - fm) < WGM ? (nM - fm) : WGM;
        u.pm = fm + ((wgid % nig) % gsz); u.pn = (wgid % nig) / gsz; return true;
    }
    __device__ __forceinline__ void a_ready(const Unit&) const {}
    __device__ __forceinline__ void done(const Unit&) const {}
    __device__ __forceinline__ const bf16_t* baseA(const Gemm& g, const Unit&) const { return g.A; }
    __device__ __forceinline__ const bf16_t* baseB(const Gemm& g, const Unit&) const { return g.Bt; }
    __device__ __forceinline__ bool zero_after(const Unit&) const { return true; }
};

__device__ __forceinline__ unsigned cvt_pk_bf16(float lo, float hi) { unsigned r; asm volatile("v_cvt_pk_bf16_f32 %0, %1, %2" : "=v"(r) : "v"(lo), "v"(hi)); return r; }
typedef float f32x2 __attribute__((ext_vector_type(2)));
constexpr int SEQ_ = 8192, DM_ = 4096;
constexpr float EPS_ = 1e-6f;
__device__ __forceinline__ float sigm(float v) { return __builtin_amdgcn_rcpf(1.0f + __builtin_amdgcn_exp2f(-1.4426950408889634f * v)); }
__device__ __forceinline__ float rs_of(float ss) { return __builtin_amdgcn_rsqf(ss * (1.0f / DM_) + EPS_); }
typedef unsigned u32x2 __attribute__((ext_vector_type(2)));
__device__ __forceinline__ f32x4 bf4_to_f32(u32x2 w) { return (f32x4){__uint_as_float(w.x << 16), __uint_as_float(w.x & 0xffff0000u), __uint_as_float(w.y << 16), __uint_as_float(w.y & 0xffff0000u)}; }

#define EPI_ROWS(k) (row0 + ((k) >> 2) * HALF + ((k) & 3) * 16)
#define EPI_ACC(k, bj, n) acc[(k) >> 2][bj][(k) & 3][n]
__device__ __forceinline__ u32x4 pack8(const f32x4 v0, const f32x4 v1) { u32x4 w; w.x = cvt_pk_bf16(v0[0], v0[1]); w.y = cvt_pk_bf16(v0[2], v0[3]); w.z = cvt_pk_bf16(v1[0], v1[1]); w.w = cvt_pk_bf16(v1[2], v1[3]); return w; }

struct EpiProj {
    static constexpr bool PERM = true, AFTER_DRAIN = false;
    bf16_t* qkv; bf16_t* gates; const float* ss;
    __device__ __forceinline__ void operator()(const f32x4 (&acc)[2][2][4][2], const Unit& u, int wr, int wc, int fr, int fq) const {
        const int row0 = u.pm * BM + wr * 64 + fr;
        bf16_t* base; int ldc, colt; const bool gate = u.pn >= 48;
        if (!gate) { base = qkv + (size_t)(u.pn >> 3) * ((size_t)SEQ_ * 2048); ldc = 2048; colt = (u.pn & 7) * 256; }
        else { const int t = u.pn - 48; base = gates + (size_t)(t >> 4) * ((size_t)SEQ_ * 4096); ldc = 4096; colt = (t & 15) * 256; }
        const int col0 = colt + wc * 32 + 8 * fq;
        float rs[8];
#pragma unroll
        for (int k = 0; k < 8; ++k) rs[k] = ss[EPI_ROWS(k)];
#pragma unroll
        for (int k = 0; k < 8; ++k) { const float r = rs_of(rs[k]); bf16_t* rowp = base + (size_t)EPI_ROWS(k) * ldc + col0;
#pragma unroll
            for (int bj = 0; bj < 2; ++bj) { f32x4 v0 = EPI_ACC(k, bj, 0) * r, v1 = EPI_ACC(k, bj, 1) * r;
                if (gate) {
#pragma unroll
                    for (int j = 0; j < 4; ++j) { v0[j] = sigm(v0[j]); v1[j] = sigm(v1[j]); } }
                *(u32x4*)(rowp + bj * HALF) = pack8(v0, v1); } }
    }
};
struct EpiResStat {
    static constexpr bool PERM = false, AFTER_DRAIN = false;
    const float* base; float* out; bf16_t* xb; float* ss;
    __device__ __forceinline__ void operator()(const f32x4 (&acc)[2][2][4][2], const Unit& u, int wr, int wc, int fr, int fq) const {
        const int row0 = u.pm * BM + wr * 64 + fr, col0 = u.pn * BM + wc * 32 + 4 * fq;
        f32x4 b[2][4];
#define LD_(k) do { const size_t off_ = (size_t)EPI_ROWS(k) * DM_ + col0; _Pragma("unroll") for (int q_ = 0; q_ < 4; ++q_) b[(k) & 1][q_] = *(const f32x4*)(base + off_ + (q_ >> 1) * HALF + (q_ & 1) * 16); } while (0)
        LD_(0);
#pragma unroll
        for (int k = 0; k < 8; ++k) {
            if (k + 1 < 8) LD_(k + 1);
            const int r = EPI_ROWS(k); const size_t off = (size_t)r * DM_ + col0; float s = 0.f;
#pragma unroll
            for (int q = 0; q < 4; ++q) { const f32x4 o = b[k & 1][q] + EPI_ACC(k, q >> 1, q & 1);
                *(f32x4*)(out + off + (q >> 1) * HALF + (q & 1) * 16) = o; s += (o[0] * o[0] + o[1] * o[1]) + (o[2] * o[2] + o[3] * o[3]);
                u32x2 w; w.x = cvt_pk_bf16(o[0], o[1]); w.y = cvt_pk_bf16(o[2], o[3]); *(u32x2*)(xb + off + (q >> 1) * HALF + (q & 1) * 16) = w; }
            s += __shfl_xor(s, 16); s += __shfl_xor(s, 32);
            if (fq == 0) __hip_atomic_fetch_add(ss + r, s, __ATOMIC_RELAXED, __HIP_MEMORY_SCOPE_AGENT);
            asm volatile("" ::: "memory");
        }
#undef LD_
    }
};
struct EpiUp {
    static constexpr bool PERM = true, AFTER_DRAIN = false;
    bf16_t* O; int ldc; const float* ss;
    __device__ __forceinline__ void operator()(const f32x4 (&acc)[2][2][4][2], const Unit& u, int wr, int wc, int fr, int fq) const {
        const int row0 = u.pm * BM + wr * 64 + fr, col0 = u.pn * BM + wc * 32 + 8 * fq;
        float rs[8];
#pragma unroll
        for (int k = 0; k < 8; ++k) rs[k] = ss[EPI_ROWS(k)];
#pragma unroll
        for (int k = 0; k < 8; ++k) { const float r = rs_of(rs[k]); bf16_t* rowp = O + (size_t)EPI_ROWS(k) * ldc + col0;
#pragma unroll
            for (int bj = 0; bj < 2; ++bj) *(u32x4*)(rowp + bj * HALF) = pack8(EPI_ACC(k, bj, 0) * r, EPI_ACC(k, bj, 1) * r); }
    }
};
template <int CTRL> __device__ __forceinline__ float dpp_upd(float old, float src) { return __builtin_bit_cast(float, __builtin_amdgcn_update_dpp(__builtin_bit_cast(int, old), __builtin_bit_cast(int, src), CTRL, 0xf, 0xf, false)); }
struct EpiConvGlu {
    static constexpr bool PERM = false, AFTER_DRAIN = false;
    static constexpr int J = 11008, ROR1 = 0x121, ROR2 = 0x122, SHR1 = 0x111, SHR2 = 0x112;
    bf16_t* act; float* edge; const float* ss; const float* cw; const float* cb; PG8_LAS float* xch;
    __device__ __forceinline__ void operator()(f32x4 (&acc)[2][2][4][2], const Unit& u, int wr, int wc, int, int) const {
        const int l_ = lane_id(), fr = l_ & 15, fq = l_ >> 4;
        const int row0 = u.pm * BM + wr * 64 + fr, colt = wc * 32 + 4 * fq, j0 = u.pn * 128 + colt;
        {   float rs[8];
#pragma unroll
            for (int k = 0; k < 8; ++k) rs[k] = ss[EPI_ROWS(k)];
#pragma unroll
            for (int k = 0; k < 8; ++k) { const float r = rs_of(rs[k]);
#pragma unroll
                for (int bj = 0; bj < 2; ++bj)
#pragma unroll
                    for (int n = 0; n < 2; ++n) EPI_ACC(k, bj, n) = EPI_ACC(k, bj, n) * r; } }
#pragma unroll
        for (int ai = 0; ai < 2; ++ai) { const int b = 2 * ai + wr;
            if (fr >= 14) {
#pragma unroll
                for (int bj = 0; bj < 2; ++bj)
#pragma unroll
                    for (int n = 0; n < 2; ++n) *(PG8_LAS f32x4*)(xch + (b * 2 + (fr - 14)) * 256 + 128 * bj + colt + 16 * n) = acc[ai][bj][3][n];
                if (b == 3) {
#pragma unroll
                    for (int bj = 0; bj < 2; ++bj)
#pragma unroll
                        for (int n = 0; n < 2; ++n) *(f32x4*)(edge + ((size_t)u.pm * 4 + 2 + (fr - 14)) * (2 * J) + bj * J + j0 + 16 * n) = acc[ai][bj][3][n]; }
            }
            if (b == 0 && fr < 2) {
#pragma unroll
                for (int bj = 0; bj < 2; ++bj)
#pragma unroll
                    for (int n = 0; n < 2; ++n) *(f32x4*)(edge + ((size_t)u.pm * 4 + fr) * (2 * J) + bj * J + j0 + 16 * n) = acc[ai][bj][0][n]; }
        }
        asm volatile("s_waitcnt lgkmcnt(0)" ::: "memory"); __builtin_amdgcn_s_barrier(); asm volatile("" ::: "memory");
#pragma unroll
        for (int n = 0; n < 2; ++n) {
            f32x4 wgt[2][3], bia[2];
#pragma unroll
            for (int bj = 0; bj < 2; ++bj) { bia[bj] = *(const f32x4*)(cb + bj * J + j0 + 16 * n);
#pragma unroll
                for (int t = 0; t < 3; ++t) wgt[bj][t] = *(const f32x4*)(cw + (size_t)t * 2 * J + bj * J + j0 + 16 * n); }
#pragma unroll
            for (int k = 0; k < 8; ++k) { const int ai = k >> 2, m = k & 3, b = 2 * ai + wr;
                f32x4 x63[2], x62[2];
                if (m == 0) {
#pragma unroll
                    for (int bj = 0; bj < 2; ++bj) { const int pb = (b + 3) & 3; x63[bj] = *(const PG8_LAS f32x4*)(xch + (pb * 2 + 1) * 256 + 128 * bj + colt + 16 * n); x62[bj] = *(const PG8_LAS f32x4*)(xch + (pb * 2 + 0) * 256 + 128 * bj + colt + 16 * n); } }
                f32x4 res;
#pragma unroll
                for (int e = 0; e < 4; ++e) { float uu[2];
#pragma unroll
                    for (int bj = 0; bj < 2; ++bj) { const float c = acc[ai][bj][m][n][e]; float o1, o2;
                        if (m == 0) { o1 = x63[bj][e]; o2 = (fr == 0) ? x62[bj][e] : x63[bj][e]; }
                        else { const float pv = acc[ai][bj][m - 1][n][e]; o1 = dpp_upd<ROR1>(pv, pv); o2 = dpp_upd<ROR2>(pv, pv); }
                        const float p1 = dpp_upd<SHR1>(o1, c), p2 = dpp_upd<SHR2>(o2, c);
                        uu[bj] = bia[bj][e] + wgt[bj][0][e] * p2 + wgt[bj][1][e] * p1 + wgt[bj][2][e] * c; }
                    res[e] = uu[0] * sigm(uu[0]) * uu[1]; }
                if (!(b == 0 && m == 0 && fr < 2)) { u32x2 w; w.x = cvt_pk_bf16(res[0], res[1]); w.y = cvt_pk_bf16(res[2], res[3]); *(u32x2*)(act + (size_t)EPI_ROWS(k) * J + j0 + 16 * n) = w; }
            }
        }
    }
};
struct EpiPle {
    static constexpr bool PERM = false, AFTER_DRAIN = false;
    float* out; const bf16_t* pp; const float* ss;
    __device__ __forceinline__ void operator()(const f32x4 (&acc)[2][2][4][2], const Unit& u, int wr, int wc, int fr, int fq) const {
        const int row0 = u.pm * BM + wr * 64 + fr, col0 = u.pn * BM + wc * 32 + 4 * fq;
        float rs[8];
#pragma unroll
        for (int k = 0; k < 8; ++k) rs[k] = ss[EPI_ROWS(k)];
        f32x4 b[2][4]; u32x2 q2[2][4];
#define LD_(k) do { const size_t off_ = (size_t)EPI_ROWS(k) * DM_ + col0; _Pragma("unroll") for (int q_ = 0; q_ < 4; ++q_) { b[(k) & 1][q_] = *(const f32x4*)(out + off_ + (q_ >> 1) * HALF + (q_ & 1) * 16); \
            q2[(k) & 1][q_] = *(const u32x2*)(pp + off_ + (q_ >> 1) * HALF + (q_ & 1) * 16); } } while (0)
        LD_(0);
#pragma unroll
        for (int k = 0; k < 8; ++k) {
            if (k + 1 < 8) LD_(k + 1);
            const size_t off = (size_t)EPI_ROWS(k) * DM_ + col0; const float r = rs_of(rs[k]);
#pragma unroll
            for (int q = 0; q < 4; ++q) { const f32x4 a = EPI_ACC(k, q >> 1, q & 1) * r, pv = bf4_to_f32(q2[k & 1][q]), bb = b[k & 1][q];
                f32x4 o; o[0] = bb[0] + sigm(a[0]) * pv[0]; o[1] = bb[1] + sigm(a[1]) * pv[1]; o[2] = bb[2] + sigm(a[2]) * pv[2]; o[3] = bb[3] + sigm(a[3]) * pv[3];
                *(f32x4*)(out + off + (q >> 1) * HALF + (q & 1) * 16) = o; }
            asm volatile("" ::: "memory");
        }
#undef LD_
    }
};
struct EpiGate2 {
    static constexpr bool PERM = true, AFTER_DRAIN = false;
    bf16_t* merged; const bf16_t* sga; const bf16_t* sgb;
    __device__ __forceinline__ void operator()(f32x4 (&acc)[2][2][4][2], const Unit& u, int wr, int wc, int fr, int fq) const {
        const int row0 = u.pm * BM + wr * 64 + fr, col0 = u.pn * BM + wc * 32 + 8 * fq;
        if (u.part == 0) {
            u32x4 ga[2][2], gb[2][2];
#define LD_(k) do { const size_t off_ = (size_t)EPI_ROWS(k) * DM_ + col0; ga[(k) & 1][0] = *(const u32x4*)(sga + off_); ga[(k) & 1][1] = *(const u32x4*)(sga + off_ + HALF); gb[(k) & 1][0] = *(const u32x4*)(sgb + off_); gb[(k) & 1][1] = *(const u32x4*)(sgb + off_ + HALF); } while (0)
            LD_(0);
#pragma unroll
            for (int k = 0; k < 8; ++k) {
                if (k + 1 < 8) LD_(k + 1);
#pragma unroll
                for (int bj = 0; bj < 2; ++bj) { const u32x4 aw = ga[k & 1][bj], bw = gb[k & 1][bj];
                    const f32x4 ga0 = bf4_to_f32((u32x2){aw.x, aw.y}), ga1 = bf4_to_f32((u32x2){aw.z, aw.w}), gb0 = bf4_to_f32((u32x2){bw.x, bw.y}), gb1 = bf4_to_f32((u32x2){bw.z, bw.w});
#pragma unroll
                    for (int j = 0; j < 4; ++j) { EPI_ACC(k, bj, 0)[j] *= ga0[j] * __builtin_amdgcn_rcpf(fmaxf(gb0[j], 1e-20f)); EPI_ACC(k, bj, 1)[j] *= ga1[j] * __builtin_amdgcn_rcpf(fmaxf(gb1[j], 1e-20f)); } }
                asm volatile("" ::: "memory");
            }
#undef LD_
        } else {
            u32x4 gb[2][2];
#define LD_(k) do { const size_t off_ = (size_t)EPI_ROWS(k) * DM_ + col0; gb[(k) & 1][0] = *(const u32x4*)(sgb + off_); gb[(k) & 1][1] = *(const u32x4*)(sgb + off_ + HALF); } while (0)
            LD_(0);
#pragma unroll
            for (int k = 0; k < 8; ++k) {
                if (k + 1 < 8) LD_(k + 1);
                const size_t off = (size_t)EPI_ROWS(k) * DM_ + col0;
#pragma unroll
                for (int bj = 0; bj < 2; ++bj) { const u32x4 bw = gb[k & 1][bj]; const f32x4 gb0 = bf4_to_f32((u32x2){bw.x, bw.y}), gb1 = bf4_to_f32((u32x2){bw.z, bw.w});
                    f32x4 v0, v1;
#pragma unroll
                    for (int j = 0; j < 4; ++j) { v0[j] = EPI_ACC(k, bj, 0)[j] * fmaxf(gb0[j], 1e-20f); v1[j] = EPI_ACC(k, bj, 1)[j] * fmaxf(gb1[j], 1e-20f); }
                    *(u32x4*)(merged + off + bj * HALF) = pack8(v0, v1); }
                asm volatile("" ::: "memory");
            }
#undef LD_
        }
    }
};
struct TwoPartOrder : StaticOrder {
    const bf16_t* A1; const bf16_t* B1;
    __device__ bool next(int i, Unit& u) const { const bool ok = StaticOrder::next(i >> 1, u); u.part = i & 1; return ok; }
    __device__ __forceinline__ const bf16_t* baseA(const Gemm& g, const Unit& u) const { return u.part ? A1 : g.A; }
    __device__ __forceinline__ const bf16_t* baseB(const Gemm& g, const Unit& u) const { return u.part ? B1 : g.Bt; }
    __device__ __forceinline__ bool zero_after(const Unit& u) const { return u.part != 0; }
};
struct EpiStoreBf16x4 {
    static constexpr bool PERM = false, AFTER_DRAIN = false;
    bf16_t* C;
    __device__ __forceinline__ void operator()(const f32x4 (&acc)[2][2][4][2], const Unit& u, int wr, int wc, int fr, int fq) const {
        const int row0 = u.pm * BM + wr * 64 + fr, col0 = u.pn * BM + wc * 32 + 4 * fq;
#pragma unroll
        for (int ai = 0; ai < 2; ++ai)
#pragma unroll
            for (int m = 0; m < 4; ++m) { bf16_t* rowp = C + (size_t)(row0 + ai * HALF + m * 16) * DM_ + col0;
#pragma unroll
                for (int bj = 0; bj < 2; ++bj)
#pragma unroll
                    for (int n = 0; n < 2; ++n) { const f32x4 v = acc[ai][bj][m][n]; u32x2 w; w.x = cvt_pk_bf16(v[0], v[1]); w.y = cvt_pk_bf16(v[2], v[3]); *(u32x2*)(rowp + bj * HALF + n * 16) = w; } }
    }
};
struct EpiNull {
    static constexpr bool PERM = true, AFTER_DRAIN = false;
    __device__ __forceinline__ void operator()(const f32x4 (&acc)[2][2][4][2], const Unit& u, int wr, int wc, int fr, int fq) const {
#pragma unroll
        for (int ai = 0; ai < 2; ++ai)
#pragma unroll
            for (int bj = 0; bj < 2; ++bj)
#pragma unroll
                for (int m = 0; m < 4; ++m)
#pragma unroll
                    for (int n = 0; n < 2; ++n) asm volatile("" :: "v"(acc[ai][bj][m][n]));
    }
};
#undef EPI_ROWS
#undef EPI_ACC
template <class Epi, class Sched, bool ALIGN_EPI = false, bool SP2 = false>
__device__ __forceinline__ void gemm_phase(PG8_LAS unsigned char* lds, const Gemm g, const Sched& S, const Epi& E, const int WAVE_) {
    const int tid = TID(), wid = __builtin_amdgcn_readfirstlane(tid >> 6), lane = tid & 63, wr = wid >> 2, wc = wid & 3, fr = lane & 15, fq = lane >> 4;
    const int K = g.K, nt = K / BK, lda = g.lda ? g.lda : K, ldb = g.ldb ? g.ldb : K;
    unsigned voffA[2], voffB[2];
#pragma unroll
    for (int i = 0; i < 2; ++i) { int R, C; stage_rc(tid * 16 + i * 8192, R, C); const int Rb = Epi::PERM ? ((R & ~31) + perm32(R & 31)) : R;
        voffA[i] = (unsigned)(R * lda + C) * 2u; voffB[i] = (unsigned)(Rb * ldb + C) * 2u; }
    const size_t kstep = (size_t)(BK * 2);
    const size_t hstepA = (size_t)HALF * lda * 2, hstepB = (size_t)HALF * ldb * 2;
    const size_t tstepA = 2 * hstepA, tstepB = 2 * hstepB;
    const unsigned ldsw = (unsigned)wid * 1024u;
    const int aoff = lds_byte(wr * 64 + fr, fq * 8), boff = lds_byte(wc * 32 + fr, fq * 8);
#define PG8_SA(b, h) (((b) * 2 + (h)) * HTB)
#define PG8_SB(b, h) ((4 + (b) * 2 + (h)) * HTB)
#define PG8_STAGE(bufoff, gbase, voff) do { _Pragma("unroll") for (int _i = 0; _i < 2; ++_i) \
        __builtin_amdgcn_global_load_lds((const unsigned*)((const char*)(gbase) + (voff)[_i]), (PG8_LAS unsigned*)(lds + (bufoff) + ldsw + _i * 8192), 16, 0, 0); } while (0)
#define PG8_LDA(dst, b, h) do { _Pragma("unroll") for (int m = 0; m < 4; ++m) _Pragma("unroll") for (int k = 0; k < 2; ++k) dst[m][k] = *(const PG8_LAS bf16x8*)(lds + PG8_SA(b, h) + aoff + m * 2048 + k * 1024); } while (0)
#define PG8_LDB(dst, b, h) do { _Pragma("unroll") for (int n = 0; n < 2; ++n) _Pragma("unroll") for (int k = 0; k < 2; ++k) dst[n][k] = *(const PG8_LAS bf16x8*)(lds + PG8_SB(b, h) + boff + n * 2048 + k * 1024); } while (0)
#define PG8_MMA(ai, bj, At, Bt) do { __builtin_amdgcn_s_setprio(1); _Pragma("unroll") for (int m = 0; m < 4; ++m) _Pragma("unroll") for (int n = 0; n < 2; ++n) _Pragma("unroll") for (int k = 0; k < 2; ++k) \
        acc[ai][bj][m][n] = __builtin_amdgcn_mfma_f32_16x16x32_bf16(Bt[n][k], At[m][k], acc[ai][bj][m][n], 0, 0, 0); __builtin_amdgcn_s_setprio(0); } while (0)
#define PG8_WAIT_V(n) asm volatile("s_waitcnt vmcnt(" #n ")" ::: "memory")
#define PG8_WAIT_L(n) asm volatile("s_waitcnt lgkmcnt(" #n ")" ::: "memory")
#define PG8_BAR __builtin_amdgcn_s_barrier()
#define PG8_SCHED __builtin_amdgcn_sched_barrier(0)
    Unit cur, nxt; int ui = 0;
    if (!S.next(0, cur)) return;
    f32x4 acc[2][2][4][2];
#pragma unroll
    for (int a = 0; a < 2; ++a)
#pragma unroll
        for (int b = 0; b < 2; ++b)
#pragma unroll
            for (int m = 0; m < 4; ++m)
#pragma unroll
                for (int n = 0; n < 2; ++n) acc[a][b][m][n] = (f32x4){0.f, 0.f, 0.f, 0.f};
    bf16x8 At[4][2], B0[2][2], B1[2][2];
    const char* cA = (const char*)S.baseA(g, cur) + (size_t)cur.pm * tstepA; const char* cB = (const char*)S.baseB(g, cur) + (size_t)cur.pn * tstepB;
    S.a_ready(cur);
    if constexpr (SP2) {
        PG8_STAGE(PG8_SB(0, 0), cB, voffB); PG8_STAGE(PG8_SB(0, 1), cB + hstepB, voffB); PG8_STAGE(PG8_SA(0, 0), cA, voffA); PG8_STAGE(PG8_SA(0, 1), cA + hstepA, voffA);
        if (wr == 1) PG8_BAR;
        PG8_WAIT_V(2); PG8_BAR;
        PG8_STAGE(PG8_SB(1, 0), cB + kstep, voffB); PG8_STAGE(PG8_SA(1, 0), cA + kstep, voffA); PG8_STAGE(PG8_SB(1, 1), cB + hstepB + kstep, voffB);
        PG8_WAIT_V(6); PG8_BAR;
    } else {
        PG8_STAGE(PG8_SB(0, 0), cB, voffB); PG8_STAGE(PG8_SA(0, 0), cA, voffA); PG8_STAGE(PG8_SB(0, 1), cB + hstepB, voffB); PG8_STAGE(PG8_SA(0, 1), cA + hstepA, voffA);
        if (wr == 1) PG8_BAR;
        PG8_WAIT_V(4); PG8_BAR;
        PG8_STAGE(PG8_SB(1, 0), cB + kstep, voffB); PG8_STAGE(PG8_SA(1, 0), cA + kstep, voffA); PG8_STAGE(PG8_SB(1, 1), cB + hstepB + kstep, voffB);
        PG8_WAIT_V(6); PG8_BAR;
    }
    for (;;) {
        const bool has_next = S.next(ui + 1, nxt);
        const char* nA = has_next ? (const char*)S.baseA(g, nxt) + (size_t)nxt.pm * tstepA : cA; const char* nB = has_next ? (const char*)S.baseB(g, nxt) + (size_t)nxt.pn * tstepB : cB;
        for (int t = 0; t < nt; t += 2) {
            const bool last = (t == nt - 2);
            const char* a1 = cA + (size_t)(t + 1) * kstep;
            const char* a2 = last ? nA : cA + (size_t)(t + 2) * kstep; const char* b2 = last ? nB : cB + (size_t)(t + 2) * kstep;
            const char* a3 = a2 + kstep; const char* b3 = b2 + kstep;
            if (last && has_next) S.a_ready(nxt);
            if constexpr (SP2) {
            PG8_LDB(B0, 0, 0); PG8_LDB(B1, 0, 1); PG8_SCHED; PG8_LDA(At, 0, 0); PG8_STAGE(PG8_SA(1, 1), a1 + hstepA, voffA);
            PG8_WAIT_V(8); PG8_WAIT_L(0); PG8_BAR; PG8_MMA(0, 0, At, B0); PG8_MMA(0, 1, At, B1); PG8_BAR; PG8_SCHED;
            PG8_LDA(At, 0, 1); PG8_STAGE(PG8_SB(0, 0), b2, voffB); PG8_STAGE(PG8_SB(0, 1), b2 + hstepB, voffB); PG8_STAGE(PG8_SA(0, 0), a2, voffA);
            PG8_WAIT_V(8); PG8_WAIT_L(0); PG8_BAR; PG8_MMA(1, 0, At, B0); PG8_MMA(1, 1, At, B1); PG8_BAR; PG8_SCHED;
            PG8_LDB(B0, 1, 0); PG8_LDB(B1, 1, 1); PG8_SCHED; PG8_LDA(At, 1, 0); PG8_STAGE(PG8_SA(0, 1), a2 + hstepA, voffA);
            PG8_WAIT_V(8); PG8_WAIT_L(0); PG8_BAR; PG8_MMA(0, 0, At, B0); PG8_MMA(0, 1, At, B1); PG8_BAR; PG8_SCHED;
            PG8_LDA(At, 1, 1); PG8_STAGE(PG8_SB(1, 0), b3, voffB); PG8_STAGE(PG8_SB(1, 1), b3 + hstepB, voffB); PG8_STAGE(PG8_SA(1, 0), a3, voffA);
            PG8_WAIT_V(8); PG8_WAIT_L(0); PG8_BAR; PG8_MMA(1, 0, At, B0); PG8_MMA(1, 1, At, B1); PG8_BAR; PG8_SCHED;
            } else {
            PG8_LDB(B0, 0, 0); PG8_SCHED; PG8_LDA(At, 0, 0); PG8_STAGE(PG8_SA(1, 1), a1 + hstepA, voffA);
            PG8_WAIT_L(8); PG8_BAR; PG8_WAIT_L(0); PG8_MMA(0, 0, At, B0); PG8_BAR; PG8_SCHED;
            PG8_LDB(B1, 0, 1); PG8_STAGE(PG8_SB(0, 0), b2, voffB);
            PG8_BAR; PG8_WAIT_L(0); PG8_MMA(0, 1, At, B1); PG8_BAR;
            PG8_LDA(At, 0, 1); PG8_STAGE(PG8_SA(0, 0), a2, voffA);
            PG8_BAR; PG8_WAIT_L(0); PG8_MMA(1, 0, At, B0); PG8_BAR; PG8_SCHED;
            PG8_STAGE(PG8_SB(0, 1), b2 + hstepB, voffB);
            PG8_WAIT_V(6); PG8_BAR; PG8_MMA(1, 1, At, B1); PG8_BAR;
            PG8_LDB(B0, 1, 0); PG8_SCHED; PG8_LDA(At, 1, 0); PG8_STAGE(PG8_SA(0, 1), a2 + hstepA, voffA);
            PG8_WAIT_L(8); PG8_BAR; PG8_WAIT_L(0); PG8_MMA(0, 0, At, B0); PG8_BAR; PG8_SCHED;
            PG8_LDB(B1, 1, 1); PG8_STAGE(PG8_SB(1, 0), b3, voffB);
            PG8_BAR; PG8_WAIT_L(0); PG8_MMA(0, 1, At, B1); PG8_BAR;
            PG8_LDA(At, 1, 1); PG8_STAGE(PG8_SA(1, 0), a3, voffA);
            PG8_BAR; PG8_WAIT_L(0); PG8_MMA(1, 0, At, B0); PG8_BAR; PG8_SCHED;
            PG8_STAGE(PG8_SB(1, 1), b3 + hstepB, voffB);
            PG8_WAIT_V(6); PG8_BAR; PG8_MMA(1, 1, At, B1); PG8_BAR;
            }
        }
        if constexpr (ALIGN_EPI) { if (wr == 0) PG8_BAR; }
        if constexpr (!Epi::AFTER_DRAIN) { E(acc, cur, wr, wc, fr, fq); S.done(cur); }
        if (!has_next) break;
        if (S.zero_after(cur))
#pragma unroll
        for (int a = 0; a < 2; ++a)
#pragma unroll
            for (int b = 0; b < 2; ++b)
#pragma unroll
                for (int m = 0; m < 4; ++m)
#pragma unroll
                    for (int n = 0; n < 2; ++n) acc[a][b][m][n] = (f32x4){0.f, 0.f, 0.f, 0.f};
        cur = nxt; cA = nA; cB = nB; ++ui;
        if constexpr (ALIGN_EPI) { if (wr == 1) PG8_BAR; }
    }
    PG8_WAIT_V(0);
    if constexpr (!ALIGN_EPI) { if (wr == 0) PG8_BAR; }
    PG8_BAR;
    if constexpr (Epi::AFTER_DRAIN) { E.fused(acc, cur, wr, wc, fr, fq, lds, wid, lane); S.done(cur); }
#undef PG8_SA
#undef PG8_SB
#undef PG8_STAGE
#undef PG8_LDA
#undef PG8_LDB
#undef PG8_MMA
#undef PG8_WAIT_V
#undef PG8_WAIT_L
#undef PG8_BAR
#undef PG8_SCHED
}
}
constexpr int NWAVES = 8;
constexpr int S = 8192, DM = 4096, HD = 128, NH = 16, WF = 2048, DFF = 11008, PLE = 256, NIN = 20496, NPROJ = 20480;
constexpr float EPS = 1e-6f;
constexpr float SCALE = 0.08838834764831845f;
constexpr size_t MiB = 1u << 20;
constexpr size_t WS_CTL = 0, CTL_ZERO_BYTES = 1 * MiB;
constexpr size_t WS_SS1 = 1 * MiB;
constexpr size_t WS_LOGF = WS_SS1 + 64 * 1024;
constexpr size_t WS_C = WS_LOGF + 512 * 1024;
constexpr size_t WS_WTF = WS_C + 512 * 1024;
constexpr size_t WS_WIN = 4 * MiB;
constexpr size_t WS_WBF = WS_WIN + 160 * MiB;
constexpr size_t WS_WBS = WS_WBF + 16 * MiB;
constexpr size_t WS_WOUT = WS_WBS + 16 * MiB;
constexpr size_t WS_WUP = WS_WOUT + 32 * MiB;
constexpr size_t WS_WDN = WS_WUP + 172 * MiB;
constexpr size_t WS_WPG = WS_WDN + 86 * MiB;
constexpr size_t WS_WPP = WS_WPG + 32 * MiB;
constexpr size_t WS_XB = WS_WPP + 2 * MiB;
constexpr size_t WS_PB = WS_XB + 64 * MiB;
constexpr size_t WS_QKV = WS_PB + 4 * MiB;
constexpr size_t WS_GATES = WS_QKV + 192 * MiB;
constexpr size_t WS_Y = WS_GATES + 128 * MiB;
constexpr size_t WS_EDGE = WS_QKV + 128 * MiB;
constexpr size_t WS_UP = WS_QKV;
constexpr size_t WS_MERGED = WS_Y + 64 * MiB;
constexpr size_t WS_ACT = WS_MERGED + 64 * MiB;
constexpr size_t WS_PP = WS_QKV;
constexpr size_t WS_END = WS_ACT + 172 * MiB;
static_assert(WS_UP + (size_t)S * 2 * DFF * 2 <= WS_MERGED, "up overlay");
constexpr int CW_BAR = 4096;
constexpr int CW_QATT = 2048;
constexpr int CW_SS2 = 32768, CW_SS3 = 32768 + 8192;
constexpr int N_BAR_REGIONS = 4;
constexpr int RING_OFF = 0, RING_BYTES = 131072;
constexpr int LDSCTL_OFF = RING_BYTES, MISC_OFF = LDSCTL_OFF + 320;
constexpr int XCH_OFF = LDSCTL_OFF + 1024;
constexpr int LDS_BYTES = 147456;
static_assert(XCH_OFF + 8192 <= LDS_BYTES, "LDS map");

#define GAS __attribute__((address_space(1)))
#define LAS __attribute__((address_space(3)))
typedef unsigned short bf16;
typedef unsigned v4u __attribute__((ext_vector_type(4)));
typedef unsigned v2u __attribute__((ext_vector_type(2)));
typedef float f32x4 __attribute__((ext_vector_type(4)));
typedef float f32x16 __attribute__((ext_vector_type(16)));
typedef short bf16x8 __attribute__((ext_vector_type(8)));
typedef GAS unsigned gu32;
#define RLX_AGENT __ATOMIC_RELAXED, __HIP_MEMORY_SCOPE_AGENT
#define LDS_WAIT() asm volatile("s_waitcnt lgkmcnt(0)" ::: "memory")
#define VM_WAIT() asm volatile("s_waitcnt vmcnt(0)" ::: "memory")
__device__ __forceinline__ unsigned pk2(float lo, float hi) { unsigned r; asm volatile("v_cvt_pk_bf16_f32 %0, %1, %2" : "=v"(r) : "v"(lo), "v"(hi)); return r; }
__device__ __forceinline__ float bf2f(bf16 b) { return __uint_as_float(((unsigned)b) << 16); }
__device__ __forceinline__ float bflo(unsigned w) { return __uint_as_float(w << 16); }
__device__ __forceinline__ float bfhi(unsigned w) { return __uint_as_float(w & 0xffff0000u); }
__device__ __forceinline__ float sigmoidf_(float v) { return 1.0f / (1.0f + __expf(-v)); }
__device__ __forceinline__ float log_sigmoidf_(float v) { return fminf(v, 0.f) - log1pf(__expf(-fabsf(v))); }
__device__ __forceinline__ float softplusf_(float v) { return fmaxf(v, 0.f) + log1pf(__expf(-fabsf(v))); }
__device__ __forceinline__ float wave_sum(float v) {
#pragma unroll
    for (int o = 1; o < 64; o <<= 1) v += __shfl_xor(v, o);
    return v;
}

#define XB_TMO      128
#define XB_XCNT(j)  (256  + 64 * (j))
#define XB_XSUB(j)  (1280 + 64 * (j))
#define XB_XGEN(j)  (2304 + 64 * (j))
#define XB_TOP      3328
#define XB_TOPGEN   3392
#define XCD_BAR_WORDS 3456
#define XB_SPIN_CAP (1u << 18)

__device__ __forceinline__ unsigned xb_ld(unsigned* p)              { return __hip_atomic_load(p, __ATOMIC_RELAXED, __HIP_MEMORY_SCOPE_AGENT); }
__device__ __forceinline__ unsigned xb_add(unsigned* p, unsigned v) { return __hip_atomic_fetch_add(p, v, __ATOMIC_RELAXED, __HIP_MEMORY_SCOPE_AGENT); }
__device__ __forceinline__ unsigned xb_xcc_id() { return (unsigned)__builtin_amdgcn_s_getreg((3 << 11) | 20) & 0xFu; }
#define XB_SPIN(cond, bar) do { unsigned _sp = 0; while (cond) { __builtin_amdgcn_s_sleep(1); \
    if ((++_sp & 255u) == 0u) { if (xb_ld(&(bar)[XB_TMO])) break; if (_sp > XB_SPIN_CAP) { atomicAdd(&(bar)[XB_TMO], 1u); break; } } } } while (0)

struct XcdBarrier {
    unsigned* bar; unsigned x; int wave;
    volatile LAS unsigned* st;
};

__device__ __forceinline__ XcdBarrier xcd_barrier_post(unsigned* bar, volatile LAS unsigned* st, const int WAVE_) {
    XcdBarrier b; b.wave = WAVE_; b.bar = bar; b.x = xb_xcc_id(); b.st = st;
    if (TID() == 0) (void)xb_add(&bar[XB_XCNT(b.x)], 1u);
    return b;
}
__device__ __forceinline__ void xcd_barrier_complete(unsigned* bar, unsigned x, unsigned& nloc, unsigned& nx) {
    const unsigned G = gridDim.x * gridDim.y * gridDim.z;
    unsigned sum, cnt, mine, sp = 0u;
    for (;;) {
        sum = 0u; cnt = 0u; mine = 0u;
#pragma unroll
        for (unsigned j = 0; j < 16; ++j) { const unsigned c = xb_ld(&bar[XB_XCNT(j)]); sum += c; cnt += (c > 0u) ? 1u : 0u; mine = (j == x) ? c : mine; }
        if (sum == G) break;
        __builtin_amdgcn_s_sleep(1);
        if ((++sp & 255u) == 0u) { if (xb_ld(&bar[XB_TMO])) break; if (sp > XB_SPIN_CAP) { atomicAdd(&bar[XB_TMO], 1u); break; } }
    }
    nloc = mine > 0u ? mine : 1u; nx = cnt > 0u ? cnt : 1u;
}

__device__ __forceinline__ void xcd_barrier(const XcdBarrier& b) {
    const int WAVE_ = b.wave;
    asm volatile("s_waitcnt vmcnt(0)" ::: "memory");
    __syncthreads();
    if (TID() == 0) {
        unsigned* bar = b.bar;
        __builtin_amdgcn_s_waitcnt(0);
        unsigned nloc = b.st[0], nx = b.st[1];
        if (nloc == 0u) { xcd_barrier_complete(bar, b.x, nloc, nx); b.st[0] = nloc; b.st[1] = nx; }
        const unsigned old = xb_add(&bar[XB_XSUB(b.x)], 1u);
        const unsigned gen = old / nloc;
        if (old + 1u == (gen + 1u) * nloc) {
            __builtin_amdgcn_fence(__ATOMIC_RELEASE, "agent");
            asm volatile("s_waitcnt vmcnt(0)" ::: "memory");
            const unsigned og = xb_add(&bar[XB_TOP], 1u);
            const unsigned tg = og / nx;
            if (og + 1u == (tg + 1u) * nx) xb_add(&bar[XB_TOPGEN], 1u);
            else XB_SPIN(xb_ld(&bar[XB_TOPGEN]) == tg, bar);
            __builtin_amdgcn_fence(__ATOMIC_ACQUIRE, "agent");
            xb_add(&bar[XB_XGEN(b.x)], 1u);
            asm volatile("s_waitcnt vmcnt(0)" ::: "memory");
        } else {
            XB_SPIN(xb_ld(&bar[XB_XGEN(b.x)]) == gen, bar);
            __builtin_amdgcn_fence(__ATOMIC_ACQUIRE, "agent");
            asm volatile("s_waitcnt vmcnt(0)" ::: "memory");
        }
    }
    __syncthreads();
}


struct Params {
    const float* in[18]; float* out; unsigned char* ws;
    int ph_lo, ph_hi, li, pad;
};
struct Frame {
    LAS unsigned char* lds; volatile LAS unsigned* MISC; gu32* ctl;
    int wave, vcu, G;
};

constexpr int CVT_WIN_TILES = 64 * 96 + 64 * 224;
constexpr int CVT_REST_TILES = 32 * 64 + 32 * 64 + 64 * 64 + 64 * 344 + 172 * 64 + 64 * 64 + 4 * 64;
struct CvtT { const float* src; const float* g; bf16* dst; int ldw, K; };
__device__ __forceinline__ CvtT cvt_decode(const Params& P, int it, int lane) {
    unsigned char* ws = P.ws;
    constexpr int T0 = 64 * 96, T1 = 64 * 224, T2 = 32 * 64, T3 = 32 * 64, T4 = 64 * 64, T5 = 64 * 344, T6 = 172 * 64, T7 = 64 * 64;
    const float* W; const float* g = nullptr; bf16* Wt; int ldw, srccol0 = 0, K, nrow0 = 0, NT; int r = it; bool is_up = false;
    if (r < T0) { W = P.in[3]; ldw = NIN; g = P.in[2]; Wt = (bf16*)(ws + WS_WIN); K = DM; NT = 96; }
    else if ((r -= T0) < T1) { W = P.in[3]; ldw = NIN; srccol0 = 6160; g = P.in[2]; Wt = (bf16*)(ws + WS_WIN); K = DM; nrow0 = 6144; NT = 224; }
    else if ((r -= T1) < T2) { W = P.in[7]; ldw = DM; Wt = (bf16*)(ws + WS_WBF); K = WF; NT = 64; }
    else if ((r -= T2) < T3) { W = P.in[8]; ldw = DM; Wt = (bf16*)(ws + WS_WBS); K = WF; NT = 64; }
    else if ((r -= T3) < T4) { W = P.in[9]; ldw = DM; Wt = (bf16*)(ws + WS_WOUT); K = DM; NT = 64; }
    else if ((r -= T4) < T5) { W = P.in[11]; ldw = 2 * DFF; g = P.in[10]; Wt = (bf16*)(ws + WS_WUP); K = DM; NT = 344; is_up = true; }
    else if ((r -= T5) < T6) { W = P.in[14]; ldw = DM; Wt = (bf16*)(ws + WS_WDN); K = DFF; NT = 64; }
    else if ((r -= T6) < T7) { W = P.in[16]; ldw = DM; g = P.in[15]; Wt = (bf16*)(ws + WS_WPG); K = DM; NT = 64; }
    else { r -= T7; W = P.in[17]; ldw = DM; Wt = (bf16*)(ws + WS_WPP); K = PLE; NT = 64; }
    const int nt = r % NT, kt = r / NT, nq = lane & 7, q = lane >> 3;
    CvtT T;
    int scol = srccol0 + 64 * nt;
    if (is_up) scol = ((nt & 3) >> 1) * DFF + 128 * (nt >> 2) + (nt & 1) * 64;
    T.src = W + (size_t)(64 * kt + 8 * q) * ldw + scol + 4 * nq;
    T.g = g ? g + 64 * kt + 8 * q : nullptr;
    T.dst = Wt + (size_t)(nrow0 + 64 * nt + 4 * nq) * K + 64 * kt + 8 * q;
    T.ldw = ldw; T.K = K;
    return T;
}
__device__ __forceinline__ void cvt_load(const CvtT& T, f32x4 (&v)[2][8]) {
#pragma unroll
    for (int p = 0; p < 2; ++p)
#pragma unroll
        for (int t = 0; t < 8; ++t) v[p][t] = __builtin_nontemporal_load((const f32x4*)(T.src + (size_t)t * T.ldw + 32 * p));
}
__device__ __forceinline__ void cvt_store(const CvtT& T, const f32x4 (&v)[2][8]) {
    f32x4 g0 = (f32x4){1.f, 1.f, 1.f, 1.f}, g1 = g0;
    if (T.g) { g0 = *(const f32x4*)T.g; g1 = *(const f32x4*)(T.g + 4); }
#pragma unroll
    for (int p = 0; p < 2; ++p)
#pragma unroll
        for (int i = 0; i < 4; ++i) {
            v4u w; w.x = pk2(v[p][0][i] * g0[0], v[p][1][i] * g0[1]); w.y = pk2(v[p][2][i] * g0[2], v[p][3][i] * g0[3]);
            w.z = pk2(v[p][4][i] * g1[0], v[p][5][i] * g1[1]); w.w = pk2(v[p][6][i] * g1[2], v[p][7][i] * g1[3]);
            *(v4u*)(T.dst + (size_t)(32 * p + i) * T.K) = w;
        }
}
__device__ __forceinline__ void p0_weights(const Frame& F, const Params& P) {
    const int WAVE_ = F.wave; const int f_lane = lane_id(), f_tid = TID();
    const int gw = F.vcu * NWAVES + F.wave, NGW = F.G * NWAVES, lane = f_lane;
    unsigned char* ws = P.ws;
    constexpr int NITEMS = CVT_WIN_TILES;
    f32x4 va[2][8], vb[2][8];
    int it = gw;
    if (it < NITEMS) {
        CvtT Ta = cvt_decode(P, it, lane); cvt_load(Ta, va);
        for (;;) {
            const int i1 = it + NGW; CvtT Tb = Ta;
            if (i1 < NITEMS) { Tb = cvt_decode(P, i1, lane); cvt_load(Tb, vb); }
            cvt_store(Ta, va);
            if (i1 >= NITEMS) break;
            const int i2 = i1 + NGW;
            if (i2 < NITEMS) { Ta = cvt_decode(P, i2, lane); cvt_load(Ta, va); }
            cvt_store(Tb, vb);
            if (i2 >= NITEMS) break;
            it = i2;
        }
    }
    { const float* w_in = P.in[3]; const float* g_mix = P.in[2]; bf16* wtf = (bf16*)(ws + WS_WTF);
      for (int i = blockIdx.x * 512 + f_tid; i < NH * (DM / 8); i += F.G * 512) { const int n = i / (DM / 8), kc = i % (DM / 8);
          float b[8];
#pragma unroll
          for (int t = 0; t < 8; ++t) b[t] = w_in[(size_t)(8 * kc + t) * NIN + 6144 + n] * g_mix[8 * kc + t];
          v4u w; w.x = pk2(b[0], b[1]); w.y = pk2(b[2], b[3]); w.z = pk2(b[4], b[5]); w.w = pk2(b[6], b[7]);
          *(v4u*)(wtf + (size_t)n * DM + 8 * kc) = w; } }
    const float* p = P.in[1]; bf16* pb = (bf16*)(ws + WS_PB);
    for (int i = blockIdx.x * 512 + f_tid; i < S * PLE / 8; i += F.G * 512) {
        const f32x4 a = *(const f32x4*)(p + (size_t)i * 8), b = *(const f32x4*)(p + (size_t)i * 8 + 4);
        v4u w; w.x = pk2(a[0], a[1]); w.y = pk2(a[2], a[3]); w.z = pk2(b[0], b[1]); w.w = pk2(b[2], b[3]);
        *(v4u*)(pb + (size_t)i * 8) = w;
    }
}
constexpr int CVT_SLOT = 18;
static_assert(2560 * CVT_SLOT >= CVT_REST_TILES, "conversion slots cover every tile");
struct ConvOrder : pg8::StaticOrder {
    const Params* P; int wave; mutable int slot;
    __device__ __forceinline__ void done(const pg8::Unit&) const {
        const int lane = lane_id();
        const int base = (slot * G + c) * CVT_SLOT; ++slot;
        const int i0 = base + wave, i1 = i0 + 8, i2 = i0 + 16;
        const int lim = (base + CVT_SLOT < CVT_REST_TILES) ? base + CVT_SLOT : CVT_REST_TILES;
        f32x4 va[2][8], vb[2][8];
        if (i0 < lim) {
            CvtT Ta = cvt_decode(*P, CVT_WIN_TILES + i0, lane); cvt_load(Ta, va);
            if (i1 < lim) {
                CvtT Tb = cvt_decode(*P, CVT_WIN_TILES + i1, lane); cvt_load(Tb, vb);
                cvt_store(Ta, va);
                if (i2 < lim) { Ta = cvt_decode(*P, CVT_WIN_TILES + i2, lane); cvt_load(Ta, va); cvt_store(Tb, vb); cvt_store(Ta, va); }
                else cvt_store(Tb, vb);
            } else cvt_store(Ta, va);
        }
    }
};
__device__ __forceinline__ void p0_rows(const Frame& F, const Params& P) {
    const int WAVE_ = F.wave; const int f_lane = lane_id();
    const float* x = P.in[0]; unsigned char* ws = P.ws;
    float* ss1 = (float*)(ws + WS_SS1); bf16* xb = (bf16*)(ws + WS_XB);
    const int gw = F.vcu * NWAVES + F.wave, NGW = F.G * NWAVES, lane = f_lane;
    for (int base = gw; base < S; base += 2 * NGW) {
        const int rowA = base, rowB = (base + NGW < S) ? base + NGW : base;
        const f32x4* xa = (const f32x4*)(x + (size_t)rowA * DM) + lane; const f32x4* xbp = (const f32x4*)(x + (size_t)rowB * DM) + lane;
        f32x4 va[16], vb[16]; float sa = 0.f, sb = 0.f;
#pragma unroll
        for (int j = 0; j < 16; ++j) va[j] = __builtin_nontemporal_load(xa + 64 * j);
#pragma unroll
        for (int j = 0; j < 16; ++j) vb[j] = __builtin_nontemporal_load(xbp + 64 * j);
#pragma unroll
        for (int j = 0; j < 16; ++j) sa += (va[j][0] * va[j][0] + va[j][1] * va[j][1]) + (va[j][2] * va[j][2] + va[j][3] * va[j][3]);
#pragma unroll
        for (int j = 0; j < 16; ++j) sb += (vb[j][0] * vb[j][0] + vb[j][1] * vb[j][1]) + (vb[j][2] * vb[j][2] + vb[j][3] * vb[j][3]);
        sa = wave_sum(sa); sb = wave_sum(sb);
        if (lane == 0) { ss1[rowA] = sa; ss1[rowB] = sb; }
        v2u* oa = (v2u*)(xb + (size_t)rowA * DM) + lane; v2u* ob = (v2u*)(xb + (size_t)rowB * DM) + lane;
#pragma unroll
        for (int j = 0; j < 16; ++j) { v2u w; w.x = pk2(va[j][0], va[j][1]); w.y = pk2(va[j][2], va[j][3]); oa[64 * j] = w; }
#pragma unroll
        for (int j = 0; j < 16; ++j) { v2u w; w.x = pk2(vb[j][0], vb[j][1]); w.y = pk2(vb[j][2], vb[j][3]); ob[64 * j] = w; }
    }
}

__device__ __forceinline__ void p1b_qknorm_fgate(const Frame& F, const Params& P) {
    const int WAVE_ = F.wave; const int f_lane = lane_id(), f_tid = TID();
    unsigned char* ws = P.ws;
    bf16* qkv = (bf16*)(ws + WS_QKV);
    const float* gq = P.in[5]; const float* gk = P.in[6];
    const int gw = F.vcu * NWAVES + F.wave, NGW = F.G * NWAVES, lane = f_lane, sub = lane >> 4, l16 = lane & 15;
    constexpr int NIT = 2 * S * NH / 4, UB = 8;
    for (int it0 = gw; it0 < NIT; it0 += NGW * UB) {
        v4u w[UB]; bf16* ptr[UB]; int tt[UB];
#pragma unroll
        for (int u = 0; u < UB; ++u) { const int it = it0 + u * NGW; const int item = (it < NIT ? it : it0) * 4 + sub;
            tt[u] = item / (S * NH); ptr[u] = qkv + (size_t)tt[u] * ((size_t)S * WF) + (size_t)(item - tt[u] * (S * NH)) * HD + l16 * 8; w[u] = *(const v4u*)ptr[u]; }
#pragma unroll
        for (int u = 0; u < UB; ++u) {
            const float* g = (tt[u] ? gk : gq) + l16 * 8;
            float v[8] = {bflo(w[u].x), bfhi(w[u].x), bflo(w[u].y), bfhi(w[u].y), bflo(w[u].z), bfhi(w[u].z), bflo(w[u].w), bfhi(w[u].w)};
            float s = 0.f;
#pragma unroll
            for (int j = 0; j < 8; ++j) s += v[j] * v[j];
            s += __shfl_xor(s, 1); s += __shfl_xor(s, 2); s += __shfl_xor(s, 4); s += __shfl_xor(s, 8);
            const float r = rsqrtf(s * (1.0f / HD) + EPS);
            const f32x4 g0 = *(const f32x4*)g, g1 = *(const f32x4*)(g + 4);
            v4u o; o.x = pk2(v[0] * r * g0[0], v[1] * r * g0[1]); o.y = pk2(v[2] * r * g0[2], v[3] * r * g0[3]); o.z = pk2(v[4] * r * g1[0], v[5] * r * g1[1]); o.w = pk2(v[6] * r * g1[2], v[7] * r * g1[3]);
            if (it0 + u * NGW < NIT) *(v4u*)ptr[u] = o;
        }
    }
    {
        const bf16* xb = (const bf16*)(ws + WS_XB); const bf16* wtf = (const bf16*)(ws + WS_WTF); const float* ss1 = (const float*)(ws + WS_SS1); const float* b_f = P.in[4];
        float* logf = (float*)(ws + WS_LOGF);
        LAS float* fbuf = (LAS float*)(F.lds + RING_OFF);
        const int wave = F.wave, rl = lane & 31, kg = lane >> 5;
        for (int grp = blockIdx.x; grp < S / 32; grp += F.G) {
            const int r0 = grp * 32;
            const bf16* pa = xb + (size_t)(r0 + rl) * DM + 512 * wave + 8 * kg;
            const bf16* pb = wtf + (size_t)(rl & 15) * DM + 512 * wave + 8 * kg;
            f32x16 acc = {};
#pragma unroll 8
            for (int ks = 0; ks < 32; ++ks) {
                const bf16x8 a = *(const bf16x8*)(pa + 16 * ks);
                bf16x8 b = *(const bf16x8*)(pb + 16 * ks);
                if (rl >= 16) b = (bf16x8){0, 0, 0, 0, 0, 0, 0, 0};
                acc = __builtin_amdgcn_mfma_f32_32x32x16_bf16(a, b, acc, 0, 0, 0);
            }
            if (rl < 16) {
#pragma unroll
                for (int r = 0; r < 16; ++r) { const int tok = (r & 3) + 8 * (r >> 2) + 4 * kg; fbuf[(wave * 32 + tok) * 16 + rl] = acc[r]; }
            }
            __syncthreads();
            {
                const int tok = f_tid >> 4, h = f_tid & 15; float fv = 0.f;
#pragma unroll
                for (int w = 0; w < 8; ++w) fv += fbuf[(w * 32 + tok) * 16 + h];
                fv = fv * rsqrtf(ss1[r0 + tok] * (1.0f / DM) + EPS) + b_f[h];
                logf[(size_t)h * S + r0 + tok] = log_sigmoidf_(fv);
            }
            __syncthreads();
        }
    }
}

__device__ __forceinline__ void p5c_fixup(const Frame& F, const Params& P) {
    const int WAVE_ = F.wave; const int f_tid = TID();
    unsigned char* ws = P.ws;
    const float* edge = (const float*)(ws + WS_EDGE); bf16* act = (bf16*)(ws + WS_ACT);
    const float* cw = P.in[12]; const float* cb = P.in[13];
    constexpr int NQ = DFF / 4;
    for (int i = blockIdx.x * 512 + f_tid; i < (S / 256) * 2 * NQ; i += F.G * 512) {
        const int row = i / NQ, jc = (i - row * NQ) * 4, p = row >> 1, rr = row & 1, t = 256 * p + rr;
        float uu[2][4];
#pragma unroll
        for (int h = 0; h < 2; ++h) {
            const size_t co = (size_t)h * DFF + jc; const f32x4 z = (f32x4){0.f, 0.f, 0.f, 0.f};
            const f32x4 c = *(const f32x4*)(edge + ((size_t)p * 4 + rr) * (2 * DFF) + co);
            const f32x4 l3 = p ? *(const f32x4*)(edge + ((size_t)(p - 1) * 4 + 3) * (2 * DFF) + co) : z;
            const f32x4 p1 = rr ? *(const f32x4*)(edge + ((size_t)p * 4 + 0) * (2 * DFF) + co) : l3;
            const f32x4 p2 = rr ? l3 : (p ? *(const f32x4*)(edge + ((size_t)(p - 1) * 4 + 2) * (2 * DFF) + co) : z);
            const f32x4 w0 = *(const f32x4*)(cw + co), w1 = *(const f32x4*)(cw + (size_t)2 * DFF + co), w2 = *(const f32x4*)(cw + (size_t)4 * DFF + co), bb = *(const f32x4*)(cb + co);
#pragma unroll
            for (int e = 0; e < 4; ++e) uu[h][e] = bb[e] + w0[e] * p2[e] + w1[e] * p1[e] + w2[e] * c[e];
        }
        v2u w; w.x = pk2(uu[0][0] * sigmoidf_(uu[0][0]) * uu[1][0], uu[0][1] * sigmoidf_(uu[0][1]) * uu[1][1]); w.y = pk2(uu[0][2] * sigmoidf_(uu[0][2]) * uu[1][2], uu[0][3] * sigmoidf_(uu[0][3]) * uu[1][3]);
        *(v2u*)(act + (size_t)t * DFF + jc) = w;
    }
}

namespace att {
constexpr int D = 128, PITCH = 2048, NW = 8, QBLK = 32, KVBLK = 64, QB = NW * QBLK;
constexpr int SHM_V = KVBLK * D * 2, SHM_K = KVBLK * D * 2;
constexpr int OFF_WS = 2 * SHM_V + 2 * SHM_K, OFF_FLAG = OFF_WS + NW * 64 * 4, OFF_WTOT = OFF_FLAG + 64, OFF_NEXT = OFF_WTOT + 64, OFF_C = 73728  , ATT_LDS_BYTES = OFF_C + 32768;
constexpr float SCALE = 0.08838834764831845f;
constexpr float THR = 8.f;
typedef short s16x4 __attribute__((ext_vector_type(4)));
typedef unsigned u32x4 __attribute__((ext_vector_type(4)));
#define KSWZ(row, colB) ((row) * 256 + ((colB) ^ (((row) & 7) << 4)))
#define SBAR() __builtin_amdgcn_sched_barrier(0)
__device__ __forceinline__ int v_st(int k, int c) { const int kk = (k & ~0xC) | ((k & 4) << 1) | ((k & 8) >> 1); return ((kk >> 3) * 4 + (c >> 5)) * 512 + ((kk & 7) * 32 + (c & 31)) * 2; }
__device__ __forceinline__ int v_rd_base(int lane) { return ((lane & 3) << 3) | (((lane >> 2) & 3) << 6) | (((lane >> 4) & 1) << 5) | (((lane >> 5) & 1) << 8); }
constexpr int v_rd_off(int d0, int ks, int half) { return d0 * 512 + ks * 4096 + half * 2048; }
__device__ __forceinline__ int crow(int r, int hi) { return (r & 3) + 8 * (r >> 2) + 4 * hi; }
__device__ __forceinline__ unsigned cvtpk(float lo, float hi) { unsigned r; asm volatile("v_cvt_pk_bf16_f32 %0, %1, %2" : "=v"(r) : "v"(lo), "v"(hi)); return r; }
__device__ __forceinline__ bf16x8 load8(const bf16* p) { return *reinterpret_cast<const bf16x8*>(p); }
__device__ __forceinline__ void mask_tile(f32x16& p0, f32x16& p1, int dq) {
    const float NEG = -__builtin_inff();
#pragma unroll
    for (int r = 0; r < 16; ++r) { const int c = (r & 3) + 8 * (r >> 2); if (dq - c < 0) p0[r] = NEG; if (dq - c - 32 < 0) p1[r] = NEG; }
}
__device__ __forceinline__ void partialSM(f32x16& p0, f32x16& p1, float& m_reg, float& mn, float& alpha) {
    float pmax = p0[0]; for (int r = 1; r < 16; ++r) pmax = fmaxf(pmax, p0[r]); for (int r = 0; r < 16; ++r) pmax = fmaxf(pmax, p1[r]);
    { auto rr = __builtin_amdgcn_permlane32_swap(__float_as_uint(pmax), __float_as_uint(pmax), false, false);
      pmax = fmaxf(__uint_as_float(rr[0]), __uint_as_float(rr[1])); }
    constexpr float C2 = 1.4426950408889634f * SCALE;
    if (__builtin_expect(__all((pmax - m_reg) * SCALE <= THR), 1)) { mn = m_reg; alpha = 1.f; }
    else { mn = fmaxf(m_reg, pmax); alpha = __builtin_amdgcn_exp2f((m_reg - mn) * C2); m_reg = mn; }
    const float mnL = -mn * C2;
    for (int r = 0; r < 16; ++r) p0[r] = fmaf(p0[r], C2, mnL); for (int r = 0; r < 16; ++r) p1[r] = fmaf(p1[r], C2, mnL);
    for (int r = 0; r < 16; ++r) p0[r] = __builtin_amdgcn_exp2f(p0[r]);
}
#define PK4(P, B_, OUT) do { unsigned a0 = cvtpk(P[B_+0], P[B_+1]), a1 = cvtpk(P[B_+2], P[B_+3]);                          \
        unsigned b0 = cvtpk(P[B_+4], P[B_+5]), b1 = cvtpk(P[B_+6], P[B_+7]);                                             \
        auto r0 = __builtin_amdgcn_permlane32_swap(a0, b0, false, false); auto r1 = __builtin_amdgcn_permlane32_swap(a1, b1, false, false); \
        u32x4 w = {r0[0], r1[0], r0[1], r1[1]}; OUT = *reinterpret_cast<bf16x8*>(&w); } while (0)
__device__ __forceinline__ void finishSM(f32x16& p0, f32x16& p1, float alpha, float& l_reg, bf16x8& pa0, bf16x8& pa1, bf16x8& pa2, bf16x8& pa3) {
    for (int r = 0; r < 16; ++r) p1[r] = __builtin_amdgcn_exp2f(p1[r]);
    float ps = 0; for (int r = 0; r < 16; ++r) ps += p0[r]; for (int r = 0; r < 16; ++r) ps += p1[r];
    { auto rr = __builtin_amdgcn_permlane32_swap(__float_as_uint(ps), __float_as_uint(ps), false, false);
      ps = __uint_as_float(rr[0]) + __uint_as_float(rr[1]); }
    l_reg = l_reg * alpha + ps;
    PK4(p0, 0, pa0); PK4(p0, 8, pa1); PK4(p1, 0, pa2); PK4(p1, 8, pa3);
}
template <int KB>
__device__ __forceinline__ void qkt(f32x16& p0, f32x16& p1, const char* K_lds, int r32, int hi, const bf16x8* qr) {
    p0 = f32x16{}; p1 = f32x16{};
    const char* kb[4];
#pragma unroll
    for (int dd = 0; dd < 4; ++dd) kb[dd] = K_lds + KB * SHM_K + KSWZ(r32, (dd * 16 + hi * 8) * 2);
#pragma unroll
    for (int d0 = 0; d0 < 8; ++d0) { const char* a = kb[d0 & 3] + (d0 >> 2) * 128;
        bf16x8 b0 = *reinterpret_cast<const bf16x8*>(a);
        bf16x8 b1 = *reinterpret_cast<const bf16x8*>(a + 32 * 256);
        p0 = __builtin_amdgcn_mfma_f32_32x32x16_bf16(b0, qr[d0], p0, 0, 0, 0);
        p1 = __builtin_amdgcn_mfma_f32_32x32x16_bf16(b1, qr[d0], p1, 0, 0, 0); }
}
template <int VB>
__device__ __forceinline__ void pv_tile(f32x16* o, int vb0, bf16x8 pa0, bf16x8 pa1, bf16x8 pa2, bf16x8 pa3) {
#define TRRD(dst, off) asm volatile("ds_read_b64_tr_b16 %0, %1 offset:%2" : "=&v"(dst) : "v"(vb0), "i"(off) : "memory")
#define PV_D0(d0) do { s16x4 l0, l1, l2, l3, h0, h1, h2, h3; constexpr int b_ = VB * SHM_V + v_rd_off(d0, 0, 0); \
        TRRD(l0, b_); TRRD(h0, b_ + 2048); TRRD(l1, b_ + 4096); TRRD(h1, b_ + 6144); TRRD(l2, b_ + 8192); TRRD(h2, b_ + 10240); TRRD(l3, b_ + 12288); TRRD(h3, b_ + 14336); \
        asm volatile("s_waitcnt lgkmcnt(0)" ::: "memory"); SBAR();   \
        o[d0] = __builtin_amdgcn_mfma_f32_32x32x16_bf16(pa0, (bf16x8){l0[0], l0[1], l0[2], l0[3], h0[0], h0[1], h0[2], h0[3]}, o[d0], 0, 0, 0);   \
        o[d0] = __builtin_amdgcn_mfma_f32_32x32x16_bf16(pa1, (bf16x8){l1[0], l1[1], l1[2], l1[3], h1[0], h1[1], h1[2], h1[3]}, o[d0], 0, 0, 0);   \
        o[d0] = __builtin_amdgcn_mfma_f32_32x32x16_bf16(pa2, (bf16x8){l2[0], l2[1], l2[2], l2[3], h2[0], h2[1], h2[2], h2[3]}, o[d0], 0, 0, 0);   \
        o[d0] = __builtin_amdgcn_mfma_f32_32x32x16_bf16(pa3, (bf16x8){l3[0], l3[1], l3[2], l3[3], h3[0], h3[1], h3[2], h3[3]}, o[d0], 0, 0, 0); } while (0)
    PV_D0(0); PV_D0(1); PV_D0(2); PV_D0(3);
#undef PV_D0
#undef TRRD
}
__device__ __forceinline__ void key_bias(f32x16& p0, f32x16& p1, const char* lds, int kbase, int hi) {
    const float* kbp = (const float*)(lds + OFF_C) + kbase + 4 * hi;
#pragma unroll
    for (int g = 0; g < 4; ++g) { const f32x4 b0 = *(const f32x4*)(kbp + 8 * g), b1 = *(const f32x4*)(kbp + 32 + 8 * g);
#pragma unroll
        for (int e = 0; e < 4; ++e) { p0[4 * g + e] -= b0[e]; p1[4 * g + e] -= b1[e]; } }
}
__device__ __forceinline__ void cgate_scan(const float* logf_h, char* lds, const int WAVE_) {
    const int lane = lane_id(), tid = WAVE_ * 64 + lane;
    float* Cl = (float*)(lds + OFF_C); float* wtot = (float*)(lds + OFF_WTOT);
    const float* src = logf_h + tid * 16;
    const f32x4 a = *(const f32x4*)src, b = *(const f32x4*)(src + 4), c = *(const f32x4*)(src + 8), d = *(const f32x4*)(src + 12);
    const float in[16] = {a[0], a[1], a[2], a[3], b[0], b[1], b[2], b[3], c[0], c[1], c[2], c[3], d[0], d[1], d[2], d[3]};
    float loc[16]; float s = 0.f;
#pragma unroll
    for (int j = 0; j < 16; ++j) { s += in[j]; loc[j] = s; }
    float incl = s;
#pragma unroll
    for (int o = 1; o < 64; o <<= 1) { const float t = __builtin_bit_cast(float, __builtin_amdgcn_ds_bpermute((lane - o) << 2, __builtin_bit_cast(int, incl))); if (lane >= o) incl += t; }
    if (lane == 63) wtot[WAVE_] = incl;
    __syncthreads();
    float base = incl - s;
    for (int w = 0; w < WAVE_; ++w) base += wtot[w];
#pragma unroll
    for (int j = 0; j < 16; j += 4) *(f32x4*)(Cl + tid * 16 + j) = (f32x4){base + loc[j], base + loc[j + 1], base + loc[j + 2], base + loc[j + 3]} * (1.0f / SCALE);
    __syncthreads();
}

struct BlockRef { const bf16* Q; const bf16* K; const bf16* V; bf16* O; int P0; };
struct Seam { bf16x8 qr[8]; bf16x8 st_v0, st_v1, st_k0, st_k1; };
#define ROW(p, k0, rr) ((p) + (size_t)((k0) + (rr)) * PITCH + sc)
#define VMW() asm volatile("s_waitcnt vmcnt(0)" ::: "memory")
#define VMWN(n) asm volatile("s_waitcnt vmcnt(%0)" :: "i"(n) : "memory")
#define SLOAD_H(Kp, Vp, k0) do { S.st_v0 = load8(ROW(Vp, k0, sr)); S.st_v1 = load8(ROW(Vp, k0, 32 + sr));              \
                         S.st_k0 = load8(ROW(Kp, k0, sr)); S.st_k1 = load8(ROW(Kp, k0, 32 + sr)); } while (0)
#define SWRITE_HK(bf) do { *(bf16x8*)(K_lds + (bf) * SHM_K + kws) = S.st_k0; *(bf16x8*)(K_lds + (bf) * SHM_K + kws + 32 * 256) = S.st_k1; } while (0)
#define SWRITE_HV(bf) do { *(bf16x8*)(V_lds + (bf) * SHM_V + vst0) = S.st_v0; *(bf16x8*)(V_lds + (bf) * SHM_V + vst1) = S.st_v1; } while (0)
#define SWRITE_H(bf) do { SWRITE_HV(bf); SWRITE_HK(bf); } while (0)
__device__ __forceinline__ void fox_prime(const BlockRef& cur, char* lds, Seam& S, const int WAVE_) {
    const int tid = TID(), wid = __builtin_amdgcn_readfirstlane(tid >> 6), lane = tid & 63, r32 = lane & 31, hi = lane >> 5;
    const int sr = tid >> 4, sc = (tid & 15) * 8, kws = KSWZ(sr, sc * 2); char* K_lds = lds + 2 * SHM_V;
    for (int d0 = 0; d0 < 8; ++d0) S.qr[d0] = load8(cur.Q + (size_t)(wid * QBLK + r32) * PITCH + d0 * 16 + hi * 8);
    SLOAD_H(cur.K, cur.V, ((cur.P0 + QB - 1) / KVBLK) * KVBLK); VMW(); SWRITE_HK(0);
    __syncthreads();
}
__device__ __forceinline__ void fox_block(const BlockRef& cur, const BlockRef& nxt, const float Uq, char* lds, Seam& S, const int WAVE_) {
    const int tid = TID(), wid = __builtin_amdgcn_readfirstlane(tid >> 6), lane = tid & 63, r32 = lane & 31, hi = lane >> 5;
    const int NT0 = (cur.P0 + QB - 1) / KVBLK + 1;
    int NT = NT0;
    volatile LAS int* flg = (volatile LAS int*)(lds + OFF_FLAG);
    const int qlo = cur.P0 + wid * QBLK, qm = qlo + r32 - 4 * hi;
    char* V_lds = lds; char* K_lds = lds + 2 * SHM_V;
    float* ws = (float*)(lds + OFF_WS) + wid * 64; float* li_l = ws, * al_l = ws + 32;
    float m_reg = -1e30f, l_reg = 0; f32x16 o[4] = {};
    const int sr = tid >> 4, sc = (tid & 15) * 8, vst0 = v_st(sr, sc), vst1 = v_st(32 + sr, sc), kws = KSWZ(sr, sc * 2);
    const int vb0 = (int)(uintptr_t)V_lds + v_rd_base(lane);
    const bf16* Kh = cur.K; const bf16* Vh = cur.V;
#define RESC(a) do { if (__any((a) < 1.f)) { if (hi == 0) al_l[r32] = (a); asm volatile("s_waitcnt lgkmcnt(0)" ::: "memory");              \
                     for (int d_ = 0; d_ < 4; ++d_) for (int r = 0; r < 16; ++r) o[d_][r] *= al_l[crow(r, hi)]; } } while (0)
#define KBASE(t) ((NT0 - 1 - (t)) * KVBLK)
#define MASKT(P0_, P1_, t, KBUF) do { const int kb_ = KBASE(t); key_bias(P0_, P1_, lds, kb_, hi); if (kb_ + KVBLK - 1 > qlo) mask_tile(P0_, P1_, qm - kb_); } while (0)
#define SEAM_K0() do { VMWN(8); SWRITE_HK(0); SBAR(); } while (0)
    f32x16 pA0, pA1, pB0, pB1; float mnA, mnB, alA, alB; bf16x8 pa0, pa1, pa2, pa3;
    SWRITE_HV(0); SBAR();
    if (NT > 1) { SLOAD_H(Kh, Vh, KBASE(1)); }
    SBAR(); qkt<0>(pA0, pA1, K_lds, r32, hi, S.qr);
    MASKT(pA0, pA1, 0, 0); partialSM(pA0, pA1, m_reg, mnA, alA);
    if (NT > 1) { VMW(); SWRITE_H(1); }
    __syncthreads();
#define VOTE(t) do { bool can_ = false; if ((t) + 2 < NT) { const float negc_ = -((const float*)(lds + OFF_C))[KBASE((t) + 2) + KVBLK - 1]; can_ = __all((Uq + negc_ - m_reg) * SCALE <= -104.f) != 0; } \
                     if (lane == 0) flg[wid] = can_ ? 1 : 0; } while (0)
#define DECIDE(t) do { int all_ = 1; _Pragma("unroll") for (int w_ = 0; w_ < 8; ++w_) all_ &= flg[w_]; if (all_ && (t) + 2 < NT) NT = (t) + 2; } while (0)
#define HALF_STEP(PX0, PX1, mnX, alX, PY0, PY1, alY, t, KB, VB, SB) do {                                                      \
        SBAR(); qkt<KB>(PX0, PX1, K_lds, r32, hi, S.qr);                                                                     \
        finishSM(PY0, PY1, alY, l_reg, pa0, pa1, pa2, pa3); SBAR();                                                           \
        if ((t) + 1 < NT) { SLOAD_H(Kh, Vh, KBASE((t) + 1)); SBAR(); }                                                    \
        pv_tile<VB>(o, vb0, pa0, pa1, pa2, pa3); MASKT(PX0, PX1, (t), KB); partialSM(PX0, PX1, m_reg, mnX, alX); VOTE(t);    \
        __syncthreads(); DECIDE(t);                                                                                           \
        if ((t) + 1 < NT) { VMW(); SWRITE_H(SB); }                                                                            \
        RESC(alX); __syncthreads(); } while (0)
    for (int t = 1; t + 1 < NT; t += 2) {
        HALF_STEP(pB0, pB1, mnB, alB, pA0, pA1, alA, t, 1, 0, 0);
        HALF_STEP(pA0, pA1, mnA, alA, pB0, pB1, alB, t + 1, 0, 1, 1);
    }
    const bool even = (NT & 1) == 0;
    if (even) { SBAR(); qkt<1>(pB0, pB1, K_lds, r32, hi, S.qr); SBAR(); }
    SLOAD_H(nxt.K, nxt.V, ((nxt.P0 + QB - 1) / KVBLK) * KVBLK); SBAR();
#pragma unroll
    for (int d0 = 0; d0 < 8; ++d0) S.qr[d0] = load8(nxt.Q + (size_t)(wid * QBLK + r32) * PITCH + d0 * 16 + hi * 8);
    SBAR();
    finishSM(pA0, pA1, alA, l_reg, pa0, pa1, pa2, pa3); SBAR();
    pv_tile<0>(o, vb0, pa0, pa1, pa2, pa3);
    if (even) { MASKT(pB0, pB1, NT - 1, 1); partialSM(pB0, pB1, m_reg, mnB, alB); __syncthreads(); RESC(alB);
        finishSM(pB0, pB1, alB, l_reg, pa0, pa1, pa2, pa3); SBAR(); pv_tile<1>(o, vb0, pa0, pa1, pa2, pa3); }
    SBAR(); SEAM_K0();
    if (hi == 0) li_l[r32] = l_reg; asm volatile("s_waitcnt lgkmcnt(0)" ::: "memory");
    float rli[16];
#pragma unroll
    for (int r = 0; r < 16; ++r) rli[r] = __builtin_amdgcn_rcpf(li_l[crow(r, hi)]);
    bf16* Ow = cur.O + (size_t)(wid * QBLK) * PITCH;
#pragma unroll
    for (int r = 0; r < 16; ++r) { const int orow = crow(r, hi);
#pragma unroll
        for (int d0 = 0; d0 < 4; ++d0) { const float v = o[d0][r] * rli[r];
            const float vn = __shfl_xor(v, 1);
            if ((r32 & 1) == 0) *(unsigned*)(Ow + (size_t)orow * PITCH + d0 * 32 + r32) = cvtpk(v, vn); } }
    __syncthreads();
#undef RESC
#undef MASKT
#undef SEAM_K0
#undef HALF_STEP
#undef VOTE
#undef DECIDE
#undef KBASE
}

template <int BUF>
__device__ __forceinline__ void sb_tile(f32x16* o, float& R, const char* K_lds, int vb0, int r32, int hi, const bf16x8* qr, int dq) {
    f32x16 p0, p1;
    qkt<BUF>(p0, p1, K_lds, r32, hi, qr);
    constexpr float L2E = 1.4426950408889634f, LN2 = 0.6931471805599453f;
    f32x16 l0, l1;
    const float NEG = -__builtin_inff();
#pragma unroll
    for (int r = 0; r < 16; ++r) { const int c = (r & 3) + 8 * (r >> 2);
        { const float z = p0[r] * SCALE; const float sp = fmaxf(z, 0.f) + LN2 * __builtin_amdgcn_logf(1.0f + __builtin_amdgcn_exp2f(-fabsf(z) * L2E)); const bool st = (dq - c) >= 1; l0[r] = st ? -sp : 0.f; p0[r] = st ? (z - sp) : NEG; }
        { const float z = p1[r] * SCALE; const float sp = fmaxf(z, 0.f) + LN2 * __builtin_amdgcn_logf(1.0f + __builtin_amdgcn_exp2f(-fabsf(z) * L2E)); const bool st = (dq - c - 32) >= 1; l1[r] = st ? -sp : 0.f; p1[r] = st ? (z - sp) : NEG; } }
    float gs[8], pg[8], ps[8];
#pragma unroll
    for (int g = 0; g < 4; ++g) { gs[g] = (l0[4 * g] + l0[4 * g + 1]) + (l0[4 * g + 2] + l0[4 * g + 3]); gs[4 + g] = (l1[4 * g] + l1[4 * g + 1]) + (l1[4 * g + 2] + l1[4 * g + 3]); }
#pragma unroll
    for (int g = 0; g < 8; ++g) { auto rr = __builtin_amdgcn_permlane32_swap(__float_as_uint(gs[g]), __float_as_uint(gs[g]), false, false);
        const float lo = __uint_as_float(rr[0]), hv = __uint_as_float(rr[1]); ps[g] = lo + hv; pg[g] = hi ? lo : hv; }
    float acc = R;
#pragma unroll
    for (int g = 7; g >= 0; --g) {
        float run = hi ? acc : acc + pg[g];
        acc += ps[g];
        if (g >= 4) { const int b = 4 * (g - 4);
#pragma unroll
            for (int e = 3; e >= 0; --e) { const float t = l1[b + e]; p1[b + e] = __builtin_amdgcn_exp2f((p1[b + e] + run) * L2E); run += t; } }
        else { const int b = 4 * g;
#pragma unroll
            for (int e = 3; e >= 0; --e) { const float t = l0[b + e]; p0[b + e] = __builtin_amdgcn_exp2f((p0[b + e] + run) * L2E); run += t; } }
    }
    R = acc;
    bf16x8 pa0, pa1, pa2, pa3;
    PK4(p0, 0, pa0); PK4(p0, 8, pa1); PK4(p1, 0, pa2); PK4(p1, 8, pa3);
    pv_tile<BUF>(o, vb0, pa0, pa1, pa2, pa3);
}
__device__ __forceinline__ void sb_block(const BlockRef& cur, char* lds, const int WAVE_) {
    const int tid = TID(), wid = __builtin_amdgcn_readfirstlane(tid >> 6), lane = tid & 63, r32 = lane & 31, hi = lane >> 5;
    const int NT = (cur.P0 + QB - 1) / KVBLK + 1;
    const int qlo = cur.P0 + wid * QBLK, qm = qlo + r32 - 4 * hi;
    char* V_lds = lds; char* K_lds = lds + 2 * SHM_V;
    volatile LAS int* flg = (volatile LAS int*)(lds + OFF_FLAG);
    const int sr = tid >> 4, sc = (tid & 15) * 8, vst0 = v_st(sr, sc), vst1 = v_st(32 + sr, sc), kws = KSWZ(sr, sc * 2);
    const int vb0 = (int)(uintptr_t)V_lds + v_rd_base(lane);
    const bf16* Kh = cur.K; const bf16* Vh = cur.V;
    bf16x8 qr[8];
#pragma unroll
    for (int d0 = 0; d0 < 8; ++d0) qr[d0] = load8(cur.Q + (size_t)(wid * QBLK + r32) * PITCH + d0 * 16 + hi * 8);
    bf16x8 st_v0, st_v1, st_k0, st_k1;
#define SB_LOAD(k0) do { st_v0 = load8(ROW(Vh, k0, sr)); st_v1 = load8(ROW(Vh, k0, 32 + sr)); st_k0 = load8(ROW(Kh, k0, sr)); st_k1 = load8(ROW(Kh, k0, 32 + sr)); } while (0)
#define SB_WRITE(bf) do { *(bf16x8*)(V_lds + (bf) * SHM_V + vst0) = st_v0; *(bf16x8*)(V_lds + (bf) * SHM_V + vst1) = st_v1; \
                          *(bf16x8*)(K_lds + (bf) * SHM_K + kws) = st_k0; *(bf16x8*)(K_lds + (bf) * SHM_K + kws + 32 * 256) = st_k1; } while (0)
    f32x16 o[4] = {}; float R = 0.f; bool fin = false;
    SB_LOAD((NT - 1) * KVBLK); VMW(); SB_WRITE(0);
    if (NT > 1) SB_LOAD((NT - 2) * KVBLK);
    __syncthreads();
#define SB_STEP(t, BUF) do { const int kb_ = (NT - 1 - (t)) * KVBLK;                                                         \
        if (!fin && kb_ <= qlo + QBLK - 2) { sb_tile<BUF>(o, R, K_lds, vb0, r32, hi, qr, qm - kb_); fin = __all(R < -105.f); } \
        if ((t) + 1 < NT) { VMW(); SB_WRITE((BUF) ^ 1); if ((t) + 2 < NT) SB_LOAD((NT - 3 - (t)) * KVBLK); }                   \
        if (lane == 0) flg[(BUF) * 8 + wid] = fin ? 1 : 0;                                                                   \
        __syncthreads();                                                                                                      \
        { int all_ = 1; _Pragma("unroll") for (int w_ = 0; w_ < 8; ++w_) all_ &= flg[(BUF) * 8 + w_]; stop = all_ != 0; } } while (0)
    bool stop = false;
    for (int t = 0; t < NT; t += 2) {
        SB_STEP(t, 0);
        if (stop || t + 1 >= NT) break;
        SB_STEP(t + 1, 1);
        if (stop) break;
    }
    bf16* Ow = cur.O + (size_t)(wid * QBLK) * PITCH;
#pragma unroll
    for (int r = 0; r < 16; ++r) { const int orow = crow(r, hi);
#pragma unroll
        for (int d0 = 0; d0 < 4; ++d0) { const float v = o[d0][r];
            const float vn = __shfl_xor(v, 1);
            if ((r32 & 1) == 0) *(unsigned*)(Ow + (size_t)orow * PITCH + d0 * 32 + r32) = cvtpk(v, vn); } }
    __syncthreads();
#undef SB_LOAD
#undef SB_WRITE
#undef SB_STEP
}
#undef ROW
#undef VMW
#undef VMWN
#undef SLOAD_H
#undef SWRITE_HK
#undef SWRITE_HV
#undef SWRITE_H
#undef PK4
#undef KSWZ
}

constexpr int REP_X3 = 0;
constexpr int REP_X2 = 0;
constexpr int X1_PAD = 0;
constexpr int X1_ALIGN = 1, X1_SP2 = 1, X1_CONSTA = 0;
constexpr int REP_X1 = 0, REP_X1N = 20480;
constexpr int REP_ATT = 1;
constexpr int REP_P0W = 1, REP_P0R = 1;
constexpr int REP_P0 = 1, REP_P1 = 1, REP_FOX = 1, REP_SB = 1, REP_P3A = 1, REP_P5 = 1, REP_P5B = 1, REP_P7A = 1;
enum { PH_P0 = 0, PH_P1, PH_P1B, PH_ATT, PH_P3A, PH_P3B, PH_P4, PH_P5, PH_P5B, PH_P6, PH_P7A, PH_P7, PH_N };
__global__ void __launch_bounds__(NWAVES * 64, 2) mega_fwd(Params P) {
    extern __shared__ __attribute__((aligned(16))) unsigned char lds[];
    Frame F;
    F.lds = (LAS unsigned char*)lds;
    F.MISC = (volatile LAS unsigned*)(F.lds + MISC_OFF);
    F.wave = __builtin_amdgcn_readfirstlane((int)(__builtin_amdgcn_workitem_id_x() >> 6));
    const int WAVE_ = F.wave; const int f_tid = TID();
    F.G = gridDim.x; { const int bx = blockIdx.x; F.vcu = (F.G % 8 == 0) ? (bx % 8) * (F.G / 8) + bx / 8 : bx; }
    unsigned char* ws = P.ws;
    F.ctl = (gu32*)(ws + WS_CTL);
    for (int u = f_tid; u < (LDS_BYTES - LDSCTL_OFF) / 4; u += NWAVES * 64) ((LAS unsigned*)(F.lds + LDSCTL_OFF))[u] = 0u;
    __syncthreads();
    XcdBarrier bar = xcd_barrier_post((unsigned*)(F.ctl + CW_BAR) + P.li * XCD_BAR_WORDS, F.MISC + 8, F.wave);
    const int lo = P.ph_lo, hi = P.ph_hi;
#define IN(k) (lo <= (k) && (k) < hi)
#define SEAM(k) do { if (IN(k) && IN((k) + 1)) xcd_barrier(bar); } while (0)
    bf16* W_in = (bf16*)(ws + WS_WIN); bf16* XB = (bf16*)(ws + WS_XB);
    float* ss1 = (float*)(ws + WS_SS1); float* ss2 = (float*)(F.ctl + CW_SS2); float* ss3 = (float*)(F.ctl + CW_SS3);
    bf16* QKV = (bf16*)(ws + WS_QKV); bf16* GATES = (bf16*)(ws + WS_GATES); bf16* Y = (bf16*)(ws + WS_Y); bf16* MERGED = (bf16*)(ws + WS_MERGED);
    LAS unsigned char* ring = F.lds + RING_OFF;

    if (IN(PH_P0)) { for (int rep = 0; rep < REP_P0; ++rep) { for (int r2 = 0; r2 < REP_P0W; ++r2) p0_weights(F, P); for (int r2 = 0; r2 < REP_P0R; ++r2) p0_rows(F, P); } }
    SEAM(PH_P0);
    if (IN(PH_P1)) { for (int rep = 0; rep < REP_P1; ++rep) {
        pg8::Gemm g{XB, W_in, S, NPROJ, DM}; ConvOrder So; So.init(S, NPROJ, F.G, (int)blockIdx.x); So.P = &P; So.wave = F.wave; So.slot = 0;
        pg8::EpiProj E{QKV, GATES, ss1};
        pg8::gemm_phase<pg8::EpiProj, ConvOrder, false, true>(ring, g, So, E, F.wave);
    } }
    if (IN(PH_P1)) { for (int rep = 0; rep < REP_X1; ++rep) {
        pg8::Gemm g{X1_CONSTA ? (bf16*)(ws + WS_ACT) : XB, W_in, S, REP_X1N, DM, DM + X1_PAD, DM + X1_PAD}; pg8::StaticOrder So; So.init(S, REP_X1N, F.G, (int)blockIdx.x);
        pg8::EpiNull E{};
        pg8::gemm_phase<pg8::EpiNull, pg8::StaticOrder, false, true>(ring, g, So, E, F.wave);
    } }
    if (IN(PH_P1)) { for (int rep = 0; rep < REP_X2; ++rep) {
        struct SameOrder : pg8::StaticOrder { __device__ bool next(int i, pg8::Unit& u) const { const bool ok = pg8::StaticOrder::next(i, u); u.pm = 0; u.pn = 0; return ok; } };
        pg8::Gemm g{XB, W_in, S, NPROJ, DM}; SameOrder So; So.init(S, NPROJ, F.G, (int)blockIdx.x);
        pg8::EpiNull E{};
        pg8::gemm_phase<pg8::EpiNull, SameOrder, true, true>(ring, g, So, E, F.wave);
    } }
    if (IN(PH_P1)) { for (int rep = 0; rep < REP_X3; ++rep) {
        const long long c0 = clock64();
        pg8::Gemm g{XB, W_in, S, NPROJ, DM}; pg8::StaticOrder So; So.init(S, NPROJ, F.G, (int)blockIdx.x);
        pg8::EpiNull E{};
        pg8::gemm_phase<pg8::EpiNull, pg8::StaticOrder, false, true>(ring, g, So, E, F.wave);
        const long long extra = (clock64() - c0) >> 7; const long long t1 = wall_clock64();
        while (wall_clock64() - t1 < extra) __builtin_amdgcn_s_sleep(10);
    } }
    SEAM(PH_P1);
    if (IN(PH_P1B)) { p1b_qknorm_fgate(F, P); }
    SEAM(PH_P1B);
    if (IN(PH_ATT)) {
        char* al = (char*)lds + RING_OFF;
        const size_t T = (size_t)S * WF;
        gu32* qctr = F.ctl + CW_QATT; volatile LAS int* nx = (volatile LAS int*)(F.lds + RING_OFF + att::OFF_NEXT);
        const int a_lane = lane_id(); const bool puller = (F.wave == 0 && a_lane == 0);
        float gqm = fmaxf(fabsf(P.in[5][a_lane]), fabsf(P.in[5][a_lane + 64])), gkm = fmaxf(fabsf(P.in[6][a_lane]), fabsf(P.in[6][a_lane + 64]));
#pragma unroll
        for (int o = 1; o < 64; o <<= 1) { gqm = fmaxf(gqm, __shfl_xor(gqm, o)); gkm = fmaxf(gkm, __shfl_xor(gkm, o)); }
        const float Uq = __builtin_bit_cast(float, __builtin_amdgcn_readfirstlane(__builtin_bit_cast(int, 128.0f * gqm * gkm * 1.02f)));
        for (int arep = 0; arep < REP_ATT; ++arep) {
        if (arep > 0) { xcd_barrier(bar); if (blockIdx.x == 0 && puller) __hip_atomic_store(qctr, 0u, RLX_AGENT); xcd_barrier(bar); }
        if (puller) nx[0] = (int)__hip_atomic_fetch_add(qctr, 1u, RLX_AGENT);
        __syncthreads();
        int item = nx[0];
        __syncthreads();
        {
            bool primed = false; att::Seam Sm;
            while (item < NH * 32) {
                int pulled = 0;
                if (puller) pulled = (int)__hip_atomic_fetch_add(qctr, 1u, RLX_AGENT);
                const int h = item & 15, qb = 31 - (item >> 4);
                att::cgate_scan((const float*)(ws + WS_LOGF) + (size_t)h * S, al, F.wave);
                if (puller) nx[0] = pulled;
                att::BlockRef cur; cur.Q = QKV + (size_t)(qb * 256) * WF + h * HD; cur.K = QKV + T + h * HD; cur.V = QKV + 2 * T + h * HD; cur.O = Y + (size_t)(qb * 256) * WF + h * HD; cur.P0 = qb * 256;
                if (!primed) att::fox_prime(cur, al, Sm, F.wave); else __syncthreads();
                const int nitem = nx[0];
                att::BlockRef nxt = cur; primed = false;
                if (nitem < NH * 32) { const int h2 = nitem & 15, q2 = 31 - (nitem >> 4);
                    nxt.Q = QKV + (size_t)(q2 * 256) * WF + h2 * HD; nxt.K = QKV + T + h2 * HD; nxt.V = QKV + 2 * T + h2 * HD; nxt.O = Y + (size_t)(q2 * 256) * WF + h2 * HD; nxt.P0 = q2 * 256; primed = true; }
                att::fox_block(cur, nxt, Uq, al, Sm, F.wave);
                item = nitem;
            }
        }
        while (item < 2 * NH * 32) {
            int pulled = 0;
            if (puller) pulled = (int)__hip_atomic_fetch_add(qctr, 1u, RLX_AGENT);
            const int L = item - NH * 32, h = L & 15, qb = 31 - (L >> 4);
            att::BlockRef b; b.Q = QKV + 3 * T + (size_t)(qb * 256) * WF + h * HD; b.K = QKV + 4 * T + h * HD; b.V = QKV + 5 * T + h * HD; b.O = Y + T + (size_t)(qb * 256) * WF + h * HD; b.P0 = qb * 256;
            if (puller) nx[0] = pulled;
            att::sb_block(b, al, F.wave);
            item = nx[0];
            __syncthreads();
        }
        }
    }
    SEAM(PH_ATT);
    if (IN(PH_P3A)) {
        pg8::Gemm g{Y, (bf16*)(ws + WS_WBF), S, DM, WF}; pg8::TwoPartOrder So; So.init(S, DM, F.G, (int)blockIdx.x); So.A1 = Y + (size_t)S * WF; So.B1 = (bf16*)(ws + WS_WBS);
        pg8::EpiGate2 E{MERGED, GATES, GATES + (size_t)S * DM};
        pg8::gemm_phase<pg8::EpiGate2, pg8::TwoPartOrder, false, true>(ring, g, So, E, F.wave);
    }
    SEAM(PH_P3B);
    if (IN(PH_P4)) {
        pg8::Gemm g{MERGED, (bf16*)(ws + WS_WOUT), S, DM, DM}; pg8::StaticOrder So; So.init(S, DM, F.G, (int)blockIdx.x);
        pg8::EpiResStat E{P.in[0], P.out, XB, ss2};
        pg8::gemm_phase<pg8::EpiResStat, pg8::StaticOrder, false, true>(ring, g, So, E, F.wave);
    }
    SEAM(PH_P4);
    if (IN(PH_P5)) { for (int rep = 0; rep < REP_P5; ++rep) {
        pg8::Gemm g{XB, (bf16*)(ws + WS_WUP), S, 2 * DFF, DM}; pg8::StaticOrder So; So.init(S, 2 * DFF, F.G, (int)blockIdx.x);
        pg8::EpiConvGlu E{(bf16*)(ws + WS_ACT), (float*)(ws + WS_EDGE), ss2, P.in[12], P.in[13], (LAS float*)(F.lds + XCH_OFF)};
        pg8::gemm_phase<pg8::EpiConvGlu, pg8::StaticOrder, true, true>(ring, g, So, E, F.wave);
    } }
    SEAM(PH_P5);
    if (IN(PH_P5B)) { for (int rep = 0; rep < REP_P5B; ++rep) p5c_fixup(F, P); }
    SEAM(PH_P5B);
    if (IN(PH_P6)) {
        pg8::Gemm g{(bf16*)(ws + WS_ACT), (bf16*)(ws + WS_WDN), S, DM, DFF}; pg8::StaticOrder So; So.init(S, DM, F.G, (int)blockIdx.x);
        pg8::EpiResStat E{P.out, P.out, XB, ss3};
        pg8::gemm_phase<pg8::EpiResStat, pg8::StaticOrder, false, true>(ring, g, So, E, F.wave);
    }
    SEAM(PH_P6);
    if (IN(PH_P7A)) { for (int rep = 0; rep < REP_P7A; ++rep) {
        pg8::Gemm g{(bf16*)(ws + WS_PB), (bf16*)(ws + WS_WPP), S, DM, PLE}; pg8::StaticOrder So; So.init(S, DM, F.G, (int)blockIdx.x);
        pg8::EpiStoreBf16x4 E{(bf16*)(ws + WS_PP)};
        pg8::gemm_phase<pg8::EpiStoreBf16x4, pg8::StaticOrder, false, true>(ring, g, So, E, F.wave);
    } }
    if (IN(PH_P7)) {
        pg8::Gemm g{XB, (bf16*)(ws + WS_WPG), S, DM, DM}; pg8::StaticOrder So; So.init(S, DM, F.G, (int)blockIdx.x);
        pg8::EpiPle E{P.out, (const bf16*)(ws + WS_PP), ss3};
        pg8::gemm_phase<pg8::EpiPle, pg8::StaticOrder, false, true>(ring, g, So, E, F.wave);
    }
#undef IN
#undef SEAM
}

extern "C" void kernel_launch(void* const* d_in, const int* in_sizes, int n_in, void* d_out, int out_size, void* d_ws, size_t ws_size, hipStream_t stream) {
    static int grid = 0;
    if (grid == 0) {
        if (n_in != 18 || out_size != S * DM || ws_size < WS_END) { fprintf(stderr, "kernel_launch: unexpected shapes / workspace (%d inputs, out %d, ws %zu < %zu)\n", n_in, out_size, ws_size, (size_t)WS_END); grid = -1; return; }
        int dev = 0, cus = 0, per_cu = 0;
        if (hipGetDevice(&dev) != hipSuccess || hipDeviceGetAttribute(&cus, hipDeviceAttributeMultiprocessorCount, dev) != hipSuccess) { grid = -1; return; }
        if (hipFuncSetAttribute((const void*)mega_fwd, hipFuncAttributeMaxDynamicSharedMemorySize, LDS_BYTES) != hipSuccess) { fprintf(stderr, "kernel_launch: hipFuncSetAttribute failed\n"); grid = -1; return; }
        if (hipOccupancyMaxActiveBlocksPerMultiprocessor(&per_cu, (const void*)mega_fwd, NWAVES * 64, LDS_BYTES) != hipSuccess || per_cu < 1)
            fprintf(stderr, "kernel_launch: note: occupancy query reports %d workgroups per CU\n", per_cu);
        (void)hipGetLastError();
        grid = cus;
    }
    if (grid < 0) return;
    if (hipMemsetAsync((char*)d_ws + WS_CTL, 0, CTL_ZERO_BYTES, stream) != hipSuccess) return;
    Params a{};
    for (int i = 0; i < 18; ++i) a.in[i] = (const float*)d_in[i];
    a.out = (float*)d_out; a.ws = (unsigned char*)d_ws;
    a.ph_lo = PH_P0; a.ph_hi = PH_N; a.li = 0;
    hipLaunchKernelGGL(mega_fwd, dim3(grid), dim3(NWAVES * 64), LDS_BYTES, stream, a);
}
```

```cpp
#include <hip/hip_runtime.h>
#include <cstdio>
#include <cstdint>
__device__ __forceinline__ int lane_id() { int l; asm volatile("v_mbcnt_lo_u32_b32 %0, -1, 0\n\tv_mbcnt_hi_u32_b32 %0, -1, %0" : "=v"(l)); return l; }
#define TID() (WAVE_ * 64 + lane_id())
namespace pg8 {
#define PG8_LAS __attribute__((address_space(3)))
typedef unsigned short bf16_t;
typedef short bf16x8 __attribute__((ext_vector_type(8)));
typedef float f32x4 __attribute__((ext_vector_type(4)));
typedef unsigned u32x4 __attribute__((ext_vector_type(4)));
constexpr int BM = 256, BK = 64, HALF = 128, HTB = HALF * BK * 2  , STAGE_BYTES = 8 * HTB, NXCD = 8, WGM = 8;

__host__ __device__ __forceinline__ int lds_byte(int r, int c) { const int st = (r >> 4) * 2 + (c >> 5), rr = r & 15, cc = c & 31, ob = rr * 64 + cc * 2; return st * 1024 + (ob ^ (((ob >> 9) & 1) << 5)); }
__host__ __device__ __forceinline__ void stage_rc(int b, int& R, int& C) { const int st = b / 1024, sb = b % 1024, swz = sb ^ (((sb >> 9) & 1) << 5); R = (st >> 1) * 16 + swz / 64; C = (st & 1) * 32 + (swz % 64) / 2; }
__host__ __device__ __forceinline__ int perm32(int rho) { const int n = rho >> 4, i = rho & 15; return 8 * (i >> 2) + 4 * n + (i & 3); }

struct Unit { int pm, pn, part; };
struct Gemm { const bf16_t* A; const bf16_t* Bt; int M, N, K, lda, ldb; };

struct StaticOrder {
    int nM, nN, nwg, G, c;
    __host__ __device__ void init(int M, int N, int G_, int c_) { nM = M / BM; nN = N / BM; nwg = nM * nN; G = G_; c = c_; }
    __host__ __device__ bool next(int i, Unit& u) const {
        const long L = (long)i * G + c; if (L >= nwg) return false;
        int wgid = (int)L; { const int q = nwg / NXCD, r = nwg % NXCD, xcd = wgid % NXCD, off = wgid / NXCD; wgid = (xcd < r ? xcd * (q + 1) : r * (q + 1) + (xcd - r) * q) + off; }
        const int nig = WGM * nN, gid = wgid / nig, fm = gid * WGM, gsz = (nM - fm) < WGM ? (nM - fm) : WGM;
        u.pm = fm + ((wgid % nig) % gsz); u.pn = (wgid % nig) / gsz; return true;
    }
    __device__ __forceinline__ void a_ready(const Unit&) const {}
    __device__ __forceinline__ void done(const Unit&) const {}
    __device__ __forceinline__ const bf16_t* baseA(const Gemm& g, const Unit&) const { return g.A; }
    __device__ __forceinline__ const bf16_t* baseB(const Gemm& g, const Unit&) const { return g.Bt; }
    __device__ __forceinline__ bool zero_after(const Unit&) const { return true; }
};

__device__ __forceinline__ unsigned cvt_pk_bf16(float lo, float hi) { unsigned r; asm volatile("v_cvt_pk_bf16_f32 %0, %1, %2" : "=v"(r) : "v"(lo), "v"(hi)); return r; }
typedef float f32x2 __attribute__((ext_vector_type(2)));
constexpr int SEQ_ = 8192, DM_ = 4096;
constexpr float EPS_ = 1e-6f;
__device__ __forceinline__ float sigm(float v) { return __builtin_amdgcn_rcpf(1.0f + __builtin_amdgcn_exp2f(-1.4426950408889634f * v)); }
__device__ __forceinline__ float rs_of(float ss) { return __builtin_amdgcn_rsqf(ss * (1.0f / DM_) + EPS_); }
typedef unsigned u32x2 __attribute__((ext_vector_type(2)));
__device__ __forceinline__ f32x4 bf4_to_f32(u32x2 w) { return (f32x4){__uint_as_float(w.x << 16), __uint_as_float(w.x & 0xffff0000u), __uint_as_float(w.y << 16), __uint_as_float(w.y & 0xffff0000u)}; }

#define EPI_ROWS(k) (row0 + ((k) >> 2) * HALF + ((k) & 3) * 16)
#define EPI_ACC(k, bj, n) acc[(k) >> 2][bj][(k) & 3][n]
__device__ __forceinline__ u32x4 pack8(const f32x4 v0, const f32x4 v1) { u32x4 w; w.x = cvt_pk_bf16(v0[0], v0[1]); w.y = cvt_pk_bf16(v0[2], v0[3]); w.z = cvt_pk_bf16(v1[0], v1[1]); w.w = cvt_pk_bf16(v1[2], v1[3]); return w; }

struct EpiProj {
    static constexpr bool PERM = true, AFTER_DRAIN = false;
    bf16_t* qkv; bf16_t* gates; const float* ss; const float* gq; const float* gk; PG8_LAS float* hx;
    __device__ __forceinline__ void operator()(f32x4 (&acc)[2][2][4][2], const Unit& u, int wr, int wc, int fr, int fq) const {
        const int row0 = u.pm * BM + wr * 64 + fr;
        bf16_t* base; int ldc, colt; const bool gate = u.pn >= 48, qknorm = u.pn < 16;
        if (!gate) { base = qkv + (size_t)(u.pn >> 3) * ((size_t)SEQ_ * 2048); ldc = 2048; colt = (u.pn & 7) * 256; }
        else { const int t = u.pn - 48; base = gates + (size_t)(t >> 4) * ((size_t)SEQ_ * 4096); ldc = 4096; colt = (t & 15) * 256; }
        const int col0 = colt + wc * 32 + 8 * fq;
        float rs[8];
#pragma unroll
        for (int k = 0; k < 8; ++k) rs[k] = ss[EPI_ROWS(k)];
        if (qknorm) {
            const float* g = (u.pn < 8 ? gq : gk) + wc * 32 + 8 * fq; const f32x4 g0 = *(const f32x4*)g, g1 = *(const f32x4*)(g + 4);
#pragma unroll
            for (int k = 0; k < 8; ++k) { const float r = rs_of(rs[k]); const int rl = wr * 64 + (k >> 2) * HALF + (k & 3) * 16 + fr;
#pragma unroll
                for (int bj = 0; bj < 2; ++bj) { f32x4 v0 = EPI_ACC(k, bj, 0) * r, v1 = EPI_ACC(k, bj, 1) * r; EPI_ACC(k, bj, 0) = v0; EPI_ACC(k, bj, 1) = v1;
                    float s = (v0[0] * v0[0] + v0[1] * v0[1]) + (v0[2] * v0[2] + v0[3] * v0[3]) + (v1[0] * v1[0] + v1[1] * v1[1]) + (v1[2] * v1[2] + v1[3] * v1[3]);
                    s += __shfl_xor(s, 16); s += __shfl_xor(s, 32);
                    if (fq == 0) hx[(rl * 2 + bj) * 4 + wc] = s; } }
            asm volatile("s_waitcnt lgkmcnt(0)" ::: "memory"); __builtin_amdgcn_s_barrier(); asm volatile("" ::: "memory");
#pragma unroll
            for (int k = 0; k < 8; ++k) { const int rl = wr * 64 + (k >> 2) * HALF + (k & 3) * 16 + fr; bf16_t* rowp = base + (size_t)EPI_ROWS(k) * ldc + col0;
#pragma unroll
                for (int bj = 0; bj < 2; ++bj) { const f32x4 p = *(const PG8_LAS f32x4*)(hx + (rl * 2 + bj) * 4);
                    const float r2 = __builtin_amdgcn_rsqf(((p[0] + p[1]) + (p[2] + p[3])) * (1.0f / 128.0f) + EPS_);
                    *(u32x4*)(rowp + bj * HALF) = pack8(EPI_ACC(k, bj, 0) * g0 * r2, EPI_ACC(k, bj, 1) * g1 * r2); } }
        } else {
#pragma unroll
            for (int k = 0; k < 8; ++k) { const float r = rs_of(rs[k]); bf16_t* rowp = base + (size_t)EPI_ROWS(k) * ldc + col0;
#pragma unroll
                for (int bj = 0; bj < 2; ++bj) { f32x4 v0 = EPI_ACC(k, bj, 0) * r, v1 = EPI_ACC(k, bj, 1) * r;
                    if (gate) {
#pragma unroll
                        for (int j = 0; j < 4; ++j) { v0[j] = sigm(v0[j]); v1[j] = sigm(v1[j]); } }
                    *(u32x4*)(rowp + bj * HALF) = pack8(v0, v1); } }
        }
    }
};
struct EpiResStat {
    static constexpr bool PERM = false, AFTER_DRAIN = false;
    const float* base; float* out; bf16_t* xb; float* ss;
    __device__ __forceinline__ void operator()(const f32x4 (&acc)[2][2][4][2], const Unit& u, int wr, int wc, int fr, int fq) const {
        const int row0 = u.pm * BM + wr * 64 + fr, col0 = u.pn * BM + wc * 32 + 4 * fq;
        f32x4 b[2][4];
#define LD_(k) do { const size_t off_ = (size_t)EPI_ROWS(k) * DM_ + col0; _Pragma("unroll") for (int q_ = 0; q_ < 4; ++q_) b[(k) & 1][q_] = *(const f32x4*)(base + off_ + (q_ >> 1) * HALF + (q_ & 1) * 16); } while (0)
        LD_(0);
#pragma unroll
        for (int k = 0; k < 8; ++k) {
            if (k + 1 < 8) LD_(k + 1);
            const int r = EPI_ROWS(k); const size_t off = (size_t)r * DM_ + col0; float s = 0.f;
#pragma unroll
            for (int q = 0; q < 4; ++q) { const f32x4 o = b[k & 1][q] + EPI_ACC(k, q >> 1, q & 1);
                *(f32x4*)(out + off + (q >> 1) * HALF + (q & 1) * 16) = o; s += (o[0] * o[0] + o[1] * o[1]) + (o[2] * o[2] + o[3] * o[3]);
                u32x2 w; w.x = cvt_pk_bf16(o[0], o[1]); w.y = cvt_pk_bf16(o[2], o[3]); *(u32x2*)(xb + off + (q >> 1) * HALF + (q & 1) * 16) = w; }
            s += __shfl_xor(s, 16); s += __shfl_xor(s, 32);
            if (fq == 0) __hip_atomic_fetch_add(ss + r, s, __ATOMIC_RELAXED, __HIP_MEMORY_SCOPE_AGENT);
            asm volatile("" ::: "memory");
        }
#undef LD_
    }
};
struct EpiUp {
    static constexpr bool PERM = true, AFTER_DRAIN = false;
    bf16_t* O; int ldc; const float* ss;
    __device__ __forceinline__ void operator()(const f32x4 (&acc)[2][2][4][2], const Unit& u, int wr, int wc, int fr, int fq) const {
        const int row0 = u.pm * BM + wr * 64 + fr, col0 = u.pn * BM + wc * 32 + 8 * fq;
        float rs[8];
#pragma unroll
        for (int k = 0; k < 8; ++k) rs[k] = ss[EPI_ROWS(k)];
#pragma unroll
        for (int k = 0; k < 8; ++k) { const float r = rs_of(rs[k]); bf16_t* rowp = O + (size_t)EPI_ROWS(k) * ldc + col0;
#pragma unroll
            for (int bj = 0; bj < 2; ++bj) *(u32x4*)(rowp + bj * HALF) = pack8(EPI_ACC(k, bj, 0) * r, EPI_ACC(k, bj, 1) * r); }
    }
};
template <int CTRL> __device__ __forceinline__ float dpp_upd(float old, float src) { return __builtin_bit_cast(float, __builtin_amdgcn_update_dpp(__builtin_bit_cast(int, old), __builtin_bit_cast(int, src), CTRL, 0xf, 0xf, false)); }
struct EpiConvGlu {
    static constexpr bool PERM = false, AFTER_DRAIN = false;
    static constexpr int J = 11008, ROR1 = 0x121, ROR2 = 0x122, SHR1 = 0x111, SHR2 = 0x112;
    bf16_t* act; float* edge; const float* ss; const float* cw; const float* cb; PG8_LAS float* xch;
    __device__ __forceinline__ void operator()(f32x4 (&acc)[2][2][4][2], const Unit& u, int wr, int wc, int, int) const {
        const int l_ = lane_id(), fr = l_ & 15, fq = l_ >> 4;
        const int row0 = u.pm * BM + wr * 64 + fr, colt = wc * 32 + 4 * fq, j0 = u.pn * 128 + colt;
        {   float rs[8];
#pragma unroll
            for (int k = 0; k < 8; ++k) rs[k] = ss[EPI_ROWS(k)];
#pragma unroll
            for (int k = 0; k < 8; ++k) { const float r = rs_of(rs[k]);
#pragma unroll
                for (int bj = 0; bj < 2; ++bj)
#pragma unroll
                    for (int n = 0; n < 2; ++n) EPI_ACC(k, bj, n) = EPI_ACC(k, bj, n) * r; } }
#pragma unroll
        for (int ai = 0; ai < 2; ++ai) { const int b = 2 * ai + wr;
            if (fr >= 14) {
#pragma unroll
                for (int bj = 0; bj < 2; ++bj)
#pragma unroll
                    for (int n = 0; n < 2; ++n) *(PG8_LAS f32x4*)(xch + (b * 2 + (fr - 14)) * 256 + 128 * bj + colt + 16 * n) = acc[ai][bj][3][n];
                if (b == 3) {
#pragma unroll
                    for (int bj = 0; bj < 2; ++bj)
#pragma unroll
                        for (int n = 0; n < 2; ++n) *(f32x4*)(edge + ((size_t)u.pm * 4 + 2 + (fr - 14)) * (2 * J) + bj * J + j0 + 16 * n) = acc[ai][bj][3][n]; }
            }
            if (b == 0 && fr < 2) {
#pragma unroll
                for (int bj = 0; bj < 2; ++bj)
#pragma unroll
                    for (int n = 0; n < 2; ++n) *(f32x4*)(edge + ((size_t)u.pm * 4 + fr) * (2 * J) + bj * J + j0 + 16 * n) = acc[ai][bj][0][n]; }
        }
        asm volatile("s_waitcnt lgkmcnt(0)" ::: "memory"); __builtin_amdgcn_s_barrier(); asm volatile("" ::: "memory");
#pragma unroll
        for (int n = 0; n < 2; ++n) {
            f32x4 wgt[2][3], bia[2];
#pragma unroll
            for (int bj = 0; bj < 2; ++bj) { bia[bj] = *(const f32x4*)(cb + bj * J + j0 + 16 * n);
#pragma unroll
                for (int t = 0; t < 3; ++t) wgt[bj][t] = *(const f32x4*)(cw + (size_t)t * 2 * J + bj * J + j0 + 16 * n); }
#pragma unroll
            for (int k = 0; k < 8; ++k) { const int ai = k >> 2, m = k & 3, b = 2 * ai + wr;
                f32x4 x63[2], x62[2];
                if (m == 0) {
#pragma unroll
                    for (int bj = 0; bj < 2; ++bj) { const int pb = (b + 3) & 3; x63[bj] = *(const PG8_LAS f32x4*)(xch + (pb * 2 + 1) * 256 + 128 * bj + colt + 16 * n); x62[bj] = *(const PG8_LAS f32x4*)(xch + (pb * 2 + 0) * 256 + 128 * bj + colt + 16 * n); } }
                f32x4 res;
#pragma unroll
                for (int e = 0; e < 4; ++e) { float uu[2];
#pragma unroll
                    for (int bj = 0; bj < 2; ++bj) { const float c = acc[ai][bj][m][n][e]; float o1, o2;
                        if (m == 0) { o1 = x63[bj][e]; o2 = (fr == 0) ? x62[bj][e] : x63[bj][e]; }
                        else { const float pv = acc[ai][bj][m - 1][n][e]; o1 = dpp_upd<ROR1>(pv, pv); o2 = dpp_upd<ROR2>(pv, pv); }
                        const float p1 = dpp_upd<SHR1>(o1, c), p2 = dpp_upd<SHR2>(o2, c);
                        uu[bj] = bia[bj][e] + wgt[bj][0][e] * p2 + wgt[bj][1][e] * p1 + wgt[bj][2][e] * c; }
                    res[e] = uu[0] * sigm(uu[0]) * uu[1]; }
                if (!(b == 0 && m == 0 && fr < 2)) { u32x2 w; w.x = cvt_pk_bf16(res[0], res[1]); w.y = cvt_pk_bf16(res[2], res[3]); *(u32x2*)(act + (size_t)EPI_ROWS(k) * J + j0 + 16 * n) = w; }
            }
        }
    }
};
struct EpiPle {
    static constexpr bool PERM = false, AFTER_DRAIN = false;
    float* out; const bf16_t* pp; const float* ss;
    __device__ __forceinline__ void operator()(const f32x4 (&acc)[2][2][4][2], const Unit& u, int wr, int wc, int fr, int fq) const {
        const int row0 = u.pm * BM + wr * 64 + fr, col0 = u.pn * BM + wc * 32 + 4 * fq;
        float rs[8];
#pragma unroll
        for (int k = 0; k < 8; ++k) rs[k] = ss[EPI_ROWS(k)];
        f32x4 b[2][4]; u32x2 q2[2][4];
#define LD_(k) do { const size_t off_ = (size_t)EPI_ROWS(k) * DM_ + col0; _Pragma("unroll") for (int q_ = 0; q_ < 4; ++q_) { b[(k) & 1][q_] = *(const f32x4*)(out + off_ + (q_ >> 1) * HALF + (q_ & 1) * 16); \
            q2[(k) & 1][q_] = *(const u32x2*)(pp + off_ + (q_ >> 1) * HALF + (q_ & 1) * 16); } } while (0)
        LD_(0);
#pragma unroll
        for (int k = 0; k < 8; ++k) {
            if (k + 1 < 8) LD_(k + 1);
            const size_t off = (size_t)EPI_ROWS(k) * DM_ + col0; const float r = rs_of(rs[k]);
#pragma unroll
            for (int q = 0; q < 4; ++q) { const f32x4 a = EPI_ACC(k, q >> 1, q & 1) * r, pv = bf4_to_f32(q2[k & 1][q]), bb = b[k & 1][q];
                f32x4 o; o[0] = bb[0] + sigm(a[0]) * pv[0]; o[1] = bb[1] + sigm(a[1]) * pv[1]; o[2] = bb[2] + sigm(a[2]) * pv[2]; o[3] = bb[3] + sigm(a[3]) * pv[3];
                *(f32x4*)(out + off + (q >> 1) * HALF + (q & 1) * 16) = o; }
            asm volatile("" ::: "memory");
        }
#undef LD_
    }
};
struct EpiGate2 {
    static constexpr bool PERM = true, AFTER_DRAIN = false;
    bf16_t* merged; const bf16_t* sga; const bf16_t* sgb;
    __device__ __forceinline__ void operator()(f32x4 (&acc)[2][2][4][2], const Unit& u, int wr, int wc, int fr, int fq) const {
        const int row0 = u.pm * BM + wr * 64 + fr, col0 = u.pn * BM + wc * 32 + 8 * fq;
        if (u.part == 0) {
            u32x4 ga[2][2], gb[2][2];
#define LD_(k) do { const size_t off_ = (size_t)EPI_ROWS(k) * DM_ + col0; ga[(k) & 1][0] = *(const u32x4*)(sga + off_); ga[(k) & 1][1] = *(const u32x4*)(sga + off_ + HALF); gb[(k) & 1][0] = *(const u32x4*)(sgb + off_); gb[(k) & 1][1] = *(const u32x4*)(sgb + off_ + HALF); } while (0)
            LD_(0);
#pragma unroll
            for (int k = 0; k < 8; ++k) {
                if (k + 1 < 8) LD_(k + 1);
#pragma unroll
                for (int bj = 0; bj < 2; ++bj) { const u32x4 aw = ga[k & 1][bj], bw = gb[k & 1][bj];
                    const f32x4 ga0 = bf4_to_f32((u32x2){aw.x, aw.y}), ga1 = bf4_to_f32((u32x2){aw.z, aw.w}), gb0 = bf4_to_f32((u32x2){bw.x, bw.y}), gb1 = bf4_to_f32((u32x2){bw.z, bw.w});
#pragma unroll
                    for (int j = 0; j < 4; ++j) { EPI_ACC(k, bj, 0)[j] *= ga0[j] * __builtin_amdgcn_rcpf(fmaxf(gb0[j], 1e-20f)); EPI_ACC(k, bj, 1)[j] *= ga1[j] * __builtin_amdgcn_rcpf(fmaxf(gb1[j], 1e-20f)); } }
                asm volatile("" ::: "memory");
            }
#undef LD_
        } else {
            u32x4 gb[2][2];
#define LD_(k) do { const size_t off_ = (size_t)EPI_ROWS(k) * DM_ + col0; gb[(k) & 1][0] = *(const u32x4*)(sgb + off_); gb[(k) & 1][1] = *(const u32x4*)(sgb + off_ + HALF); } while (0)
            LD_(0);
#pragma unroll
            for (int k = 0; k < 8; ++k) {
                if (k + 1 < 8) LD_(k + 1);
                const size_t off = (size_t)EPI_ROWS(k) * DM_ + col0;
#pragma unroll
                for (int bj = 0; bj < 2; ++bj) { const u32x4 bw = gb[k & 1][bj]; const f32x4 gb0 = bf4_to_f32((u32x2){bw.x, bw.y}), gb1 = bf4_to_f32((u32x2){bw.z, bw.w});
                    f32x4 v0, v1;
#pragma unroll
                    for (int j = 0; j < 4; ++j) { v0[j] = EPI_ACC(k, bj, 0)[j] * fmaxf(gb0[j], 1e-20f); v1[j] = EPI_ACC(k, bj, 1)[j] * fmaxf(gb1[j], 1e-20f); }
                    *(u32x4*)(merged + off + bj * HALF) = pack8(v0, v1); }
                asm volatile("" ::: "memory");
            }
#undef LD_
        }
    }
};
struct TwoPartOrder : StaticOrder {
    const bf16_t* A1; const bf16_t* B1;
    __device__ bool next(int i, Unit& u) const { const bool ok = StaticOrder::next(i >> 1, u); u.part = i & 1; return ok; }
    __device__ __forceinline__ const bf16_t* baseA(const Gemm& g, const Unit& u) const { return u.part ? A1 : g.A; }
    __device__ __forceinline__ const bf16_t* baseB(const Gemm& g, const Unit& u) const { return u.part ? B1 : g.Bt; }
    __device__ __forceinline__ bool zero_after(const Unit& u) const { return u.part != 0; }
};
struct EpiStoreBf16x4 {
    static constexpr bool PERM = false, AFTER_DRAIN = false;
    bf16_t* C;
    __device__ __forceinline__ void operator()(const f32x4 (&acc)[2][2][4][2], const Unit& u, int wr, int wc, int fr, int fq) const {
        const int row0 = u.pm * BM + wr * 64 + fr, col0 = u.pn * BM + wc * 32 + 4 * fq;
#pragma unroll
        for (int ai = 0; ai < 2; ++ai)
#pragma unroll
            for (int m = 0; m < 4; ++m) { bf16_t* rowp = C + (size_t)(row0 + ai * HALF + m * 16) * DM_ + col0;
#pragma unroll
                for (int bj = 0; bj < 2; ++bj)
#pragma unroll
                    for (int n = 0; n < 2; ++n) { const f32x4 v = acc[ai][bj][m][n]; u32x2 w; w.x = cvt_pk_bf16(v[0], v[1]); w.y = cvt_pk_bf16(v[2], v[3]); *(u32x2*)(rowp + bj * HALF + n * 16) = w; } }
    }
};
struct EpiNull {
    static constexpr bool PERM = true, AFTER_DRAIN = false;
    __device__ __forceinline__ void operator()(const f32x4 (&acc)[2][2][4][2], const Unit& u, int wr, int wc, int fr, int fq) const {
#pragma unroll
        for (int ai = 0; ai < 2; ++ai)
#pragma unroll
            for (int bj = 0; bj < 2; ++bj)
#pragma unroll
                for (int m = 0; m < 4; ++m)
#pragma unroll
                    for (int n = 0; n < 2; ++n) asm volatile("" :: "v"(acc[ai][bj][m][n]));
    }
};
#undef EPI_ROWS
#undef EPI_ACC
template <class Epi, class Sched, bool ALIGN_EPI = false, bool SP2 = false>
__device__ __forceinline__ void gemm_phase(PG8_LAS unsigned char* lds, const Gemm g, const Sched& S, const Epi& E, const int WAVE_) {
    const int tid = TID(), wid = __builtin_amdgcn_readfirstlane(tid >> 6), lane = tid & 63, wr = wid >> 2, wc = wid & 3, fr = lane & 15, fq = lane >> 4;
    const int K = g.K, nt = K / BK, lda = g.lda ? g.lda : K, ldb = g.ldb ? g.ldb : K;
    unsigned voffA[2], voffB[2];
#pragma unroll
    for (int i = 0; i < 2; ++i) { int R, C; stage_rc(tid * 16 + i * 8192, R, C); const int Rb = Epi::PERM ? ((R & ~31) + perm32(R & 31)) : R;
        voffA[i] = (unsigned)(R * lda + C) * 2u; voffB[i] = (unsigned)(Rb * ldb + C) * 2u; }
    const size_t kstep = (size_t)(BK * 2);
    const size_t hstepA = (size_t)HALF * lda * 2, hstepB = (size_t)HALF * ldb * 2;
    const size_t tstepA = 2 * hstepA, tstepB = 2 * hstepB;
    const unsigned ldsw = (unsigned)wid * 1024u;
    const int aoff = lds_byte(wr * 64 + fr, fq * 8), boff = lds_byte(wc * 32 + fr, fq * 8);
#define PG8_SA(b, h) (((b) * 2 + (h)) * HTB)
#define PG8_SB(b, h) ((4 + (b) * 2 + (h)) * HTB)
#define PG8_STAGE(bufoff, gbase, voff) do { _Pragma("unroll") for (int _i = 0; _i < 2; ++_i) \
        __builtin_amdgcn_global_load_lds((const unsigned*)((const char*)(gbase) + (voff)[_i]), (PG8_LAS unsigned*)(lds + (bufoff) + ldsw + _i * 8192), 16, 0, 0); } while (0)
#define PG8_LDA(dst, b, h) do { _Pragma("unroll") for (int m = 0; m < 4; ++m) _Pragma("unroll") for (int k = 0; k < 2; ++k) dst[m][k] = *(const PG8_LAS bf16x8*)(lds + PG8_SA(b, h) + aoff + m * 2048 + k * 1024); } while (0)
#define PG8_LDB(dst, b, h) do { _Pragma("unroll") for (int n = 0; n < 2; ++n) _Pragma("unroll") for (int k = 0; k < 2; ++k) dst[n][k] = *(const PG8_LAS bf16x8*)(lds + PG8_SB(b, h) + boff + n * 2048 + k * 1024); } while (0)
#define PG8_MMA(ai, bj, At, Bt) do { __builtin_amdgcn_s_setprio(1); _Pragma("unroll") for (int m = 0; m < 4; ++m) _Pragma("unroll") for (int n = 0; n < 2; ++n) _Pragma("unroll") for (int k = 0; k < 2; ++k) \
        acc[ai][bj][m][n] = __builtin_amdgcn_mfma_f32_16x16x32_bf16(Bt[n][k], At[m][k], acc[ai][bj][m][n], 0, 0, 0); __builtin_amdgcn_s_setprio(0); } while (0)
#define PG8_WAIT_V(n) asm volatile("s_waitcnt vmcnt(" #n ")" ::: "memory")
#define PG8_WAIT_L(n) asm volatile("s_waitcnt lgkmcnt(" #n ")" ::: "memory")
#define PG8_BAR __builtin_amdgcn_s_barrier()
#define PG8_SCHED __builtin_amdgcn_sched_barrier(0)
    Unit cur, nxt; int ui = 0;
    if (!S.next(0, cur)) return;
    f32x4 acc[2][2][4][2];
#pragma unroll
    for (int a = 0; a < 2; ++a)
#pragma unroll
        for (int b = 0; b < 2; ++b)
#pragma unroll
            for (int m = 0; m < 4; ++m)
#pragma unroll
                for (int n = 0; n < 2; ++n) acc[a][b][m][n] = (f32x4){0.f, 0.f, 0.f, 0.f};
    bf16x8 At[4][2], B0[2][2], B1[2][2];
    const char* cA = (const char*)S.baseA(g, cur) + (size_t)cur.pm * tstepA; const char* cB = (const char*)S.baseB(g, cur) + (size_t)cur.pn * tstepB;
    S.a_ready(cur);
    if constexpr (SP2) {
        PG8_STAGE(PG8_SB(0, 0), cB, voffB); PG8_STAGE(PG8_SB(0, 1), cB + hstepB, voffB); PG8_STAGE(PG8_SA(0, 0), cA, voffA); PG8_STAGE(PG8_SA(0, 1), cA + hstepA, voffA);
        if (wr == 1) PG8_BAR;
        PG8_WAIT_V(2); PG8_BAR;
        PG8_STAGE(PG8_SB(1, 0), cB + kstep, voffB); PG8_STAGE(PG8_SA(1, 0), cA + kstep, voffA); PG8_STAGE(PG8_SB(1, 1), cB + hstepB + kstep, voffB);
        PG8_WAIT_V(6); PG8_BAR;
    } else {
        PG8_STAGE(PG8_SB(0, 0), cB, voffB); PG8_STAGE(PG8_SA(0, 0), cA, voffA); PG8_STAGE(PG8_SB(0, 1), cB + hstepB, voffB); PG8_STAGE(PG8_SA(0, 1), cA + hstepA, voffA);
        if (wr == 1) PG8_BAR;
        PG8_WAIT_V(4); PG8_BAR;
        PG8_STAGE(PG8_SB(1, 0), cB + kstep, voffB); PG8_STAGE(PG8_SA(1, 0), cA + kstep, voffA); PG8_STAGE(PG8_SB(1, 1), cB + hstepB + kstep, voffB);
        PG8_WAIT_V(6); PG8_BAR;
    }
    for (;;) {
        const bool has_next = S.next(ui + 1, nxt);
        const char* nA = has_next ? (const char*)S.baseA(g, nxt) + (size_t)nxt.pm * tstepA : cA; const char* nB = has_next ? (const char*)S.baseB(g, nxt) + (size_t)nxt.pn * tstepB : cB;
        for (int t = 0; t < nt; t += 2) {
            const bool last = (t == nt - 2);
            const char* a1 = cA + (size_t)(t + 1) * kstep;
            const char* a2 = last ? nA : cA + (size_t)(t + 2) * kstep; const char* b2 = last ? nB : cB + (size_t)(t + 2) * kstep;
            const char* a3 = a2 + kstep; const char* b3 = b2 + kstep;
            if (last && has_next) S.a_ready(nxt);
            if constexpr (SP2) {
            PG8_LDB(B0, 0, 0); PG8_LDB(B1, 0, 1); PG8_SCHED; PG8_LDA(At, 0, 0); PG8_STAGE(PG8_SA(1, 1), a1 + hstepA, voffA);
            PG8_WAIT_V(8); PG8_WAIT_L(0); PG8_BAR; PG8_MMA(0, 0, At, B0); PG8_MMA(0, 1, At, B1); PG8_BAR; PG8_SCHED;
            PG8_LDA(At, 0, 1); PG8_STAGE(PG8_SB(0, 0), b2, voffB); PG8_STAGE(PG8_SB(0, 1), b2 + hstepB, voffB); PG8_STAGE(PG8_SA(0, 0), a2, voffA);
            PG8_WAIT_V(8); PG8_WAIT_L(0); PG8_BAR; PG8_MMA(1, 0, At, B0); PG8_MMA(1, 1, At, B1); PG8_BAR; PG8_SCHED;
            PG8_LDB(B0, 1, 0); PG8_LDB(B1, 1, 1); PG8_SCHED; PG8_LDA(At, 1, 0); PG8_STAGE(PG8_SA(0, 1), a2 + hstepA, voffA);
            PG8_WAIT_V(8); PG8_WAIT_L(0); PG8_BAR; PG8_MMA(0, 0, At, B0); PG8_MMA(0, 1, At, B1); PG8_BAR; PG8_SCHED;
            PG8_LDA(At, 1, 1); PG8_STAGE(PG8_SB(1, 0), b3, voffB); PG8_STAGE(PG8_SB(1, 1), b3 + hstepB, voffB); PG8_STAGE(PG8_SA(1, 0), a3, voffA);
            PG8_WAIT_V(8); PG8_WAIT_L(0); PG8_BAR; PG8_MMA(1, 0, At, B0); PG8_MMA(1, 1, At, B1); PG8_BAR; PG8_SCHED;
            } else {
            PG8_LDB(B0, 0, 0); PG8_SCHED; PG8_LDA(At, 0, 0); PG8_STAGE(PG8_SA(1, 1), a1 + hstepA, voffA);
            PG8_WAIT_L(8); PG8_BAR; PG8_WAIT_L(0); PG8_MMA(0, 0, At, B0); PG8_BAR; PG8_SCHED;
            PG8_LDB(B1, 0, 1); PG8_STAGE(PG8_SB(0, 0), b2, voffB);
            PG8_BAR; PG8_WAIT_L(0); PG8_MMA(0, 1, At, B1); PG8_BAR;
            PG8_LDA(At, 0, 1); PG8_STAGE(PG8_SA(0, 0), a2, voffA);
            PG8_BAR; PG8_WAIT_L(0); PG8_MMA(1, 0, At, B0); PG8_BAR; PG8_SCHED;
            PG8_STAGE(PG8_SB(0, 1), b2 + hstepB, voffB);
            PG8_WAIT_V(6); PG8_BAR; PG8_MMA(1, 1, At, B1); PG8_BAR;
            PG8_LDB(B0, 1, 0); PG8_SCHED; PG8_LDA(At, 1, 0); PG8_STAGE(PG8_SA(0, 1), a2 + hstepA, voffA);
            PG8_WAIT_L(8); PG8_BAR; PG8_WAIT_L(0); PG8_MMA(0, 0, At, B0); PG8_BAR; PG8_SCHED;
            PG8_LDB(B1, 1, 1); PG8_STAGE(PG8_SB(1, 0), b3, voffB);
            PG8_BAR; PG8_WAIT_L(0); PG8_MMA(0, 1, At, B1); PG8_BAR;
            PG8_LDA(At, 1, 1); PG8_STAGE(PG8_SA(1, 0), a3, voffA);
            PG8_BAR; PG8_WAIT_L(0); PG8_MMA(1, 0, At, B0); PG8_BAR; PG8_SCHED;
            PG8_STAGE(PG8_SB(1, 1), b3 + hstepB, voffB);
            PG8_WAIT_V(6); PG8_BAR; PG8_MMA(1, 1, At, B1); PG8_BAR;
            }
        }
        if constexpr (ALIGN_EPI) { if (wr == 0) PG8_BAR; }
        if constexpr (!Epi::AFTER_DRAIN) { E(acc, cur, wr, wc, fr, fq); S.done(cur); }
        if (!has_next) break;
        if (S.zero_after(cur))
#pragma unroll
        for (int a = 0; a < 2; ++a)
#pragma unroll
            for (int b = 0; b < 2; ++b)
#pragma unroll
                for (int m = 0; m < 4; ++m)
#pragma unroll
                    for (int n = 0; n < 2; ++n) acc[a][b][m][n] = (f32x4){0.f, 0.f, 0.f, 0.f};
        cur = nxt; cA = nA; cB = nB; ++ui;
        if constexpr (ALIGN_EPI) { if (wr == 1) PG8_BAR; }
    }
    PG8_WAIT_V(0);
    if constexpr (!ALIGN_EPI) { if (wr == 0) PG8_BAR; }
    PG8_BAR;
    if constexpr (Epi::AFTER_DRAIN) { E.fused(acc, cur, wr, wc, fr, fq, lds, wid, lane); S.done(cur); }
#undef PG8_SA
#undef PG8_SB
#undef PG8_STAGE
#undef PG8_LDA
#undef PG8_LDB
#undef PG8_MMA
#undef PG8_WAIT_V
#undef PG8_WAIT_L
#undef PG8_BAR
#undef PG8_SCHED
}
}
constexpr int NWAVES = 8;
constexpr int S = 8192, DM = 4096, HD = 128, NH = 16, WF = 2048, DFF = 11008, PLE = 256, NIN = 20496, NPROJ = 20480;
constexpr float EPS = 1e-6f;
constexpr float SCALE = 0.08838834764831845f;
constexpr size_t MiB = 1u << 20;
constexpr size_t WS_CTL = 0, CTL_ZERO_BYTES = 1 * MiB;
constexpr size_t WS_SS1 = 1 * MiB;
constexpr size_t WS_LOGF = WS_SS1 + 64 * 1024;
constexpr size_t WS_C = WS_LOGF + 512 * 1024;
constexpr size_t WS_WTF = WS_C + 512 * 1024;
constexpr size_t WS_WIN = 4 * MiB;
constexpr size_t WS_WBF = WS_WIN + 160 * MiB;
constexpr size_t WS_WBS = WS_WBF + 16 * MiB;
constexpr size_t WS_WOUT = WS_WBS + 16 * MiB;
constexpr size_t WS_WUP = WS_WOUT + 32 * MiB;
constexpr size_t WS_WDN = WS_WUP + 172 * MiB;
constexpr size_t WS_WPG = WS_WDN + 86 * MiB;
constexpr size_t WS_WPP = WS_WPG + 32 * MiB;
constexpr size_t WS_XB = WS_WPP + 2 * MiB;
constexpr size_t WS_PB = WS_XB + 64 * MiB;
constexpr size_t WS_QKV = WS_PB + 4 * MiB;
constexpr size_t WS_GATES = WS_QKV + 192 * MiB;
constexpr size_t WS_Y = WS_GATES + 128 * MiB;
constexpr size_t WS_EDGE = WS_QKV + 128 * MiB;
constexpr size_t WS_UP = WS_QKV;
constexpr size_t WS_MERGED = WS_Y + 64 * MiB;
constexpr size_t WS_ACT = WS_MERGED + 64 * MiB;
constexpr size_t WS_PP = WS_QKV;
constexpr size_t WS_END = WS_ACT + 172 * MiB;
static_assert(WS_UP + (size_t)S * 2 * DFF * 2 <= WS_MERGED, "up overlay");
constexpr int CW_BAR = 4096;
constexpr int CW_QATT = 2048;
constexpr int CW_SS2 = 32768, CW_SS3 = 32768 + 8192;
constexpr int N_BAR_REGIONS = 4;
constexpr int RING_OFF = 0, RING_BYTES = 131072;
constexpr int LDSCTL_OFF = RING_BYTES, MISC_OFF = LDSCTL_OFF + 320;
constexpr int XCH_OFF = LDSCTL_OFF + 1024;
constexpr int LDS_BYTES = 147456;
static_assert(XCH_OFF + 8192 <= LDS_BYTES, "LDS map");

#define GAS __attribute__((address_space(1)))
#define LAS __attribute__((address_space(3)))
typedef unsigned short bf16;
typedef unsigned v4u __attribute__((ext_vector_type(4)));
typedef unsigned v2u __attribute__((ext_vector_type(2)));
typedef float f32x4 __attribute__((ext_vector_type(4)));
typedef float f32x16 __attribute__((ext_vector_type(16)));
typedef short bf16x8 __attribute__((ext_vector_type(8)));
typedef GAS unsigned gu32;
#define RLX_AGENT __ATOMIC_RELAXED, __HIP_MEMORY_SCOPE_AGENT
#define LDS_WAIT() asm volatile("s_waitcnt lgkmcnt(0)" ::: "memory")
#define VM_WAIT() asm volatile("s_waitcnt vmcnt(0)" ::: "memory")
__device__ __forceinline__ unsigned pk2(float lo, float hi) { unsigned r; asm volatile("v_cvt_pk_bf16_f32 %0, %1, %2" : "=v"(r) : "v"(lo), "v"(hi)); return r; }
__device__ __forceinline__ float bf2f(bf16 b) { return __uint_as_float(((unsigned)b) << 16); }
__device__ __forceinline__ float bflo(unsigned w) { return __uint_as_float(w << 16); }
__device__ __forceinline__ float bfhi(unsigned w) { return __uint_as_float(w & 0xffff0000u); }
__device__ __forceinline__ float sigmoidf_(float v) { return 1.0f / (1.0f + __expf(-v)); }
__device__ __forceinline__ float log_sigmoidf_(float v) { return fminf(v, 0.f) - log1pf(__expf(-fabsf(v))); }
__device__ __forceinline__ float softplusf_(float v) { return fmaxf(v, 0.f) + log1pf(__expf(-fabsf(v))); }
__device__ __forceinline__ float wave_sum(float v) {
#pragma unroll
    for (int o = 1; o < 64; o <<= 1) v += __shfl_xor(v, o);
    return v;
}

#define XB_TMO      128
#define XB_XCNT(j)  (256  + 64 * (j))
#define XB_XSUB(j)  (1280 + 64 * (j))
#define XB_XGEN(j)  (2304 + 64 * (j))
#define XB_TOP      3328
#define XB_TOPGEN   3392
#define XCD_BAR_WORDS 3456
#define XB_SPIN_CAP (1u << 18)

__device__ __forceinline__ unsigned xb_ld(unsigned* p)              { return __hip_atomic_load(p, __ATOMIC_RELAXED, __HIP_MEMORY_SCOPE_AGENT); }
__device__ __forceinline__ unsigned xb_add(unsigned* p, unsigned v) { return __hip_atomic_fetch_add(p, v, __ATOMIC_RELAXED, __HIP_MEMORY_SCOPE_AGENT); }
__device__ __forceinline__ unsigned xb_xcc_id() { return (unsigned)__builtin_amdgcn_s_getreg((3 << 11) | 20) & 0xFu; }
#define XB_SPIN(cond, bar) do { unsigned _sp = 0; while (cond) { __builtin_amdgcn_s_sleep(1); \
    if ((++_sp & 255u) == 0u) { if (xb_ld(&(bar)[XB_TMO])) break; if (_sp > XB_SPIN_CAP) { atomicAdd(&(bar)[XB_TMO], 1u); break; } } } } while (0)

struct XcdBarrier {
    unsigned* bar; unsigned x; int wave;
    volatile LAS unsigned* st;
};

__device__ __forceinline__ XcdBarrier xcd_barrier_post(unsigned* bar, volatile LAS unsigned* st, const int WAVE_) {
    XcdBarrier b; b.wave = WAVE_; b.bar = bar; b.x = xb_xcc_id(); b.st = st;
    if (TID() == 0) (void)xb_add(&bar[XB_XCNT(b.x)], 1u);
    return b;
}
__device__ __forceinline__ void xcd_barrier_complete(unsigned* bar, unsigned x, unsigned& nloc, unsigned& nx) {
    const unsigned G = gridDim.x * gridDim.y * gridDim.z;
    unsigned sum, cnt, mine, sp = 0u;
    for (;;) {
        sum = 0u; cnt = 0u; mine = 0u;
#pragma unroll
        for (unsigned j = 0; j < 16; ++j) { const unsigned c = xb_ld(&bar[XB_XCNT(j)]); sum += c; cnt += (c > 0u) ? 1u : 0u; mine = (j == x) ? c : mine; }
        if (sum == G) break;
        __builtin_amdgcn_s_sleep(1);
        if ((++sp & 255u) == 0u) { if (xb_ld(&bar[XB_TMO])) break; if (sp > XB_SPIN_CAP) { atomicAdd(&bar[XB_TMO], 1u); break; } }
    }
    nloc = mine > 0u ? mine : 1u; nx = cnt > 0u ? cnt : 1u;
}

__device__ __forceinline__ void xcd_barrier(const XcdBarrier& b) {
    const int WAVE_ = b.wave;
    asm volatile("s_waitcnt vmcnt(0)" ::: "memory");
    __syncthreads();
    if (TID() == 0) {
        unsigned* bar = b.bar;
        __builtin_amdgcn_s_waitcnt(0);
        unsigned nloc = b.st[0], nx = b.st[1];
        if (nloc == 0u) { xcd_barrier_complete(bar, b.x, nloc, nx); b.st[0] = nloc; b.st[1] = nx; }
        const unsigned old = xb_add(&bar[XB_XSUB(b.x)], 1u);
        const unsigned gen = old / nloc;
        if (old + 1u == (gen + 1u) * nloc) {
            __builtin_amdgcn_fence(__ATOMIC_RELEASE, "agent");
            asm volatile("s_waitcnt vmcnt(0)" ::: "memory");
            const unsigned og = xb_add(&bar[XB_TOP], 1u);
            const unsigned tg = og / nx;
            if (og + 1u == (tg + 1u) * nx) xb_add(&bar[XB_TOPGEN], 1u);
            else XB_SPIN(xb_ld(&bar[XB_TOPGEN]) == tg, bar);
            __builtin_amdgcn_fence(__ATOMIC_ACQUIRE, "agent");
            xb_add(&bar[XB_XGEN(b.x)], 1u);
            asm volatile("s_waitcnt vmcnt(0)" ::: "memory");
        } else {
            XB_SPIN(xb_ld(&bar[XB_XGEN(b.x)]) == gen, bar);
            __builtin_amdgcn_fence(__ATOMIC_ACQUIRE, "agent");
            asm volatile("s_waitcnt vmcnt(0)" ::: "memory");
        }
    }
    __syncthreads();
}


struct Params {
    const float* in[18]; float* out; unsigned char* ws;
    int ph_lo, ph_hi, li, pad;
};
struct Frame {
    LAS unsigned char* lds; volatile LAS unsigned* MISC; gu32* ctl;
    int wave, vcu, G;
};

constexpr int CVT_WIN_TILES = 64 * 96 + 64 * 224;
constexpr int CVT_REST_TILES = 32 * 64 + 32 * 64 + 64 * 64 + 64 * 344 + 172 * 64 + 64 * 64 + 4 * 64;
struct CvtT { const float* src; const float* g; bf16* dst; int ldw, K; };
__device__ __forceinline__ CvtT cvt_decode(const Params& P, int it, int lane) {
    unsigned char* ws = P.ws;
    constexpr int T0 = 64 * 96, T1 = 64 * 224, T2 = 32 * 64, T3 = 32 * 64, T4 = 64 * 64, T5 = 64 * 344, T6 = 172 * 64, T7 = 64 * 64;
    const float* W; const float* g = nullptr; bf16* Wt; int ldw, srccol0 = 0, K, nrow0 = 0, NT; int r = it; bool is_up = false;
    if (r < T0) { W = P.in[3]; ldw = NIN; g = P.in[2]; Wt = (bf16*)(ws + WS_WIN); K = DM; NT = 96; }
    else if ((r -= T0) < T1) { W = P.in[3]; ldw = NIN; srccol0 = 6160; g = P.in[2]; Wt = (bf16*)(ws + WS_WIN); K = DM; nrow0 = 6144; NT = 224; }
    else if ((r -= T1) < T2) { W = P.in[7]; ldw = DM; Wt = (bf16*)(ws + WS_WBF); K = WF; NT = 64; }
    else if ((r -= T2) < T3) { W = P.in[8]; ldw = DM; Wt = (bf16*)(ws + WS_WBS); K = WF; NT = 64; }
    else if ((r -= T3) < T4) { W = P.in[9]; ldw = DM; Wt = (bf16*)(ws + WS_WOUT); K = DM; NT = 64; }
    else if ((r -= T4) < T5) { W = P.in[11]; ldw = 2 * DFF; g = P.in[10]; Wt = (bf16*)(ws + WS_WUP); K = DM; NT = 344; is_up = true; }
    else if ((r -= T5) < T6) { W = P.in[14]; ldw = DM; Wt = (bf16*)(ws + WS_WDN); K = DFF; NT = 64; }
    else if ((r -= T6) < T7) { W = P.in[16]; ldw = DM; g = P.in[15]; Wt = (bf16*)(ws + WS_WPG); K = DM; NT = 64; }
    else { r -= T7; W = P.in[17]; ldw = DM; Wt = (bf16*)(ws + WS_WPP); K = PLE; NT = 64; }
    const int nt = r % NT, kt = r / NT, nq = lane & 7, q = lane >> 3;
    CvtT T;
    int scol = srccol0 + 64 * nt;
    if (is_up) scol = ((nt & 3) >> 1) * DFF + 128 * (nt >> 2) + (nt & 1) * 64;
    T.src = W + (size_t)(64 * kt + 8 * q) * ldw + scol + 4 * nq;
    T.g = g ? g + 64 * kt + 8 * q : nullptr;
    T.dst = Wt + (size_t)(nrow0 + 64 * nt + 4 * nq) * K + 64 * kt + 8 * q;
    T.ldw = ldw; T.K = K;
    return T;
}
__device__ __forceinline__ void cvt_load(const CvtT& T, f32x4 (&v)[2][8]) {
#pragma unroll
    for (int p = 0; p < 2; ++p)
#pragma unroll
        for (int t = 0; t < 8; ++t) v[p][t] = __builtin_nontemporal_load((const f32x4*)(T.src + (size_t)t * T.ldw + 32 * p));
}
__device__ __forceinline__ void cvt_store(const CvtT& T, const f32x4 (&v)[2][8]) {
    f32x4 g0 = (f32x4){1.f, 1.f, 1.f, 1.f}, g1 = g0;
    if (T.g) { g0 = *(const f32x4*)T.g; g1 = *(const f32x4*)(T.g + 4); }
#pragma unroll
    for (int p = 0; p < 2; ++p)
#pragma unroll
        for (int i = 0; i < 4; ++i) {
            v4u w; w.x = pk2(v[p][0][i] * g0[0], v[p][1][i] * g0[1]); w.y = pk2(v[p][2][i] * g0[2], v[p][3][i] * g0[3]);
            w.z = pk2(v[p][4][i] * g1[0], v[p][5][i] * g1[1]); w.w = pk2(v[p][6][i] * g1[2], v[p][7][i] * g1[3]);
            *(v4u*)(T.dst + (size_t)(32 * p + i) * T.K) = w;
        }
}
__device__ __forceinline__ void p0_weights(const Frame& F, const Params& P) {
    const int WAVE_ = F.wave; const int f_lane = lane_id(), f_tid = TID();
    const int gw = F.vcu * NWAVES + F.wave, NGW = F.G * NWAVES, lane = f_lane;
    unsigned char* ws = P.ws;
    constexpr int NITEMS = CVT_WIN_TILES;
    f32x4 va[2][8], vb[2][8];
    int it = gw;
    if (it < NITEMS) {
        CvtT Ta = cvt_decode(P, it, lane); cvt_load(Ta, va);
        for (;;) {
            const int i1 = it + NGW; CvtT Tb = Ta;
            if (i1 < NITEMS) { Tb = cvt_decode(P, i1, lane); cvt_load(Tb, vb); }
            cvt_store(Ta, va);
            if (i1 >= NITEMS) break;
            const int i2 = i1 + NGW;
            if (i2 < NITEMS) { Ta = cvt_decode(P, i2, lane); cvt_load(Ta, va); }
            cvt_store(Tb, vb);
            if (i2 >= NITEMS) break;
            it = i2;
        }
    }
    { const float* w_in = P.in[3]; const float* g_mix = P.in[2]; bf16* wtf = (bf16*)(ws + WS_WTF);
      for (int i = blockIdx.x * 512 + f_tid; i < NH * (DM / 8); i += F.G * 512) { const int n = i / (DM / 8), kc = i % (DM / 8);
          float b[8];
#pragma unroll
          for (int t = 0; t < 8; ++t) b[t] = w_in[(size_t)(8 * kc + t) * NIN + 6144 + n] * g_mix[8 * kc + t];
          v4u w; w.x = pk2(b[0], b[1]); w.y = pk2(b[2], b[3]); w.z = pk2(b[4], b[5]); w.w = pk2(b[6], b[7]);
          *(v4u*)(wtf + (size_t)n * DM + 8 * kc) = w; } }
    const float* p = P.in[1]; bf16* pb = (bf16*)(ws + WS_PB);
    for (int i = blockIdx.x * 512 + f_tid; i < S * PLE / 8; i += F.G * 512) {
        const f32x4 a = *(const f32x4*)(p + (size_t)i * 8), b = *(const f32x4*)(p + (size_t)i * 8 + 4);
        v4u w; w.x = pk2(a[0], a[1]); w.y = pk2(a[2], a[3]); w.z = pk2(b[0], b[1]); w.w = pk2(b[2], b[3]);
        *(v4u*)(pb + (size_t)i * 8) = w;
    }
}
constexpr int CVT_SLOT = 18;
static_assert(2560 * CVT_SLOT >= CVT_REST_TILES, "conversion slots cover every tile");
struct ConvOrder : pg8::StaticOrder {
    const Params* P; int wave; mutable int slot;
    __device__ __forceinline__ void done(const pg8::Unit&) const {
        const int lane = lane_id();
        const int base = (slot * G + c) * CVT_SLOT; ++slot;
        const int i0 = base + wave, i1 = i0 + 8, i2 = i0 + 16;
        const int lim = (base + CVT_SLOT < CVT_REST_TILES) ? base + CVT_SLOT : CVT_REST_TILES;
        f32x4 va[2][8], vb[2][8];
        if (i0 < lim) {
            CvtT Ta = cvt_decode(*P, CVT_WIN_TILES + i0, lane); cvt_load(Ta, va);
            if (i1 < lim) {
                CvtT Tb = cvt_decode(*P, CVT_WIN_TILES + i1, lane); cvt_load(Tb, vb);
                cvt_store(Ta, va);
                if (i2 < lim) { Ta = cvt_decode(*P, CVT_WIN_TILES + i2, lane); cvt_load(Ta, va); cvt_store(Tb, vb); cvt_store(Ta, va); }
                else cvt_store(Tb, vb);
            } else cvt_store(Ta, va);
        }
    }
};
__device__ __forceinline__ void p0_rows(const Frame& F, const Params& P) {
    const int WAVE_ = F.wave; const int f_lane = lane_id();
    const float* x = P.in[0]; unsigned char* ws = P.ws;
    float* ss1 = (float*)(ws + WS_SS1); bf16* xb = (bf16*)(ws + WS_XB);
    const int gw = F.vcu * NWAVES + F.wave, NGW = F.G * NWAVES, lane = f_lane;
    for (int base = gw; base < S; base += 2 * NGW) {
        const int rowA = base, rowB = (base + NGW < S) ? base + NGW : base;
        const f32x4* xa = (const f32x4*)(x + (size_t)rowA * DM) + lane; const f32x4* xbp = (const f32x4*)(x + (size_t)rowB * DM) + lane;
        f32x4 va[16], vb[16]; float sa = 0.f, sb = 0.f;
#pragma unroll
        for (int j = 0; j < 16; ++j) va[j] = __builtin_nontemporal_load(xa + 64 * j);
#pragma unroll
        for (int j = 0; j < 16; ++j) vb[j] = __builtin_nontemporal_load(xbp + 64 * j);
#pragma unroll
        for (int j = 0; j < 16; ++j) sa += (va[j][0] * va[j][0] + va[j][1] * va[j][1]) + (va[j][2] * va[j][2] + va[j][3] * va[j][3]);
#pragma unroll
        for (int j = 0; j < 16; ++j) sb += (vb[j][0] * vb[j][0] + vb[j][1] * vb[j][1]) + (vb[j][2] * vb[j][2] + vb[j][3] * vb[j][3]);
        sa = wave_sum(sa); sb = wave_sum(sb);
        if (lane == 0) { ss1[rowA] = sa; ss1[rowB] = sb; }
        v2u* oa = (v2u*)(xb + (size_t)rowA * DM) + lane; v2u* ob = (v2u*)(xb + (size_t)rowB * DM) + lane;
#pragma unroll
        for (int j = 0; j < 16; ++j) { v2u w; w.x = pk2(va[j][0], va[j][1]); w.y = pk2(va[j][2], va[j][3]); oa[64 * j] = w; }
#pragma unroll
        for (int j = 0; j < 16; ++j) { v2u w; w.x = pk2(vb[j][0], vb[j][1]); w.y = pk2(vb[j][2], vb[j][3]); ob[64 * j] = w; }
    }
}

__device__ __forceinline__ void p1b_qknorm_fgate(const Frame& F, const Params& P) {
    const int WAVE_ = F.wave; const int f_lane = lane_id(), f_tid = TID();
    unsigned char* ws = P.ws;
    bf16* qkv = (bf16*)(ws + WS_QKV);
    const float* gq = P.in[5]; const float* gk = P.in[6];
    const int gw = F.vcu * NWAVES + F.wave, NGW = F.G * NWAVES, lane = f_lane, sub = lane >> 4, l16 = lane & 15;
    {
        const bf16* xb = (const bf16*)(ws + WS_XB); const bf16* wtf = (const bf16*)(ws + WS_WTF); const float* ss1 = (const float*)(ws + WS_SS1); const float* b_f = P.in[4];
        float* logf = (float*)(ws + WS_LOGF);
        LAS float* fbuf = (LAS float*)(F.lds + RING_OFF);
        const int wave = F.wave, rl = lane & 31, kg = lane >> 5;
        for (int grp = blockIdx.x; grp < S / 32; grp += F.G) {
            const int r0 = grp * 32;
            const bf16* pa = xb + (size_t)(r0 + rl) * DM + 512 * wave + 8 * kg;
            const bf16* pb = wtf + (size_t)(rl & 15) * DM + 512 * wave + 8 * kg;
            f32x16 acc = {};
#pragma unroll 8
            for (int ks = 0; ks < 32; ++ks) {
                const bf16x8 a = *(const bf16x8*)(pa + 16 * ks);
                bf16x8 b = *(const bf16x8*)(pb + 16 * ks);
                if (rl >= 16) b = (bf16x8){0, 0, 0, 0, 0, 0, 0, 0};
                acc = __builtin_amdgcn_mfma_f32_32x32x16_bf16(a, b, acc, 0, 0, 0);
            }
            if (rl < 16) {
#pragma unroll
                for (int r = 0; r < 16; ++r) { const int tok = (r & 3) + 8 * (r >> 2) + 4 * kg; fbuf[(wave * 32 + tok) * 16 + rl] = acc[r]; }
            }
            __syncthreads();
            {
                const int tok = f_tid >> 4, h = f_tid & 15; float fv = 0.f;
#pragma unroll
                for (int w = 0; w < 8; ++w) fv += fbuf[(w * 32 + tok) * 16 + h];
                fv = fv * rsqrtf(ss1[r0 + tok] * (1.0f / DM) + EPS) + b_f[h];
                logf[(size_t)h * S + r0 + tok] = log_sigmoidf_(fv);
            }
            __syncthreads();
        }
    }
}

__device__ __forceinline__ void p5c_fixup(const Frame& F, const Params& P) {
    const int WAVE_ = F.wave; const int f_tid = TID();
    unsigned char* ws = P.ws;
    const float* edge = (const float*)(ws + WS_EDGE); bf16* act = (bf16*)(ws + WS_ACT);
    const float* cw = P.in[12]; const float* cb = P.in[13];
    constexpr int NQ = DFF / 4;
    for (int i = blockIdx.x * 512 + f_tid; i < (S / 256) * 2 * NQ; i += F.G * 512) {
        const int row = i / NQ, jc = (i - row * NQ) * 4, p = row >> 1, rr = row & 1, t = 256 * p + rr;
        float uu[2][4];
#pragma unroll
        for (int h = 0; h < 2; ++h) {
            const size_t co = (size_t)h * DFF + jc; const f32x4 z = (f32x4){0.f, 0.f, 0.f, 0.f};
            const f32x4 c = *(const f32x4*)(edge + ((size_t)p * 4 + rr) * (2 * DFF) + co);
            const f32x4 l3 = p ? *(const f32x4*)(edge + ((size_t)(p - 1) * 4 + 3) * (2 * DFF) + co) : z;
            const f32x4 p1 = rr ? *(const f32x4*)(edge + ((size_t)p * 4 + 0) * (2 * DFF) + co) : l3;
            const f32x4 p2 = rr ? l3 : (p ? *(const f32x4*)(edge + ((size_t)(p - 1) * 4 + 2) * (2 * DFF) + co) : z);
            const f32x4 w0 = *(const f32x4*)(cw + co), w1 = *(const f32x4*)(cw + (size_t)2 * DFF + co), w2 = *(const f32x4*)(cw + (size_t)4 * DFF + co), bb = *(const f32x4*)(cb + co);
#pragma unroll
            for (int e = 0; e < 4; ++e) uu[h][e] = bb[e] + w0[e] * p2[e] + w1[e] * p1[e] + w2[e] * c[e];
        }
        v2u w; w.x = pk2(uu[0][0] * sigmoidf_(uu[0][0]) * uu[1][0], uu[0][1] * sigmoidf_(uu[0][1]) * uu[1][1]); w.y = pk2(uu[0][2] * sigmoidf_(uu[0][2]) * uu[1][2], uu[0][3] * sigmoidf_(uu[0][3]) * uu[1][3]);
        *(v2u*)(act + (size_t)t * DFF + jc) = w;
    }
}

namespace att {
constexpr int D = 128, PITCH = 2048, NW = 8, QBLK = 32, KVBLK = 64, QB = NW * QBLK;
constexpr int SHM_V = KVBLK * D * 2, SHM_K = KVBLK * D * 2;
constexpr int OFF_WS = 2 * SHM_V + 2 * SHM_K, OFF_FLAG = OFF_WS + NW * 64 * 4, OFF_WTOT = OFF_FLAG + 64, OFF_NEXT = OFF_WTOT + 64, OFF_C = 73728  , ATT_LDS_BYTES = OFF_C + 32768;
constexpr float SCALE = 0.08838834764831845f;
constexpr float THR = 8.f;
typedef short s16x4 __attribute__((ext_vector_type(4)));
typedef unsigned u32x4 __attribute__((ext_vector_type(4)));
#define KSWZ(row, colB) ((row) * 256 + ((colB) ^ (((row) & 7) << 4)))
#define SBAR() __builtin_amdgcn_sched_barrier(0)
__device__ __forceinline__ int v_st(int k, int c) { const int kk = (k & ~0xC) | ((k & 4) << 1) | ((k & 8) >> 1); return ((kk >> 3) * 4 + (c >> 5)) * 512 + ((kk & 7) * 32 + (c & 31)) * 2; }
__device__ __forceinline__ int v_rd_base(int lane) { return ((lane & 3) << 3) | (((lane >> 2) & 3) << 6) | (((lane >> 4) & 1) << 5) | (((lane >> 5) & 1) << 8); }
constexpr int v_rd_off(int d0, int ks, int half) { return d0 * 512 + ks * 4096 + half * 2048; }
__device__ __forceinline__ int crow(int r, int hi) { return (r & 3) + 8 * (r >> 2) + 4 * hi; }
__device__ __forceinline__ unsigned cvtpk(float lo, float hi) { unsigned r; asm volatile("v_cvt_pk_bf16_f32 %0, %1, %2" : "=v"(r) : "v"(lo), "v"(hi)); return r; }
__device__ __forceinline__ bf16x8 load8(const bf16* p) { return *reinterpret_cast<const bf16x8*>(p); }
__device__ __forceinline__ void mask_tile(f32x16& p0, f32x16& p1, int dq) {
    const float NEG = -__builtin_inff();
#pragma unroll
    for (int r = 0; r < 16; ++r) { const int c = (r & 3) + 8 * (r >> 2); if (dq - c < 0) p0[r] = NEG; if (dq - c - 32 < 0) p1[r] = NEG; }
}
__device__ __forceinline__ void partialSM(f32x16& p0, f32x16& p1, float& m_reg, float& mn, float& alpha) {
    float pmax = p0[0]; for (int r = 1; r < 16; ++r) pmax = fmaxf(pmax, p0[r]); for (int r = 0; r < 16; ++r) pmax = fmaxf(pmax, p1[r]);
    { auto rr = __builtin_amdgcn_permlane32_swap(__float_as_uint(pmax), __float_as_uint(pmax), false, false);
      pmax = fmaxf(__uint_as_float(rr[0]), __uint_as_float(rr[1])); }
    constexpr float C2 = 1.4426950408889634f * SCALE;
    if (__builtin_expect(__all((pmax - m_reg) * SCALE <= THR), 1)) { mn = m_reg; alpha = 1.f; }
    else { mn = fmaxf(m_reg, pmax); alpha = __builtin_amdgcn_exp2f((m_reg - mn) * C2); m_reg = mn; }
    const float mnL = -mn * C2;
    for (int r = 0; r < 16; ++r) p0[r] = fmaf(p0[r], C2, mnL); for (int r = 0; r < 16; ++r) p1[r] = fmaf(p1[r], C2, mnL);
    for (int r = 0; r < 16; ++r) p0[r] = __builtin_amdgcn_exp2f(p0[r]);
}
#define PK4(P, B_, OUT) do { unsigned a0 = cvtpk(P[B_+0], P[B_+1]), a1 = cvtpk(P[B_+2], P[B_+3]);                          \
        unsigned b0 = cvtpk(P[B_+4], P[B_+5]), b1 = cvtpk(P[B_+6], P[B_+7]);                                             \
        auto r0 = __builtin_amdgcn_permlane32_swap(a0, b0, false, false); auto r1 = __builtin_amdgcn_permlane32_swap(a1, b1, false, false); \
        u32x4 w = {r0[0], r1[0], r0[1], r1[1]}; OUT = *reinterpret_cast<bf16x8*>(&w); } while (0)
__device__ __forceinline__ void finishSM(f32x16& p0, f32x16& p1, float alpha, float& l_reg, bf16x8& pa0, bf16x8& pa1, bf16x8& pa2, bf16x8& pa3) {
    for (int r = 0; r < 16; ++r) p1[r] = __builtin_amdgcn_exp2f(p1[r]);
    float ps = 0; for (int r = 0; r < 16; ++r) ps += p0[r]; for (int r = 0; r < 16; ++r) ps += p1[r];
    { auto rr = __builtin_amdgcn_permlane32_swap(__float_as_uint(ps), __float_as_uint(ps), false, false);
      ps = __uint_as_float(rr[0]) + __uint_as_float(rr[1]); }
    l_reg = l_reg * alpha + ps;
    PK4(p0, 0, pa0); PK4(p0, 8, pa1); PK4(p1, 0, pa2); PK4(p1, 8, pa3);
}
template <int KB>
__device__ __forceinline__ void qkt(f32x16& p0, f32x16& p1, const char* K_lds, int r32, int hi, const bf16x8* qr) {
    p0 = f32x16{}; p1 = f32x16{};
    const char* kb[4];
#pragma unroll
    for (int dd = 0; dd < 4; ++dd) kb[dd] = K_lds + KB * SHM_K + KSWZ(r32, (dd * 16 + hi * 8) * 2);
#pragma unroll
    for (int d0 = 0; d0 < 8; ++d0) { const char* a = kb[d0 & 3] + (d0 >> 2) * 128;
        bf16x8 b0 = *reinterpret_cast<const bf16x8*>(a);
        bf16x8 b1 = *reinterpret_cast<const bf16x8*>(a + 32 * 256);
        p0 = __builtin_amdgcn_mfma_f32_32x32x16_bf16(b0, qr[d0], p0, 0, 0, 0);
        p1 = __builtin_amdgcn_mfma_f32_32x32x16_bf16(b1, qr[d0], p1, 0, 0, 0); }
}
template <int VB>
__device__ __forceinline__ void pv_tile(f32x16* o, int vb0, bf16x8 pa0, bf16x8 pa1, bf16x8 pa2, bf16x8 pa3) {
#define TRRD(dst, off) asm volatile("ds_read_b64_tr_b16 %0, %1 offset:%2" : "=&v"(dst) : "v"(vb0), "i"(off) : "memory")
#define PV_D0(d0) do { s16x4 l0, l1, l2, l3, h0, h1, h2, h3; constexpr int b_ = VB * SHM_V + v_rd_off(d0, 0, 0); \
        TRRD(l0, b_); TRRD(h0, b_ + 2048); TRRD(l1, b_ + 4096); TRRD(h1, b_ + 6144); TRRD(l2, b_ + 8192); TRRD(h2, b_ + 10240); TRRD(l3, b_ + 12288); TRRD(h3, b_ + 14336); \
        asm volatile("s_waitcnt lgkmcnt(0)" ::: "memory"); SBAR();   \
        o[d0] = __builtin_amdgcn_mfma_f32_32x32x16_bf16(pa0, (bf16x8){l0[0], l0[1], l0[2], l0[3], h0[0], h0[1], h0[2], h0[3]}, o[d0], 0, 0, 0);   \
        o[d0] = __builtin_amdgcn_mfma_f32_32x32x16_bf16(pa1, (bf16x8){l1[0], l1[1], l1[2], l1[3], h1[0], h1[1], h1[2], h1[3]}, o[d0], 0, 0, 0);   \
        o[d0] = __builtin_amdgcn_mfma_f32_32x32x16_bf16(pa2, (bf16x8){l2[0], l2[1], l2[2], l2[3], h2[0], h2[1], h2[2], h2[3]}, o[d0], 0, 0, 0);   \
        o[d0] = __builtin_amdgcn_mfma_f32_32x32x16_bf16(pa3, (bf16x8){l3[0], l3[1], l3[2], l3[3], h3[0], h3[1], h3[2], h3[3]}, o[d0], 0, 0, 0); } while (0)
    PV_D0(0); PV_D0(1); PV_D0(2); PV_D0(3);
#undef PV_D0
#undef TRRD
}
__device__ __forceinline__ void key_bias(f32x16& p0, f32x16& p1, const char* lds, int kbase, int hi) {
    const float* kbp = (const float*)(lds + OFF_C) + kbase + 4 * hi;
#pragma unroll
    for (int g = 0; g < 4; ++g) { const f32x4 b0 = *(const f32x4*)(kbp + 8 * g), b1 = *(const f32x4*)(kbp + 32 + 8 * g);
#pragma unroll
        for (int e = 0; e < 4; ++e) { p0[4 * g + e] -= b0[e]; p1[4 * g + e] -= b1[e]; } }
}
__device__ __forceinline__ void cgate_scan(const float* logf_h, char* lds, const int WAVE_) {
    const int lane = lane_id(), tid = WAVE_ * 64 + lane;
    float* Cl = (float*)(lds + OFF_C); float* wtot = (float*)(lds + OFF_WTOT);
    const float* src = logf_h + tid * 16;
    const f32x4 a = *(const f32x4*)src, b = *(const f32x4*)(src + 4), c = *(const f32x4*)(src + 8), d = *(const f32x4*)(src + 12);
    const float in[16] = {a[0], a[1], a[2], a[3], b[0], b[1], b[2], b[3], c[0], c[1], c[2], c[3], d[0], d[1], d[2], d[3]};
    float loc[16]; float s = 0.f;
#pragma unroll
    for (int j = 0; j < 16; ++j) { s += in[j]; loc[j] = s; }
    float incl = s;
#pragma unroll
    for (int o = 1; o < 64; o <<= 1) { const float t = __builtin_bit_cast(float, __builtin_amdgcn_ds_bpermute((lane - o) << 2, __builtin_bit_cast(int, incl))); if (lane >= o) incl += t; }
    if (lane == 63) wtot[WAVE_] = incl;
    __syncthreads();
    float base = incl - s;
    for (int w = 0; w < WAVE_; ++w) base += wtot[w];
#pragma unroll
    for (int j = 0; j < 16; j += 4) *(f32x4*)(Cl + tid * 16 + j) = (f32x4){base + loc[j], base + loc[j + 1], base + loc[j + 2], base + loc[j + 3]} * (1.0f / SCALE);
    __syncthreads();
}

struct BlockRef { const bf16* Q; const bf16* K; const bf16* V; bf16* O; int P0; };
struct Seam { bf16x8 qr[8]; bf16x8 st_v0, st_v1, st_k0, st_k1; };
#define ROW(p, k0, rr) ((p) + (size_t)((k0) + (rr)) * PITCH + sc)
#define VMW() asm volatile("s_waitcnt vmcnt(0)" ::: "memory")
#define VMWN(n) asm volatile("s_waitcnt vmcnt(%0)" :: "i"(n) : "memory")
#define SLOAD_H(Kp, Vp, k0) do { S.st_v0 = load8(ROW(Vp, k0, sr)); S.st_v1 = load8(ROW(Vp, k0, 32 + sr));              \
                         S.st_k0 = load8(ROW(Kp, k0, sr)); S.st_k1 = load8(ROW(Kp, k0, 32 + sr)); } while (0)
#define SWRITE_HK(bf) do { *(bf16x8*)(K_lds + (bf) * SHM_K + kws) = S.st_k0; *(bf16x8*)(K_lds + (bf) * SHM_K + kws + 32 * 256) = S.st_k1; } while (0)
#define SWRITE_HV(bf) do { *(bf16x8*)(V_lds + (bf) * SHM_V + vst0) = S.st_v0; *(bf16x8*)(V_lds + (bf) * SHM_V + vst1) = S.st_v1; } while (0)
#define SWRITE_H(bf) do { SWRITE_HV(bf); SWRITE_HK(bf); } while (0)
__device__ __forceinline__ void fox_prime(const BlockRef& cur, char* lds, Seam& S, const int WAVE_) {
    const int tid = TID(), wid = __builtin_amdgcn_readfirstlane(tid >> 6), lane = tid & 63, r32 = lane & 31, hi = lane >> 5;
    const int sr = tid >> 4, sc = (tid & 15) * 8, kws = KSWZ(sr, sc * 2); char* K_lds = lds + 2 * SHM_V;
    for (int d0 = 0; d0 < 8; ++d0) S.qr[d0] = load8(cur.Q + (size_t)(wid * QBLK + r32) * PITCH + d0 * 16 + hi * 8);
    SLOAD_H(cur.K, cur.V, ((cur.P0 + QB - 1) / KVBLK) * KVBLK); VMW(); SWRITE_HK(0);
    __syncthreads();
}
__device__ __forceinline__ void fox_block(const BlockRef& cur, const BlockRef& nxt, const float Uq, char* lds, Seam& S, const int WAVE_) {
    const int tid = TID(), wid = __builtin_amdgcn_readfirstlane(tid >> 6), lane = tid & 63, r32 = lane & 31, hi = lane >> 5;
    const int NT0 = (cur.P0 + QB - 1) / KVBLK + 1;
    int NT = NT0;
    volatile LAS int* flg = (volatile LAS int*)(lds + OFF_FLAG);
    const int qlo = cur.P0 + wid * QBLK, qm = qlo + r32 - 4 * hi;
    char* V_lds = lds; char* K_lds = lds + 2 * SHM_V;
    float* ws = (float*)(lds + OFF_WS) + wid * 64; float* li_l = ws, * al_l = ws + 32;
    float m_reg = -1e30f, l_reg = 0; f32x16 o[4] = {};
    const int sr = tid >> 4, sc = (tid & 15) * 8, vst0 = v_st(sr, sc), vst1 = v_st(32 + sr, sc), kws = KSWZ(sr, sc * 2);
    const int vb0 = (int)(uintptr_t)V_lds + v_rd_base(lane);
    const bf16* Kh = cur.K; const bf16* Vh = cur.V;
#define RESC(a) do { if (__any((a) < 1.f)) { if (hi == 0) al_l[r32] = (a); asm volatile("s_waitcnt lgkmcnt(0)" ::: "memory");              \
                     for (int d_ = 0; d_ < 4; ++d_) for (int r = 0; r < 16; ++r) o[d_][r] *= al_l[crow(r, hi)]; } } while (0)
#define KBASE(t) ((NT0 - 1 - (t)) * KVBLK)
#define MASKT(P0_, P1_, t, KBUF) do { const int kb_ = KBASE(t); key_bias(P0_, P1_, lds, kb_, hi); if (kb_ + KVBLK - 1 > qlo) mask_tile(P0_, P1_, qm - kb_); } while (0)
#define SEAM_K0() do { VMWN(8); SWRITE_HK(0); SBAR(); } while (0)
    f32x16 pA0, pA1, pB0, pB1; float mnA, mnB, alA, alB; bf16x8 pa0, pa1, pa2, pa3;
    SWRITE_HV(0); SBAR();
    if (NT > 1) { SLOAD_H(Kh, Vh, KBASE(1)); }
    SBAR(); qkt<0>(pA0, pA1, K_lds, r32, hi, S.qr);
    MASKT(pA0, pA1, 0, 0); partialSM(pA0, pA1, m_reg, mnA, alA);
    if (NT > 1) { VMW(); SWRITE_H(1); }
    __syncthreads();
#define VOTE(t) do { bool can_ = false; if ((t) + 2 < NT) { const float negc_ = -((const float*)(lds + OFF_C))[KBASE((t) + 2) + KVBLK - 1]; can_ = __all((Uq + negc_ - m_reg) * SCALE <= -104.f) != 0; } \
                     if (lane == 0) flg[wid] = can_ ? 1 : 0; } while (0)
#define DECIDE(t) do { int all_ = 1; _Pragma("unroll") for (int w_ = 0; w_ < 8; ++w_) all_ &= flg[w_]; if (all_ && (t) + 2 < NT) NT = (t) + 2; } while (0)
#define HALF_STEP(PX0, PX1, mnX, alX, PY0, PY1, alY, t, KB, VB, SB) do {                                                      \
        SBAR(); qkt<KB>(PX0, PX1, K_lds, r32, hi, S.qr);                                                                     \
        finishSM(PY0, PY1, alY, l_reg, pa0, pa1, pa2, pa3); SBAR();                                                           \
        if ((t) + 1 < NT) { SLOAD_H(Kh, Vh, KBASE((t) + 1)); SBAR(); }                                                    \
        pv_tile<VB>(o, vb0, pa0, pa1, pa2, pa3); MASKT(PX0, PX1, (t), KB); partialSM(PX0, PX1, m_reg, mnX, alX); VOTE(t);    \
        __syncthreads(); DECIDE(t);                                                                                           \
        if ((t) + 1 < NT) { VMW(); SWRITE_H(SB); }                                                                            \
        RESC(alX); __syncthreads(); } while (0)
    for (int t = 1; t + 1 < NT; t += 2) {
        HALF_STEP(pB0, pB1, mnB, alB, pA0, pA1, alA, t, 1, 0, 0);
        HALF_STEP(pA0, pA1, mnA, alA, pB0, pB1, alB, t + 1, 0, 1, 1);
    }
    const bool even = (NT & 1) == 0;
    if (even) { SBAR(); qkt<1>(pB0, pB1, K_lds, r32, hi, S.qr); SBAR(); }
    SLOAD_H(nxt.K, nxt.V, ((nxt.P0 + QB - 1) / KVBLK) * KVBLK); SBAR();
#pragma unroll
    for (int d0 = 0; d0 < 8; ++d0) S.qr[d0] = load8(nxt.Q + (size_t)(wid * QBLK + r32) * PITCH + d0 * 16 + hi * 8);
    SBAR();
    finishSM(pA0, pA1, alA, l_reg, pa0, pa1, pa2, pa3); SBAR();
    pv_tile<0>(o, vb0, pa0, pa1, pa2, pa3);
    if (even) { MASKT(pB0, pB1, NT - 1, 1); partialSM(pB0, pB1, m_reg, mnB, alB); __syncthreads(); RESC(alB);
        finishSM(pB0, pB1, alB, l_reg, pa0, pa1, pa2, pa3); SBAR(); pv_tile<1>(o, vb0, pa0, pa1, pa2, pa3); }
    SBAR(); SEAM_K0();
    if (hi == 0) li_l[r32] = l_reg; asm volatile("s_waitcnt lgkmcnt(0)" ::: "memory");
    float rli[16];
#pragma unroll
    for (int r = 0; r < 16; ++r) rli[r] = __builtin_amdgcn_rcpf(li_l[crow(r, hi)]);
    bf16* Ow = cur.O + (size_t)(wid * QBLK) * PITCH;
#pragma unroll
    for (int r = 0; r < 16; ++r) { const int orow = crow(r, hi);
#pragma unroll
        for (int d0 = 0; d0 < 4; ++d0) { const float v = o[d0][r] * rli[r];
            const float vn = __shfl_xor(v, 1);
            if ((r32 & 1) == 0) *(unsigned*)(Ow + (size_t)orow * PITCH + d0 * 32 + r32) = cvtpk(v, vn); } }
    __syncthreads();
#undef RESC
#undef MASKT
#undef SEAM_K0
#undef HALF_STEP
#undef VOTE
#undef DECIDE
#undef KBASE
}

template <int BUF>
__device__ __forceinline__ void sb_tile(f32x16* o, float& R, const char* K_lds, int vb0, int r32, int hi, const bf16x8* qr, int dq) {
    f32x16 p0, p1;
    qkt<BUF>(p0, p1, K_lds, r32, hi, qr);
    constexpr float L2E = 1.4426950408889634f, LN2 = 0.6931471805599453f;
    f32x16 l0, l1;
    const float NEG = -__builtin_inff();
#pragma unroll
    for (int r = 0; r < 16; ++r) { const int c = (r & 3) + 8 * (r >> 2);
        { const float z = p0[r] * SCALE; const float sp = fmaxf(z, 0.f) + LN2 * __builtin_amdgcn_logf(1.0f + __builtin_amdgcn_exp2f(-fabsf(z) * L2E)); const bool st = (dq - c) >= 1; l0[r] = st ? -sp : 0.f; p0[r] = st ? (z - sp) : NEG; }
        { const float z = p1[r] * SCALE; const float sp = fmaxf(z, 0.f) + LN2 * __builtin_amdgcn_logf(1.0f + __builtin_amdgcn_exp2f(-fabsf(z) * L2E)); const bool st = (dq - c - 32) >= 1; l1[r] = st ? -sp : 0.f; p1[r] = st ? (z - sp) : NEG; } }
    float gs[8], pg[8], ps[8];
#pragma unroll
    for (int g = 0; g < 4; ++g) { gs[g] = (l0[4 * g] + l0[4 * g + 1]) + (l0[4 * g + 2] + l0[4 * g + 3]); gs[4 + g] = (l1[4 * g] + l1[4 * g + 1]) + (l1[4 * g + 2] + l1[4 * g + 3]); }
#pragma unroll
    for (int g = 0; g < 8; ++g) { auto rr = __builtin_amdgcn_permlane32_swap(__float_as_uint(gs[g]), __float_as_uint(gs[g]), false, false);
        const float lo = __uint_as_float(rr[0]), hv = __uint_as_float(rr[1]); ps[g] = lo + hv; pg[g] = hi ? lo : hv; }
    float acc = R;
#pragma unroll
    for (int g = 7; g >= 0; --g) {
        float run = hi ? acc : acc + pg[g];
        acc += ps[g];
        if (g >= 4) { const int b = 4 * (g - 4);
#pragma unroll
            for (int e = 3; e >= 0; --e) { const float t = l1[b + e]; p1[b + e] = __builtin_amdgcn_exp2f((p1[b + e] + run) * L2E); run += t; } }
        else { const int b = 4 * g;
#pragma unroll
            for (int e = 3; e >= 0; --e) { const float t = l0[b + e]; p0[b + e] = __builtin_amdgcn_exp2f((p0[b + e] + run) * L2E); run += t; } }
    }
    R = acc;
    bf16x8 pa0, pa1, pa2, pa3;
    PK4(p0, 0, pa0); PK4(p0, 8, pa1); PK4(p1, 0, pa2); PK4(p1, 8, pa3);
    pv_tile<BUF>(o, vb0, pa0, pa1, pa2, pa3);
}
__device__ __forceinline__ void sb_block(const BlockRef& cur, char* lds, const int WAVE_) {
    const int tid = TID(), wid = __builtin_amdgcn_readfirstlane(tid >> 6), lane = tid & 63, r32 = lane & 31, hi = lane >> 5;
    const int NT = (cur.P0 + QB - 1) / KVBLK + 1;
    const int qlo = cur.P0 + wid * QBLK, qm = qlo + r32 - 4 * hi;
    char* V_lds = lds; char* K_lds = lds + 2 * SHM_V;
    volatile LAS int* flg = (volatile LAS int*)(lds + OFF_FLAG);
    const int sr = tid >> 4, sc = (tid & 15) * 8, vst0 = v_st(sr, sc), vst1 = v_st(32 + sr, sc), kws = KSWZ(sr, sc * 2);
    const int vb0 = (int)(uintptr_t)V_lds + v_rd_base(lane);
    const bf16* Kh = cur.K; const bf16* Vh = cur.V;
    bf16x8 qr[8];
#pragma unroll
    for (int d0 = 0; d0 < 8; ++d0) qr[d0] = load8(cur.Q + (size_t)(wid * QBLK + r32) * PITCH + d0 * 16 + hi * 8);
    bf16x8 st_v0, st_v1, st_k0, st_k1;
#define SB_LOAD(k0) do { st_v0 = load8(ROW(Vh, k0, sr)); st_v1 = load8(ROW(Vh, k0, 32 + sr)); st_k0 = load8(ROW(Kh, k0, sr)); st_k1 = load8(ROW(Kh, k0, 32 + sr)); } while (0)
#define SB_WRITE(bf) do { *(bf16x8*)(V_lds + (bf) * SHM_V + vst0) = st_v0; *(bf16x8*)(V_lds + (bf) * SHM_V + vst1) = st_v1; \
                          *(bf16x8*)(K_lds + (bf) * SHM_K + kws) = st_k0; *(bf16x8*)(K_lds + (bf) * SHM_K + kws + 32 * 256) = st_k1; } while (0)
    f32x16 o[4] = {}; float R = 0.f; bool fin = false;
    SB_LOAD((NT - 1) * KVBLK); VMW(); SB_WRITE(0);
    if (NT > 1) SB_LOAD((NT - 2) * KVBLK);
    __syncthreads();
#define SB_STEP(t, BUF) do { const int kb_ = (NT - 1 - (t)) * KVBLK;                                                         \
        if (!fin && kb_ <= qlo + QBLK - 2) { sb_tile<BUF>(o, R, K_lds, vb0, r32, hi, qr, qm - kb_); fin = __all(R < -105.f); } \
        if ((t) + 1 < NT) { VMW(); SB_WRITE((BUF) ^ 1); if ((t) + 2 < NT) SB_LOAD((NT - 3 - (t)) * KVBLK); }                   \
        if (lane == 0) flg[(BUF) * 8 + wid] = fin ? 1 : 0;                                                                   \
        __syncthreads();                                                                                                      \
        { int all_ = 1; _Pragma("unroll") for (int w_ = 0; w_ < 8; ++w_) all_ &= flg[(BUF) * 8 + w_]; stop = all_ != 0; } } while (0)
    bool stop = false;
    for (int t = 0; t < NT; t += 2) {
        SB_STEP(t, 0);
        if (stop || t + 1 >= NT) break;
        SB_STEP(t + 1, 1);
        if (stop) break;
    }
    bf16* Ow = cur.O + (size_t)(wid * QBLK) * PITCH;
#pragma unroll
    for (int r = 0; r < 16; ++r) { const int orow = crow(r, hi);
#pragma unroll
        for (int d0 = 0; d0 < 4; ++d0) { const float v = o[d0][r];
            const float vn = __shfl_xor(v, 1);
            if ((r32 & 1) == 0) *(unsigned*)(Ow + (size_t)orow * PITCH + d0 * 32 + r32) = cvtpk(v, vn); } }
    __syncthreads();
#undef SB_LOAD
#undef SB_WRITE
#undef SB_STEP
}
#undef ROW
#undef VMW
#undef VMWN
#undef SLOAD_H
#undef SWRITE_HK
#undef SWRITE_HV
#undef SWRITE_H
#undef PK4
#undef KSWZ
}

constexpr int REP_X3 = 0;
constexpr int REP_X2 = 0;
constexpr int X1_PAD = 0;
constexpr int X1_ALIGN = 1, X1_SP2 = 1, X1_CONSTA = 0;
constexpr int REP_X1 = 0, REP_X1N = 20480;
constexpr int REP_ATT = 1;
constexpr int REP_P0W = 1, REP_P0R = 1;
constexpr int REP_P0 = 1, REP_P1 = 1, REP_FOX = 1, REP_SB = 1, REP_P3A = 1, REP_P5 = 1, REP_P5B = 1, REP_P7A = 1;
enum { PH_P0 = 0, PH_P1, PH_P1B, PH_ATT, PH_P3A, PH_P3B, PH_P4, PH_P5, PH_P5B, PH_P6, PH_P7A, PH_P7, PH_N };
__global__ void __launch_bounds__(NWAVES * 64, 2) mega_fwd(Params P) {
    extern __shared__ __attribute__((aligned(16))) unsigned char lds[];
    Frame F;
    F.lds = (LAS unsigned char*)lds;
    F.MISC = (volatile LAS unsigned*)(F.lds + MISC_OFF);
    F.wave = __builtin_amdgcn_readfirstlane((int)(__builtin_amdgcn_workitem_id_x() >> 6));
    const int WAVE_ = F.wave; const int f_tid = TID();
    F.G = gridDim.x; { const int bx = blockIdx.x; F.vcu = (F.G % 8 == 0) ? (bx % 8) * (F.G / 8) + bx / 8 : bx; }
    unsigned char* ws = P.ws;
    F.ctl = (gu32*)(ws + WS_CTL);
    for (int u = f_tid; u < (LDS_BYTES - LDSCTL_OFF) / 4; u += NWAVES * 64) ((LAS unsigned*)(F.lds + LDSCTL_OFF))[u] = 0u;
    __syncthreads();
    XcdBarrier bar = xcd_barrier_post((unsigned*)(F.ctl + CW_BAR) + P.li * XCD_BAR_WORDS, F.MISC + 8, F.wave);
    const int lo = P.ph_lo, hi = P.ph_hi;
#define IN(k) (lo <= (k) && (k) < hi)
#define SEAM(k) do { if (IN(k) && IN((k) + 1)) xcd_barrier(bar); } while (0)
    bf16* W_in = (bf16*)(ws + WS_WIN); bf16* XB = (bf16*)(ws + WS_XB);
    float* ss1 = (float*)(ws + WS_SS1); float* ss2 = (float*)(F.ctl + CW_SS2); float* ss3 = (float*)(F.ctl + CW_SS3);
    bf16* QKV = (bf16*)(ws + WS_QKV); bf16* GATES = (bf16*)(ws + WS_GATES); bf16* Y = (bf16*)(ws + WS_Y); bf16* MERGED = (bf16*)(ws + WS_MERGED);
    LAS unsigned char* ring = F.lds + RING_OFF;

    if (IN(PH_P0)) { for (int rep = 0; rep < REP_P0; ++rep) { for (int r2 = 0; r2 < REP_P0W; ++r2) p0_weights(F, P); for (int r2 = 0; r2 < REP_P0R; ++r2) p0_rows(F, P); } }
    SEAM(PH_P0);
    if (IN(PH_P1)) { p1b_qknorm_fgate(F, P);
      for (int rep = 0; rep < REP_P1; ++rep) {
        pg8::Gemm g{XB, W_in, S, NPROJ, DM}; ConvOrder So; So.init(S, NPROJ, F.G, (int)blockIdx.x); So.P = &P; So.wave = F.wave; So.slot = 0;
        pg8::EpiProj E{QKV, GATES, ss1, P.in[5], P.in[6], (LAS float*)(F.lds + XCH_OFF)};
        pg8::gemm_phase<pg8::EpiProj, ConvOrder, false, true>(ring, g, So, E, F.wave);
    } }
    if (IN(PH_P1)) { for (int rep = 0; rep < REP_X1; ++rep) {
        pg8::Gemm g{X1_CONSTA ? (bf16*)(ws + WS_ACT) : XB, W_in, S, REP_X1N, DM, DM + X1_PAD, DM + X1_PAD}; pg8::StaticOrder So; So.init(S, REP_X1N, F.G, (int)blockIdx.x);
        pg8::EpiNull E{};
        pg8::gemm_phase<pg8::EpiNull, pg8::StaticOrder, false, true>(ring, g, So, E, F.wave);
    } }
    if (IN(PH_P1)) { for (int rep = 0; rep < REP_X2; ++rep) {
        struct SameOrder : pg8::StaticOrder { __device__ bool next(int i, pg8::Unit& u) const { const bool ok = pg8::StaticOrder::next(i, u); u.pm = 0; u.pn = 0; return ok; } };
        pg8::Gemm g{XB, W_in, S, NPROJ, DM}; SameOrder So; So.init(S, NPROJ, F.G, (int)blockIdx.x);
        pg8::EpiNull E{};
        pg8::gemm_phase<pg8::EpiNull, SameOrder, true, true>(ring, g, So, E, F.wave);
    } }
    if (IN(PH_P1)) { for (int rep = 0; rep < REP_X3; ++rep) {
        const long long c0 = clock64();
        pg8::Gemm g{XB, W_in, S, NPROJ, DM}; pg8::StaticOrder So; So.init(S, NPROJ, F.G, (int)blockIdx.x);
        pg8::EpiNull E{};
        pg8::gemm_phase<pg8::EpiNull, pg8::StaticOrder, false, true>(ring, g, So, E, F.wave);
        const long long extra = (clock64() - c0) >> 7; const long long t1 = wall_clock64();
        while (wall_clock64() - t1 < extra) __builtin_amdgcn_s_sleep(10);
    } }
    SEAM(PH_P1);
    if (IN(PH_ATT)) {
        char* al = (char*)lds + RING_OFF;
        const size_t T = (size_t)S * WF;
        gu32* qctr = F.ctl + CW_QATT; volatile LAS int* nx = (volatile LAS int*)(F.lds + RING_OFF + att::OFF_NEXT);
        const int a_lane = lane_id(); const bool puller = (F.wave == 0 && a_lane == 0);
        float gqm = fmaxf(fabsf(P.in[5][a_lane]), fabsf(P.in[5][a_lane + 64])), gkm = fmaxf(fabsf(P.in[6][a_lane]), fabsf(P.in[6][a_lane + 64]));
#pragma unroll
        for (int o = 1; o < 64; o <<= 1) { gqm = fmaxf(gqm, __shfl_xor(gqm, o)); gkm = fmaxf(gkm, __shfl_xor(gkm, o)); }
        const float Uq = __builtin_bit_cast(float, __builtin_amdgcn_readfirstlane(__builtin_bit_cast(int, 128.0f * gqm * gkm * 1.02f)));
        for (int arep = 0; arep < REP_ATT; ++arep) {
        if (arep > 0) { xcd_barrier(bar); if (blockIdx.x == 0 && puller) __hip_atomic_store(qctr, 0u, RLX_AGENT); xcd_barrier(bar); }
        if (puller) nx[0] = (int)__hip_atomic_fetch_add(qctr, 1u, RLX_AGENT);
        __syncthreads();
        int item = nx[0];
        __syncthreads();
        {
            bool primed = false; att::Seam Sm;
            while (item < NH * 32) {
                int pulled = 0;
                if (puller) pulled = (int)__hip_atomic_fetch_add(qctr, 1u, RLX_AGENT);
                const int h = item & 15, qb = 31 - (item >> 4);
                att::cgate_scan((const float*)(ws + WS_LOGF) + (size_t)h * S, al, F.wave);
                if (puller) nx[0] = pulled;
                att::BlockRef cur; cur.Q = QKV + (size_t)(qb * 256) * WF + h * HD; cur.K = QKV + T + h * HD; cur.V = QKV + 2 * T + h * HD; cur.O = Y + (size_t)(qb * 256) * WF + h * HD; cur.P0 = qb * 256;
                if (!primed) att::fox_prime(cur, al, Sm, F.wave); else __syncthreads();
                const int nitem = nx[0];
                att::BlockRef nxt = cur; primed = false;
                if (nitem < NH * 32) { const int h2 = nitem & 15, q2 = 31 - (nitem >> 4);
                    nxt.Q = QKV + (size_t)(q2 * 256) * WF + h2 * HD; nxt.K = QKV + T + h2 * HD; nxt.V = QKV + 2 * T + h2 * HD; nxt.O = Y + (size_t)(q2 * 256) * WF + h2 * HD; nxt.P0 = q2 * 256; primed = true; }
                att::fox_block(cur, nxt, Uq, al, Sm, F.wave);
                item = nitem;
            }
        }
        while (item < 2 * NH * 32) {
            int pulled = 0;
            if (puller) pulled = (int)__hip_atomic_fetch_add(qctr, 1u, RLX_AGENT);
            const int L = item - NH * 32, h = L & 15, qb = 31 - (L >> 4);
            att::BlockRef b; b.Q = QKV + 3 * T + (size_t)(qb * 256) * WF + h * HD; b.K = QKV + 4 * T + h * HD; b.V = QKV + 5 * T + h * HD; b.O = Y + T + (size_t)(qb * 256) * WF + h * HD; b.P0 = qb * 256;
            if (puller) nx[0] = pulled;
            att::sb_block(b, al, F.wave);
            item = nx[0];
            __syncthreads();
        }
        }
    }
    SEAM(PH_ATT);
    if (IN(PH_P3A)) {
        pg8::Gemm g{Y, (bf16*)(ws + WS_WBF), S, DM, WF}; pg8::TwoPartOrder So; So.init(S, DM, F.G, (int)blockIdx.x); So.A1 = Y + (size_t)S * WF; So.B1 = (bf16*)(ws + WS_WBS);
        pg8::EpiGate2 E{MERGED, GATES, GATES + (size_t)S * DM};
        pg8::gemm_phase<pg8::EpiGate2, pg8::TwoPartOrder, false, true>(ring, g, So, E, F.wave);
    }
    SEAM(PH_P3B);
    if (IN(PH_P4)) {
        pg8::Gemm g{MERGED, (bf16*)(ws + WS_WOUT), S, DM, DM}; pg8::StaticOrder So; So.init(S, DM, F.G, (int)blockIdx.x);
        pg8::EpiResStat E{P.in[0], P.out, XB, ss2};
        pg8::gemm_phase<pg8::EpiResStat, pg8::StaticOrder, false, true>(ring, g, So, E, F.wave);
    }
    SEAM(PH_P4);
    if (IN(PH_P5)) { for (int rep = 0; rep < REP_P5; ++rep) {
        pg8::Gemm g{XB, (bf16*)(ws + WS_WUP), S, 2 * DFF, DM}; pg8::StaticOrder So; So.init(S, 2 * DFF, F.G, (int)blockIdx.x);
        pg8::EpiConvGlu E{(bf16*)(ws + WS_ACT), (float*)(ws + WS_EDGE), ss2, P.in[12], P.in[13], (LAS float*)(F.lds + XCH_OFF)};
        pg8::gemm_phase<pg8::EpiConvGlu, pg8::StaticOrder, true, true>(ring, g, So, E, F.wave);
      }
      {
        const int nwg5 = (S / 256) * (2 * DFF / 256), n_extra = nwg5 % F.G, Gi = F.G - n_extra, ci = (int)blockIdx.x - n_extra;
        if (ci >= 0) {
            pg8::Gemm g{(bf16*)(ws + WS_PB), (bf16*)(ws + WS_WPP), S, DM, PLE}; pg8::StaticOrder So; So.init(S, DM, Gi, ci);
            pg8::EpiStoreBf16x4 E{(bf16*)(ws + WS_PP)};
            pg8::gemm_phase<pg8::EpiStoreBf16x4, pg8::StaticOrder, false, true>(ring, g, So, E, F.wave);
        }
      }
    }
    SEAM(PH_P5);
    if (IN(PH_P5B)) { for (int rep = 0; rep < REP_P5B; ++rep) p5c_fixup(F, P); }
    SEAM(PH_P5B);
    if (IN(PH_P6)) {
        pg8::Gemm g{(bf16*)(ws + WS_ACT), (bf16*)(ws + WS_WDN), S, DM, DFF}; pg8::StaticOrder So; So.init(S, DM, F.G, (int)blockIdx.x);
        pg8::EpiResStat E{P.out, P.out, XB, ss3};
        pg8::gemm_phase<pg8::EpiResStat, pg8::StaticOrder, false, true>(ring, g, So, E, F.wave);
    }
    SEAM(PH_P6);
    if (IN(PH_P7)) {
        pg8::Gemm g{XB, (bf16*)(ws + WS_WPG), S, DM, DM}; pg8::StaticOrder So; So.init(S, DM, F.G, (int)blockIdx.x);
        pg8::EpiPle E{P.out, (const bf16*)(ws + WS_PP), ss3};
        pg8::gemm_phase<pg8::EpiPle, pg8::StaticOrder, false, true>(ring, g, So, E, F.wave);
    }
#undef IN
#undef SEAM
}

extern "C" void kernel_launch(void* const* d_in, const int* in_sizes, int n_in, void* d_out, int out_size, void* d_ws, size_t ws_size, hipStream_t stream) {
    static int grid = 0;
    if (grid == 0) {
        if (n_in != 18 || out_size != S * DM || ws_size < WS_END) { fprintf(stderr, "kernel_launch: unexpected shapes / workspace (%d inputs, out %d, ws %zu < %zu)\n", n_in, out_size, ws_size, (size_t)WS_END); grid = -1; return; }
        int dev = 0, cus = 0, per_cu = 0;
        if (hipGetDevice(&dev) != hipSuccess || hipDeviceGetAttribute(&cus, hipDeviceAttributeMultiprocessorCount, dev) != hipSuccess) { grid = -1; return; }
        if (hipFuncSetAttribute((const void*)mega_fwd, hipFuncAttributeMaxDynamicSharedMemorySize, LDS_BYTES) != hipSuccess) { fprintf(stderr, "kernel_launch: hipFuncSetAttribute failed\n"); grid = -1; return; }
        if (hipOccupancyMaxActiveBlocksPerMultiprocessor(&per_cu, (const void*)mega_fwd, NWAVES * 64, LDS_BYTES) != hipSuccess || per_cu < 1)
            fprintf(stderr, "kernel_launch: note: occupancy query reports %d workgroups per CU\n", per_cu);
        (void)hipGetLastError();
        grid = cus;
    }
    if (grid < 0) return;
    if (hipMemsetAsync((char*)d_ws + WS_CTL, 0, CTL_ZERO_BYTES, stream) != hipSuccess) return;
    Params a{};
    for (int i = 0; i < 18; ++i) a.in[i] = (const float*)d_in[i];
    a.out = (float*)d_out; a.ws = (unsigned char*)d_ws;
    a.ph_lo = PH_P0; a.ph_hi = PH_N; a.li = 0;
    hipLaunchKernelGGL(mega_fwd, dim3(grid), dim3(NWAVES * 64), LDS_BYTES, stream, a);
}
```

```cpp
#include <hip/hip_runtime.h>
#include <cstdio>
#include <cstdint>
__device__ __forceinline__ int lane_id() { int l; asm volatile("v_mbcnt_lo_u32_b32 %0, -1, 0\n\tv_mbcnt_hi_u32_b32 %0, -1, %0" : "=v"(l)); return l; }
#define TID() (WAVE_ * 64 + lane_id())
namespace pg8 {
constexpr int PG8_AUXA = 0, PG8_AUXB = 0;
#define PG8_LAS __attribute__((address_space(3)))
typedef unsigned short bf16_t;
typedef short bf16x8 __attribute__((ext_vector_type(8)));
typedef float f32x4 __attribute__((ext_vector_type(4)));
typedef unsigned u32x4 __attribute__((ext_vector_type(4)));
constexpr int BM = 256, BK = 64, HALF = 128, HTB = HALF * BK * 2  , STAGE_BYTES = 8 * HTB, NXCD = 8, WGM = 8;

__host__ __device__ __forceinline__ int lds_byte(int r, int c) { const int st = (r >> 4) * 2 + (c >> 5), rr = r & 15, cc = c & 31, ob = rr * 64 + cc * 2; return st * 1024 + (ob ^ (((ob >> 9) & 1) << 5)); }
__host__ __device__ __forceinline__ void stage_rc(int b, int& R, int& C) { const int st = b / 1024, sb = b % 1024, swz = sb ^ (((sb >> 9) & 1) << 5); R = (st >> 1) * 16 + swz / 64; C = (st & 1) * 32 + (swz % 64) / 2; }
__host__ __device__ __forceinline__ int perm32(int rho) { const int n = rho >> 4, i = rho & 15; return 8 * (i >> 2) + 4 * n + (i & 3); }

struct Unit { int pm, pn, part; };
struct Gemm { const bf16_t* A; const bf16_t* Bt; int M, N, K, lda, ldb; };

struct StaticOrder {
    int nM, nN, nwg, G, c;
    __host__ __device__ void init(int M, int N, int G_, int c_) { nM = M / BM; nN = N / BM; nwg = nM * nN; G = G_; c = c_; }
    __host__ __device__ bool next(int i, Unit& u) const {
        const long L = (long)i * G + c; if (L >= nwg) return false;
        int wgid = (int)L; { const int q = nwg / NXCD, r = nwg % NXCD, xcd = wgid % NXCD, off = wgid / NXCD; wgid = (xcd < r ? xcd * (q + 1) : r * (q + 1) + (xcd - r) * q) + off; }
        const int nig = WGM * nN, gid = wgid / nig, fm = gid * WGM, gsz = (nM - fm) < WGM ? (nM - fm) : WGM;
        u.pm = fm + ((wgid % nig) % gsz); u.pn = (wgid % nig) / gsz; return true;
    }
    __device__ __forceinline__ void a_ready(const Unit&) const {}
    __device__ __forceinline__ void done(const Unit&) const {}
    __device__ __forceinline__ const bf16_t* baseA(const Gemm& g, const Unit&) const { return g.A; }
    __device__ __forceinline__ const bf16_t* baseB(const Gemm& g, const Unit&) const { return g.Bt; }
    __device__ __forceinline__ bool zero_after(const Unit&) const { return true; }
};

__device__ __forceinline__ unsigned cvt_pk_bf16(float lo, float hi) { unsigned r; asm volatile("v_cvt_pk_bf16_f32 %0, %1, %2" : "=v"(r) : "v"(lo), "v"(hi)); return r; }
typedef float f32x2 __attribute__((ext_vector_type(2)));
constexpr int SEQ_ = 8192, DM_ = 4096;
constexpr float EPS_ = 1e-6f;
__device__ __forceinline__ float sigm(float v) { return __builtin_amdgcn_rcpf(1.0f + __builtin_amdgcn_exp2f(-1.4426950408889634f * v)); }
__device__ __forceinline__ float rs_of(float ss) { return __builtin_amdgcn_rsqf(ss * (1.0f / DM_) + EPS_); }
typedef unsigned u32x2 __attribute__((ext_vector_type(2)));
__device__ __forceinline__ f32x4 bf4_to_f32(u32x2 w) { return (f32x4){__uint_as_float(w.x << 16), __uint_as_float(w.x & 0xffff0000u), __uint_as_float(w.y << 16), __uint_as_float(w.y & 0xffff0000u)}; }

#define EPI_ROWS(k) (row0 + ((k) >> 2) * HALF + ((k) & 3) * 16)
#define EPI_ACC(k, bj, n) acc[(k) >> 2][bj][(k) & 3][n]
__device__ __forceinline__ u32x4 pack8(const f32x4 v0, const f32x4 v1) { u32x4 w; w.x = cvt_pk_bf16(v0[0], v0[1]); w.y = cvt_pk_bf16(v0[2], v0[3]); w.z = cvt_pk_bf16(v1[0], v1[1]); w.w = cvt_pk_bf16(v1[2], v1[3]); return w; }

struct EpiProj {
    static constexpr bool PERM = true, AFTER_DRAIN = false;
    bf16_t* qkv; bf16_t* gates; const float* ss; const float* gq; const float* gk; PG8_LAS float* hx;
    __device__ __forceinline__ void operator()(f32x4 (&acc)[2][2][4][2], const Unit& u, int wr, int wc, int fr, int fq) const {
        const int row0 = u.pm * BM + wr * 64 + fr;
        bf16_t* base; int ldc, colt; const bool gate = u.pn >= 48, qknorm = u.pn < 16;
        if (!gate) { base = qkv + (size_t)(u.pn >> 3) * ((size_t)SEQ_ * 2048); ldc = 2048; colt = (u.pn & 7) * 256; }
        else { const int t = u.pn - 48; base = gates + (size_t)(t >> 4) * ((size_t)SEQ_ * 4096); ldc = 4096; colt = (t & 15) * 256; }
        const int col0 = colt + wc * 32 + 8 * fq;
        float rs[8];
#pragma unroll
        for (int k = 0; k < 8; ++k) rs[k] = ss[EPI_ROWS(k)];
        if (qknorm) {
            const float* g = (u.pn < 8 ? gq : gk) + wc * 32 + 8 * fq; const f32x4 g0 = *(const f32x4*)g, g1 = *(const f32x4*)(g + 4);
#pragma unroll
            for (int k = 0; k < 8; ++k) { const float r = rs_of(rs[k]); const int rl = wr * 64 + (k >> 2) * HALF + (k & 3) * 16 + fr;
#pragma unroll
                for (int bj = 0; bj < 2; ++bj) { f32x4 v0 = EPI_ACC(k, bj, 0) * r, v1 = EPI_ACC(k, bj, 1) * r; EPI_ACC(k, bj, 0) = v0; EPI_ACC(k, bj, 1) = v1;
                    float s = (v0[0] * v0[0] + v0[1] * v0[1]) + (v0[2] * v0[2] + v0[3] * v0[3]) + (v1[0] * v1[0] + v1[1] * v1[1]) + (v1[2] * v1[2] + v1[3] * v1[3]);
                    s += __shfl_xor(s, 16); s += __shfl_xor(s, 32);
                    if (fq == 0) hx[(rl * 2 + bj) * 4 + wc] = s; } }
            asm volatile("s_waitcnt lgkmcnt(0)" ::: "memory"); __builtin_amdgcn_s_barrier(); asm volatile("" ::: "memory");
#pragma unroll
            for (int k = 0; k < 8; ++k) { const int rl = wr * 64 + (k >> 2) * HALF + (k & 3) * 16 + fr; bf16_t* rowp = base + (size_t)EPI_ROWS(k) * ldc + col0;
#pragma unroll
                for (int bj = 0; bj < 2; ++bj) { const f32x4 p = *(const PG8_LAS f32x4*)(hx + (rl * 2 + bj) * 4);
                    const float r2 = __builtin_amdgcn_rsqf(((p[0] + p[1]) + (p[2] + p[3])) * (1.0f / 128.0f) + EPS_);
                    *(u32x4*)(rowp + bj * HALF) = pack8(EPI_ACC(k, bj, 0) * g0 * r2, EPI_ACC(k, bj, 1) * g1 * r2); } }
        } else {
#pragma unroll
            for (int k = 0; k < 8; ++k) { const float r = rs_of(rs[k]); bf16_t* rowp = base + (size_t)EPI_ROWS(k) * ldc + col0;
#pragma unroll
                for (int bj = 0; bj < 2; ++bj) { f32x4 v0 = EPI_ACC(k, bj, 0) * r, v1 = EPI_ACC(k, bj, 1) * r;
                    if (gate) {
#pragma unroll
                        for (int j = 0; j < 4; ++j) { v0[j] = sigm(v0[j]); v1[j] = sigm(v1[j]); } }
                    *(u32x4*)(rowp + bj * HALF) = pack8(v0, v1); } }
        }
    }
};
template <bool BASE_BF16> struct EpiResStat {
    static constexpr bool PERM = true, AFTER_DRAIN = false;
    const float* basef; bf16_t* xb; float* ss;
    __device__ __forceinline__ void operator()(const f32x4 (&acc)[2][2][4][2], const Unit& u, int wr, int wc, int fr, int fq) const {
        const int row0 = u.pm * BM + wr * 64 + fr, col0 = u.pn * BM + wc * 32 + 8 * fq;
        f32x4 b[2][2][2];
#define LD_(k) do { const size_t off_ = (size_t)EPI_ROWS(k) * DM_ + col0; _Pragma("unroll") for (int bj_ = 0; bj_ < 2; ++bj_) { \
            if constexpr (BASE_BF16) { const u32x4 w_ = *(const u32x4*)(xb + off_ + bj_ * HALF); b[(k) & 1][bj_][0] = bf4_to_f32((u32x2){w_.x, w_.y}); b[(k) & 1][bj_][1] = bf4_to_f32((u32x2){w_.z, w_.w}); } \
            else { b[(k) & 1][bj_][0] = *(const f32x4*)(basef + off_ + bj_ * HALF); b[(k) & 1][bj_][1] = *(const f32x4*)(basef + off_ + bj_ * HALF + 4); } } } while (0)
        LD_(0);
#pragma unroll
        for (int k = 0; k < 8; ++k) {
            if (k + 1 < 8) LD_(k + 1);
            const int r = EPI_ROWS(k); const size_t off = (size_t)r * DM_ + col0; float s = 0.f;
#pragma unroll
            for (int bj = 0; bj < 2; ++bj) { const f32x4 o0 = b[k & 1][bj][0] + EPI_ACC(k, bj, 0), o1 = b[k & 1][bj][1] + EPI_ACC(k, bj, 1);
                s += ((o0[0] * o0[0] + o0[1] * o0[1]) + (o0[2] * o0[2] + o0[3] * o0[3])) + ((o1[0] * o1[0] + o1[1] * o1[1]) + (o1[2] * o1[2] + o1[3] * o1[3]));
                *(u32x4*)(xb + off + bj * HALF) = pack8(o0, o1); }
            s += __shfl_xor(s, 16); s += __shfl_xor(s, 32);
            if (fq == 0) __hip_atomic_fetch_add(ss + r, s, __ATOMIC_RELAXED, __HIP_MEMORY_SCOPE_AGENT);
            asm volatile("" ::: "memory");
        }
#undef LD_
    }
};
struct EpiUp {
    static constexpr bool PERM = true, AFTER_DRAIN = false;
    bf16_t* O; int ldc; const float* ss;
    __device__ __forceinline__ void operator()(const f32x4 (&acc)[2][2][4][2], const Unit& u, int wr, int wc, int fr, int fq) const {
        const int row0 = u.pm * BM + wr * 64 + fr, col0 = u.pn * BM + wc * 32 + 8 * fq;
        float rs[8];
#pragma unroll
        for (int k = 0; k < 8; ++k) rs[k] = ss[EPI_ROWS(k)];
#pragma unroll
        for (int k = 0; k < 8; ++k) { const float r = rs_of(rs[k]); bf16_t* rowp = O + (size_t)EPI_ROWS(k) * ldc + col0;
#pragma unroll
            for (int bj = 0; bj < 2; ++bj) *(u32x4*)(rowp + bj * HALF) = pack8(EPI_ACC(k, bj, 0) * r, EPI_ACC(k, bj, 1) * r); }
    }
};
template <int CTRL> __device__ __forceinline__ float dpp_upd(float old, float src) { return __builtin_bit_cast(float, __builtin_amdgcn_update_dpp(__builtin_bit_cast(int, old), __builtin_bit_cast(int, src), CTRL, 0xf, 0xf, false)); }
struct EpiConvGlu {
    static constexpr bool PERM = false, AFTER_DRAIN = false;
    static constexpr int J = 11008, ROR1 = 0x121, ROR2 = 0x122, SHR1 = 0x111, SHR2 = 0x112;
    bf16_t* act; float* edge; const float* ss; const float* cw; const float* cb; PG8_LAS float* xch;
    __device__ __forceinline__ void operator()(f32x4 (&acc)[2][2][4][2], const Unit& u, int wr, int wc, int, int) const {
        const int l_ = lane_id(), fr = l_ & 15, fq = l_ >> 4;
        const int row0 = u.pm * BM + wr * 64 + fr, colt = wc * 32 + 4 * fq, j0 = u.pn * 128 + colt;
        {   float rs[8];
#pragma unroll
            for (int k = 0; k < 8; ++k) rs[k] = ss[EPI_ROWS(k)];
#pragma unroll
            for (int k = 0; k < 8; ++k) { const float r = rs_of(rs[k]);
#pragma unroll
                for (int bj = 0; bj < 2; ++bj)
#pragma unroll
                    for (int n = 0; n < 2; ++n) EPI_ACC(k, bj, n) = EPI_ACC(k, bj, n) * r; } }
#pragma unroll
        for (int ai = 0; ai < 2; ++ai) { const int b = 2 * ai + wr;
            if (fr >= 14) {
#pragma unroll
                for (int bj = 0; bj < 2; ++bj)
#pragma unroll
                    for (int n = 0; n < 2; ++n) *(PG8_LAS f32x4*)(xch + (b * 2 + (fr - 14)) * 256 + 128 * bj + colt + 16 * n) = acc[ai][bj][3][n];
                if (b == 3) {
#pragma unroll
                    for (int bj = 0; bj < 2; ++bj)
#pragma unroll
                        for (int n = 0; n < 2; ++n) *(f32x4*)(edge + ((size_t)u.pm * 4 + 2 + (fr - 14)) * (2 * J) + bj * J + j0 + 16 * n) = acc[ai][bj][3][n]; }
            }
            if (b == 0 && fr < 2) {
#pragma unroll
                for (int bj = 0; bj < 2; ++bj)
#pragma unroll
                    for (int n = 0; n < 2; ++n) *(f32x4*)(edge + ((size_t)u.pm * 4 + fr) * (2 * J) + bj * J + j0 + 16 * n) = acc[ai][bj][0][n]; }
        }
        asm volatile("s_waitcnt lgkmcnt(0)" ::: "memory"); __builtin_amdgcn_s_barrier(); asm volatile("" ::: "memory");
#pragma unroll
        for (int n = 0; n < 2; ++n) {
            f32x4 wgt[2][3], bia[2];
#pragma unroll
            for (int bj = 0; bj < 2; ++bj) { bia[bj] = *(const f32x4*)(cb + bj * J + j0 + 16 * n);
#pragma unroll
                for (int t = 0; t < 3; ++t) wgt[bj][t] = *(const f32x4*)(cw + (size_t)t * 2 * J + bj * J + j0 + 16 * n); }
#pragma unroll
            for (int k = 0; k < 8; ++k) { const int ai = k >> 2, m = k & 3, b = 2 * ai + wr;
                f32x4 x63[2], x62[2];
                if (m == 0) {
#pragma unroll
                    for (int bj = 0; bj < 2; ++bj) { const int pb = (b + 3) & 3; x63[bj] = *(const PG8_LAS f32x4*)(xch + (pb * 2 + 1) * 256 + 128 * bj + colt + 16 * n); x62[bj] = *(const PG8_LAS f32x4*)(xch + (pb * 2 + 0) * 256 + 128 * bj + colt + 16 * n); } }
                f32x4 res;
#pragma unroll
                for (int e = 0; e < 4; ++e) { float uu[2];
#pragma unroll
                    for (int bj = 0; bj < 2; ++bj) { const float c = acc[ai][bj][m][n][e]; float o1, o2;
                        if (m == 0) { o1 = x63[bj][e]; o2 = (fr == 0) ? x62[bj][e] : x63[bj][e]; }
                        else { const float pv = acc[ai][bj][m - 1][n][e]; o1 = dpp_upd<ROR1>(pv, pv); o2 = dpp_upd<ROR2>(pv, pv); }
                        const float p1 = dpp_upd<SHR1>(o1, c), p2 = dpp_upd<SHR2>(o2, c);
                        uu[bj] = bia[bj][e] + wgt[bj][0][e] * p2 + wgt[bj][1][e] * p1 + wgt[bj][2][e] * c; }
                    res[e] = uu[0] * sigm(uu[0]) * uu[1]; }
                if (!(b == 0 && m == 0 && fr < 2)) { u32x2 w; w.x = cvt_pk_bf16(res[0], res[1]); w.y = cvt_pk_bf16(res[2], res[3]); *(u32x2*)(act + (size_t)EPI_ROWS(k) * J + j0 + 16 * n) = w; }
            }
        }
    }
};
struct EpiPle {
    static constexpr bool PERM = true, AFTER_DRAIN = false;
    float* out; const bf16_t* xb; const bf16_t* pp; const float* ss;
    __device__ __forceinline__ void operator()(const f32x4 (&acc)[2][2][4][2], const Unit& u, int wr, int wc, int fr, int fq) const {
        const int row0 = u.pm * BM + wr * 64 + fr, col0 = u.pn * BM + wc * 32 + 8 * fq;
        float rs[8];
#pragma unroll
        for (int k = 0; k < 8; ++k) rs[k] = ss[EPI_ROWS(k)];
        u32x4 b2[2][2], q2[2][2];
#define LD_(k) do { const size_t off_ = (size_t)EPI_ROWS(k) * DM_ + col0; _Pragma("unroll") for (int bj_ = 0; bj_ < 2; ++bj_) { b2[(k) & 1][bj_] = *(const u32x4*)(xb + off_ + bj_ * HALF); q2[(k) & 1][bj_] = *(const u32x4*)(pp + off_ + bj_ * HALF); } } while (0)
        LD_(0);
#pragma unroll
        for (int k = 0; k < 8; ++k) {
            if (k + 1 < 8) LD_(k + 1);
            const size_t off = (size_t)EPI_ROWS(k) * DM_ + col0; const float r = rs_of(rs[k]);
#pragma unroll
            for (int bj = 0; bj < 2; ++bj) { const u32x4 bw = b2[k & 1][bj], qw = q2[k & 1][bj];
#pragma unroll
                for (int n = 0; n < 2; ++n) { const f32x4 a = EPI_ACC(k, bj, n) * r, pv = bf4_to_f32(n ? (u32x2){qw.z, qw.w} : (u32x2){qw.x, qw.y}), bb = bf4_to_f32(n ? (u32x2){bw.z, bw.w} : (u32x2){bw.x, bw.y});
                    f32x4 o; o[0] = bb[0] + sigm(a[0]) * pv[0]; o[1] = bb[1] + sigm(a[1]) * pv[1]; o[2] = bb[2] + sigm(a[2]) * pv[2]; o[3] = bb[3] + sigm(a[3]) * pv[3];
                    *(f32x4*)(out + off + bj * HALF + 4 * n) = o; } }
            asm volatile("" ::: "memory");
        }
#undef LD_
    }
};
struct EpiGate2 {
    static constexpr bool PERM = true, AFTER_DRAIN = false;
    bf16_t* merged; const bf16_t* sga; const bf16_t* sgb;
    __device__ __forceinline__ void operator()(f32x4 (&acc)[2][2][4][2], const Unit& u, int wr, int wc, int fr, int fq) const {
        const int row0 = u.pm * BM + wr * 64 + fr, col0 = u.pn * BM + wc * 32 + 8 * fq;
        if (u.part == 0) {
            u32x4 ga[2][2], gb[2][2];
#define LD_(k) do { const size_t off_ = (size_t)EPI_ROWS(k) * DM_ + col0; ga[(k) & 1][0] = *(const u32x4*)(sga + off_); ga[(k) & 1][1] = *(const u32x4*)(sga + off_ + HALF); gb[(k) & 1][0] = *(const u32x4*)(sgb + off_); gb[(k) & 1][1] = *(const u32x4*)(sgb + off_ + HALF); } while (0)
            LD_(0);
#pragma unroll
            for (int k = 0; k < 8; ++k) {
                if (k + 1 < 8) LD_(k + 1);
#pragma unroll
                for (int bj = 0; bj < 2; ++bj) { const u32x4 aw = ga[k & 1][bj], bw = gb[k & 1][bj];
                    const f32x4 ga0 = bf4_to_f32((u32x2){aw.x, aw.y}), ga1 = bf4_to_f32((u32x2){aw.z, aw.w}), gb0 = bf4_to_f32((u32x2){bw.x, bw.y}), gb1 = bf4_to_f32((u32x2){bw.z, bw.w});
#pragma unroll
                    for (int j = 0; j < 4; ++j) { EPI_ACC(k, bj, 0)[j] *= ga0[j] * __builtin_amdgcn_rcpf(fmaxf(gb0[j], 1e-20f)); EPI_ACC(k, bj, 1)[j] *= ga1[j] * __builtin_amdgcn_rcpf(fmaxf(gb1[j], 1e-20f)); } }
                asm volatile("" ::: "memory");
            }
#undef LD_
        } else {
            u32x4 gb[2][2];
#define LD_(k) do { const size_t off_ = (size_t)EPI_ROWS(k) * DM_ + col0; gb[(k) & 1][0] = *(const u32x4*)(sgb + off_); gb[(k) & 1][1] = *(const u32x4*)(sgb + off_ + HALF); } while (0)
            LD_(0);
#pragma unroll
            for (int k = 0; k < 8; ++k) {
                if (k + 1 < 8) LD_(k + 1);
                const size_t off = (size_t)EPI_ROWS(k) * DM_ + col0;
#pragma unroll
                for (int bj = 0; bj < 2; ++bj) { const u32x4 bw = gb[k & 1][bj]; const f32x4 gb0 = bf4_to_f32((u32x2){bw.x, bw.y}), gb1 = bf4_to_f32((u32x2){bw.z, bw.w});
                    f32x4 v0, v1;
#pragma unroll
                    for (int j = 0; j < 4; ++j) { v0[j] = EPI_ACC(k, bj, 0)[j] * fmaxf(gb0[j], 1e-20f); v1[j] = EPI_ACC(k, bj, 1)[j] * fmaxf(gb1[j], 1e-20f); }
                    *(u32x4*)(merged + off + bj * HALF) = pack8(v0, v1); }
                asm volatile("" ::: "memory");
            }
#undef LD_
        }
    }
};
struct TwoPartOrder : StaticOrder {
    const bf16_t* A1; const bf16_t* B1;
    __device__ bool next(int i, Unit& u) const { const bool ok = StaticOrder::next(i >> 1, u); u.part = i & 1; return ok; }
    __device__ __forceinline__ const bf16_t* baseA(const Gemm& g, const Unit& u) const { return u.part ? A1 : g.A; }
    __device__ __forceinline__ const bf16_t* baseB(const Gemm& g, const Unit& u) const { return u.part ? B1 : g.Bt; }
    __device__ __forceinline__ bool zero_after(const Unit& u) const { return u.part != 0; }
};
struct EpiStoreBf16x4 {
    static constexpr bool PERM = false, AFTER_DRAIN = false;
    bf16_t* C;
    __device__ __forceinline__ void operator()(const f32x4 (&acc)[2][2][4][2], const Unit& u, int wr, int wc, int fr, int fq) const {
        const int row0 = u.pm * BM + wr * 64 + fr, col0 = u.pn * BM + wc * 32 + 4 * fq;
#pragma unroll
        for (int ai = 0; ai < 2; ++ai)
#pragma unroll
            for (int m = 0; m < 4; ++m) { bf16_t* rowp = C + (size_t)(row0 + ai * HALF + m * 16) * DM_ + col0;
#pragma unroll
                for (int bj = 0; bj < 2; ++bj)
#pragma unroll
                    for (int n = 0; n < 2; ++n) { const f32x4 v = acc[ai][bj][m][n]; u32x2 w; w.x = cvt_pk_bf16(v[0], v[1]); w.y = cvt_pk_bf16(v[2], v[3]); *(u32x2*)(rowp + bj * HALF + n * 16) = w; } }
    }
};
struct EpiNull {
    static constexpr bool PERM = true, AFTER_DRAIN = false;
    __device__ __forceinline__ void operator()(const f32x4 (&acc)[2][2][4][2], const Unit& u, int wr, int wc, int fr, int fq) const {
#pragma unroll
        for (int ai = 0; ai < 2; ++ai)
#pragma unroll
            for (int bj = 0; bj < 2; ++bj)
#pragma unroll
                for (int m = 0; m < 4; ++m)
#pragma unroll
                    for (int n = 0; n < 2; ++n) asm volatile("" :: "v"(acc[ai][bj][m][n]));
    }
};
#undef EPI_ROWS
#undef EPI_ACC
template <class Epi, class Sched, bool ALIGN_EPI = false, bool SP2 = false, int DIAGMODE = 0, int STG = 0, bool RELAX1ST = false>
__device__ __forceinline__ void gemm_phase(PG8_LAS unsigned char* lds, const Gemm g, const Sched& S, const Epi& E, const int WAVE_) {
    const int tid = TID(), wid = __builtin_amdgcn_readfirstlane(tid >> 6), lane = tid & 63, wr = wid >> 2, wc = wid & 3, fr = lane & 15, fq = lane >> 4;
    const int K = g.K, nt = K / BK, lda = g.lda ? g.lda : K, ldb = g.ldb ? g.ldb : K;
    unsigned voffA[2], voffB[2];
#pragma unroll
    for (int i = 0; i < 2; ++i) { int R, C; stage_rc(tid * 16 + i * 8192, R, C); const int Rb = Epi::PERM ? ((R & ~31) + perm32(R & 31)) : R;
        voffA[i] = (unsigned)(R * lda + C) * 2u; voffB[i] = (unsigned)(Rb * ldb + C) * 2u; }
    const size_t kstep = (size_t)(BK * 2);
    const size_t hstepA = (size_t)HALF * lda * 2, hstepB = (size_t)HALF * ldb * 2;
    const size_t tstepA = 2 * hstepA, tstepB = 2 * hstepB;
    const unsigned ldsw = (unsigned)wid * 1024u;
    const int aoff = lds_byte(wr * 64 + fr, fq * 8), boff = lds_byte(wc * 32 + fr, fq * 8);
#define PG8_SA(b, h) (((b) * 2 + (h)) * HTB)
#define PG8_SB(b, h) ((4 + (b) * 2 + (h)) * HTB)
#define PG8_STAGE(bufoff, gbase, voff) do { if (DIAGMODE != 2 && DIAGMODE != 4 && DIAGMODE != 5) _Pragma("unroll") for (int _i = 0; _i < 2; ++_i) \
        { if ((bufoff) >= 4 * HTB) __builtin_amdgcn_global_load_lds((const unsigned*)((const char*)(gbase) + (voff)[_i]), (PG8_LAS unsigned*)(lds + (bufoff) + ldsw + _i * 8192), 16, 0, PG8_AUXB); else __builtin_amdgcn_global_load_lds((const unsigned*)((const char*)(gbase) + (voff)[_i]), (PG8_LAS unsigned*)(lds + (bufoff) + ldsw + _i * 8192), 16, 0, PG8_AUXA); } } while (0)
#define PG8_LDA(dst, b, h) do { if ((DIAGMODE != 1 && DIAGMODE != 4 && DIAGMODE != 5) || t == 0) _Pragma("unroll") for (int m = 0; m < 4; ++m) _Pragma("unroll") for (int k = 0; k < 2; ++k) dst[m][k] = *(const PG8_LAS bf16x8*)(lds + PG8_SA(b, h) + aoff + m * 2048 + k * 1024); } while (0)
#define PG8_LDB(dst, b, h) do { if ((DIAGMODE != 1 && DIAGMODE != 4 && DIAGMODE != 5) || t == 0) _Pragma("unroll") for (int n = 0; n < 2; ++n) _Pragma("unroll") for (int k = 0; k < 2; ++k) dst[n][k] = *(const PG8_LAS bf16x8*)(lds + PG8_SB(b, h) + boff + n * 2048 + k * 1024); } while (0)
#define PG8_MMA(ai, bj, At, Bt) do { __builtin_amdgcn_s_setprio(1); if (DIAGMODE != 3 && DIAGMODE != 4) _Pragma("unroll") for (int m = 0; m < 4; ++m) _Pragma("unroll") for (int n = 0; n < 2; ++n) _Pragma("unroll") for (int k = 0; k < 2; ++k) \
        acc[ai][bj][m][n] = __builtin_amdgcn_mfma_f32_16x16x32_bf16(Bt[n][k], At[m][k], acc[ai][bj][m][n], 0, 0, 0); __builtin_amdgcn_s_setprio(0); } while (0)
#define PG8_WAIT_V(n) asm volatile("s_waitcnt vmcnt(" #n ")" ::: "memory")
#define PG8_WAIT_L(n) asm volatile("s_waitcnt lgkmcnt(" #n ")" ::: "memory")
#define PG8_BAR __builtin_amdgcn_s_barrier()
#define PG8_SCHED __builtin_amdgcn_sched_barrier(0)
    Unit cur, nxt; int ui = 0;
    if (!S.next(0, cur)) return;
    f32x4 acc[2][2][4][2];
#pragma unroll
    for (int a = 0; a < 2; ++a)
#pragma unroll
        for (int b = 0; b < 2; ++b)
#pragma unroll
            for (int m = 0; m < 4; ++m)
#pragma unroll
                for (int n = 0; n < 2; ++n) acc[a][b][m][n] = (f32x4){0.f, 0.f, 0.f, 0.f};
    bf16x8 At[4][2], B0[2][2], B1[2][2];
    const char* cA = (const char*)S.baseA(g, cur) + (size_t)cur.pm * tstepA; const char* cB = (const char*)S.baseB(g, cur) + (size_t)cur.pn * tstepB;
    S.a_ready(cur);
    if constexpr (SP2) {
        PG8_STAGE(PG8_SB(0, 0), cB, voffB); PG8_STAGE(PG8_SB(0, 1), cB + hstepB, voffB); PG8_STAGE(PG8_SA(0, 0), cA, voffA); PG8_STAGE(PG8_SA(0, 1), cA + hstepA, voffA);
        if (wr == 1) PG8_BAR;
        PG8_WAIT_V(2); PG8_BAR;
        PG8_STAGE(PG8_SB(1, 0), cB + kstep, voffB); PG8_STAGE(PG8_SA(1, 0), cA + kstep, voffA); PG8_STAGE(PG8_SB(1, 1), cB + hstepB + kstep, voffB);
        PG8_WAIT_V(6); PG8_BAR;
    } else {
        PG8_STAGE(PG8_SB(0, 0), cB, voffB); PG8_STAGE(PG8_SA(0, 0), cA, voffA); PG8_STAGE(PG8_SB(0, 1), cB + hstepB, voffB); PG8_STAGE(PG8_SA(0, 1), cA + hstepA, voffA);
        if (wr == 1) PG8_BAR;
        PG8_WAIT_V(4); PG8_BAR;
        PG8_STAGE(PG8_SB(1, 0), cB + kstep, voffB); PG8_STAGE(PG8_SA(1, 0), cA + kstep, voffA); PG8_STAGE(PG8_SB(1, 1), cB + hstepB + kstep, voffB);
        PG8_WAIT_V(6); PG8_BAR;
    }
    for (;;) {
        const bool has_next = S.next(ui + 1, nxt);
        const char* nA = has_next ? (const char*)S.baseA(g, nxt) + (size_t)nxt.pm * tstepA : cA; const char* nB = has_next ? (const char*)S.baseB(g, nxt) + (size_t)nxt.pn * tstepB : cB;
        for (int t = 0; t < nt; t += 2) {
            const bool last = (t == nt - 2);
            const char* a1 = cA + (size_t)(t + 1) * kstep;
            const char* a2 = last ? nA : cA + (size_t)(t + 2) * kstep; const char* b2 = last ? nB : cB + (size_t)(t + 2) * kstep;
            const char* a3 = a2 + kstep; const char* b3 = b2 + kstep;
            if (last && has_next) S.a_ready(nxt);
            if constexpr (SP2) {
#define PG8_WAIT_VN(n) asm volatile("s_waitcnt vmcnt(%0)" :: "n"(n) : "memory")
#define PG8_WAIT_VC(n, flag) do { if constexpr (RELAX1ST) asm volatile("s_cmp_lg_u32 %1, 0\n\ts_cbranch_scc1 1f\n\ts_waitcnt vmcnt(%0)\n1:" :: "n"(n), "s"(__builtin_amdgcn_readfirstlane(flag)) : "memory", "scc"); else PG8_WAIT_VN(n); } while (0)
#define PG8_KT(b, pa11, pb, pa0, RELAX_) do { \
    constexpr bool A11_SEG = (STG == 0 || STG == 2 || STG == 4), B0_SEG = (STG != 1), B1_SEG = (STG == 0 || STG == 4 || STG == 5), A0_SEG = (STG == 0); \
    constexpr int W1 = A11_SEG ? 8 : 6, W2 = (STG == 0) ? 8 : (STG == 1) ? 2 : (STG == 2) ? 4 : 6; \
    PG8_LDB(B0, b, 0); PG8_LDB(B1, b, 1); PG8_SCHED; PG8_LDA(At, b, 0); if constexpr (A11_SEG) PG8_STAGE(PG8_SA((b) ^ 1, 1), pa11, voffA); \
    PG8_WAIT_VC(W1, RELAX_); PG8_WAIT_L(0); PG8_BAR; PG8_MMA(0, 0, At, B0); if constexpr (!A11_SEG) { PG8_SCHED; PG8_STAGE(PG8_SA((b) ^ 1, 1), pa11, voffA); PG8_SCHED; } PG8_MMA(0, 1, At, B1); PG8_BAR; PG8_SCHED; \
    PG8_LDA(At, b, 1); if constexpr (B0_SEG) PG8_STAGE(PG8_SB(b, 0), pb, voffB); if constexpr (B1_SEG) PG8_STAGE(PG8_SB(b, 1), (pb) + hstepB, voffB); if constexpr (A0_SEG) PG8_STAGE(PG8_SA(b, 0), pa0, voffA); \
    PG8_WAIT_VC(W2, RELAX_); PG8_WAIT_L(0); PG8_BAR; \
    if constexpr (!B0_SEG) { PG8_STAGE(PG8_SB(b, 0), pb, voffB); PG8_SCHED; } \
    PG8_MMA(1, 0, At, B0); \
    if constexpr (!B1_SEG) { PG8_SCHED; PG8_STAGE(PG8_SB(b, 1), (pb) + hstepB, voffB); PG8_SCHED; } \
    if constexpr (!A0_SEG && STG != 2) { PG8_SCHED; PG8_STAGE(PG8_SA(b, 0), pa0, voffA); PG8_SCHED; } \
    PG8_MMA(1, 1, At, B1); \
    if constexpr (!A0_SEG && STG == 2) { PG8_SCHED; PG8_STAGE(PG8_SA(b, 0), pa0, voffA); } \
    PG8_BAR; PG8_SCHED; } while (0)
            PG8_KT(0, a1 + hstepA, b2, a2, ((t == 0 && ui > 0) ? 1 : 0));
            PG8_KT(1, a2 + hstepA, b3, a3, 0);
#undef PG8_KT
            } else {
            PG8_LDB(B0, 0, 0); PG8_SCHED; PG8_LDA(At, 0, 0); PG8_STAGE(PG8_SA(1, 1), a1 + hstepA, voffA);
            PG8_WAIT_L(8); PG8_BAR; PG8_WAIT_L(0); PG8_MMA(0, 0, At, B0); PG8_BAR; PG8_SCHED;
            PG8_LDB(B1, 0, 1); PG8_STAGE(PG8_SB(0, 0), b2, voffB);
            PG8_BAR; PG8_WAIT_L(0); PG8_MMA(0, 1, At, B1); PG8_BAR;
            PG8_LDA(At, 0, 1); PG8_STAGE(PG8_SA(0, 0), a2, voffA);
            PG8_BAR; PG8_WAIT_L(0); PG8_MMA(1, 0, At, B0); PG8_BAR; PG8_SCHED;
            PG8_STAGE(PG8_SB(0, 1), b2 + hstepB, voffB);
            PG8_WAIT_V(6); PG8_BAR; PG8_MMA(1, 1, At, B1); PG8_BAR;
            PG8_LDB(B0, 1, 0); PG8_SCHED; PG8_LDA(At, 1, 0); PG8_STAGE(PG8_SA(0, 1), a2 + hstepA, voffA);
            PG8_WAIT_L(8); PG8_BAR; PG8_WAIT_L(0); PG8_MMA(0, 0, At, B0); PG8_BAR; PG8_SCHED;
            PG8_LDB(B1, 1, 1); PG8_STAGE(PG8_SB(1, 0), b3, voffB);
            PG8_BAR; PG8_WAIT_L(0); PG8_MMA(0, 1, At, B1); PG8_BAR;
            PG8_LDA(At, 1, 1); PG8_STAGE(PG8_SA(1, 0), a3, voffA);
            PG8_BAR; PG8_WAIT_L(0); PG8_MMA(1, 0, At, B0); PG8_BAR; PG8_SCHED;
            PG8_STAGE(PG8_SB(1, 1), b3 + hstepB, voffB);
            PG8_WAIT_V(6); PG8_BAR; PG8_MMA(1, 1, At, B1); PG8_BAR;
            }
        }
        if constexpr (ALIGN_EPI) { if (wr == 0) PG8_BAR; }
        if constexpr (!Epi::AFTER_DRAIN) { if constexpr (RELAX1ST) PG8_WAIT_V(0); E(acc, cur, wr, wc, fr, fq); S.done(cur); }
        if (!has_next) break;
        if (S.zero_after(cur))
#pragma unroll
        for (int a = 0; a < 2; ++a)
#pragma unroll
            for (int b = 0; b < 2; ++b)
#pragma unroll
                for (int m = 0; m < 4; ++m)
#pragma unroll
                    for (int n = 0; n < 2; ++n) acc[a][b][m][n] = (f32x4){0.f, 0.f, 0.f, 0.f};
        cur = nxt; cA = nA; cB = nB; ++ui;
        if constexpr (ALIGN_EPI) { if (wr == 1) PG8_BAR; }
    }
    PG8_WAIT_V(0);
    if constexpr (!ALIGN_EPI) { if (wr == 0) PG8_BAR; }
    PG8_BAR;
    if constexpr (Epi::AFTER_DRAIN) { E.fused(acc, cur, wr, wc, fr, fq, lds, wid, lane); S.done(cur); }
#undef PG8_SA
#undef PG8_SB
#undef PG8_STAGE
#undef PG8_LDA
#undef PG8_LDB
#undef PG8_MMA
#undef PG8_WAIT_V
#undef PG8_WAIT_L
#undef PG8_BAR
#undef PG8_SCHED
}
}
constexpr int NWAVES = 8;
constexpr int S = 8192, DM = 4096, HD = 128, NH = 16, WF = 2048, DFF = 11008, PLE = 256, NIN = 20496, NPROJ = 20480;
constexpr float EPS = 1e-6f;
constexpr float SCALE = 0.08838834764831845f;
constexpr size_t MiB = 1u << 20;
constexpr size_t WS_CTL = 0, CTL_ZERO_BYTES = 1 * MiB;
constexpr size_t WS_SS1 = 1 * MiB;
constexpr size_t WS_LOGF = WS_SS1 + 64 * 1024;
constexpr size_t WS_C = WS_LOGF + 512 * 1024;
constexpr size_t WS_WTF = WS_C + 512 * 1024;
constexpr size_t WS_WIN = 4 * MiB;
constexpr size_t WS_WBF = WS_WIN + 160 * MiB;
constexpr size_t WS_WBS = WS_WBF + 16 * MiB;
constexpr size_t WS_WOUT = WS_WBS + 16 * MiB;
constexpr size_t WS_WUP = WS_WOUT + 32 * MiB;
constexpr size_t WS_WDN = WS_WUP + 172 * MiB;
constexpr size_t WS_WPG = WS_WDN + 86 * MiB;
constexpr size_t WS_WPP = WS_WPG + 32 * MiB;
constexpr size_t WS_XB = WS_WPP + 2 * MiB;
constexpr size_t WS_PB = WS_XB + 64 * MiB;
constexpr size_t WS_QKV = WS_PB + 4 * MiB;
constexpr size_t WS_GATES = WS_QKV + 192 * MiB;
constexpr size_t WS_Y = WS_GATES + 128 * MiB;
constexpr size_t WS_EDGE = WS_QKV + 128 * MiB;
constexpr size_t WS_UP = WS_QKV;
constexpr size_t WS_MERGED = WS_Y + 64 * MiB;
constexpr size_t WS_ACT = WS_MERGED + 64 * MiB;
constexpr size_t WS_PP = WS_QKV;
constexpr size_t WS_END = WS_ACT + 172 * MiB;
static_assert(WS_UP + (size_t)S * 2 * DFF * 2 <= WS_MERGED, "up overlay");
constexpr int CW_BAR = 4096;
constexpr int CW_FBLK = 2560;
constexpr int CW_QATT = 2048;
constexpr int CW_SS2 = 32768, CW_SS3 = 32768 + 8192;
constexpr int N_BAR_REGIONS = 4;
constexpr int RING_OFF = 0, RING_BYTES = 131072;
constexpr int LDSCTL_OFF = RING_BYTES, MISC_OFF = LDSCTL_OFF + 320;
constexpr int XCH_OFF = LDSCTL_OFF + 1024;
constexpr int LDS_BYTES = 147456;
static_assert(XCH_OFF + 8192 <= LDS_BYTES, "LDS map");

#define GAS __attribute__((address_space(1)))
#define LAS __attribute__((address_space(3)))
typedef unsigned short bf16;
typedef unsigned v4u __attribute__((ext_vector_type(4)));
typedef unsigned v2u __attribute__((ext_vector_type(2)));
typedef float f32x4 __attribute__((ext_vector_type(4)));
typedef float f32x16 __attribute__((ext_vector_type(16)));
typedef short bf16x8 __attribute__((ext_vector_type(8)));
typedef GAS unsigned gu32;
#define RLX_AGENT __ATOMIC_RELAXED, __HIP_MEMORY_SCOPE_AGENT
#define LDS_WAIT() asm volatile("s_waitcnt lgkmcnt(0)" ::: "memory")
#define VM_WAIT() asm volatile("s_waitcnt vmcnt(0)" ::: "memory")
__device__ __forceinline__ unsigned pk2(float lo, float hi) { unsigned r; asm volatile("v_cvt_pk_bf16_f32 %0, %1, %2" : "=v"(r) : "v"(lo), "v"(hi)); return r; }
__device__ __forceinline__ float bf2f(bf16 b) { return __uint_as_float(((unsigned)b) << 16); }
__device__ __forceinline__ float bflo(unsigned w) { return __uint_as_float(w << 16); }
__device__ __forceinline__ float bfhi(unsigned w) { return __uint_as_float(w & 0xffff0000u); }
__device__ __forceinline__ float sigmoidf_(float v) { return 1.0f / (1.0f + __expf(-v)); }
__device__ __forceinline__ float log_sigmoidf_(float v) { return fminf(v, 0.f) - log1pf(__expf(-fabsf(v))); }
__device__ __forceinline__ float softplusf_(float v) { return fmaxf(v, 0.f) + log1pf(__expf(-fabsf(v))); }
__device__ __forceinline__ float wave_sum(float v) {
#pragma unroll
    for (int o = 1; o < 64; o <<= 1) v += __shfl_xor(v, o);
    return v;
}

#define XB_TMO      128
#define XB_XCNT(j)  (256  + 64 * (j))
#define XB_XSUB(j)  (1280 + 64 * (j))
#define XB_XGEN(j)  (2304 + 64 * (j))
#define XB_TOP      3328
#define XB_TOPGEN   3392
#define XCD_BAR_WORDS 3456
#define XB_SPIN_CAP (1u << 18)

__device__ __forceinline__ unsigned xb_ld(unsigned* p)              { return __hip_atomic_load(p, __ATOMIC_RELAXED, __HIP_MEMORY_SCOPE_AGENT); }
__device__ __forceinline__ unsigned xb_add(unsigned* p, unsigned v) { return __hip_atomic_fetch_add(p, v, __ATOMIC_RELAXED, __HIP_MEMORY_SCOPE_AGENT); }
__device__ __forceinline__ unsigned xb_xcc_id() { return (unsigned)__builtin_amdgcn_s_getreg((3 << 11) | 20) & 0xFu; }
#define XB_SPIN(cond, bar) do { unsigned _sp = 0; while (cond) { __builtin_amdgcn_s_sleep(1); \
    if ((++_sp & 255u) == 0u) { if (xb_ld(&(bar)[XB_TMO])) break; if (_sp > XB_SPIN_CAP) { atomicAdd(&(bar)[XB_TMO], 1u); break; } } } } while (0)

struct XcdBarrier {
    unsigned* bar; unsigned x; int wave;
    volatile LAS unsigned* st;
};

__device__ __forceinline__ XcdBarrier xcd_barrier_post(unsigned* bar, volatile LAS unsigned* st, const int WAVE_) {
    XcdBarrier b; b.wave = WAVE_; b.bar = bar; b.x = xb_xcc_id(); b.st = st;
    if (TID() == 0) (void)xb_add(&bar[XB_XCNT(b.x)], 1u);
    return b;
}
__device__ __forceinline__ void xcd_barrier_complete(unsigned* bar, unsigned x, unsigned& nloc, unsigned& nx) {
    const unsigned G = gridDim.x * gridDim.y * gridDim.z;
    unsigned sum, cnt, mine, sp = 0u;
    for (;;) {
        sum = 0u; cnt = 0u; mine = 0u;
#pragma unroll
        for (unsigned j = 0; j < 16; ++j) { const unsigned c = xb_ld(&bar[XB_XCNT(j)]); sum += c; cnt += (c > 0u) ? 1u : 0u; mine = (j == x) ? c : mine; }
        if (sum == G) break;
        __builtin_amdgcn_s_sleep(1);
        if ((++sp & 255u) == 0u) { if (xb_ld(&bar[XB_TMO])) break; if (sp > XB_SPIN_CAP) { atomicAdd(&bar[XB_TMO], 1u); break; } }
    }
    nloc = mine > 0u ? mine : 1u; nx = cnt > 0u ? cnt : 1u;
}

__device__ __forceinline__ void xcd_barrier(const XcdBarrier& b) {
    const int WAVE_ = b.wave;
    asm volatile("s_waitcnt vmcnt(0)" ::: "memory");
    __syncthreads();
    if (TID() == 0) {
        unsigned* bar = b.bar;
        __builtin_amdgcn_s_waitcnt(0);
        unsigned nloc = b.st[0], nx = b.st[1];
        if (nloc == 0u) { xcd_barrier_complete(bar, b.x, nloc, nx); b.st[0] = nloc; b.st[1] = nx; }
        const unsigned old = xb_add(&bar[XB_XSUB(b.x)], 1u);
        const unsigned gen = old / nloc;
        if (old + 1u == (gen + 1u) * nloc) {
            __builtin_amdgcn_fence(__ATOMIC_RELEASE, "agent");
            asm volatile("s_waitcnt vmcnt(0)" ::: "memory");
            const unsigned og = xb_add(&bar[XB_TOP], 1u);
            const unsigned tg = og / nx;
            if (og + 1u == (tg + 1u) * nx) xb_add(&bar[XB_TOPGEN], 1u);
            else XB_SPIN(xb_ld(&bar[XB_TOPGEN]) == tg, bar);
            __builtin_amdgcn_fence(__ATOMIC_ACQUIRE, "agent");
            xb_add(&bar[XB_XGEN(b.x)], 1u);
            asm volatile("s_waitcnt vmcnt(0)" ::: "memory");
        } else {
            XB_SPIN(xb_ld(&bar[XB_XGEN(b.x)]) == gen, bar);
            __builtin_amdgcn_fence(__ATOMIC_ACQUIRE, "agent");
            asm volatile("s_waitcnt vmcnt(0)" ::: "memory");
        }
    }
    __syncthreads();
}


struct Params {
    const float* in[18]; float* out; unsigned char* ws;
    int ph_lo, ph_hi, li, pad;
};
struct Frame {
    LAS unsigned char* lds; volatile LAS unsigned* MISC; gu32* ctl;
    int wave, vcu, G;
};

constexpr int CVT_WIN_TILES = 64 * 96 + 64 * 224;
constexpr int CVT_REST_TILES = 32 * 64 + 32 * 64 + 64 * 64 + 64 * 344 + 172 * 64 + 64 * 64 + 4 * 64;
struct CvtT { const float* src; const float* g; bf16* dst; int ldw, K; };
__device__ __forceinline__ CvtT cvt_decode(const Params& P, int it, int lane) {
    unsigned char* ws = P.ws;
    constexpr int T0 = 64 * 96, T1 = 64 * 224, T2 = 32 * 64, T3 = 32 * 64, T4 = 64 * 64, T5 = 64 * 344, T6 = 172 * 64, T7 = 64 * 64;
    const float* W; const float* g = nullptr; bf16* Wt; int ldw, srccol0 = 0, K, nrow0 = 0, NT; int r = it; bool is_up = false;
    if (r < T0) { W = P.in[3]; ldw = NIN; g = P.in[2]; Wt = (bf16*)(ws + WS_WIN); K = DM; NT = 96; }
    else if ((r -= T0) < T1) { W = P.in[3]; ldw = NIN; srccol0 = 6160; g = P.in[2]; Wt = (bf16*)(ws + WS_WIN); K = DM; nrow0 = 6144; NT = 224; }
    else if ((r -= T1) < T2) { W = P.in[7]; ldw = DM; Wt = (bf16*)(ws + WS_WBF); K = WF; NT = 64; }
    else if ((r -= T2) < T3) { W = P.in[8]; ldw = DM; Wt = (bf16*)(ws + WS_WBS); K = WF; NT = 64; }
    else if ((r -= T3) < T4) { W = P.in[9]; ldw = DM; Wt = (bf16*)(ws + WS_WOUT); K = DM; NT = 64; }
    else if ((r -= T4) < T5) { W = P.in[11]; ldw = 2 * DFF; g = P.in[10]; Wt = (bf16*)(ws + WS_WUP); K = DM; NT = 344; is_up = true; }
    else if ((r -= T5) < T6) { W = P.in[14]; ldw = DM; Wt = (bf16*)(ws + WS_WDN); K = DFF; NT = 64; }
    else if ((r -= T6) < T7) { W = P.in[16]; ldw = DM; g = P.in[15]; Wt = (bf16*)(ws + WS_WPG); K = DM; NT = 64; }
    else { r -= T7; W = P.in[17]; ldw = DM; Wt = (bf16*)(ws + WS_WPP); K = PLE; NT = 64; }
    const int nt = r % NT, kt = r / NT, nq = lane & 7, q = lane >> 3;
    CvtT T;
    int scol = srccol0 + 64 * nt;
    if (is_up) scol = ((nt & 3) >> 1) * DFF + 128 * (nt >> 2) + (nt & 1) * 64;
    T.src = W + (size_t)(64 * kt + 8 * q) * ldw + scol + 4 * nq;
    T.g = g ? g + 64 * kt + 8 * q : nullptr;
    T.dst = Wt + (size_t)(nrow0 + 64 * nt + 4 * nq) * K + 64 * kt + 8 * q;
    T.ldw = ldw; T.K = K;
    return T;
}
__device__ __forceinline__ void cvt_load(const CvtT& T, f32x4 (&v)[2][8]) {
#pragma unroll
    for (int p = 0; p < 2; ++p)
#pragma unroll
        for (int t = 0; t < 8; ++t) v[p][t] = __builtin_nontemporal_load((const f32x4*)(T.src + (size_t)t * T.ldw + 32 * p));
}
__device__ __forceinline__ void cvt_store(const CvtT& T, const f32x4 (&v)[2][8]) {
    f32x4 g0 = (f32x4){1.f, 1.f, 1.f, 1.f}, g1 = g0;
    if (T.g) { g0 = *(const f32x4*)T.g; g1 = *(const f32x4*)(T.g + 4); }
#pragma unroll
    for (int p = 0; p < 2; ++p)
#pragma unroll
        for (int i = 0; i < 4; ++i) {
            v4u w; w.x = pk2(v[p][0][i] * g0[0], v[p][1][i] * g0[1]); w.y = pk2(v[p][2][i] * g0[2], v[p][3][i] * g0[3]);
            w.z = pk2(v[p][4][i] * g1[0], v[p][5][i] * g1[1]); w.w = pk2(v[p][6][i] * g1[2], v[p][7][i] * g1[3]);
            *(v4u*)(T.dst + (size_t)(32 * p + i) * T.K) = w;
        }
}
__device__ __forceinline__ void p0_weights(const Frame& F, const Params& P) {
    const int WAVE_ = F.wave; const int f_lane = lane_id(), f_tid = TID();
    const int gw = F.vcu * NWAVES + F.wave, NGW = F.G * NWAVES, lane = f_lane;
    unsigned char* ws = P.ws;
    constexpr int NITEMS = CVT_WIN_TILES;
    f32x4 va[2][8], vb[2][8];
    int it = gw;
    if (it < NITEMS) {
        CvtT Ta = cvt_decode(P, it, lane); cvt_load(Ta, va);
        for (;;) {
            const int i1 = it + NGW; CvtT Tb = Ta;
            if (i1 < NITEMS) { Tb = cvt_decode(P, i1, lane); cvt_load(Tb, vb); }
            cvt_store(Ta, va);
            if (i1 >= NITEMS) break;
            const int i2 = i1 + NGW;
            if (i2 < NITEMS) { Ta = cvt_decode(P, i2, lane); cvt_load(Ta, va); }
            cvt_store(Tb, vb);
            if (i2 >= NITEMS) break;
            it = i2;
        }
    }
    { const float* w_in = P.in[3]; const float* g_mix = P.in[2]; bf16* wtf = (bf16*)(ws + WS_WTF);
      for (int i = blockIdx.x * 512 + f_tid; i < NH * (DM / 8); i += F.G * 512) { const int n = i / (DM / 8), kc = i % (DM / 8);
          float b[8];
#pragma unroll
          for (int t = 0; t < 8; ++t) b[t] = w_in[(size_t)(8 * kc + t) * NIN + 6144 + n] * g_mix[8 * kc + t];
          v4u w; w.x = pk2(b[0], b[1]); w.y = pk2(b[2], b[3]); w.z = pk2(b[4], b[5]); w.w = pk2(b[6], b[7]);
          *(v4u*)(wtf + (size_t)n * DM + 8 * kc) = w; } }
    const float* p = P.in[1]; bf16* pb = (bf16*)(ws + WS_PB);
    for (int i = blockIdx.x * 512 + f_tid; i < S * PLE / 8; i += F.G * 512) {
        const f32x4 a = *(const f32x4*)(p + (size_t)i * 8), b = *(const f32x4*)(p + (size_t)i * 8 + 4);
        v4u w; w.x = pk2(a[0], a[1]); w.y = pk2(a[2], a[3]); w.z = pk2(b[0], b[1]); w.w = pk2(b[2], b[3]);
        *(v4u*)(pb + (size_t)i * 8) = w;
    }
}
constexpr int CVT_SLOT = 18;
static_assert(2560 * CVT_SLOT >= CVT_REST_TILES, "conversion slots cover every tile");
struct ConvOrder : pg8::StaticOrder {
    const Params* P; int wave; mutable int slot;
    __device__ __forceinline__ void done(const pg8::Unit&) const {
        const int lane = lane_id();
        const int base = (slot * G + c) * CVT_SLOT; ++slot;
        const int i0 = base + wave, i1 = i0 + 8, i2 = i0 + 16;
        const int lim = (base + CVT_SLOT < CVT_REST_TILES) ? base + CVT_SLOT : CVT_REST_TILES;
        f32x4 va[2][8], vb[2][8];
        if (i0 < lim) {
            CvtT Ta = cvt_decode(*P, CVT_WIN_TILES + i0, lane); cvt_load(Ta, va);
            if (i1 < lim) {
                CvtT Tb = cvt_decode(*P, CVT_WIN_TILES + i1, lane); cvt_load(Tb, vb);
                cvt_store(Ta, va);
                if (i2 < lim) { Ta = cvt_decode(*P, CVT_WIN_TILES + i2, lane); cvt_load(Ta, va); cvt_store(Tb, vb); cvt_store(Ta, va); }
                else cvt_store(Tb, vb);
            } else cvt_store(Ta, va);
        }
    }
};
__device__ __forceinline__ void p0_rows(const Frame& F, const Params& P) {
    const int WAVE_ = F.wave; const int f_lane = lane_id();
    const float* x = P.in[0]; unsigned char* ws = P.ws;
    float* ss1 = (float*)(ws + WS_SS1); bf16* xb = (bf16*)(ws + WS_XB);
    const int gw = F.vcu * NWAVES + F.wave, NGW = F.G * NWAVES, lane = f_lane;
    for (int base = gw; base < S; base += 2 * NGW) {
        const int rowA = base, rowB = (base + NGW < S) ? base + NGW : base;
        const f32x4* xa = (const f32x4*)(x + (size_t)rowA * DM) + lane; const f32x4* xbp = (const f32x4*)(x + (size_t)rowB * DM) + lane;
        f32x4 va[16], vb[16]; float sa = 0.f, sb = 0.f;
#pragma unroll
        for (int j = 0; j < 16; ++j) va[j] = __builtin_nontemporal_load(xa + 64 * j);
#pragma unroll
        for (int j = 0; j < 16; ++j) vb[j] = __builtin_nontemporal_load(xbp + 64 * j);
#pragma unroll
        for (int j = 0; j < 16; ++j) sa += (va[j][0] * va[j][0] + va[j][1] * va[j][1]) + (va[j][2] * va[j][2] + va[j][3] * va[j][3]);
#pragma unroll
        for (int j = 0; j < 16; ++j) sb += (vb[j][0] * vb[j][0] + vb[j][1] * vb[j][1]) + (vb[j][2] * vb[j][2] + vb[j][3] * vb[j][3]);
        sa = wave_sum(sa); sb = wave_sum(sb);
        if (lane == 0) { ss1[rowA] = sa; ss1[rowB] = sb; }
        v2u* oa = (v2u*)(xb + (size_t)rowA * DM) + lane; v2u* ob = (v2u*)(xb + (size_t)rowB * DM) + lane;
#pragma unroll
        for (int j = 0; j < 16; ++j) { v2u w; w.x = pk2(va[j][0], va[j][1]); w.y = pk2(va[j][2], va[j][3]); oa[64 * j] = w; }
#pragma unroll
        for (int j = 0; j < 16; ++j) { v2u w; w.x = pk2(vb[j][0], vb[j][1]); w.y = pk2(vb[j][2], vb[j][3]); ob[64 * j] = w; }
    }
}

__device__ __forceinline__ void p1b_qknorm_fgate(const Frame& F, const Params& P) {
    const int WAVE_ = F.wave; const int f_lane = lane_id(), f_tid = TID();
    unsigned char* ws = P.ws;
    bf16* qkv = (bf16*)(ws + WS_QKV);
    const float* gq = P.in[5]; const float* gk = P.in[6];
    const int gw = F.vcu * NWAVES + F.wave, NGW = F.G * NWAVES, lane = f_lane, sub = lane >> 4, l16 = lane & 15;
    {
        const bf16* xb = (const bf16*)(ws + WS_XB); const bf16* wtf = (const bf16*)(ws + WS_WTF); const float* ss1 = (const float*)(ws + WS_SS1); const float* b_f = P.in[4];
        float* logf = (float*)(ws + WS_LOGF);
        LAS float* fbuf = (LAS float*)(F.lds + RING_OFF);
        const int wave = F.wave, rl = lane & 31, kg = lane >> 5;
        for (int grp = blockIdx.x; grp < S / 32; grp += F.G) {
            const int r0 = grp * 32;
            const bf16* pa = xb + (size_t)(r0 + rl) * DM + 512 * wave + 8 * kg;
            const bf16* pb = wtf + (size_t)(rl & 15) * DM + 512 * wave + 8 * kg;
            f32x16 acc = {};
#pragma unroll 8
            for (int ks = 0; ks < 32; ++ks) {
                const bf16x8 a = *(const bf16x8*)(pa + 16 * ks);
                bf16x8 b = *(const bf16x8*)(pb + 16 * ks);
                if (rl >= 16) b = (bf16x8){0, 0, 0, 0, 0, 0, 0, 0};
                acc = __builtin_amdgcn_mfma_f32_32x32x16_bf16(a, b, acc, 0, 0, 0);
            }
            if (rl < 16) {
#pragma unroll
                for (int r = 0; r < 16; ++r) { const int tok = (r & 3) + 8 * (r >> 2) + 4 * kg; fbuf[(wave * 32 + tok) * 16 + rl] = acc[r]; }
            }
            __syncthreads();
            {
                const int tok = f_tid >> 4, h = f_tid & 15; float fv = 0.f;
#pragma unroll
                for (int w = 0; w < 8; ++w) fv += fbuf[(w * 32 + tok) * 16 + h];
                fv = fv * rsqrtf(ss1[r0 + tok] * (1.0f / DM) + EPS) + b_f[h];
                const float lv = log_sigmoidf_(fv);
                logf[(size_t)h * S + r0 + tok] = lv;
                float bs = lv; bs += __shfl_xor(bs, 16); bs += __shfl_xor(bs, 32);
                if (lane < 16) __hip_atomic_fetch_add((float*)(F.ctl + CW_FBLK) + h * 32 + (r0 >> 8), bs, __ATOMIC_RELAXED, __HIP_MEMORY_SCOPE_AGENT);
            }
            __syncthreads();
        }
    }
}

__device__ __forceinline__ void p5c_fixup(const Frame& F, const Params& P) {
    const int WAVE_ = F.wave; const int f_tid = TID();
    unsigned char* ws = P.ws;
    const float* edge = (const float*)(ws + WS_EDGE); bf16* act = (bf16*)(ws + WS_ACT);
    const float* cw = P.in[12]; const float* cb = P.in[13];
    constexpr int NQ = DFF / 4;
    for (int i = blockIdx.x * 512 + f_tid; i < (S / 256) * 2 * NQ; i += F.G * 512) {
        const int row = i / NQ, jc = (i - row * NQ) * 4, p = row >> 1, rr = row & 1, t = 256 * p + rr;
        float uu[2][4];
#pragma unroll
        for (int h = 0; h < 2; ++h) {
            const size_t co = (size_t)h * DFF + jc; const f32x4 z = (f32x4){0.f, 0.f, 0.f, 0.f};
            const f32x4 c = *(const f32x4*)(edge + ((size_t)p * 4 + rr) * (2 * DFF) + co);
            const f32x4 l3 = p ? *(const f32x4*)(edge + ((size_t)(p - 1) * 4 + 3) * (2 * DFF) + co) : z;
            const f32x4 p1 = rr ? *(const f32x4*)(edge + ((size_t)p * 4 + 0) * (2 * DFF) + co) : l3;
            const f32x4 p2 = rr ? l3 : (p ? *(const f32x4*)(edge + ((size_t)(p - 1) * 4 + 2) * (2 * DFF) + co) : z);
            const f32x4 w0 = *(const f32x4*)(cw + co), w1 = *(const f32x4*)(cw + (size_t)2 * DFF + co), w2 = *(const f32x4*)(cw + (size_t)4 * DFF + co), bb = *(const f32x4*)(cb + co);
#pragma unroll
            for (int e = 0; e < 4; ++e) uu[h][e] = bb[e] + w0[e] * p2[e] + w1[e] * p1[e] + w2[e] * c[e];
        }
        v2u w; w.x = pk2(uu[0][0] * sigmoidf_(uu[0][0]) * uu[1][0], uu[0][1] * sigmoidf_(uu[0][1]) * uu[1][1]); w.y = pk2(uu[0][2] * sigmoidf_(uu[0][2]) * uu[1][2], uu[0][3] * sigmoidf_(uu[0][3]) * uu[1][3]);
        *(v2u*)(act + (size_t)t * DFF + jc) = w;
    }
}

namespace att {
constexpr int D = 128, PITCH = 2048, NW = 8, QBLK = 32, KVBLK = 64, QB = NW * QBLK;
constexpr int SHM_V = KVBLK * D * 2, SHM_K = KVBLK * D * 2;
constexpr int OFF_WS = 2 * SHM_V + 2 * SHM_K, OFF_FLAG = OFF_WS + NW * 64 * 4, OFF_WTOT = OFF_FLAG + 64, OFF_NEXT = OFF_WTOT + 64, OFF_C = 73728  , ATT_LDS_BYTES = OFF_C + 32768;
constexpr int OFF_TAB = ATT_LDS_BYTES  , OFF_SPL = OFF_TAB + 8192  , OFF_FBS = OFF_SPL + 2048  , OFF_TOT = OFF_FBS + 2048  ;
constexpr int PART_F = QB * D + 2 * QB;
constexpr float SCALE = 0.08838834764831845f;
constexpr float THR = 8.f;
constexpr int PRUNE_NATS = 40;
typedef short s16x4 __attribute__((ext_vector_type(4)));
typedef unsigned u32x4 __attribute__((ext_vector_type(4)));
#define KSWZ(row, colB) ((row) * 256 + ((colB) ^ (((row) & 7) << 4)))
#define SBAR() __builtin_amdgcn_sched_barrier(0)
__device__ __forceinline__ int v_st(int k, int c) { const int kk = (k & ~0xC) | ((k & 4) << 1) | ((k & 8) >> 1); return ((kk >> 3) * 4 + (c >> 5)) * 512 + ((kk & 7) * 32 + (c & 31)) * 2; }
__device__ __forceinline__ int v_rd_base(int lane) { return ((lane & 3) << 3) | (((lane >> 2) & 3) << 6) | (((lane >> 4) & 1) << 5) | (((lane >> 5) & 1) << 8); }
constexpr int v_rd_off(int d0, int ks, int half) { return d0 * 512 + ks * 4096 + half * 2048; }
__device__ __forceinline__ int crow(int r, int hi) { return (r & 3) + 8 * (r >> 2) + 4 * hi; }
__device__ __forceinline__ unsigned cvtpk(float lo, float hi) { unsigned r; asm volatile("v_cvt_pk_bf16_f32 %0, %1, %2" : "=v"(r) : "v"(lo), "v"(hi)); return r; }
__device__ __forceinline__ bf16x8 load8(const bf16* p) { return *reinterpret_cast<const bf16x8*>(p); }
__device__ __forceinline__ void mask_tile(f32x16& p0, f32x16& p1, int dq) {
    const float NEG = -__builtin_inff();
#pragma unroll
    for (int r = 0; r < 16; ++r) { const int c = (r & 3) + 8 * (r >> 2); if (dq - c < 0) p0[r] = NEG; if (dq - c - 32 < 0) p1[r] = NEG; }
}
__device__ __forceinline__ void partialSM(f32x16& p0, f32x16& p1, float& m_reg, float& mn, float& alpha) {
    float pmax = p0[0]; for (int r = 1; r < 16; ++r) pmax = fmaxf(pmax, p0[r]); for (int r = 0; r < 16; ++r) pmax = fmaxf(pmax, p1[r]);
    { auto rr = __builtin_amdgcn_permlane32_swap(__float_as_uint(pmax), __float_as_uint(pmax), false, false);
      pmax = fmaxf(__uint_as_float(rr[0]), __uint_as_float(rr[1])); }
    constexpr float C2 = 1.4426950408889634f * SCALE;
    if (__builtin_expect(__all((pmax - m_reg) * SCALE <= THR), 1)) { mn = m_reg; alpha = 1.f; }
    else { mn = fmaxf(m_reg, pmax); alpha = __builtin_amdgcn_exp2f((m_reg - mn) * C2); m_reg = mn; }
    const float mnL = -mn * C2;
    for (int r = 0; r < 16; ++r) p0[r] = fmaf(p0[r], C2, mnL); for (int r = 0; r < 16; ++r) p1[r] = fmaf(p1[r], C2, mnL);
    for (int r = 0; r < 16; ++r) p0[r] = __builtin_amdgcn_exp2f(p0[r]);
}
#define PK4(P, B_, OUT) do { unsigned a0 = cvtpk(P[B_+0], P[B_+1]), a1 = cvtpk(P[B_+2], P[B_+3]);                          \
        unsigned b0 = cvtpk(P[B_+4], P[B_+5]), b1 = cvtpk(P[B_+6], P[B_+7]);                                             \
        auto r0 = __builtin_amdgcn_permlane32_swap(a0, b0, false, false); auto r1 = __builtin_amdgcn_permlane32_swap(a1, b1, false, false); \
        u32x4 w = {r0[0], r1[0], r0[1], r1[1]}; OUT = *reinterpret_cast<bf16x8*>(&w); } while (0)
__device__ __forceinline__ void finishSM(f32x16& p0, f32x16& p1, float alpha, float& l_reg, bf16x8& pa0, bf16x8& pa1, bf16x8& pa2, bf16x8& pa3) {
    for (int r = 0; r < 16; ++r) p1[r] = __builtin_amdgcn_exp2f(p1[r]);
    float ps = 0; for (int r = 0; r < 16; ++r) ps += p0[r]; for (int r = 0; r < 16; ++r) ps += p1[r];
    { auto rr = __builtin_amdgcn_permlane32_swap(__float_as_uint(ps), __float_as_uint(ps), false, false);
      ps = __uint_as_float(rr[0]) + __uint_as_float(rr[1]); }
    l_reg = l_reg * alpha + ps;
    PK4(p0, 0, pa0); PK4(p0, 8, pa1); PK4(p1, 0, pa2); PK4(p1, 8, pa3);
}
template <int KB>
__device__ __forceinline__ void qkt(f32x16& p0, f32x16& p1, const char* K_lds, int r32, int hi, const bf16x8* qr) {
    p0 = f32x16{}; p1 = f32x16{};
    const char* kb[4];
#pragma unroll
    for (int dd = 0; dd < 4; ++dd) kb[dd] = K_lds + KB * SHM_K + KSWZ(r32, (dd * 16 + hi * 8) * 2);
#pragma unroll
    for (int d0 = 0; d0 < 8; ++d0) { const char* a = kb[d0 & 3] + (d0 >> 2) * 128;
        bf16x8 b0 = *reinterpret_cast<const bf16x8*>(a);
        bf16x8 b1 = *reinterpret_cast<const bf16x8*>(a + 32 * 256);
        p0 = __builtin_amdgcn_mfma_f32_32x32x16_bf16(b0, qr[d0], p0, 0, 0, 0);
        p1 = __builtin_amdgcn_mfma_f32_32x32x16_bf16(b1, qr[d0], p1, 0, 0, 0); }
}
template <int VB>
__device__ __forceinline__ void pv_tile(f32x16* o, int vb0, bf16x8 pa0, bf16x8 pa1, bf16x8 pa2, bf16x8 pa3) {
#define TRRD(dst, off) asm volatile("ds_read_b64_tr_b16 %0, %1 offset:%2" : "=&v"(dst) : "v"(vb0), "i"(off) : "memory")
#define PV_D0(d0) do { s16x4 l0, l1, l2, l3, h0, h1, h2, h3; constexpr int b_ = VB * SHM_V + v_rd_off(d0, 0, 0); \
        TRRD(l0, b_); TRRD(h0, b_ + 2048); TRRD(l1, b_ + 4096); TRRD(h1, b_ + 6144); TRRD(l2, b_ + 8192); TRRD(h2, b_ + 10240); TRRD(l3, b_ + 12288); TRRD(h3, b_ + 14336); \
        asm volatile("s_waitcnt lgkmcnt(0)" ::: "memory"); SBAR();   \
        o[d0] = __builtin_amdgcn_mfma_f32_32x32x16_bf16(pa0, (bf16x8){l0[0], l0[1], l0[2], l0[3], h0[0], h0[1], h0[2], h0[3]}, o[d0], 0, 0, 0);   \
        o[d0] = __builtin_amdgcn_mfma_f32_32x32x16_bf16(pa1, (bf16x8){l1[0], l1[1], l1[2], l1[3], h1[0], h1[1], h1[2], h1[3]}, o[d0], 0, 0, 0);   \
        o[d0] = __builtin_amdgcn_mfma_f32_32x32x16_bf16(pa2, (bf16x8){l2[0], l2[1], l2[2], l2[3], h2[0], h2[1], h2[2], h2[3]}, o[d0], 0, 0, 0);   \
        o[d0] = __builtin_amdgcn_mfma_f32_32x32x16_bf16(pa3, (bf16x8){l3[0], l3[1], l3[2], l3[3], h3[0], h3[1], h3[2], h3[3]}, o[d0], 0, 0, 0); } while (0)
    PV_D0(0); PV_D0(1); PV_D0(2); PV_D0(3);
#undef PV_D0
#undef TRRD
}
__device__ __forceinline__ void key_bias(f32x16& p0, f32x16& p1, const char* lds, int kbase, int hi) {
    const float* kbp = (const float*)(lds + OFF_C) + kbase + 4 * hi;
#pragma unroll
    for (int g = 0; g < 4; ++g) { const f32x4 b0 = *(const f32x4*)(kbp + 8 * g), b1 = *(const f32x4*)(kbp + 32 + 8 * g);
#pragma unroll
        for (int e = 0; e < 4; ++e) { p0[4 * g + e] -= b0[e]; p1[4 * g + e] -= b1[e]; } }
}
__device__ __forceinline__ void cgate_scan(const float* logf_h, char* lds, const int WAVE_) {
    const int lane = lane_id(), tid = WAVE_ * 64 + lane;
    float* Cl = (float*)(lds + OFF_C); float* wtot = (float*)(lds + OFF_WTOT);
    const float* src = logf_h + tid * 16;
    const f32x4 a = *(const f32x4*)src, b = *(const f32x4*)(src + 4), c = *(const f32x4*)(src + 8), d = *(const f32x4*)(src + 12);
    const float in[16] = {a[0], a[1], a[2], a[3], b[0], b[1], b[2], b[3], c[0], c[1], c[2], c[3], d[0], d[1], d[2], d[3]};
    float loc[16]; float s = 0.f;
#pragma unroll
    for (int j = 0; j < 16; ++j) { s += in[j]; loc[j] = s; }
    float incl = s;
#pragma unroll
    for (int o = 1; o < 64; o <<= 1) { const float t = __builtin_bit_cast(float, __builtin_amdgcn_ds_bpermute((lane - o) << 2, __builtin_bit_cast(int, incl))); if (lane >= o) incl += t; }
    if (lane == 63) wtot[WAVE_] = incl;
    __syncthreads();
    float base = incl - s;
    for (int w = 0; w < WAVE_; ++w) base += wtot[w];
#pragma unroll
    for (int j = 0; j < 16; j += 4) *(f32x4*)(Cl + tid * 16 + j) = (f32x4){base + loc[j], base + loc[j + 1], base + loc[j + 2], base + loc[j + 3]} * (1.0f / SCALE);
    __syncthreads();
}

struct BlockRef { const bf16* Q; const bf16* K; const bf16* V; bf16* O; int P0; int top, nst; float* part; };
struct Seam { bf16x8 qr[8]; bf16x8 st_v0, st_v1, st_k0, st_k1; };
#define ROW(p, k0, rr) ((p) + (size_t)((k0) + (rr)) * PITCH + sc)
#define VMW() asm volatile("s_waitcnt vmcnt(0)" ::: "memory")
#define VMWN(n) asm volatile("s_waitcnt vmcnt(%0)" :: "i"(n) : "memory")
#define SLOAD_H(Kp, Vp, k0) do { S.st_v0 = load8(ROW(Vp, k0, sr)); S.st_v1 = load8(ROW(Vp, k0, 32 + sr));              \
                         S.st_k0 = load8(ROW(Kp, k0, sr)); S.st_k1 = load8(ROW(Kp, k0, 32 + sr)); } while (0)
#define SWRITE_HK(bf) do { *(bf16x8*)(K_lds + (bf) * SHM_K + kws) = S.st_k0; *(bf16x8*)(K_lds + (bf) * SHM_K + kws + 32 * 256) = S.st_k1; } while (0)
#define SWRITE_HV(bf) do { *(bf16x8*)(V_lds + (bf) * SHM_V + vst0) = S.st_v0; *(bf16x8*)(V_lds + (bf) * SHM_V + vst1) = S.st_v1; } while (0)
#define SWRITE_H(bf) do { SWRITE_HV(bf); SWRITE_HK(bf); } while (0)
__device__ __forceinline__ void fox_prime(const BlockRef& cur, char* lds, Seam& S, const int WAVE_) {
    const int tid = TID(), wid = __builtin_amdgcn_readfirstlane(tid >> 6), lane = tid & 63, r32 = lane & 31, hi = lane >> 5;
    const int sr = tid >> 4, sc = (tid & 15) * 8, kws = KSWZ(sr, sc * 2); char* K_lds = lds + 2 * SHM_V;
    for (int d0 = 0; d0 < 8; ++d0) S.qr[d0] = load8(cur.Q + (size_t)(wid * QBLK + r32) * PITCH + d0 * 16 + hi * 8);
    SLOAD_H(cur.K, cur.V, cur.top * KVBLK); VMW(); SWRITE_HK(0);
    __syncthreads();
}
__device__ __forceinline__ void fox_block(const BlockRef& cur, const BlockRef& nxt, const float Uq, char* lds, Seam& S, const int WAVE_) {
    const int tid = TID(), wid = __builtin_amdgcn_readfirstlane(tid >> 6), lane = tid & 63, r32 = lane & 31, hi = lane >> 5;
    const int NT0 = cur.top + 1;
    int NT = cur.nst;
    volatile LAS int* flg = (volatile LAS int*)(lds + OFF_FLAG);
    const int qlo = cur.P0 + wid * QBLK, qm = qlo + r32 - 4 * hi;
    char* V_lds = lds; char* K_lds = lds + 2 * SHM_V;
    float* ws = (float*)(lds + OFF_WS) + wid * 64; float* li_l = ws, * al_l = ws + 32;
    float m_reg = -Uq - ((const float*)(lds + OFF_C))[cur.P0 + wid * QBLK + r32], l_reg = 0; f32x16 o[4] = {};
    const int sr = tid >> 4, sc = (tid & 15) * 8, vst0 = v_st(sr, sc), vst1 = v_st(32 + sr, sc), kws = KSWZ(sr, sc * 2);
    const int vb0 = (int)(uintptr_t)V_lds + v_rd_base(lane);
    const bf16* Kh = cur.K; const bf16* Vh = cur.V;
#define RESC(a) do { if (__any((a) < 1.f)) { if (hi == 0) al_l[r32] = (a); asm volatile("s_waitcnt lgkmcnt(0)" ::: "memory");              \
                     for (int d_ = 0; d_ < 4; ++d_) for (int r = 0; r < 16; ++r) o[d_][r] *= al_l[crow(r, hi)]; } } while (0)
#define KBASE(t) ((NT0 - 1 - (t)) * KVBLK)
#define MASKT(P0_, P1_, t, KBUF) do { const int kb_ = KBASE(t); key_bias(P0_, P1_, lds, kb_, hi); if (kb_ + KVBLK - 1 > qlo) mask_tile(P0_, P1_, qm - kb_); } while (0)
#define SEAM_K0() do { VMWN(8); SWRITE_HK(0); SBAR(); } while (0)
    f32x16 pA0, pA1, pB0, pB1; float mnA, mnB, alA, alB; bf16x8 pa0, pa1, pa2, pa3;
    SWRITE_HV(0); SBAR();
    if (NT > 1) { SLOAD_H(Kh, Vh, KBASE(1)); }
    SBAR(); qkt<0>(pA0, pA1, K_lds, r32, hi, S.qr);
    MASKT(pA0, pA1, 0, 0); partialSM(pA0, pA1, m_reg, mnA, alA);
    if (NT > 1) { VMW(); SWRITE_H(1); }
    __syncthreads();
#define VOTE(t) do { bool can_ = false; if ((t) + 2 < NT) { const float negc_ = -((const float*)(lds + OFF_C))[KBASE((t) + 2) + KVBLK - 1]; can_ = __all((Uq + negc_ - m_reg) * SCALE <= -(float)PRUNE_NATS) != 0; } \
                     if (lane == 0) flg[wid] = can_ ? 1 : 0; } while (0)
#define DECIDE(t) do { int all_ = 1; _Pragma("unroll") for (int w_ = 0; w_ < 8; ++w_) all_ &= flg[w_]; if (all_ && (t) + 2 < NT) NT = (t) + 2; } while (0)
#define HALF_STEP(PX0, PX1, mnX, alX, PY0, PY1, alY, t, KB, VB, SB) do {                                                      \
        SBAR(); qkt<KB>(PX0, PX1, K_lds, r32, hi, S.qr);                                                                     \
        finishSM(PY0, PY1, alY, l_reg, pa0, pa1, pa2, pa3); SBAR();                                                           \
        if ((t) + 1 < NT) { SLOAD_H(Kh, Vh, KBASE((t) + 1)); SBAR(); }                                                    \
        pv_tile<VB>(o, vb0, pa0, pa1, pa2, pa3); MASKT(PX0, PX1, (t), KB); partialSM(PX0, PX1, m_reg, mnX, alX); VOTE(t);    \
        __syncthreads(); DECIDE(t);                                                                                           \
        if ((t) + 1 < NT) { VMW(); SWRITE_H(SB); }                                                                            \
        RESC(alX); __syncthreads(); } while (0)
    for (int t = 1; t + 1 < NT; t += 2) {
        HALF_STEP(pB0, pB1, mnB, alB, pA0, pA1, alA, t, 1, 0, 0);
        HALF_STEP(pA0, pA1, mnA, alA, pB0, pB1, alB, t + 1, 0, 1, 1);
    }
    const bool even = (NT & 1) == 0;
    if (even) { SBAR(); qkt<1>(pB0, pB1, K_lds, r32, hi, S.qr); SBAR(); }
    SLOAD_H(nxt.K, nxt.V, nxt.top * KVBLK); SBAR();
#pragma unroll
    for (int d0 = 0; d0 < 8; ++d0) S.qr[d0] = load8(nxt.Q + (size_t)(wid * QBLK + r32) * PITCH + d0 * 16 + hi * 8);
    SBAR();
    finishSM(pA0, pA1, alA, l_reg, pa0, pa1, pa2, pa3); SBAR();
    pv_tile<0>(o, vb0, pa0, pa1, pa2, pa3);
    if (even) { MASKT(pB0, pB1, NT - 1, 1); partialSM(pB0, pB1, m_reg, mnB, alB); __syncthreads(); RESC(alB);
        finishSM(pB0, pB1, alB, l_reg, pa0, pa1, pa2, pa3); SBAR(); pv_tile<1>(o, vb0, pa0, pa1, pa2, pa3); }
    SBAR(); SEAM_K0();
    if (cur.part != nullptr) {
        float* po = cur.part + (size_t)(wid * QBLK) * D + r32;
#pragma unroll
        for (int r = 0; r < 16; ++r) { const int orow = crow(r, hi);
#pragma unroll
            for (int d0 = 0; d0 < 4; ++d0) po[orow * D + d0 * 32] = o[d0][r]; }
        if (hi == 0) { cur.part[QB * D + wid * QBLK + r32] = m_reg; cur.part[QB * D + QB + wid * QBLK + r32] = l_reg; }
    } else {
    if (hi == 0) li_l[r32] = l_reg; asm volatile("s_waitcnt lgkmcnt(0)" ::: "memory");
    float rli[16];
#pragma unroll
    for (int r = 0; r < 16; ++r) rli[r] = __builtin_amdgcn_rcpf(li_l[crow(r, hi)]);
    bf16* Ow = cur.O + (size_t)(wid * QBLK) * PITCH;
#pragma unroll
    for (int r = 0; r < 16; ++r) { const int orow = crow(r, hi);
#pragma unroll
        for (int d0 = 0; d0 < 4; ++d0) { const float v = o[d0][r] * rli[r];
            const float vn = __shfl_xor(v, 1);
            if ((r32 & 1) == 0) *(unsigned*)(Ow + (size_t)orow * PITCH + d0 * 32 + r32) = cvtpk(v, vn); } }
    }
    __syncthreads();
#undef RESC
#undef MASKT
#undef SEAM_K0
#undef HALF_STEP
#undef VOTE
#undef DECIDE
#undef KBASE
}

__device__ __forceinline__ void fox_combine(const float* __restrict__ slot0, const int np, bf16* __restrict__ O, const int WAVE_) {
    const int lane = lane_id(), c = (lane & 31) * 4;
    constexpr float C2 = 1.4426950408889634f * SCALE;
    const float NINF = -__builtin_inff();
    for (int it0 = 0; it0 < 16; it0 += 4) {
        float mv[4][4], lv[4][4]; f32x4 dv[4][4];
#pragma unroll
        for (int u = 0; u < 4; ++u) { const int row = WAVE_ * 32 + (it0 + u) * 2 + (lane >> 5);
#pragma unroll
            for (int p = 0; p < 4; ++p) { mv[u][p] = NINF; lv[u][p] = 0.f; dv[u][p] = (f32x4){0.f, 0.f, 0.f, 0.f};
                if (p < np) { const float* s = slot0 + (size_t)p * PART_F; mv[u][p] = s[QB * D + row]; lv[u][p] = s[QB * D + QB + row]; dv[u][p] = *(const f32x4*)(s + (size_t)row * D + c); } } }
#pragma unroll
        for (int u = 0; u < 4; ++u) { const int row = WAVE_ * 32 + (it0 + u) * 2 + (lane >> 5);
            const float M = fmaxf(fmaxf(mv[u][0], mv[u][1]), fmaxf(mv[u][2], mv[u][3]));
            float den = 0.f; f32x4 a = {0.f, 0.f, 0.f, 0.f};
#pragma unroll
            for (int p = 0; p < 4; ++p) { const float e = __builtin_amdgcn_exp2f((mv[u][p] - M) * C2); den += e * lv[u][p]; a += dv[u][p] * e; }
            a *= 1.0f / den;
            unsigned x, y;
            asm("v_cvt_pk_bf16_f32 %0, %1, %2" : "=v"(x) : "v"(a[0]), "v"(a[1]));
            asm("v_cvt_pk_bf16_f32 %0, %1, %2" : "=v"(y) : "v"(a[2]), "v"(a[3]));
            uint2 pk; pk.x = x; pk.y = y;
            *(uint2*)(O + (size_t)row * PITCH + c) = pk; }
    }
}

template <int BUF>
__device__ __forceinline__ void sb_tile(f32x16* o, float& R, const char* K_lds, int vb0, int r32, int hi, const bf16x8* qr, int dq) {
    f32x16 p0, p1;
    qkt<BUF>(p0, p1, K_lds, r32, hi, qr);
    constexpr float L2E = 1.4426950408889634f, LN2 = 0.6931471805599453f;
    f32x16 l0, l1;
    const float NEG = -__builtin_inff();
#pragma unroll
    for (int r = 0; r < 16; ++r) { const int c = (r & 3) + 8 * (r >> 2);
        { const float z = p0[r] * SCALE; const float sp = fmaxf(z, 0.f) + LN2 * __builtin_amdgcn_logf(1.0f + __builtin_amdgcn_exp2f(-fabsf(z) * L2E)); const bool st = (dq - c) >= 1; l0[r] = st ? -sp : 0.f; p0[r] = st ? (z - sp) : NEG; }
        { const float z = p1[r] * SCALE; const float sp = fmaxf(z, 0.f) + LN2 * __builtin_amdgcn_logf(1.0f + __builtin_amdgcn_exp2f(-fabsf(z) * L2E)); const bool st = (dq - c - 32) >= 1; l1[r] = st ? -sp : 0.f; p1[r] = st ? (z - sp) : NEG; } }
    float gs[8], pg[8], ps[8];
#pragma unroll
    for (int g = 0; g < 4; ++g) { gs[g] = (l0[4 * g] + l0[4 * g + 1]) + (l0[4 * g + 2] + l0[4 * g + 3]); gs[4 + g] = (l1[4 * g] + l1[4 * g + 1]) + (l1[4 * g + 2] + l1[4 * g + 3]); }
#pragma unroll
    for (int g = 0; g < 8; ++g) { auto rr = __builtin_amdgcn_permlane32_swap(__float_as_uint(gs[g]), __float_as_uint(gs[g]), false, false);
        const float lo = __uint_as_float(rr[0]), hv = __uint_as_float(rr[1]); ps[g] = lo + hv; pg[g] = hi ? lo : hv; }
    float acc = R;
#pragma unroll
    for (int g = 7; g >= 0; --g) {
        float run = hi ? acc : acc + pg[g];
        acc += ps[g];
        if (g >= 4) { const int b = 4 * (g - 4);
#pragma unroll
            for (int e = 3; e >= 0; --e) { const float t = l1[b + e]; p1[b + e] = __builtin_amdgcn_exp2f((p1[b + e] + run) * L2E); run += t; } }
        else { const int b = 4 * g;
#pragma unroll
            for (int e = 3; e >= 0; --e) { const float t = l0[b + e]; p0[b + e] = __builtin_amdgcn_exp2f((p0[b + e] + run) * L2E); run += t; } }
    }
    R = acc;
    bf16x8 pa0, pa1, pa2, pa3;
    PK4(p0, 0, pa0); PK4(p0, 8, pa1); PK4(p1, 0, pa2); PK4(p1, 8, pa3);
    pv_tile<BUF>(o, vb0, pa0, pa1, pa2, pa3);
}
__device__ __forceinline__ void sb_block(const BlockRef& cur, char* lds, const int WAVE_) {
    const int tid = TID(), wid = __builtin_amdgcn_readfirstlane(tid >> 6), lane = tid & 63, r32 = lane & 31, hi = lane >> 5;
    const int NT = (cur.P0 + QB - 1) / KVBLK + 1;
    const int qlo = cur.P0 + wid * QBLK, qm = qlo + r32 - 4 * hi;
    char* V_lds = lds; char* K_lds = lds + 2 * SHM_V;
    volatile LAS int* flg = (volatile LAS int*)(lds + OFF_FLAG);
    const int sr = tid >> 4, sc = (tid & 15) * 8, vst0 = v_st(sr, sc), vst1 = v_st(32 + sr, sc), kws = KSWZ(sr, sc * 2);
    const int vb0 = (int)(uintptr_t)V_lds + v_rd_base(lane);
    const bf16* Kh = cur.K; const bf16* Vh = cur.V;
    bf16x8 qr[8];
#pragma unroll
    for (int d0 = 0; d0 < 8; ++d0) qr[d0] = load8(cur.Q + (size_t)(wid * QBLK + r32) * PITCH + d0 * 16 + hi * 8);
    bf16x8 st_v0, st_v1, st_k0, st_k1;
#define SB_LOAD(k0) do { st_v0 = load8(ROW(Vh, k0, sr)); st_v1 = load8(ROW(Vh, k0, 32 + sr)); st_k0 = load8(ROW(Kh, k0, sr)); st_k1 = load8(ROW(Kh, k0, 32 + sr)); } while (0)
#define SB_WRITE(bf) do { *(bf16x8*)(V_lds + (bf) * SHM_V + vst0) = st_v0; *(bf16x8*)(V_lds + (bf) * SHM_V + vst1) = st_v1; \
                          *(bf16x8*)(K_lds + (bf) * SHM_K + kws) = st_k0; *(bf16x8*)(K_lds + (bf) * SHM_K + kws + 32 * 256) = st_k1; } while (0)
    f32x16 o[4] = {}; float R = 0.f; bool fin = false;
    SB_LOAD((NT - 1) * KVBLK); VMW(); SB_WRITE(0);
    if (NT > 1) SB_LOAD((NT - 2) * KVBLK);
    __syncthreads();
#define SB_STEP(t, BUF) do { const int kb_ = (NT - 1 - (t)) * KVBLK;                                                         \
        if (!fin && kb_ <= qlo + QBLK - 2) { sb_tile<BUF>(o, R, K_lds, vb0, r32, hi, qr, qm - kb_); fin = __all(R < -(float)(PRUNE_NATS + 1)); } \
        if ((t) + 1 < NT) { VMW(); SB_WRITE((BUF) ^ 1); if ((t) + 2 < NT) SB_LOAD((NT - 3 - (t)) * KVBLK); }                   \
        if (lane == 0) flg[(BUF) * 8 + wid] = fin ? 1 : 0;                                                                   \
        __syncthreads();                                                                                                      \
        { int all_ = 1; _Pragma("unroll") for (int w_ = 0; w_ < 8; ++w_) all_ &= flg[(BUF) * 8 + w_]; stop = all_ != 0; } } while (0)
    bool stop = false;
    for (int t = 0; t < NT; t += 2) {
        SB_STEP(t, 0);
        if (stop || t + 1 >= NT) break;
        SB_STEP(t + 1, 1);
        if (stop) break;
    }
    bf16* Ow = cur.O + (size_t)(wid * QBLK) * PITCH;
#pragma unroll
    for (int r = 0; r < 16; ++r) { const int orow = crow(r, hi);
#pragma unroll
        for (int d0 = 0; d0 < 4; ++d0) { const float v = o[d0][r];
            const float vn = __shfl_xor(v, 1);
            if ((r32 & 1) == 0) *(unsigned*)(Ow + (size_t)orow * PITCH + d0 * 32 + r32) = cvtpk(v, vn); } }
    __syncthreads();
#undef SB_LOAD
#undef SB_WRITE
#undef SB_STEP
}
#undef ROW
#undef VMW
#undef VMWN
#undef SLOAD_H
#undef SWRITE_HK
#undef SWRITE_HV
#undef SWRITE_H
#undef PK4
#undef KSWZ
}

constexpr int REP_X3 = 0;
constexpr int REP_X2 = 0;
constexpr int X1_PAD = 0;
constexpr bool GRELAX = false;
constexpr int X1_RELAX = 0;
constexpr int X1_STG = 0;
constexpr int X1_DIAG = 0;
constexpr int X1_ALIGN = 0, X1_SP2 = 1, X1_CONSTA = 0;
constexpr int REP_X1 = 0, REP_X1N = 20480;
constexpr int REP_ATT = 1;
constexpr int REP_P0W = 1, REP_P0R = 1;
constexpr int REP_P0 = 1, REP_P1 = 1, REP_FOX = 1, REP_SB = 1, REP_P3A = 1, REP_P5 = 1, REP_P5B = 1, REP_P7A = 1;
constexpr int TIMER_A = -2, TIMER_B = -2;
constexpr int SPLIT_TILES = 24;
constexpr int PARTS_MAIN = (int)((172 * MiB) / ((size_t)att::PART_F * 4)) - 4, PARTS_OVF = (int)((64 * MiB) / ((size_t)att::PART_F * 4));
__device__ __forceinline__ float* parts_base(unsigned char* ws, int slot0) {
    return (slot0 < PARTS_MAIN) ? (float*)(ws + WS_ACT) + (size_t)slot0 * att::PART_F : (float*)(ws + WS_MERGED) + (size_t)(slot0 - PARTS_MAIN) * att::PART_F;
}
constexpr int fox_worst_slots() { int s = 0; for (int qb = 0; qb < 32; ++qb) { const int nt = 4 * qb + 4; int np = (nt + SPLIT_TILES - 1) / SPLIT_TILES; np = np > 4 ? 4 : np; if (np > 1) s += np; } return s * NH; }
static_assert(fox_worst_slots() <= PARTS_MAIN + PARTS_OVF && fox_worst_slots() < 2048, "partial-result slots fit the scratch (and the 11-bit slot field)");
__device__ __forceinline__ void fox_table(const Frame& F, const float Uq) {
    const int WAVE_ = F.wave; const int lane = lane_id(), tid = WAVE_ * 64 + lane;
    LAS float* fbs = (LAS float*)(F.lds + RING_OFF + att::OFF_FBS); volatile LAS unsigned* tot = (volatile LAS unsigned*)(F.lds + RING_OFF + att::OFF_TOT);
    volatile LAS unsigned* tab = (volatile LAS unsigned*)(F.lds + RING_OFF + att::OFF_TAB); volatile LAS unsigned* spl = (volatile LAS unsigned*)(F.lds + RING_OFF + att::OFF_SPL);
    fbs[tid] = ((const float*)(F.ctl + CW_FBLK))[tid];
    __syncthreads();
    const int h = tid & 15, qb = 31 - (tid >> 4);
    const float thr = (float)att::PRUNE_NATS + 2.f * Uq * att::SCALE;
    float dec = 0.f; int nb = 0;
    while (nb < qb && dec > -thr) { dec += fbs[h * 32 + qb - 1 - nb]; ++nb; }
    const int NT0 = 4 * qb + 4; int Tn = 4 + 4 * nb + 1; Tn = Tn < NT0 ? Tn : NT0;
    int np = (Tn + SPLIT_TILES - 1) / SPLIT_TILES; np = np > 4 ? 4 : np;
    const int ps = (Tn + np - 1) / np;
    const unsigned mine = (unsigned)np | ((np > 1 ? (unsigned)np : 0u) << 12) | ((np > 1 ? 1u : 0u) << 23);
    unsigned incl = mine;
#pragma unroll
    for (int o = 1; o < 64; o <<= 1) { const unsigned t = (unsigned)__builtin_amdgcn_ds_bpermute((lane - o) << 2, (int)incl); if (lane >= o) incl += t; }
    if (lane == 63) tot[WAVE_] = incl;
    __syncthreads();
    unsigned base = incl - mine;
    for (int w = 0; w < WAVE_; ++w) base += tot[w];
    const unsigned s0 = (base >> 12) & 2047u, x0 = base >> 23;
    if (np > 1) spl[x0] = (unsigned)tid | ((unsigned)np << 11) | (s0 << 21);
    if (tid == NWAVES * 64 - 1) { tot[8] = (base & 4095u) + np; tot[9] = x0 + (np > 1 ? 1u : 0u); }
    volatile LAS unsigned* key = (volatile LAS unsigned*)(F.lds + RING_OFF + att::OFF_SPL + 2048 + 2048 + 64);
    key[tid] = ((unsigned)ps << 16) | (unsigned)np;
    __syncthreads();
    unsigned rank = 0;
    {   const LAS v4u* k4 = (const LAS v4u*)(F.lds + RING_OFF + att::OFF_SPL + 2048 + 2048 + 64);
#pragma unroll 8
        for (int j4 = 0; j4 < NWAVES * 16; ++j4) { const v4u kk = k4[j4];
#pragma unroll
            for (int e = 0; e < 4; ++e) { const unsigned kj = e == 0 ? kk.x : e == 1 ? kk.y : e == 2 ? kk.z : kk.w; const int psj = (int)(kj >> 16), j = 4 * j4 + e; if (psj > ps || (psj == ps && j < tid)) rank += kj & 0xffffu; } } }
    for (int p = 0; p < np; ++p) tab[rank + p] = (unsigned)tid | ((unsigned)p << 9) | ((unsigned)np << 11) | ((unsigned)ps << 14) | (s0 << 21);
    __syncthreads();
}
enum { PH_P0 = 0, PH_P1, PH_P1B, PH_ATT, PH_P3A, PH_P3B, PH_P4, PH_P5, PH_P5B, PH_P6, PH_P7A, PH_P7, PH_N };
__global__ void __launch_bounds__(NWAVES * 64, 2) mega_fwd(Params P) {
    extern __shared__ __attribute__((aligned(16))) unsigned char lds[];
    Frame F;
    F.lds = (LAS unsigned char*)lds;
    F.MISC = (volatile LAS unsigned*)(F.lds + MISC_OFF);
    F.wave = __builtin_amdgcn_readfirstlane((int)(__builtin_amdgcn_workitem_id_x() >> 6));
    const int WAVE_ = F.wave; const int f_tid = TID();
    F.G = gridDim.x; { const int bx = blockIdx.x; F.vcu = (F.G % 8 == 0) ? (bx % 8) * (F.G / 8) + bx / 8 : bx; }
    unsigned char* ws = P.ws;
    F.ctl = (gu32*)(ws + WS_CTL);
    for (int u = f_tid; u < (LDS_BYTES - LDSCTL_OFF) / 4; u += NWAVES * 64) ((LAS unsigned*)(F.lds + LDSCTL_OFF))[u] = 0u;
    __syncthreads();
    XcdBarrier bar = xcd_barrier_post((unsigned*)(F.ctl + CW_BAR) + P.li * XCD_BAR_WORDS, F.MISC + 8, F.wave);
    const int lo = P.ph_lo, hi = P.ph_hi;
    volatile LAS long long* tmv = (volatile LAS long long*)(F.lds + LDSCTL_OFF + 896);
    if (TIMER_A == -1 && TIMER_B >= 0 && f_tid == 0) tmv[0] = wall_clock64();
#define IN(k) (lo <= (k) && (k) < hi)
#define SEAM(k) do { if (IN(k) && IN((k) + 1)) xcd_barrier(bar); if (TIMER_B >= 0 && blockIdx.x == 0) { if ((k) == TIMER_A && TID() == 0) tmv[0] = wall_clock64(); if ((k) == TIMER_B && TID() == 0) tmv[1] = wall_clock64(); } } while (0)
    bf16* W_in = (bf16*)(ws + WS_WIN); bf16* XB = (bf16*)(ws + WS_XB);
    float* ss1 = (float*)(ws + WS_SS1); float* ss2 = (float*)(F.ctl + CW_SS2); float* ss3 = (float*)(F.ctl + CW_SS3);
    bf16* QKV = (bf16*)(ws + WS_QKV); bf16* GATES = (bf16*)(ws + WS_GATES); bf16* Y = (bf16*)(ws + WS_Y); bf16* MERGED = (bf16*)(ws + WS_MERGED);
    LAS unsigned char* ring = F.lds + RING_OFF;

    if (IN(PH_P0)) { for (int rep = 0; rep < REP_P0; ++rep) { for (int r2 = 0; r2 < REP_P0W; ++r2) p0_weights(F, P); for (int r2 = 0; r2 < REP_P0R; ++r2) p0_rows(F, P); } }
    SEAM(PH_P0);
    if (IN(PH_P1)) { p1b_qknorm_fgate(F, P);
      for (int rep = 0; rep < REP_P1; ++rep) {
        pg8::Gemm g{XB, W_in, S, NPROJ, DM}; ConvOrder So; So.init(S, NPROJ, F.G, (int)blockIdx.x); So.P = &P; So.wave = F.wave; So.slot = 0;
        pg8::EpiProj E{QKV, GATES, ss1, P.in[5], P.in[6], (LAS float*)(F.lds + XCH_OFF)};
        pg8::gemm_phase<pg8::EpiProj, ConvOrder, false, true, 0, 0, GRELAX>(ring, g, So, E, F.wave);
    } }
    if (IN(PH_P1)) { for (int rep = 0; rep < REP_X1; ++rep) {
        pg8::Gemm g{X1_CONSTA ? (bf16*)(ws + WS_ACT) : XB, W_in, S, REP_X1N, DM, DM + X1_PAD, DM + X1_PAD}; pg8::StaticOrder So; So.init(S, REP_X1N, F.G, (int)blockIdx.x);
        pg8::EpiNull E{};
        pg8::gemm_phase<pg8::EpiNull, pg8::StaticOrder, X1_ALIGN != 0, X1_SP2 != 0, X1_DIAG, X1_STG, X1_RELAX != 0>(ring, g, So, E, F.wave);
    } }
    if (IN(PH_P1)) { for (int rep = 0; rep < REP_X2; ++rep) {
        struct SameOrder : pg8::StaticOrder { __device__ bool next(int i, pg8::Unit& u) const { const bool ok = pg8::StaticOrder::next(i, u); u.pm = 0; u.pn = 0; return ok; } };
        pg8::Gemm g{XB, W_in, S, NPROJ, DM}; SameOrder So; So.init(S, NPROJ, F.G, (int)blockIdx.x);
        pg8::EpiNull E{};
        pg8::gemm_phase<pg8::EpiNull, SameOrder, true, true, 0, 0, GRELAX>(ring, g, So, E, F.wave);
    } }
    if (IN(PH_P1)) { for (int rep = 0; rep < REP_X3; ++rep) {
        const long long c0 = clock64();
        pg8::Gemm g{XB, W_in, S, NPROJ, DM}; pg8::StaticOrder So; So.init(S, NPROJ, F.G, (int)blockIdx.x);
        pg8::EpiNull E{};
        pg8::gemm_phase<pg8::EpiNull, pg8::StaticOrder, false, true, 0, 0, GRELAX>(ring, g, So, E, F.wave);
        const long long extra = (clock64() - c0) >> 7; const long long t1 = wall_clock64();
        while (wall_clock64() - t1 < extra) __builtin_amdgcn_s_sleep(10);
    } }
    SEAM(PH_P1);
    if (IN(PH_ATT)) {
        char* al = (char*)lds + RING_OFF;
        const size_t T = (size_t)S * WF;
        gu32* qctr = F.ctl + CW_QATT; volatile LAS int* nx = (volatile LAS int*)(F.lds + RING_OFF + att::OFF_NEXT);
        const int a_lane = lane_id(); const bool puller = (F.wave == 0 && a_lane == 0);
        float gqm = fmaxf(fabsf(P.in[5][a_lane]), fabsf(P.in[5][a_lane + 64])), gkm = fmaxf(fabsf(P.in[6][a_lane]), fabsf(P.in[6][a_lane + 64]));
#pragma unroll
        for (int o = 1; o < 64; o <<= 1) { gqm = fmaxf(gqm, __shfl_xor(gqm, o)); gkm = fmaxf(gkm, __shfl_xor(gkm, o)); }
        const float Uq = __builtin_bit_cast(float, __builtin_amdgcn_readfirstlane(__builtin_bit_cast(int, 128.0f * gqm * gkm * 1.02f)));
        for (int arep = 0; arep < REP_ATT; ++arep) {
        if (arep > 0) { xcd_barrier(bar); if (blockIdx.x == 0 && puller) __hip_atomic_store(qctr, 0u, RLX_AGENT); xcd_barrier(bar); }
        if (puller) nx[0] = (int)__hip_atomic_fetch_add(qctr, 1u, RLX_AGENT);
        if (arep == 0) fox_table(F, Uq);
        __syncthreads();
        const int NI = __builtin_amdgcn_readfirstlane(((volatile LAS int*)(F.lds + RING_OFF + att::OFF_TOT))[8]);
        if (TIMER_B >= 70 && TIMER_B < 80 && TID() == 0) tmv[2] = wall_clock64();
        if (TIMER_B == 60 && blockIdx.x == 0 && TID() == 0) { tmv[0] = 0; tmv[1] = 100ll * NI; }
        if (TIMER_B == 61 && blockIdx.x == 0 && TID() == 0) { tmv[0] = 0; tmv[1] = 100ll * ((volatile LAS int*)(F.lds + RING_OFF + att::OFF_TOT))[9]; }
        int item = nx[0];
        __syncthreads();
        {
            bool primed = false; att::Seam Sm;
#define FOX_REF(R, e_) do { const unsigned e__ = (e_); const int b_ = e__ & 511, h_ = b_ & 15, q_ = 31 - (b_ >> 4), p_ = (e__ >> 9) & 3, np_ = (e__ >> 11) & 7, ps_ = (e__ >> 14) & 127, sl_ = e__ >> 21;   \
                R.Q = QKV + (size_t)(q_ * 256) * WF + h_ * HD; R.K = QKV + T + h_ * HD; R.V = QKV + 2 * T + h_ * HD; R.O = Y + (size_t)(q_ * 256) * WF + h_ * HD; R.P0 = q_ * 256;                          \
                R.top = q_ * 4 + 3 - p_ * ps_; R.nst = (p_ == np_ - 1) ? R.top + 1 : ps_; R.part = (np_ > 1) ? parts_base(ws, sl_) + (size_t)p_ * att::PART_F : nullptr; } while (0)
            volatile LAS unsigned* tab = (volatile LAS unsigned*)(F.lds + RING_OFF + att::OFF_TAB);
            while (item < NI) {
                int pulled = 0;
                if (puller) pulled = (int)__hip_atomic_fetch_add(qctr, 1u, RLX_AGENT);
                const unsigned ent = __builtin_amdgcn_readfirstlane(tab[item]);
                att::cgate_scan((const float*)(ws + WS_LOGF) + (size_t)(ent & 15) * S, al, F.wave);
                if (puller) nx[0] = pulled;
                att::BlockRef cur; FOX_REF(cur, ent);
                if (!primed) att::fox_prime(cur, al, Sm, F.wave); else __syncthreads();
                const int nitem = nx[0];
                att::BlockRef nxt = cur; primed = false;
                if (nitem < NI) { const unsigned e2 = __builtin_amdgcn_readfirstlane(tab[nitem]); FOX_REF(nxt, e2); primed = true; }
                att::fox_block(cur, nxt, Uq, al, Sm, F.wave);
                item = nitem;
            }
#undef FOX_REF
        }
        if (TIMER_B == 50 && blockIdx.x == 0 && TID() == 0) tmv[1] = wall_clock64();
        if ((TIMER_B == 70 || TIMER_B == 71) && TID() == 0) { const unsigned d = (unsigned)(wall_clock64() - tmv[2]); __hip_atomic_fetch_add(F.ctl + 3072, d, RLX_AGENT); __hip_atomic_fetch_max(F.ctl + 3073, d, RLX_AGENT); }
        while (item < NI + NH * 32) {
            int pulled = 0;
            if (puller) pulled = (int)__hip_atomic_fetch_add(qctr, 1u, RLX_AGENT);
            const int L = item - NI, h = L & 15, qb = 31 - (L >> 4);
            att::BlockRef b; b.Q = QKV + 3 * T + (size_t)(qb * 256) * WF + h * HD; b.K = QKV + 4 * T + h * HD; b.V = QKV + 5 * T + h * HD; b.O = Y + T + (size_t)(qb * 256) * WF + h * HD; b.P0 = qb * 256; b.top = 0; b.nst = 0; b.part = nullptr;
            if (puller) nx[0] = pulled;
            att::sb_block(b, al, F.wave);
            item = nx[0];
            __syncthreads();
        }
        if (TIMER_B == 51 && blockIdx.x == 0 && TID() == 0) tmv[1] = wall_clock64();
        if ((TIMER_B == 72 || TIMER_B == 73) && TID() == 0) { const unsigned d = (unsigned)(wall_clock64() - tmv[2]); __hip_atomic_fetch_add(F.ctl + 3072, d, RLX_AGENT); __hip_atomic_fetch_max(F.ctl + 3073, d, RLX_AGENT); }
        }
    }
    SEAM(PH_ATT);
    if (IN(PH_P3A)) {
        const int nsp = __builtin_amdgcn_readfirstlane(((volatile LAS int*)(F.lds + RING_OFF + att::OFF_TOT))[9]);
        volatile LAS unsigned* spl = (volatile LAS unsigned*)(F.lds + RING_OFF + att::OFF_SPL);
        for (int si = F.vcu; si < nsp; si += F.G) {
            const unsigned e = __builtin_amdgcn_readfirstlane(spl[si]); const int b = e & 511, h = b & 15, qb = 31 - (b >> 4), np = (e >> 11) & 7, sl = e >> 21;
            att::fox_combine(parts_base(ws, sl), np, Y + (size_t)(qb * 256) * WF + h * HD, F.wave);
        }
    }
    SEAM(PH_P3A);
    if (IN(PH_P3B)) {
        pg8::Gemm g{Y, (bf16*)(ws + WS_WBF), S, DM, WF}; pg8::TwoPartOrder So; So.init(S, DM, F.G, (int)blockIdx.x); So.A1 = Y + (size_t)S * WF; So.B1 = (bf16*)(ws + WS_WBS);
        pg8::EpiGate2 E{MERGED, GATES, GATES + (size_t)S * DM};
        pg8::gemm_phase<pg8::EpiGate2, pg8::TwoPartOrder, false, true, 0, 0, GRELAX>(ring, g, So, E, F.wave);
    }
    SEAM(PH_P3B);
    if (IN(PH_P4)) {
        pg8::Gemm g{MERGED, (bf16*)(ws + WS_WOUT), S, DM, DM}; pg8::StaticOrder So; So.init(S, DM, F.G, (int)blockIdx.x);
        pg8::EpiResStat<true> E{nullptr, XB, ss2};
        pg8::gemm_phase<pg8::EpiResStat<true>, pg8::StaticOrder, false, true, 0, 0, GRELAX>(ring, g, So, E, F.wave);
    }
    SEAM(PH_P4);
    if (IN(PH_P5)) { for (int rep = 0; rep < REP_P5; ++rep) {
        pg8::Gemm g{XB, (bf16*)(ws + WS_WUP), S, 2 * DFF, DM}; pg8::StaticOrder So; So.init(S, 2 * DFF, F.G, (int)blockIdx.x);
        pg8::EpiConvGlu E{(bf16*)(ws + WS_ACT), (float*)(ws + WS_EDGE), ss2, P.in[12], P.in[13], (LAS float*)(F.lds + XCH_OFF)};
        pg8::gemm_phase<pg8::EpiConvGlu, pg8::StaticOrder, true, true, 0, 0, GRELAX>(ring, g, So, E, F.wave);
      }
      {
        const int nwg5 = (S / 256) * (2 * DFF / 256), n_extra = nwg5 % F.G, Gi = F.G - n_extra, ci = (int)blockIdx.x - n_extra;
        if (ci >= 0) {
            pg8::Gemm g{(bf16*)(ws + WS_PB), (bf16*)(ws + WS_WPP), S, DM, PLE}; pg8::StaticOrder So; So.init(S, DM, Gi, ci);
            pg8::EpiStoreBf16x4 E{(bf16*)(ws + WS_PP)};
            pg8::gemm_phase<pg8::EpiStoreBf16x4, pg8::StaticOrder, false, true, 0, 0, GRELAX>(ring, g, So, E, F.wave);
        }
      }
    }
    SEAM(PH_P5);
    if (IN(PH_P5B)) { for (int rep = 0; rep < REP_P5B; ++rep) p5c_fixup(F, P); }
    SEAM(PH_P5B);
    if (IN(PH_P6)) {
        pg8::Gemm g{(bf16*)(ws + WS_ACT), (bf16*)(ws + WS_WDN), S, DM, DFF}; pg8::StaticOrder So; So.init(S, DM, F.G, (int)blockIdx.x);
        pg8::EpiResStat<true> E{nullptr, XB, ss3};
        pg8::gemm_phase<pg8::EpiResStat<true>, pg8::StaticOrder, false, true, 0, 0, GRELAX>(ring, g, So, E, F.wave);
    }
    SEAM(PH_P6);
    if (IN(PH_P7)) {
        pg8::Gemm g{XB, (bf16*)(ws + WS_WPG), S, DM, DM}; pg8::StaticOrder So; So.init(S, DM, F.G, (int)blockIdx.x);
        pg8::EpiPle E{P.out, XB, (const bf16*)(ws + WS_PP), ss3};
        pg8::gemm_phase<pg8::EpiPle, pg8::StaticOrder, false, true, 0, 0, GRELAX>(ring, g, So, E, F.wave);
    }
    if (TIMER_B >= 0 && blockIdx.x == 0) {
        if (TIMER_B >= 70 && TIMER_B < 80 && TID() == 0) { tmv[0] = 0; tmv[1] = (TIMER_B & 1) ? (long long)__hip_atomic_load(F.ctl + 3073, RLX_AGENT) : (long long)(__hip_atomic_load(F.ctl + 3072, RLX_AGENT) / 256u); }
        __syncthreads();
        const long long t0 = wall_clock64(), w = ((TIMER_B == 99) ? t0 : tmv[1]) - tmv[0]; while (wall_clock64() - t0 < w) __builtin_amdgcn_s_sleep(20); }
#undef IN
#undef SEAM
}

extern "C" void kernel_launch(void* const* d_in, const int* in_sizes, int n_in, void* d_out, int out_size, void* d_ws, size_t ws_size, hipStream_t stream) {
    static int grid = 0;
    if (grid == 0) {
        if (n_in != 18 || out_size != S * DM || ws_size < WS_END) { fprintf(stderr, "kernel_launch: unexpected shapes / workspace (%d inputs, out %d, ws %zu < %zu)\n", n_in, out_size, ws_size, (size_t)WS_END); grid = -1; return; }
        int dev = 0, cus = 0, per_cu = 0;
        if (hipGetDevice(&dev) != hipSuccess || hipDeviceGetAttribute(&cus, hipDeviceAttributeMultiprocessorCount, dev) != hipSuccess) { grid = -1; return; }
        if (hipFuncSetAttribute((const void*)mega_fwd, hipFuncAttributeMaxDynamicSharedMemorySize, LDS_BYTES) != hipSuccess) { fprintf(stderr, "kernel_launch: hipFuncSetAttribute failed\n"); grid = -1; return; }
        if (hipOccupancyMaxActiveBlocksPerMultiprocessor(&per_cu, (const void*)mega_fwd, NWAVES * 64, LDS_BYTES) != hipSuccess || per_cu < 1)
            fprintf(stderr, "kernel_launch: note: occupancy query reports %d workgroups per CU\n", per_cu);
        (void)hipGetLastError();
        grid = cus;
    }
    if (grid < 0) return;
    if (hipMemsetAsync((char*)d_ws + WS_CTL, 0, CTL_ZERO_BYTES, stream) != hipSuccess) return;
    Params a{};
    for (int i = 0; i < 18; ++i) a.in[i] = (const float*)d_in[i];
    a.out = (float*)d_out; a.ws = (unsigned char*)d_ws;
    a.ph_lo = PH_P0; a.ph_hi = PH_N; a.li = 0;
    hipLaunchKernelGGL(mega_fwd, dim3(grid), dim3(NWAVES * 64), LDS_BYTES, stream, a);
}
```

```cpp
#include <hip/hip_runtime.h>
#include <cstdio>
#include <cstdint>
__device__ __forceinline__ int lane_id() { int l; asm volatile("v_mbcnt_lo_u32_b32 %0, -1, 0\n\tv_mbcnt_hi_u32_b32 %0, -1, %0" : "=v"(l)); return l; }
#define TID() (WAVE_ * 64 + lane_id())
namespace pg8 {
constexpr int PG8_AUXA = 0, PG8_AUXB = 0;
#define PG8_LAS __attribute__((address_space(3)))
typedef unsigned short bf16_t;
typedef short bf16x8 __attribute__((ext_vector_type(8)));
typedef float f32x4 __attribute__((ext_vector_type(4)));
typedef unsigned u32x4 __attribute__((ext_vector_type(4)));
constexpr int BM = 256, BK = 64, HALF = 128, HTB = HALF * BK * 2  , STAGE_BYTES = 8 * HTB, NXCD = 8, WGM = 8;

__host__ __device__ __forceinline__ int lds_byte(int r, int c) { const int st = (r >> 4) * 2 + (c >> 5), rr = r & 15, cc = c & 31, ob = rr * 64 + cc * 2; return st * 1024 + (ob ^ (((ob >> 9) & 1) << 5)); }
__host__ __device__ __forceinline__ void stage_rc(int b, int& R, int& C) { const int st = b / 1024, sb = b % 1024, swz = sb ^ (((sb >> 9) & 1) << 5); R = (st >> 1) * 16 + swz / 64; C = (st & 1) * 32 + (swz % 64) / 2; }
__host__ __device__ __forceinline__ int perm32(int rho) { const int n = rho >> 4, i = rho & 15; return 8 * (i >> 2) + 4 * n + (i & 3); }

struct Unit { int pm, pn, part; };
struct Gemm { const bf16_t* A; const bf16_t* Bt; int M, N, K, lda, ldb; };

struct StaticOrder {
    int nM, nN, nwg, G, c;
    __host__ __device__ void init(int M, int N, int G_, int c_) { nM = M / BM; nN = N / BM; nwg = nM * nN; G = G_; c = c_; }
    __host__ __device__ bool next(int i, Unit& u) const {
        const long L = (long)i * G + c; if (L >= nwg) return false;
        int wgid = (int)L; { const int q = nwg / NXCD, r = nwg % NXCD, xcd = wgid % NXCD, off = wgid / NXCD; wgid = (xcd < r ? xcd * (q + 1) : r * (q + 1) + (xcd - r) * q) + off; }
        const int nig = WGM * nN, gid = wgid / nig, fm = gid * WGM, gsz = (nM - fm) < WGM ? (nM - fm) : WGM;
        u.pm = fm + ((wgid % nig) % gsz); u.pn = (wgid % nig) / gsz; return true;
    }
    __device__ __forceinline__ void a_ready(const Unit&) const {}
    __device__ __forceinline__ void done(const Unit&) const {}
    __device__ __forceinline__ const bf16_t* baseA(const Gemm& g, const Unit&) const { return g.A; }
    __device__ __forceinline__ const bf16_t* baseB(const Gemm& g, const Unit&) const { return g.Bt; }
    __device__ __forceinline__ bool zero_after(const Unit&) const { return true; }
};

__device__ __forceinline__ unsigned cvt_pk_bf16(float lo, float hi) { unsigned r; asm volatile("v_cvt_pk_bf16_f32 %0, %1, %2" : "=v"(r) : "v"(lo), "v"(hi)); return r; }
typedef float f32x2 __attribute__((ext_vector_type(2)));
constexpr int SEQ_ = 8192, DM_ = 4096;
constexpr float EPS_ = 1e-6f;
__device__ __forceinline__ float sigm(float v) { return __builtin_amdgcn_rcpf(1.0f + __builtin_amdgcn_exp2f(-1.4426950408889634f * v)); }
__device__ __forceinline__ float rs_of(float ss) { return __builtin_amdgcn_rsqf(ss * (1.0f / DM_) + EPS_); }
typedef unsigned u32x2 __attribute__((ext_vector_type(2)));
__device__ __forceinline__ f32x4 bf4_to_f32(u32x2 w) { return (f32x4){__uint_as_float(w.x << 16), __uint_as_float(w.x & 0xffff0000u), __uint_as_float(w.y << 16), __uint_as_float(w.y & 0xffff0000u)}; }

#define EPI_ROWS(k) (row0 + ((k) >> 2) * HALF + ((k) & 3) * 16)
#define EPI_ACC(k, bj, n) acc[(k) >> 2][bj][(k) & 3][n]
__device__ __forceinline__ u32x4 pack8(const f32x4 v0, const f32x4 v1) { u32x4 w; w.x = cvt_pk_bf16(v0[0], v0[1]); w.y = cvt_pk_bf16(v0[2], v0[3]); w.z = cvt_pk_bf16(v1[0], v1[1]); w.w = cvt_pk_bf16(v1[2], v1[3]); return w; }

struct EpiProj {
    static constexpr bool PERM = true, AFTER_DRAIN = false;
    bf16_t* qkv; bf16_t* gates; const float* ss; const float* gq; const float* gk; PG8_LAS float* hx;
    __device__ __forceinline__ void operator()(f32x4 (&acc)[2][2][4][2], const Unit& u, int wr, int wc, int fr, int fq) const {
        const int row0 = u.pm * BM + wr * 64 + fr;
        bf16_t* base; int ldc, colt; const bool gate = u.pn >= 48, qknorm = u.pn < 16;
        if (!gate) { base = qkv + (size_t)(u.pn >> 3) * ((size_t)SEQ_ * 2048); ldc = 2048; colt = (u.pn & 7) * 256; }
        else { const int t = u.pn - 48; base = gates + (size_t)(t >> 4) * ((size_t)SEQ_ * 4096); ldc = 4096; colt = (t & 15) * 256; }
        const int col0 = colt + wc * 32 + 8 * fq;
        float rs[8];
#pragma unroll
        for (int k = 0; k < 8; ++k) rs[k] = ss[EPI_ROWS(k)];
        if (qknorm) {
            const float* g = (u.pn < 8 ? gq : gk) + wc * 32 + 8 * fq; const f32x4 g0 = *(const f32x4*)g, g1 = *(const f32x4*)(g + 4);
#pragma unroll
            for (int k = 0; k < 8; ++k) { const float r = rs_of(rs[k]); const int rl = wr * 64 + (k >> 2) * HALF + (k & 3) * 16 + fr;
#pragma unroll
                for (int bj = 0; bj < 2; ++bj) { f32x4 v0 = EPI_ACC(k, bj, 0) * r, v1 = EPI_ACC(k, bj, 1) * r; EPI_ACC(k, bj, 0) = v0; EPI_ACC(k, bj, 1) = v1;
                    float s = (v0[0] * v0[0] + v0[1] * v0[1]) + (v0[2] * v0[2] + v0[3] * v0[3]) + (v1[0] * v1[0] + v1[1] * v1[1]) + (v1[2] * v1[2] + v1[3] * v1[3]);
                    s += __shfl_xor(s, 16); s += __shfl_xor(s, 32);
                    if (fq == 0) hx[(rl * 2 + bj) * 4 + wc] = s; } }
            asm volatile("s_waitcnt lgkmcnt(0)" ::: "memory"); __builtin_amdgcn_s_barrier(); asm volatile("" ::: "memory");
#pragma unroll
            for (int k = 0; k < 8; ++k) { const int rl = wr * 64 + (k >> 2) * HALF + (k & 3) * 16 + fr; bf16_t* rowp = base + (size_t)EPI_ROWS(k) * ldc + col0;
#pragma unroll
                for (int bj = 0; bj < 2; ++bj) { const f32x4 p = *(const PG8_LAS f32x4*)(hx + (rl * 2 + bj) * 4);
                    const float r2 = __builtin_amdgcn_rsqf(((p[0] + p[1]) + (p[2] + p[3])) * (1.0f / 128.0f) + EPS_);
                    *(u32x4*)(rowp + bj * HALF) = pack8(EPI_ACC(k, bj, 0) * g0 * r2, EPI_ACC(k, bj, 1) * g1 * r2); } }
        } else {
#pragma unroll
            for (int k = 0; k < 8; ++k) { const float r = rs_of(rs[k]); bf16_t* rowp = base + (size_t)EPI_ROWS(k) * ldc + col0;
#pragma unroll
                for (int bj = 0; bj < 2; ++bj) { f32x4 v0 = EPI_ACC(k, bj, 0) * r, v1 = EPI_ACC(k, bj, 1) * r;
                    if (gate) {
#pragma unroll
                        for (int j = 0; j < 4; ++j) { v0[j] = sigm(v0[j]); v1[j] = sigm(v1[j]); } }
                    *(u32x4*)(rowp + bj * HALF) = pack8(v0, v1); } }
        }
    }
};
template <bool BASE_BF16> struct EpiResStat {
    static constexpr bool PERM = true, AFTER_DRAIN = false;
    const float* basef; bf16_t* xb; float* ss;
    __device__ __forceinline__ void operator()(const f32x4 (&acc)[2][2][4][2], const Unit& u, int wr, int wc, int fr, int fq) const {
        const int row0 = u.pm * BM + wr * 64 + fr, col0 = u.pn * BM + wc * 32 + 8 * fq;
        f32x4 b[2][2][2];
#define LD_(k) do { const size_t off_ = (size_t)EPI_ROWS(k) * DM_ + col0; _Pragma("unroll") for (int bj_ = 0; bj_ < 2; ++bj_) { \
            if constexpr (BASE_BF16) { const u32x4 w_ = *(const u32x4*)(xb + off_ + bj_ * HALF); b[(k) & 1][bj_][0] = bf4_to_f32((u32x2){w_.x, w_.y}); b[(k) & 1][bj_][1] = bf4_to_f32((u32x2){w_.z, w_.w}); } \
            else { b[(k) & 1][bj_][0] = *(const f32x4*)(basef + off_ + bj_ * HALF); b[(k) & 1][bj_][1] = *(const f32x4*)(basef + off_ + bj_ * HALF + 4); } } } while (0)
        LD_(0);
#pragma unroll
        for (int k = 0; k < 8; ++k) {
            if (k + 1 < 8) LD_(k + 1);
            const int r = EPI_ROWS(k); const size_t off = (size_t)r * DM_ + col0; float s = 0.f;
#pragma unroll
            for (int bj = 0; bj < 2; ++bj) { const f32x4 o0 = b[k & 1][bj][0] + EPI_ACC(k, bj, 0), o1 = b[k & 1][bj][1] + EPI_ACC(k, bj, 1);
                s += ((o0[0] * o0[0] + o0[1] * o0[1]) + (o0[2] * o0[2] + o0[3] * o0[3])) + ((o1[0] * o1[0] + o1[1] * o1[1]) + (o1[2] * o1[2] + o1[3] * o1[3]));
                *(u32x4*)(xb + off + bj * HALF) = pack8(o0, o1); }
            s += __shfl_xor(s, 16); s += __shfl_xor(s, 32);
            if (fq == 0) __hip_atomic_fetch_add(ss + r, s, __ATOMIC_RELAXED, __HIP_MEMORY_SCOPE_AGENT);
            asm volatile("" ::: "memory");
        }
#undef LD_
    }
};
struct EpiUp {
    static constexpr bool PERM = true, AFTER_DRAIN = false;
    bf16_t* O; int ldc; const float* ss;
    __device__ __forceinline__ void operator()(const f32x4 (&acc)[2][2][4][2], const Unit& u, int wr, int wc, int fr, int fq) const {
        const int row0 = u.pm * BM + wr * 64 + fr, col0 = u.pn * BM + wc * 32 + 8 * fq;
        float rs[8];
#pragma unroll
        for (int k = 0; k < 8; ++k) rs[k] = ss[EPI_ROWS(k)];
#pragma unroll
        for (int k = 0; k < 8; ++k) { const float r = rs_of(rs[k]); bf16_t* rowp = O + (size_t)EPI_ROWS(k) * ldc + col0;
#pragma unroll
            for (int bj = 0; bj < 2; ++bj) *(u32x4*)(rowp + bj * HALF) = pack8(EPI_ACC(k, bj, 0) * r, EPI_ACC(k, bj, 1) * r); }
    }
};
template <int CTRL> __device__ __forceinline__ float dpp_upd(float old, float src) { return __builtin_bit_cast(float, __builtin_amdgcn_update_dpp(__builtin_bit_cast(int, old), __builtin_bit_cast(int, src), CTRL, 0xf, 0xf, false)); }
struct EpiConvGlu {
    static constexpr bool PERM = false, AFTER_DRAIN = false;
    static constexpr int J = 11008, ROR1 = 0x121, ROR2 = 0x122, SHR1 = 0x111, SHR2 = 0x112;
    bf16_t* act; float* edge; const float* ss; const float* cw; const float* cb; PG8_LAS float* xch;
    __device__ __forceinline__ void operator()(f32x4 (&acc)[2][2][4][2], const Unit& u, int wr, int wc, int, int) const {
        const int l_ = lane_id(), fr = l_ & 15, fq = l_ >> 4;
        const int row0 = u.pm * BM + wr * 64 + fr, colt = wc * 32 + 4 * fq, j0 = u.pn * 128 + colt;
        {   float rs[8];
#pragma unroll
            for (int k = 0; k < 8; ++k) rs[k] = ss[EPI_ROWS(k)];
#pragma unroll
            for (int k = 0; k < 8; ++k) { const float r = rs_of(rs[k]);
#pragma unroll
                for (int bj = 0; bj < 2; ++bj)
#pragma unroll
                    for (int n = 0; n < 2; ++n) EPI_ACC(k, bj, n) = EPI_ACC(k, bj, n) * r; } }
#pragma unroll
        for (int ai = 0; ai < 2; ++ai) { const int b = 2 * ai + wr;
            if (fr >= 14) {
#pragma unroll
                for (int bj = 0; bj < 2; ++bj)
#pragma unroll
                    for (int n = 0; n < 2; ++n) *(PG8_LAS f32x4*)(xch + (b * 2 + (fr - 14)) * 256 + 128 * bj + colt + 16 * n) = acc[ai][bj][3][n];
                if (b == 3) {
#pragma unroll
                    for (int bj = 0; bj < 2; ++bj)
#pragma unroll
                        for (int n = 0; n < 2; ++n) *(f32x4*)(edge + ((size_t)u.pm * 4 + 2 + (fr - 14)) * (2 * J) + bj * J + j0 + 16 * n) = acc[ai][bj][3][n]; }
            }
            if (b == 0 && fr < 2) {
#pragma unroll
                for (int bj = 0; bj < 2; ++bj)
#pragma unroll
                    for (int n = 0; n < 2; ++n) *(f32x4*)(edge + ((size_t)u.pm * 4 + fr) * (2 * J) + bj * J + j0 + 16 * n) = acc[ai][bj][0][n]; }
        }
        asm volatile("s_waitcnt lgkmcnt(0)" ::: "memory"); __builtin_amdgcn_s_barrier(); asm volatile("" ::: "memory");
#pragma unroll
        for (int n = 0; n < 2; ++n) {
            f32x4 wgt[2][3], bia[2];
#pragma unroll
            for (int bj = 0; bj < 2; ++bj) { bia[bj] = *(const f32x4*)(cb + bj * J + j0 + 16 * n);
#pragma unroll
                for (int t = 0; t < 3; ++t) wgt[bj][t] = *(const f32x4*)(cw + (size_t)t * 2 * J + bj * J + j0 + 16 * n); }
#pragma unroll
            for (int k = 0; k < 8; ++k) { const int ai = k >> 2, m = k & 3, b = 2 * ai + wr;
                f32x4 x63[2], x62[2];
                if (m == 0) {
#pragma unroll
                    for (int bj = 0; bj < 2; ++bj) { const int pb = (b + 3) & 3; x63[bj] = *(const PG8_LAS f32x4*)(xch + (pb * 2 + 1) * 256 + 128 * bj + colt + 16 * n); x62[bj] = *(const PG8_LAS f32x4*)(xch + (pb * 2 + 0) * 256 + 128 * bj + colt + 16 * n); } }
                f32x4 res;
#pragma unroll
                for (int e = 0; e < 4; ++e) { float uu[2];
#pragma unroll
                    for (int bj = 0; bj < 2; ++bj) { const float c = acc[ai][bj][m][n][e]; float o1, o2;
                        if (m == 0) { o1 = x63[bj][e]; o2 = (fr == 0) ? x62[bj][e] : x63[bj][e]; }
                        else { const float pv = acc[ai][bj][m - 1][n][e]; o1 = dpp_upd<ROR1>(pv, pv); o2 = dpp_upd<ROR2>(pv, pv); }
                        const float p1 = dpp_upd<SHR1>(o1, c), p2 = dpp_upd<SHR2>(o2, c);
                        uu[bj] = bia[bj][e] + wgt[bj][0][e] * p2 + wgt[bj][1][e] * p1 + wgt[bj][2][e] * c; }
                    res[e] = uu[0] * sigm(uu[0]) * uu[1]; }
                if (!(b == 0 && m == 0 && fr < 2)) { u32x2 w; w.x = cvt_pk_bf16(res[0], res[1]); w.y = cvt_pk_bf16(res[2], res[3]); *(u32x2*)(act + (size_t)EPI_ROWS(k) * J + j0 + 16 * n) = w; }
            }
        }
    }
};
struct EpiPle {
    static constexpr bool PERM = true, AFTER_DRAIN = false;
    float* out; const bf16_t* xb; const bf16_t* pp; const float* ss;
    __device__ __forceinline__ void operator()(const f32x4 (&acc)[2][2][4][2], const Unit& u, int wr, int wc, int fr, int fq) const {
        const int row0 = u.pm * BM + wr * 64 + fr, col0 = u.pn * BM + wc * 32 + 8 * fq;
        float rs[8];
#pragma unroll
        for (int k = 0; k < 8; ++k) rs[k] = ss[EPI_ROWS(k)];
        u32x4 b2[2][2], q2[2][2];
#define LD_(k) do { const size_t off_ = (size_t)EPI_ROWS(k) * DM_ + col0; _Pragma("unroll") for (int bj_ = 0; bj_ < 2; ++bj_) { b2[(k) & 1][bj_] = *(const u32x4*)(xb + off_ + bj_ * HALF); q2[(k) & 1][bj_] = *(const u32x4*)(pp + off_ + bj_ * HALF); } } while (0)
        LD_(0);
#pragma unroll
        for (int k = 0; k < 8; ++k) {
            if (k + 1 < 8) LD_(k + 1);
            const size_t off = (size_t)EPI_ROWS(k) * DM_ + col0; const float r = rs_of(rs[k]);
#pragma unroll
            for (int bj = 0; bj < 2; ++bj) { const u32x4 bw = b2[k & 1][bj], qw = q2[k & 1][bj];
#pragma unroll
                for (int n = 0; n < 2; ++n) { const f32x4 a = EPI_ACC(k, bj, n) * r, pv = bf4_to_f32(n ? (u32x2){qw.z, qw.w} : (u32x2){qw.x, qw.y}), bb = bf4_to_f32(n ? (u32x2){bw.z, bw.w} : (u32x2){bw.x, bw.y});
                    f32x4 o; o[0] = bb[0] + sigm(a[0]) * pv[0]; o[1] = bb[1] + sigm(a[1]) * pv[1]; o[2] = bb[2] + sigm(a[2]) * pv[2]; o[3] = bb[3] + sigm(a[3]) * pv[3];
                    *(f32x4*)(out + off + bj * HALF + 4 * n) = o; } }
            asm volatile("" ::: "memory");
        }
#undef LD_
    }
};
struct EpiGate2 {
    static constexpr bool PERM = true, AFTER_DRAIN = false;
    bf16_t* merged; const bf16_t* sga; const bf16_t* sgb;
    __device__ __forceinline__ void operator()(f32x4 (&acc)[2][2][4][2], const Unit& u, int wr, int wc, int fr, int fq) const {
        const int row0 = u.pm * BM + wr * 64 + fr, col0 = u.pn * BM + wc * 32 + 8 * fq;
        if (u.part == 0) {
            u32x4 ga[2][2], gb[2][2];
#define LD_(k) do { const size_t off_ = (size_t)EPI_ROWS(k) * DM_ + col0; ga[(k) & 1][0] = *(const u32x4*)(sga + off_); ga[(k) & 1][1] = *(const u32x4*)(sga + off_ + HALF); gb[(k) & 1][0] = *(const u32x4*)(sgb + off_); gb[(k) & 1][1] = *(const u32x4*)(sgb + off_ + HALF); } while (0)
            LD_(0);
#pragma unroll
            for (int k = 0; k < 8; ++k) {
                if (k + 1 < 8) LD_(k + 1);
#pragma unroll
                for (int bj = 0; bj < 2; ++bj) { const u32x4 aw = ga[k & 1][bj], bw = gb[k & 1][bj];
                    const f32x4 ga0 = bf4_to_f32((u32x2){aw.x, aw.y}), ga1 = bf4_to_f32((u32x2){aw.z, aw.w}), gb0 = bf4_to_f32((u32x2){bw.x, bw.y}), gb1 = bf4_to_f32((u32x2){bw.z, bw.w});
#pragma unroll
                    for (int j = 0; j < 4; ++j) { EPI_ACC(k, bj, 0)[j] *= ga0[j] * __builtin_amdgcn_rcpf(fmaxf(gb0[j], 1e-20f)); EPI_ACC(k, bj, 1)[j] *= ga1[j] * __builtin_amdgcn_rcpf(fmaxf(gb1[j], 1e-20f)); } }
                asm volatile("" ::: "memory");
            }
#undef LD_
        } else {
            u32x4 gb[2][2];
#define LD_(k) do { const size_t off_ = (size_t)EPI_ROWS(k) * DM_ + col0; gb[(k) & 1][0] = *(const u32x4*)(sgb + off_); gb[(k) & 1][1] = *(const u32x4*)(sgb + off_ + HALF); } while (0)
            LD_(0);
#pragma unroll
            for (int k = 0; k < 8; ++k) {
                if (k + 1 < 8) LD_(k + 1);
                const size_t off = (size_t)EPI_ROWS(k) * DM_ + col0;
#pragma unroll
                for (int bj = 0; bj < 2; ++bj) { const u32x4 bw = gb[k & 1][bj]; const f32x4 gb0 = bf4_to_f32((u32x2){bw.x, bw.y}), gb1 = bf4_to_f32((u32x2){bw.z, bw.w});
                    f32x4 v0, v1;
#pragma unroll
                    for (int j = 0; j < 4; ++j) { v0[j] = EPI_ACC(k, bj, 0)[j] * fmaxf(gb0[j], 1e-20f); v1[j] = EPI_ACC(k, bj, 1)[j] * fmaxf(gb1[j], 1e-20f); }
                    *(u32x4*)(merged + off + bj * HALF) = pack8(v0, v1); }
                asm volatile("" ::: "memory");
            }
#undef LD_
        }
    }
};
struct TwoPartOrder : StaticOrder {
    const bf16_t* A1; const bf16_t* B1;
    __device__ bool next(int i, Unit& u) const { const bool ok = StaticOrder::next(i >> 1, u); u.part = i & 1; return ok; }
    __device__ __forceinline__ const bf16_t* baseA(const Gemm& g, const Unit& u) const { return u.part ? A1 : g.A; }
    __device__ __forceinline__ const bf16_t* baseB(const Gemm& g, const Unit& u) const { return u.part ? B1 : g.Bt; }
    __device__ __forceinline__ bool zero_after(const Unit& u) const { return u.part != 0; }
};
struct EpiStoreBf16x4 {
    static constexpr bool PERM = false, AFTER_DRAIN = false;
    bf16_t* C;
    __device__ __forceinline__ void operator()(const f32x4 (&acc)[2][2][4][2], const Unit& u, int wr, int wc, int fr, int fq) const {
        const int row0 = u.pm * BM + wr * 64 + fr, col0 = u.pn * BM + wc * 32 + 4 * fq;
#pragma unroll
        for (int ai = 0; ai < 2; ++ai)
#pragma unroll
            for (int m = 0; m < 4; ++m) { bf16_t* rowp = C + (size_t)(row0 + ai * HALF + m * 16) * DM_ + col0;
#pragma unroll
                for (int bj = 0; bj < 2; ++bj)
#pragma unroll
                    for (int n = 0; n < 2; ++n) { const f32x4 v = acc[ai][bj][m][n]; u32x2 w; w.x = cvt_pk_bf16(v[0], v[1]); w.y = cvt_pk_bf16(v[2], v[3]); *(u32x2*)(rowp + bj * HALF + n * 16) = w; } }
    }
};
struct EpiNull {
    static constexpr bool PERM = true, AFTER_DRAIN = false;
    __device__ __forceinline__ void operator()(const f32x4 (&acc)[2][2][4][2], const Unit& u, int wr, int wc, int fr, int fq) const {
#pragma unroll
        for (int ai = 0; ai < 2; ++ai)
#pragma unroll
            for (int bj = 0; bj < 2; ++bj)
#pragma unroll
                for (int m = 0; m < 4; ++m)
#pragma unroll
                    for (int n = 0; n < 2; ++n) asm volatile("" :: "v"(acc[ai][bj][m][n]));
    }
};
#undef EPI_ROWS
#undef EPI_ACC
template <class Epi, class Sched, bool ALIGN_EPI = false, bool SP2 = false, int DIAGMODE = 0, int STG = 0, bool RELAX1ST = false>
__device__ __forceinline__ void gemm_phase(PG8_LAS unsigned char* lds, const Gemm g, const Sched& S, const Epi& E, const int WAVE_) {
    const int tid = TID(), wid = __builtin_amdgcn_readfirstlane(tid >> 6), lane = tid & 63, wr = wid >> 2, wc = wid & 3, fr = lane & 15, fq = lane >> 4;
    const int K = g.K, nt = K / BK, lda = g.lda ? g.lda : K, ldb = g.ldb ? g.ldb : K;
    unsigned voffA[2], voffB[2];
#pragma unroll
    for (int i = 0; i < 2; ++i) { int R, C; stage_rc(tid * 16 + i * 8192, R, C); const int Rb = Epi::PERM ? ((R & ~31) + perm32(R & 31)) : R;
        voffA[i] = (unsigned)(R * lda + C) * 2u; voffB[i] = (unsigned)(Rb * ldb + C) * 2u; }
    const size_t kstep = (size_t)(BK * 2);
    const size_t hstepA = (size_t)HALF * lda * 2, hstepB = (size_t)HALF * ldb * 2;
    const size_t tstepA = 2 * hstepA, tstepB = 2 * hstepB;
    const unsigned ldsw = (unsigned)wid * 1024u;
    const int aoff = lds_byte(wr * 64 + fr, fq * 8), boff = lds_byte(wc * 32 + fr, fq * 8);
#define PG8_SA(b, h) (((b) * 2 + (h)) * HTB)
#define PG8_SB(b, h) ((4 + (b) * 2 + (h)) * HTB)
#define PG8_STAGE(bufoff, gbase, voff) do { if (DIAGMODE != 2 && DIAGMODE != 4 && DIAGMODE != 5) _Pragma("unroll") for (int _i = 0; _i < 2; ++_i) \
        { if ((bufoff) >= 4 * HTB) __builtin_amdgcn_global_load_lds((const unsigned*)((const char*)(gbase) + (voff)[_i]), (PG8_LAS unsigned*)(lds + (bufoff) + ldsw + _i * 8192), 16, 0, PG8_AUXB); else __builtin_amdgcn_global_load_lds((const unsigned*)((const char*)(gbase) + (voff)[_i]), (PG8_LAS unsigned*)(lds + (bufoff) + ldsw + _i * 8192), 16, 0, PG8_AUXA); } } while (0)
#define PG8_LDA(dst, b, h) do { if ((DIAGMODE != 1 && DIAGMODE != 4 && DIAGMODE != 5) || t == 0) _Pragma("unroll") for (int m = 0; m < 4; ++m) _Pragma("unroll") for (int k = 0; k < 2; ++k) dst[m][k] = *(const PG8_LAS bf16x8*)(lds + PG8_SA(b, h) + aoff + m * 2048 + k * 1024); } while (0)
#define PG8_LDB(dst, b, h) do { if ((DIAGMODE != 1 && DIAGMODE != 4 && DIAGMODE != 5) || t == 0) _Pragma("unroll") for (int n = 0; n < 2; ++n) _Pragma("unroll") for (int k = 0; k < 2; ++k) dst[n][k] = *(const PG8_LAS bf16x8*)(lds + PG8_SB(b, h) + boff + n * 2048 + k * 1024); } while (0)
#define PG8_MMA(ai, bj, At, Bt) do { __builtin_amdgcn_s_setprio(1); if (DIAGMODE != 3 && DIAGMODE != 4) _Pragma("unroll") for (int m = 0; m < 4; ++m) _Pragma("unroll") for (int n = 0; n < 2; ++n) _Pragma("unroll") for (int k = 0; k < 2; ++k) \
        acc[ai][bj][m][n] = __builtin_amdgcn_mfma_f32_16x16x32_bf16(Bt[n][k], At[m][k], acc[ai][bj][m][n], 0, 0, 0); __builtin_amdgcn_s_setprio(0); } while (0)
#define PG8_WAIT_V(n) asm volatile("s_waitcnt vmcnt(" #n ")" ::: "memory")
#define PG8_WAIT_L(n) asm volatile("s_waitcnt lgkmcnt(" #n ")" ::: "memory")
#define PG8_BAR __builtin_amdgcn_s_barrier()
#define PG8_SCHED __builtin_amdgcn_sched_barrier(0)
    Unit cur, nxt; int ui = 0;
    if (!S.next(0, cur)) return;
    f32x4 acc[2][2][4][2];
#pragma unroll
    for (int a = 0; a < 2; ++a)
#pragma unroll
        for (int b = 0; b < 2; ++b)
#pragma unroll
            for (int m = 0; m < 4; ++m)
#pragma unroll
                for (int n = 0; n < 2; ++n) acc[a][b][m][n] = (f32x4){0.f, 0.f, 0.f, 0.f};
    bf16x8 At[4][2], B0[2][2], B1[2][2];
    const char* cA = (const char*)S.baseA(g, cur) + (size_t)cur.pm * tstepA; const char* cB = (const char*)S.baseB(g, cur) + (size_t)cur.pn * tstepB;
    S.a_ready(cur);
    if constexpr (SP2) {
        PG8_STAGE(PG8_SB(0, 0), cB, voffB); PG8_STAGE(PG8_SB(0, 1), cB + hstepB, voffB); PG8_STAGE(PG8_SA(0, 0), cA, voffA); PG8_STAGE(PG8_SA(0, 1), cA + hstepA, voffA);
        if (wr == 1) PG8_BAR;
        PG8_WAIT_V(2); PG8_BAR;
        PG8_STAGE(PG8_SB(1, 0), cB + kstep, voffB); PG8_STAGE(PG8_SA(1, 0), cA + kstep, voffA); PG8_STAGE(PG8_SB(1, 1), cB + hstepB + kstep, voffB);
        PG8_WAIT_V(6); PG8_BAR;
    } else {
        PG8_STAGE(PG8_SB(0, 0), cB, voffB); PG8_STAGE(PG8_SA(0, 0), cA, voffA); PG8_STAGE(PG8_SB(0, 1), cB + hstepB, voffB); PG8_STAGE(PG8_SA(0, 1), cA + hstepA, voffA);
        if (wr == 1) PG8_BAR;
        PG8_WAIT_V(4); PG8_BAR;
        PG8_STAGE(PG8_SB(1, 0), cB + kstep, voffB); PG8_STAGE(PG8_SA(1, 0), cA + kstep, voffA); PG8_STAGE(PG8_SB(1, 1), cB + hstepB + kstep, voffB);
        PG8_WAIT_V(6); PG8_BAR;
    }
    for (;;) {
        const bool has_next = S.next(ui + 1, nxt);
        const char* nA = has_next ? (const char*)S.baseA(g, nxt) + (size_t)nxt.pm * tstepA : cA; const char* nB = has_next ? (const char*)S.baseB(g, nxt) + (size_t)nxt.pn * tstepB : cB;
        for (int t = 0; t < nt; t += 2) {
            const bool last = (t == nt - 2);
            const char* a1 = cA + (size_t)(t + 1) * kstep;
            const char* a2 = last ? nA : cA + (size_t)(t + 2) * kstep; const char* b2 = last ? nB : cB + (size_t)(t + 2) * kstep;
            const char* a3 = a2 + kstep; const char* b3 = b2 + kstep;
            if (last && has_next) S.a_ready(nxt);
            if constexpr (SP2) {
#define PG8_WAIT_VN(n) asm volatile("s_waitcnt vmcnt(%0)" :: "n"(n) : "memory")
#define PG8_WAIT_VC(n, flag) do { if constexpr (RELAX1ST) asm volatile("s_cmp_lg_u32 %1, 0\n\ts_cbranch_scc1 1f\n\ts_waitcnt vmcnt(%0)\n1:" :: "n"(n), "s"(__builtin_amdgcn_readfirstlane(flag)) : "memory", "scc"); else PG8_WAIT_VN(n); } while (0)
#define PG8_KT(b, pa11, pb, pa0, RELAX_) do { \
    constexpr bool A11_SEG = (STG == 0 || STG == 2 || STG == 4), B0_SEG = (STG != 1), B1_SEG = (STG == 0 || STG == 4 || STG == 5), A0_SEG = (STG == 0); \
    constexpr int W1 = A11_SEG ? 8 : 6, W2 = (STG == 0) ? 8 : (STG == 1) ? 2 : (STG == 2) ? 4 : 6; \
    PG8_LDB(B0, b, 0); PG8_LDB(B1, b, 1); PG8_SCHED; PG8_LDA(At, b, 0); if constexpr (A11_SEG) PG8_STAGE(PG8_SA((b) ^ 1, 1), pa11, voffA); \
    PG8_WAIT_VC(W1, RELAX_); PG8_WAIT_L(0); PG8_BAR; PG8_MMA(0, 0, At, B0); if constexpr (!A11_SEG) { PG8_SCHED; PG8_STAGE(PG8_SA((b) ^ 1, 1), pa11, voffA); PG8_SCHED; } PG8_MMA(0, 1, At, B1); PG8_BAR; PG8_SCHED; \
    PG8_LDA(At, b, 1); if constexpr (B0_SEG) PG8_STAGE(PG8_SB(b, 0), pb, voffB); if constexpr (B1_SEG) PG8_STAGE(PG8_SB(b, 1), (pb) + hstepB, voffB); if constexpr (A0_SEG) PG8_STAGE(PG8_SA(b, 0), pa0, voffA); \
    PG8_WAIT_VC(W2, RELAX_); PG8_WAIT_L(0); PG8_BAR; \
    if constexpr (!B0_SEG) { PG8_STAGE(PG8_SB(b, 0), pb, voffB); PG8_SCHED; } \
    PG8_MMA(1, 0, At, B0); \
    if constexpr (!B1_SEG) { PG8_SCHED; PG8_STAGE(PG8_SB(b, 1), (pb) + hstepB, voffB); PG8_SCHED; } \
    if constexpr (!A0_SEG && STG != 2) { PG8_SCHED; PG8_STAGE(PG8_SA(b, 0), pa0, voffA); PG8_SCHED; } \
    PG8_MMA(1, 1, At, B1); \
    if constexpr (!A0_SEG && STG == 2) { PG8_SCHED; PG8_STAGE(PG8_SA(b, 0), pa0, voffA); } \
    PG8_BAR; PG8_SCHED; } while (0)
            PG8_KT(0, a1 + hstepA, b2, a2, ((t == 0 && ui > 0) ? 1 : 0));
            PG8_KT(1, a2 + hstepA, b3, a3, 0);
#undef PG8_KT
            } else {
            PG8_LDB(B0, 0, 0); PG8_SCHED; PG8_LDA(At, 0, 0); PG8_STAGE(PG8_SA(1, 1), a1 + hstepA, voffA);
            PG8_WAIT_L(8); PG8_BAR; PG8_WAIT_L(0); PG8_MMA(0, 0, At, B0); PG8_BAR; PG8_SCHED;
            PG8_LDB(B1, 0, 1); PG8_STAGE(PG8_SB(0, 0), b2, voffB);
            PG8_BAR; PG8_WAIT_L(0); PG8_MMA(0, 1, At, B1); PG8_BAR;
            PG8_LDA(At, 0, 1); PG8_STAGE(PG8_SA(0, 0), a2, voffA);
            PG8_BAR; PG8_WAIT_L(0); PG8_MMA(1, 0, At, B0); PG8_BAR; PG8_SCHED;
            PG8_STAGE(PG8_SB(0, 1), b2 + hstepB, voffB);
            PG8_WAIT_V(6); PG8_BAR; PG8_MMA(1, 1, At, B1); PG8_BAR;
            PG8_LDB(B0, 1, 0); PG8_SCHED; PG8_LDA(At, 1, 0); PG8_STAGE(PG8_SA(0, 1), a2 + hstepA, voffA);
            PG8_WAIT_L(8); PG8_BAR; PG8_WAIT_L(0); PG8_MMA(0, 0, At, B0); PG8_BAR; PG8_SCHED;
            PG8_LDB(B1, 1, 1); PG8_STAGE(PG8_SB(1, 0), b3, voffB);
            PG8_BAR; PG8_WAIT_L(0); PG8_MMA(0, 1, At, B1); PG8_BAR;
            PG8_LDA(At, 1, 1); PG8_STAGE(PG8_SA(1, 0), a3, voffA);
            PG8_BAR; PG8_WAIT_L(0); PG8_MMA(1, 0, At, B0); PG8_BAR; PG8_SCHED;
            PG8_STAGE(PG8_SB(1, 1), b3 + hstepB, voffB);
            PG8_WAIT_V(6); PG8_BAR; PG8_MMA(1, 1, At, B1); PG8_BAR;
            }
        }
        if constexpr (ALIGN_EPI) { if (wr == 0) PG8_BAR; }
        if constexpr (!Epi::AFTER_DRAIN) { if constexpr (RELAX1ST) PG8_WAIT_V(0); E(acc, cur, wr, wc, fr, fq); S.done(cur); }
        if (!has_next) break;
        if (S.zero_after(cur))
#pragma unroll
        for (int a = 0; a < 2; ++a)
#pragma unroll
            for (int b = 0; b < 2; ++b)
#pragma unroll
                for (int m = 0; m < 4; ++m)
#pragma unroll
                    for (int n = 0; n < 2; ++n) acc[a][b][m][n] = (f32x4){0.f, 0.f, 0.f, 0.f};
        cur = nxt; cA = nA; cB = nB; ++ui;
        if constexpr (ALIGN_EPI) { if (wr == 1) PG8_BAR; }
    }
    PG8_WAIT_V(0);
    if constexpr (!ALIGN_EPI) { if (wr == 0) PG8_BAR; }
    PG8_BAR;
    if constexpr (Epi::AFTER_DRAIN) { E.fused(acc, cur, wr, wc, fr, fq, lds, wid, lane); S.done(cur); }
#undef PG8_SA
#undef PG8_SB
#undef PG8_STAGE
#undef PG8_LDA
#undef PG8_LDB
#undef PG8_MMA
#undef PG8_WAIT_V
#undef PG8_WAIT_L
#undef PG8_BAR
#undef PG8_SCHED
}
}
constexpr int NWAVES = 8;
constexpr int S = 8192, DM = 4096, HD = 128, NH = 16, WF = 2048, DFF = 11008, PLE = 256, NIN = 20496, NPROJ = 20480;
constexpr float EPS = 1e-6f;
constexpr float SCALE = 0.08838834764831845f;
constexpr size_t MiB = 1u << 20;
constexpr size_t WS_CTL = 0, CTL_ZERO_BYTES = 1 * MiB;
constexpr size_t WS_SS1 = 1 * MiB;
constexpr size_t WS_LOGF = WS_SS1 + 64 * 1024;
constexpr size_t WS_C = WS_LOGF + 512 * 1024;
constexpr size_t WS_WTF = WS_C + 512 * 1024;
constexpr size_t WS_WIN = 4 * MiB;
constexpr size_t WS_WBF = WS_WIN + 160 * MiB;
constexpr size_t WS_WBS = WS_WBF + 16 * MiB;
constexpr size_t WS_WOUT = WS_WBS + 16 * MiB;
constexpr size_t WS_WUP = WS_WOUT + 32 * MiB;
constexpr size_t WS_WDN = WS_WUP + 172 * MiB;
constexpr size_t WS_WPG = WS_WDN + 86 * MiB;
constexpr size_t WS_WPP = WS_WPG + 32 * MiB;
constexpr size_t WS_XB = WS_WPP + 2 * MiB;
constexpr size_t WS_PB = WS_XB + 64 * MiB;
constexpr size_t WS_QKV = WS_PB + 4 * MiB;
constexpr size_t WS_GATES = WS_QKV + 192 * MiB;
constexpr size_t WS_Y = WS_GATES + 128 * MiB;
constexpr size_t WS_EDGE = WS_QKV + 128 * MiB;
constexpr size_t WS_UP = WS_QKV;
constexpr size_t WS_MERGED = WS_Y + 64 * MiB;
constexpr size_t WS_ACT = WS_MERGED + 64 * MiB;
constexpr size_t WS_PP = WS_QKV;
constexpr size_t WS_END = WS_ACT + 172 * MiB;
static_assert(WS_UP + (size_t)S * 2 * DFF * 2 <= WS_MERGED, "up overlay");
constexpr int CW_BAR = 4096;
constexpr int CW_FBLK = 2560;
constexpr int CW_QATT = 2048;
constexpr int CW_SS2 = 32768, CW_SS3 = 32768 + 8192;
constexpr int N_BAR_REGIONS = 4;
constexpr int RING_OFF = 0, RING_BYTES = 131072;
constexpr int LDSCTL_OFF = RING_BYTES, MISC_OFF = LDSCTL_OFF + 320;
constexpr int XCH_OFF = LDSCTL_OFF + 1024;
constexpr int LDS_BYTES = 147456;
static_assert(XCH_OFF + 8192 <= LDS_BYTES, "LDS map");

#define GAS __attribute__((address_space(1)))
#define LAS __attribute__((address_space(3)))
typedef unsigned short bf16;
typedef unsigned v4u __attribute__((ext_vector_type(4)));
typedef unsigned v2u __attribute__((ext_vector_type(2)));
typedef float f32x4 __attribute__((ext_vector_type(4)));
typedef float f32x16 __attribute__((ext_vector_type(16)));
typedef short bf16x8 __attribute__((ext_vector_type(8)));
typedef GAS unsigned gu32;
#define RLX_AGENT __ATOMIC_RELAXED, __HIP_MEMORY_SCOPE_AGENT
#define LDS_WAIT() asm volatile("s_waitcnt lgkmcnt(0)" ::: "memory")
#define VM_WAIT() asm volatile("s_waitcnt vmcnt(0)" ::: "memory")
__device__ __forceinline__ unsigned pk2(float lo, float hi) { unsigned r; asm volatile("v_cvt_pk_bf16_f32 %0, %1, %2" : "=v"(r) : "v"(lo), "v"(hi)); return r; }
__device__ __forceinline__ float bf2f(bf16 b) { return __uint_as_float(((unsigned)b) << 16); }
__device__ __forceinline__ float bflo(unsigned w) { return __uint_as_float(w << 16); }
__device__ __forceinline__ float bfhi(unsigned w) { return __uint_as_float(w & 0xffff0000u); }
__device__ __forceinline__ float sigmoidf_(float v) { return 1.0f / (1.0f + __expf(-v)); }
__device__ __forceinline__ float log_sigmoidf_(float v) { return fminf(v, 0.f) - log1pf(__expf(-fabsf(v))); }
__device__ __forceinline__ float softplusf_(float v) { return fmaxf(v, 0.f) + log1pf(__expf(-fabsf(v))); }
__device__ __forceinline__ float wave_sum(float v) {
#pragma unroll
    for (int o = 1; o < 64; o <<= 1) v += __shfl_xor(v, o);
    return v;
}

#define XB_TMO      128
#define XB_XCNT(j)  (256  + 64 * (j))
#define XB_XSUB(j)  (1280 + 64 * (j))
#define XB_XGEN(j)  (2304 + 64 * (j))
#define XB_TOP      3328
#define XB_TOPGEN   3392
#define XCD_BAR_WORDS 3456
#define XB_SPIN_CAP (1u << 18)

__device__ __forceinline__ unsigned xb_ld(unsigned* p)              { return __hip_atomic_load(p, __ATOMIC_RELAXED, __HIP_MEMORY_SCOPE_AGENT); }
__device__ __forceinline__ unsigned xb_add(unsigned* p, unsigned v) { return __hip_atomic_fetch_add(p, v, __ATOMIC_RELAXED, __HIP_MEMORY_SCOPE_AGENT); }
__device__ __forceinline__ unsigned xb_xcc_id() { return (unsigned)__builtin_amdgcn_s_getreg((3 << 11) | 20) & 0xFu; }
#define XB_SPIN(cond, bar) do { unsigned _sp = 0; while (cond) { __builtin_amdgcn_s_sleep(1); \
    if ((++_sp & 255u) == 0u) { if (xb_ld(&(bar)[XB_TMO])) break; if (_sp > XB_SPIN_CAP) { atomicAdd(&(bar)[XB_TMO], 1u); break; } } } } while (0)

struct XcdBarrier {
    unsigned* bar; unsigned x; int wave;
    volatile LAS unsigned* st;
};

__device__ __forceinline__ XcdBarrier xcd_barrier_post(unsigned* bar, volatile LAS unsigned* st, const int WAVE_) {
    XcdBarrier b; b.wave = WAVE_; b.bar = bar; b.x = xb_xcc_id(); b.st = st;
    if (TID() == 0) (void)xb_add(&bar[XB_XCNT(b.x)], 1u);
    return b;
}
__device__ __forceinline__ void xcd_barrier_complete(unsigned* bar, unsigned x, unsigned& nloc, unsigned& nx) {
    const unsigned G = gridDim.x * gridDim.y * gridDim.z;
    unsigned sum, cnt, mine, sp = 0u;
    for (;;) {
        sum = 0u; cnt = 0u; mine = 0u;
#pragma unroll
        for (unsigned j = 0; j < 16; ++j) { const unsigned c = xb_ld(&bar[XB_XCNT(j)]); sum += c; cnt += (c > 0u) ? 1u : 0u; mine = (j == x) ? c : mine; }
        if (sum == G) break;
        __builtin_amdgcn_s_sleep(1);
        if ((++sp & 255u) == 0u) { if (xb_ld(&bar[XB_TMO])) break; if (sp > XB_SPIN_CAP) { atomicAdd(&bar[XB_TMO], 1u); break; } }
    }
    nloc = mine > 0u ? mine : 1u; nx = cnt > 0u ? cnt : 1u;
}

__device__ __forceinline__ void xcd_barrier(const XcdBarrier& b) {
    const int WAVE_ = b.wave;
    asm volatile("s_waitcnt vmcnt(0)" ::: "memory");
    __syncthreads();
    if (TID() == 0) {
        unsigned* bar = b.bar;
        __builtin_amdgcn_s_waitcnt(0);
        unsigned nloc = b.st[0], nx = b.st[1];
        if (nloc == 0u) { xcd_barrier_complete(bar, b.x, nloc, nx); b.st[0] = nloc; b.st[1] = nx; }
        const unsigned old = xb_add(&bar[XB_XSUB(b.x)], 1u);
        const unsigned gen = old / nloc;
        if (old + 1u == (gen + 1u) * nloc) {
            __builtin_amdgcn_fence(__ATOMIC_RELEASE, "agent");
            asm volatile("s_waitcnt vmcnt(0)" ::: "memory");
            const unsigned og = xb_add(&bar[XB_TOP], 1u);
            const unsigned tg = og / nx;
            if (og + 1u == (tg + 1u) * nx) xb_add(&bar[XB_TOPGEN], 1u);
            else XB_SPIN(xb_ld(&bar[XB_TOPGEN]) == tg, bar);
            __builtin_amdgcn_fence(__ATOMIC_ACQUIRE, "agent");
            xb_add(&bar[XB_XGEN(b.x)], 1u);
            asm volatile("s_waitcnt vmcnt(0)" ::: "memory");
        } else {
            XB_SPIN(xb_ld(&bar[XB_XGEN(b.x)]) == gen, bar);
            __builtin_amdgcn_fence(__ATOMIC_ACQUIRE, "agent");
            asm volatile("s_waitcnt vmcnt(0)" ::: "memory");
        }
    }
    __syncthreads();
}


struct Params {
    const float* in[18]; float* out; unsigned char* ws;
    int ph_lo, ph_hi, li, pad;
};
struct Frame {
    LAS unsigned char* lds; volatile LAS unsigned* MISC; gu32* ctl;
    int wave, vcu, G;
};

constexpr int CVT_WIN_TILES = 64 * 96 + 64 * 224;
constexpr int CVT_REST_TILES = 32 * 64 + 32 * 64 + 64 * 64 + 64 * 344 + 172 * 64 + 64 * 64 + 4 * 64;
struct CvtT { const float* src; const float* g; bf16* dst; int ldw, K; };
__device__ __forceinline__ CvtT cvt_decode(const Params& P, int it, int lane) {
    unsigned char* ws = P.ws;
    constexpr int T0 = 64 * 96, T1 = 64 * 224, T2 = 32 * 64, T3 = 32 * 64, T4 = 64 * 64, T5 = 64 * 344, T6 = 172 * 64, T7 = 64 * 64;
    const float* W; const float* g = nullptr; bf16* Wt; int ldw, srccol0 = 0, K, nrow0 = 0, NT; int r = it; bool is_up = false;
    if (r < T0) { W = P.in[3]; ldw = NIN; g = P.in[2]; Wt = (bf16*)(ws + WS_WIN); K = DM; NT = 96; }
    else if ((r -= T0) < T1) { W = P.in[3]; ldw = NIN; srccol0 = 6160; g = P.in[2]; Wt = (bf16*)(ws + WS_WIN); K = DM; nrow0 = 6144; NT = 224; }
    else if ((r -= T1) < T2) { W = P.in[7]; ldw = DM; Wt = (bf16*)(ws + WS_WBF); K = WF; NT = 64; }
    else if ((r -= T2) < T3) { W = P.in[8]; ldw = DM; Wt = (bf16*)(ws + WS_WBS); K = WF; NT = 64; }
    else if ((r -= T3) < T4) { W = P.in[9]; ldw = DM; Wt = (bf16*)(ws + WS_WOUT); K = DM; NT = 64; }
    else if ((r -= T4) < T5) { W = P.in[11]; ldw = 2 * DFF; g = P.in[10]; Wt = (bf16*)(ws + WS_WUP); K = DM; NT = 344; is_up = true; }
    else if ((r -= T5) < T6) { W = P.in[14]; ldw = DM; Wt = (bf16*)(ws + WS_WDN); K = DFF; NT = 64; }
    else if ((r -= T6) < T7) { W = P.in[16]; ldw = DM; g = P.in[15]; Wt = (bf16*)(ws + WS_WPG); K = DM; NT = 64; }
    else { r -= T7; W = P.in[17]; ldw = DM; Wt = (bf16*)(ws + WS_WPP); K = PLE; NT = 64; }
    const int nt = r % NT, kt = r / NT, nq = lane & 7, q = lane >> 3;
    CvtT T;
    int scol = srccol0 + 64 * nt;
    if (is_up) scol = ((nt & 3) >> 1) * DFF + 128 * (nt >> 2) + (nt & 1) * 64;
    T.src = W + (size_t)(64 * kt + 8 * q) * ldw + scol + 4 * nq;
    T.g = g ? g + 64 * kt + 8 * q : nullptr;
    T.dst = Wt + (size_t)(nrow0 + 64 * nt + 4 * nq) * K + 64 * kt + 8 * q;
    T.ldw = ldw; T.K = K;
    return T;
}
__device__ __forceinline__ void cvt_load(const CvtT& T, f32x4 (&v)[2][8]) {
#pragma unroll
    for (int p = 0; p < 2; ++p)
#pragma unroll
        for (int t = 0; t < 8; ++t) v[p][t] = __builtin_nontemporal_load((const f32x4*)(T.src + (size_t)t * T.ldw + 32 * p));
}
__device__ __forceinline__ void cvt_store(const CvtT& T, const f32x4 (&v)[2][8]) {
    f32x4 g0 = (f32x4){1.f, 1.f, 1.f, 1.f}, g1 = g0;
    if (T.g) { g0 = *(const f32x4*)T.g; g1 = *(const f32x4*)(T.g + 4); }
#pragma unroll
    for (int p = 0; p < 2; ++p)
#pragma unroll
        for (int i = 0; i < 4; ++i) {
            v4u w; w.x = pk2(v[p][0][i] * g0[0], v[p][1][i] * g0[1]); w.y = pk2(v[p][2][i] * g0[2], v[p][3][i] * g0[3]);
            w.z = pk2(v[p][4][i] * g1[0], v[p][5][i] * g1[1]); w.w = pk2(v[p][6][i] * g1[2], v[p][7][i] * g1[3]);
            *(v4u*)(T.dst + (size_t)(32 * p + i) * T.K) = w;
        }
}
__device__ __forceinline__ void p0_weights(const Frame& F, const Params& P) {
    const int WAVE_ = F.wave; const int f_lane = lane_id(), f_tid = TID();
    const int gw = F.vcu * NWAVES + F.wave, NGW = F.G * NWAVES, lane = f_lane;
    unsigned char* ws = P.ws;
    constexpr int NITEMS = CVT_WIN_TILES;
    f32x4 va[2][8], vb[2][8];
    int it = gw;
    if (it < NITEMS) {
        CvtT Ta = cvt_decode(P, it, lane); cvt_load(Ta, va);
        for (;;) {
            const int i1 = it + NGW; CvtT Tb = Ta;
            if (i1 < NITEMS) { Tb = cvt_decode(P, i1, lane); cvt_load(Tb, vb); }
            cvt_store(Ta, va);
            if (i1 >= NITEMS) break;
            const int i2 = i1 + NGW;
            if (i2 < NITEMS) { Ta = cvt_decode(P, i2, lane); cvt_load(Ta, va); }
            cvt_store(Tb, vb);
            if (i2 >= NITEMS) break;
            it = i2;
        }
    }
    { const float* w_in = P.in[3]; const float* g_mix = P.in[2]; bf16* wtf = (bf16*)(ws + WS_WTF);
      for (int i = blockIdx.x * 512 + f_tid; i < NH * (DM / 8); i += F.G * 512) { const int n = i / (DM / 8), kc = i % (DM / 8);
          float b[8];
#pragma unroll
          for (int t = 0; t < 8; ++t) b[t] = w_in[(size_t)(8 * kc + t) * NIN + 6144 + n] * g_mix[8 * kc + t];
          v4u w; w.x = pk2(b[0], b[1]); w.y = pk2(b[2], b[3]); w.z = pk2(b[4], b[5]); w.w = pk2(b[6], b[7]);
          *(v4u*)(wtf + (size_t)n * DM + 8 * kc) = w; } }
    const float* p = P.in[1]; bf16* pb = (bf16*)(ws + WS_PB);
    for (int i = blockIdx.x * 512 + f_tid; i < S * PLE / 8; i += F.G * 512) {
        const f32x4 a = *(const f32x4*)(p + (size_t)i * 8), b = *(const f32x4*)(p + (size_t)i * 8 + 4);
        v4u w; w.x = pk2(a[0], a[1]); w.y = pk2(a[2], a[3]); w.z = pk2(b[0], b[1]); w.w = pk2(b[2], b[3]);
        *(v4u*)(pb + (size_t)i * 8) = w;
    }
}
constexpr int CVT_SLOT = 18;
static_assert(2560 * CVT_SLOT >= CVT_REST_TILES, "conversion slots cover every tile");
struct ConvOrder : pg8::StaticOrder {
    const Params* P; int wave; mutable int slot;
    __device__ __forceinline__ void done(const pg8::Unit&) const {
        const int lane = lane_id();
        const int base = (slot * G + c) * CVT_SLOT; ++slot;
        const int i0 = base + wave, i1 = i0 + 8, i2 = i0 + 16;
        const int lim = (base + CVT_SLOT < CVT_REST_TILES) ? base + CVT_SLOT : CVT_REST_TILES;
        f32x4 va[2][8], vb[2][8];
        if (i0 < lim) {
            CvtT Ta = cvt_decode(*P, CVT_WIN_TILES + i0, lane); cvt_load(Ta, va);
            if (i1 < lim) {
                CvtT Tb = cvt_decode(*P, CVT_WIN_TILES + i1, lane); cvt_load(Tb, vb);
                cvt_store(Ta, va);
                if (i2 < lim) { Ta = cvt_decode(*P, CVT_WIN_TILES + i2, lane); cvt_load(Ta, va); cvt_store(Tb, vb); cvt_store(Ta, va); }
                else cvt_store(Tb, vb);
            } else cvt_store(Ta, va);
        }
    }
};
__device__ __forceinline__ void p0_rows(const Frame& F, const Params& P) {
    const int WAVE_ = F.wave; const int f_lane = lane_id();
    const float* x = P.in[0]; unsigned char* ws = P.ws;
    float* ss1 = (float*)(ws + WS_SS1); bf16* xb = (bf16*)(ws + WS_XB);
    const int gw = F.vcu * NWAVES + F.wave, NGW = F.G * NWAVES, lane = f_lane;
    for (int base = gw; base < S; base += 2 * NGW) {
        const int rowA = base, rowB = (base + NGW < S) ? base + NGW : base;
        const f32x4* xa = (const f32x4*)(x + (size_t)rowA * DM) + lane; const f32x4* xbp = (const f32x4*)(x + (size_t)rowB * DM) + lane;
        f32x4 va[16], vb[16]; float sa = 0.f, sb = 0.f;
#pragma unroll
        for (int j = 0; j < 16; ++j) va[j] = __builtin_nontemporal_load(xa + 64 * j);
#pragma unroll
        for (int j = 0; j < 16; ++j) vb[j] = __builtin_nontemporal_load(xbp + 64 * j);
#pragma unroll
        for (int j = 0; j < 16; ++j) sa += (va[j][0] * va[j][0] + va[j][1] * va[j][1]) + (va[j][2] * va[j][2] + va[j][3] * va[j][3]);
#pragma unroll
        for (int j = 0; j < 16; ++j) sb += (vb[j][0] * vb[j][0] + vb[j][1] * vb[j][1]) + (vb[j][2] * vb[j][2] + vb[j][3] * vb[j][3]);
        sa = wave_sum(sa); sb = wave_sum(sb);
        if (lane == 0) { ss1[rowA] = sa; ss1[rowB] = sb; }
        v2u* oa = (v2u*)(xb + (size_t)rowA * DM) + lane; v2u* ob = (v2u*)(xb + (size_t)rowB * DM) + lane;
#pragma unroll
        for (int j = 0; j < 16; ++j) { v2u w; w.x = pk2(va[j][0], va[j][1]); w.y = pk2(va[j][2], va[j][3]); oa[64 * j] = w; }
#pragma unroll
        for (int j = 0; j < 16; ++j) { v2u w; w.x = pk2(vb[j][0], vb[j][1]); w.y = pk2(vb[j][2], vb[j][3]); ob[64 * j] = w; }
    }
}

__device__ __forceinline__ void p1b_qknorm_fgate(const Frame& F, const Params& P) {
    const int WAVE_ = F.wave; const int f_lane = lane_id(), f_tid = TID();
    unsigned char* ws = P.ws;
    bf16* qkv = (bf16*)(ws + WS_QKV);
    const float* gq = P.in[5]; const float* gk = P.in[6];
    const int gw = F.vcu * NWAVES + F.wave, NGW = F.G * NWAVES, lane = f_lane, sub = lane >> 4, l16 = lane & 15;
    {
        const bf16* xb = (const bf16*)(ws + WS_XB); const bf16* wtf = (const bf16*)(ws + WS_WTF); const float* ss1 = (const float*)(ws + WS_SS1); const float* b_f = P.in[4];
        float* logf = (float*)(ws + WS_LOGF);
        LAS float* fbuf = (LAS float*)(F.lds + RING_OFF);
        const int wave = F.wave, rl = lane & 31, kg = lane >> 5;
        for (int grp = blockIdx.x; grp < S / 32; grp += F.G) {
            const int r0 = grp * 32;
            const bf16* pa = xb + (size_t)(r0 + rl) * DM + 512 * wave + 8 * kg;
            const bf16* pb = wtf + (size_t)(rl & 15) * DM + 512 * wave + 8 * kg;
            f32x16 acc = {};
#pragma unroll 8
            for (int ks = 0; ks < 32; ++ks) {
                const bf16x8 a = *(const bf16x8*)(pa + 16 * ks);
                bf16x8 b = *(const bf16x8*)(pb + 16 * ks);
                if (rl >= 16) b = (bf16x8){0, 0, 0, 0, 0, 0, 0, 0};
                acc = __builtin_amdgcn_mfma_f32_32x32x16_bf16(a, b, acc, 0, 0, 0);
            }
            if (rl < 16) {
#pragma unroll
                for (int r = 0; r < 16; ++r) { const int tok = (r & 3) + 8 * (r >> 2) + 4 * kg; fbuf[(wave * 32 + tok) * 16 + rl] = acc[r]; }
            }
            __syncthreads();
            {
                const int tok = f_tid >> 4, h = f_tid & 15; float fv = 0.f;
#pragma unroll
                for (int w = 0; w < 8; ++w) fv += fbuf[(w * 32 + tok) * 16 + h];
                fv = fv * rsqrtf(ss1[r0 + tok] * (1.0f / DM) + EPS) + b_f[h];
                const float lv = log_sigmoidf_(fv);
                logf[(size_t)h * S + r0 + tok] = lv;
                float bs = lv; bs += __shfl_xor(bs, 16); bs += __shfl_xor(bs, 32);
                if (lane < 16) __hip_atomic_fetch_add((float*)(F.ctl + CW_FBLK) + h * 32 + (r0 >> 8), bs, __ATOMIC_RELAXED, __HIP_MEMORY_SCOPE_AGENT);
            }
            __syncthreads();
        }
    }
}

__device__ __forceinline__ void p5c_fixup(const Frame& F, const Params& P) {
    const int WAVE_ = F.wave; const int f_tid = TID();
    unsigned char* ws = P.ws;
    const float* edge = (const float*)(ws + WS_EDGE); bf16* act = (bf16*)(ws + WS_ACT);
    const float* cw = P.in[12]; const float* cb = P.in[13];
    constexpr int NQ = DFF / 4;
    for (int i = blockIdx.x * 512 + f_tid; i < (S / 256) * 2 * NQ; i += F.G * 512) {
        const int row = i / NQ, jc = (i - row * NQ) * 4, p = row >> 1, rr = row & 1, t = 256 * p + rr;
        float uu[2][4];
#pragma unroll
        for (int h = 0; h < 2; ++h) {
            const size_t co = (size_t)h * DFF + jc; const f32x4 z = (f32x4){0.f, 0.f, 0.f, 0.f};
            const f32x4 c = *(const f32x4*)(edge + ((size_t)p * 4 + rr) * (2 * DFF) + co);
            const f32x4 l3 = p ? *(const f32x4*)(edge + ((size_t)(p - 1) * 4 + 3) * (2 * DFF) + co) : z;
            const f32x4 p1 = rr ? *(const f32x4*)(edge + ((size_t)p * 4 + 0) * (2 * DFF) + co) : l3;
            const f32x4 p2 = rr ? l3 : (p ? *(const f32x4*)(edge + ((size_t)(p - 1) * 4 + 2) * (2 * DFF) + co) : z);
            const f32x4 w0 = *(const f32x4*)(cw + co), w1 = *(const f32x4*)(cw + (size_t)2 * DFF + co), w2 = *(const f32x4*)(cw + (size_t)4 * DFF + co), bb = *(const f32x4*)(cb + co);
#pragma unroll
            for (int e = 0; e < 4; ++e) uu[h][e] = bb[e] + w0[e] * p2[e] + w1[e] * p1[e] + w2[e] * c[e];
        }
        v2u w; w.x = pk2(uu[0][0] * sigmoidf_(uu[0][0]) * uu[1][0], uu[0][1] * sigmoidf_(uu[0][1]) * uu[1][1]); w.y = pk2(uu[0][2] * sigmoidf_(uu[0][2]) * uu[1][2], uu[0][3] * sigmoidf_(uu[0][3]) * uu[1][3]);
        *(v2u*)(act + (size_t)t * DFF + jc) = w;
    }
}

namespace att {
constexpr int D = 128, PITCH = 2048, NW = 8, QBLK = 32, KVBLK = 64, QB = NW * QBLK;
constexpr int SHM_V = KVBLK * D * 2, SHM_K = KVBLK * D * 2;
constexpr int OFF_WS = 2 * SHM_V + 2 * SHM_K, OFF_FLAG = OFF_WS + NW * 64 * 4, OFF_WTOT = OFF_FLAG + 64, OFF_NEXT = OFF_WTOT + 64, OFF_C = 73728  , ATT_LDS_BYTES = OFF_C + 32768;
constexpr int OFF_TAB = ATT_LDS_BYTES  , OFF_SPL = OFF_TAB + 8192  , OFF_FBS = OFF_SPL + 2048  , OFF_TOT = OFF_FBS + 2048  ;
constexpr int PART_F = QB * D + 2 * QB;
constexpr float SCALE = 0.08838834764831845f;
constexpr float THR = 8.f;
constexpr int PRUNE_NATS = 40;
typedef short s16x4 __attribute__((ext_vector_type(4)));
typedef unsigned u32x4 __attribute__((ext_vector_type(4)));
#define KSWZ(row, colB) ((row) * 256 + ((colB) ^ (((row) & 7) << 4)))
#define SBAR() __builtin_amdgcn_sched_barrier(0)
__device__ __forceinline__ int v_st(int k, int c) { const int kk = (k & ~0xC) | ((k & 4) << 1) | ((k & 8) >> 1); return ((kk >> 3) * 4 + (c >> 5)) * 512 + ((kk & 7) * 32 + (c & 31)) * 2; }
__device__ __forceinline__ int v_rd_base(int lane) { return ((lane & 3) << 3) | (((lane >> 2) & 3) << 6) | (((lane >> 4) & 1) << 5) | (((lane >> 5) & 1) << 8); }
constexpr int v_rd_off(int d0, int ks, int half) { return d0 * 512 + ks * 4096 + half * 2048; }
__device__ __forceinline__ int crow(int r, int hi) { return (r & 3) + 8 * (r >> 2) + 4 * hi; }
__device__ __forceinline__ unsigned cvtpk(float lo, float hi) { unsigned r; asm volatile("v_cvt_pk_bf16_f32 %0, %1, %2" : "=v"(r) : "v"(lo), "v"(hi)); return r; }
__device__ __forceinline__ bf16x8 load8(const bf16* p) { return *reinterpret_cast<const bf16x8*>(p); }
__device__ __forceinline__ void mask_tile(f32x16& p0, f32x16& p1, int dq) {
    const float NEG = -__builtin_inff();
#pragma unroll
    for (int r = 0; r < 16; ++r) { const int c = (r & 3) + 8 * (r >> 2); if (dq - c < 0) p0[r] = NEG; if (dq - c - 32 < 0) p1[r] = NEG; }
}
__device__ __forceinline__ void partialSM(f32x16& p0, f32x16& p1, float& m_reg, float& mn, float& alpha) {
    float pmax = p0[0]; for (int r = 1; r < 16; ++r) pmax = fmaxf(pmax, p0[r]); for (int r = 0; r < 16; ++r) pmax = fmaxf(pmax, p1[r]);
    { auto rr = __builtin_amdgcn_permlane32_swap(__float_as_uint(pmax), __float_as_uint(pmax), false, false);
      pmax = fmaxf(__uint_as_float(rr[0]), __uint_as_float(rr[1])); }
    constexpr float C2 = 1.4426950408889634f * SCALE;
    if (__builtin_expect(__all((pmax - m_reg) * SCALE <= THR), 1)) { mn = m_reg; alpha = 1.f; }
    else { mn = fmaxf(m_reg, pmax); alpha = __builtin_amdgcn_exp2f((m_reg - mn) * C2); m_reg = mn; }
    const float mnL = -mn * C2;
    for (int r = 0; r < 16; ++r) p0[r] = fmaf(p0[r], C2, mnL); for (int r = 0; r < 16; ++r) p1[r] = fmaf(p1[r], C2, mnL);
    for (int r = 0; r < 16; ++r) p0[r] = __builtin_amdgcn_exp2f(p0[r]);
}
#define PK4(P, B_, OUT) do { unsigned a0 = cvtpk(P[B_+0], P[B_+1]), a1 = cvtpk(P[B_+2], P[B_+3]);                          \
        unsigned b0 = cvtpk(P[B_+4], P[B_+5]), b1 = cvtpk(P[B_+6], P[B_+7]);                                             \
        auto r0 = __builtin_amdgcn_permlane32_swap(a0, b0, false, false); auto r1 = __builtin_amdgcn_permlane32_swap(a1, b1, false, false); \
        u32x4 w = {r0[0], r1[0], r0[1], r1[1]}; OUT = *reinterpret_cast<bf16x8*>(&w); } while (0)
__device__ __forceinline__ void finishSM(f32x16& p0, f32x16& p1, float alpha, float& l_reg, bf16x8& pa0, bf16x8& pa1, bf16x8& pa2, bf16x8& pa3) {
    for (int r = 0; r < 16; ++r) p1[r] = __builtin_amdgcn_exp2f(p1[r]);
    float ps = 0; for (int r = 0; r < 16; ++r) ps += p0[r]; for (int r = 0; r < 16; ++r) ps += p1[r];
    { auto rr = __builtin_amdgcn_permlane32_swap(__float_as_uint(ps), __float_as_uint(ps), false, false);
      ps = __uint_as_float(rr[0]) + __uint_as_float(rr[1]); }
    l_reg = l_reg * alpha + ps;
    PK4(p0, 0, pa0); PK4(p0, 8, pa1); PK4(p1, 0, pa2); PK4(p1, 8, pa3);
}
template <int KB>
__device__ __forceinline__ void qkt(f32x16& p0, f32x16& p1, const char* K_lds, int r32, int hi, const bf16x8* qr) {
    p0 = f32x16{}; p1 = f32x16{};
    const char* kb[4];
#pragma unroll
    for (int dd = 0; dd < 4; ++dd) kb[dd] = K_lds + KB * SHM_K + KSWZ(r32, (dd * 16 + hi * 8) * 2);
#pragma unroll
    for (int d0 = 0; d0 < 8; ++d0) { const char* a = kb[d0 & 3] + (d0 >> 2) * 128;
        bf16x8 b0 = *reinterpret_cast<const bf16x8*>(a);
        bf16x8 b1 = *reinterpret_cast<const bf16x8*>(a + 32 * 256);
        p0 = __builtin_amdgcn_mfma_f32_32x32x16_bf16(b0, qr[d0], p0, 0, 0, 0);
        p1 = __builtin_amdgcn_mfma_f32_32x32x16_bf16(b1, qr[d0], p1, 0, 0, 0); }
}
template <int VB>
__device__ __forceinline__ void pv_tile(f32x16* o, int vb0, bf16x8 pa0, bf16x8 pa1, bf16x8 pa2, bf16x8 pa3) {
#define TRRD(dst, off) asm volatile("ds_read_b64_tr_b16 %0, %1 offset:%2" : "=&v"(dst) : "v"(vb0), "i"(off) : "memory")
#define PV_D0(d0) do { s16x4 l0, l1, l2, l3, h0, h1, h2, h3; constexpr int b_ = VB * SHM_V + v_rd_off(d0, 0, 0); \
        TRRD(l0, b_); TRRD(h0, b_ + 2048); TRRD(l1, b_ + 4096); TRRD(h1, b_ + 6144); TRRD(l2, b_ + 8192); TRRD(h2, b_ + 10240); TRRD(l3, b_ + 12288); TRRD(h3, b_ + 14336); \
        asm volatile("s_waitcnt lgkmcnt(0)" ::: "memory"); SBAR();   \
        o[d0] = __builtin_amdgcn_mfma_f32_32x32x16_bf16(pa0, (bf16x8){l0[0], l0[1], l0[2], l0[3], h0[0], h0[1], h0[2], h0[3]}, o[d0], 0, 0, 0);   \
        o[d0] = __builtin_amdgcn_mfma_f32_32x32x16_bf16(pa1, (bf16x8){l1[0], l1[1], l1[2], l1[3], h1[0], h1[1], h1[2], h1[3]}, o[d0], 0, 0, 0);   \
        o[d0] = __builtin_amdgcn_mfma_f32_32x32x16_bf16(pa2, (bf16x8){l2[0], l2[1], l2[2], l2[3], h2[0], h2[1], h2[2], h2[3]}, o[d0], 0, 0, 0);   \
        o[d0] = __builtin_amdgcn_mfma_f32_32x32x16_bf16(pa3, (bf16x8){l3[0], l3[1], l3[2], l3[3], h3[0], h3[1], h3[2], h3[3]}, o[d0], 0, 0, 0); } while (0)
    PV_D0(0); PV_D0(1); PV_D0(2); PV_D0(3);
#undef PV_D0
#undef TRRD
}
__device__ __forceinline__ void key_bias(f32x16& p0, f32x16& p1, const char* lds, int kbase, int hi) {
    const float* kbp = (const float*)(lds + OFF_C) + kbase + 4 * hi;
#pragma unroll
    for (int g = 0; g < 4; ++g) { const f32x4 b0 = *(const f32x4*)(kbp + 8 * g), b1 = *(const f32x4*)(kbp + 32 + 8 * g);
#pragma unroll
        for (int e = 0; e < 4; ++e) { p0[4 * g + e] -= b0[e]; p1[4 * g + e] -= b1[e]; } }
}
__device__ __forceinline__ void cgate_scan(const float* logf_h, char* lds, const int WAVE_) {
    const int lane = lane_id(), tid = WAVE_ * 64 + lane;
    float* Cl = (float*)(lds + OFF_C); float* wtot = (float*)(lds + OFF_WTOT);
    const float* src = logf_h + tid * 16;
    const f32x4 a = *(const f32x4*)src, b = *(const f32x4*)(src + 4), c = *(const f32x4*)(src + 8), d = *(const f32x4*)(src + 12);
    const float in[16] = {a[0], a[1], a[2], a[3], b[0], b[1], b[2], b[3], c[0], c[1], c[2], c[3], d[0], d[1], d[2], d[3]};
    float loc[16]; float s = 0.f;
#pragma unroll
    for (int j = 0; j < 16; ++j) { s += in[j]; loc[j] = s; }
    float incl = s;
#pragma unroll
    for (int o = 1; o < 64; o <<= 1) { const float t = __builtin_bit_cast(float, __builtin_amdgcn_ds_bpermute((lane - o) << 2, __builtin_bit_cast(int, incl))); if (lane >= o) incl += t; }
    if (lane == 63) wtot[WAVE_] = incl;
    __syncthreads();
    float base = incl - s;
    for (int w = 0; w < WAVE_; ++w) base += wtot[w];
#pragma unroll
    for (int j = 0; j < 16; j += 4) *(f32x4*)(Cl + tid * 16 + j) = (f32x4){base + loc[j], base + loc[j + 1], base + loc[j + 2], base + loc[j + 3]} * (1.0f / SCALE);
    __syncthreads();
}

struct BlockRef { const bf16* Q; const bf16* K; const bf16* V; bf16* O; int P0; int top, nst; float* part; };
struct Seam { bf16x8 qr[8]; bf16x8 st_v0, st_v1, st_k0, st_k1; };
#define ROW(p, k0, rr) ((p) + (size_t)((k0) + (rr)) * PITCH + sc)
#define VMW() asm volatile("s_waitcnt vmcnt(0)" ::: "memory")
#define VMWN(n) asm volatile("s_waitcnt vmcnt(%0)" :: "i"(n) : "memory")
#define SLOAD_H(Kp, Vp, k0) do { S.st_v0 = load8(ROW(Vp, k0, sr)); S.st_v1 = load8(ROW(Vp, k0, 32 + sr));              \
                         S.st_k0 = load8(ROW(Kp, k0, sr)); S.st_k1 = load8(ROW(Kp, k0, 32 + sr)); } while (0)
#define SWRITE_HK(bf) do { *(bf16x8*)(K_lds + (bf) * SHM_K + kws) = S.st_k0; *(bf16x8*)(K_lds + (bf) * SHM_K + kws + 32 * 256) = S.st_k1; } while (0)
#define SWRITE_HV(bf) do { *(bf16x8*)(V_lds + (bf) * SHM_V + vst0) = S.st_v0; *(bf16x8*)(V_lds + (bf) * SHM_V + vst1) = S.st_v1; } while (0)
#define SWRITE_H(bf) do { SWRITE_HV(bf); SWRITE_HK(bf); } while (0)
__device__ __forceinline__ void fox_prime(const BlockRef& cur, char* lds, Seam& S, const int WAVE_) {
    const int tid = TID(), wid = __builtin_amdgcn_readfirstlane(tid >> 6), lane = tid & 63, r32 = lane & 31, hi = lane >> 5;
    const int sr = tid >> 4, sc = (tid & 15) * 8, kws = KSWZ(sr, sc * 2); char* K_lds = lds + 2 * SHM_V;
    for (int d0 = 0; d0 < 8; ++d0) S.qr[d0] = load8(cur.Q + (size_t)(wid * QBLK + r32) * PITCH + d0 * 16 + hi * 8);
    SLOAD_H(cur.K, cur.V, cur.top * KVBLK); VMW(); SWRITE_HK(0);
    __syncthreads();
}
__device__ __forceinline__ void fox_block(const BlockRef& cur, const BlockRef& nxt, const float Uq, char* lds, Seam& S, const int WAVE_) {
    const int tid = TID(), wid = __builtin_amdgcn_readfirstlane(tid >> 6), lane = tid & 63, r32 = lane & 31, hi = lane >> 5;
    const int NT0 = cur.top + 1;
    int NT = cur.nst;
    volatile LAS int* flg = (volatile LAS int*)(lds + OFF_FLAG);
    const int qlo = cur.P0 + wid * QBLK, qm = qlo + r32 - 4 * hi;
    char* V_lds = lds; char* K_lds = lds + 2 * SHM_V;
    float* ws = (float*)(lds + OFF_WS) + wid * 64; float* li_l = ws, * al_l = ws + 32;
    float m_reg = -Uq - ((const float*)(lds + OFF_C))[cur.P0 + wid * QBLK + r32], l_reg = 0; f32x16 o[4] = {};
    const int sr = tid >> 4, sc = (tid & 15) * 8, vst0 = v_st(sr, sc), vst1 = v_st(32 + sr, sc), kws = KSWZ(sr, sc * 2);
    const int vb0 = (int)(uintptr_t)V_lds + v_rd_base(lane);
    const bf16* Kh = cur.K; const bf16* Vh = cur.V;
#define RESC(a) do { if (__any((a) < 1.f)) { if (hi == 0) al_l[r32] = (a); asm volatile("s_waitcnt lgkmcnt(0)" ::: "memory");              \
                     for (int d_ = 0; d_ < 4; ++d_) for (int r = 0; r < 16; ++r) o[d_][r] *= al_l[crow(r, hi)]; } } while (0)
#define KBASE(t) ((NT0 - 1 - (t)) * KVBLK)
#define MASKT(P0_, P1_, t, KBUF) do { const int kb_ = KBASE(t); key_bias(P0_, P1_, lds, kb_, hi); if (kb_ + KVBLK - 1 > qlo) mask_tile(P0_, P1_, qm - kb_); } while (0)
#define SEAM_K0() do { VMWN(8); SWRITE_HK(0); SBAR(); } while (0)
    f32x16 pA0, pA1, pB0, pB1; float mnA, mnB, alA, alB; bf16x8 pa0, pa1, pa2, pa3;
    SWRITE_HV(0); SBAR();
    if (NT > 1) { SLOAD_H(Kh, Vh, KBASE(1)); }
    SBAR(); qkt<0>(pA0, pA1, K_lds, r32, hi, S.qr);
    MASKT(pA0, pA1, 0, 0); partialSM(pA0, pA1, m_reg, mnA, alA);
    if (NT > 1) { VMW(); SWRITE_H(1); }
    __syncthreads();
#define VOTE(t) do { bool can_ = false; if ((t) + 2 < NT) { const float negc_ = -((const float*)(lds + OFF_C))[KBASE((t) + 2) + KVBLK - 1]; can_ = __all((Uq + negc_ - m_reg) * SCALE <= -(float)PRUNE_NATS) != 0; } \
                     if (lane == 0) flg[wid] = can_ ? 1 : 0; } while (0)
#define DECIDE(t) do { int all_ = 1; _Pragma("unroll") for (int w_ = 0; w_ < 8; ++w_) all_ &= flg[w_]; if (all_ && (t) + 2 < NT) NT = (t) + 2; } while (0)
#define HALF_STEP(PX0, PX1, mnX, alX, PY0, PY1, alY, t, KB, VB, SB) do {                                                      \
        SBAR(); qkt<KB>(PX0, PX1, K_lds, r32, hi, S.qr);                                                                     \
        finishSM(PY0, PY1, alY, l_reg, pa0, pa1, pa2, pa3); SBAR();                                                           \
        if ((t) + 1 < NT) { SLOAD_H(Kh, Vh, KBASE((t) + 1)); SBAR(); }                                                    \
        pv_tile<VB>(o, vb0, pa0, pa1, pa2, pa3); MASKT(PX0, PX1, (t), KB); partialSM(PX0, PX1, m_reg, mnX, alX); VOTE(t);    \
        __syncthreads(); DECIDE(t);                                                                                           \
        if ((t) + 1 < NT) { VMW(); SWRITE_H(SB); }                                                                            \
        RESC(alX); __syncthreads(); } while (0)
    for (int t = 1; t + 1 < NT; t += 2) {
        HALF_STEP(pB0, pB1, mnB, alB, pA0, pA1, alA, t, 1, 0, 0);
        HALF_STEP(pA0, pA1, mnA, alA, pB0, pB1, alB, t + 1, 0, 1, 1);
    }
    const bool even = (NT & 1) == 0;
    if (even) { SBAR(); qkt<1>(pB0, pB1, K_lds, r32, hi, S.qr); SBAR(); }
    SLOAD_H(nxt.K, nxt.V, nxt.top * KVBLK); SBAR();
#pragma unroll
    for (int d0 = 0; d0 < 8; ++d0) S.qr[d0] = load8(nxt.Q + (size_t)(wid * QBLK + r32) * PITCH + d0 * 16 + hi * 8);
    SBAR();
    finishSM(pA0, pA1, alA, l_reg, pa0, pa1, pa2, pa3); SBAR();
    pv_tile<0>(o, vb0, pa0, pa1, pa2, pa3);
    if (even) { MASKT(pB0, pB1, NT - 1, 1); partialSM(pB0, pB1, m_reg, mnB, alB); __syncthreads(); RESC(alB);
        finishSM(pB0, pB1, alB, l_reg, pa0, pa1, pa2, pa3); SBAR(); pv_tile<1>(o, vb0, pa0, pa1, pa2, pa3); }
    SBAR(); SEAM_K0();
    if (cur.part != nullptr) {
        float* po = cur.part + (size_t)(wid * QBLK) * D + r32;
#pragma unroll
        for (int r = 0; r < 16; ++r) { const int orow = crow(r, hi);
#pragma unroll
            for (int d0 = 0; d0 < 4; ++d0) po[orow * D + d0 * 32] = o[d0][r]; }
        if (hi == 0) { cur.part[QB * D + wid * QBLK + r32] = m_reg; cur.part[QB * D + QB + wid * QBLK + r32] = l_reg; }
    } else {
    if (hi == 0) li_l[r32] = l_reg; asm volatile("s_waitcnt lgkmcnt(0)" ::: "memory");
    float rli[16];
#pragma unroll
    for (int r = 0; r < 16; ++r) rli[r] = __builtin_amdgcn_rcpf(li_l[crow(r, hi)]);
    bf16* Ow = cur.O + (size_t)(wid * QBLK) * PITCH;
#pragma unroll
    for (int r = 0; r < 16; ++r) { const int orow = crow(r, hi);
#pragma unroll
        for (int d0 = 0; d0 < 4; ++d0) { const float v = o[d0][r] * rli[r];
            const float vn = __shfl_xor(v, 1);
            if ((r32 & 1) == 0) *(unsigned*)(Ow + (size_t)orow * PITCH + d0 * 32 + r32) = cvtpk(v, vn); } }
    }
    __syncthreads();
#undef RESC
#undef MASKT
#undef SEAM_K0
#undef HALF_STEP
#undef VOTE
#undef DECIDE
#undef KBASE
}

__device__ __forceinline__ void fox_combine(const float* __restrict__ slot0, const int np, bf16* __restrict__ O, const int WAVE_) {
    const int lane = lane_id(), c = (lane & 31) * 4;
    constexpr float C2 = 1.4426950408889634f * SCALE;
    const float NINF = -__builtin_inff();
    for (int it0 = 0; it0 < 16; it0 += 4) {
        float mv[4][4], lv[4][4]; f32x4 dv[4][4];
#pragma unroll
        for (int u = 0; u < 4; ++u) { const int row = WAVE_ * 32 + (it0 + u) * 2 + (lane >> 5);
#pragma unroll
            for (int p = 0; p < 4; ++p) { mv[u][p] = NINF; lv[u][p] = 0.f; dv[u][p] = (f32x4){0.f, 0.f, 0.f, 0.f};
                if (p < np) { const float* s = slot0 + (size_t)p * PART_F; mv[u][p] = s[QB * D + row]; lv[u][p] = s[QB * D + QB + row]; dv[u][p] = *(const f32x4*)(s + (size_t)row * D + c); } } }
#pragma unroll
        for (int u = 0; u < 4; ++u) { const int row = WAVE_ * 32 + (it0 + u) * 2 + (lane >> 5);
            const float M = fmaxf(fmaxf(mv[u][0], mv[u][1]), fmaxf(mv[u][2], mv[u][3]));
            float den = 0.f; f32x4 a = {0.f, 0.f, 0.f, 0.f};
#pragma unroll
            for (int p = 0; p < 4; ++p) { const float e = __builtin_amdgcn_exp2f((mv[u][p] - M) * C2); den += e * lv[u][p]; a += dv[u][p] * e; }
            a *= 1.0f / den;
            unsigned x, y;
            asm("v_cvt_pk_bf16_f32 %0, %1, %2" : "=v"(x) : "v"(a[0]), "v"(a[1]));
            asm("v_cvt_pk_bf16_f32 %0, %1, %2" : "=v"(y) : "v"(a[2]), "v"(a[3]));
            uint2 pk; pk.x = x; pk.y = y;
            *(uint2*)(O + (size_t)row * PITCH + c) = pk; }
    }
}

template <int BUF>
__device__ __forceinline__ void sb_tile(f32x16* o, float& R, const char* K_lds, int vb0, int r32, int hi, const bf16x8* qr, int dq) {
    f32x16 p0, p1;
    qkt<BUF>(p0, p1, K_lds, r32, hi, qr);
    constexpr float L2E = 1.4426950408889634f, LN2 = 0.6931471805599453f;
    f32x16 l0, l1;
    const float NEG = -__builtin_inff();
#pragma unroll
    for (int r = 0; r < 16; ++r) { const int c = (r & 3) + 8 * (r >> 2);
        { const float z = p0[r] * SCALE; const float sp = fmaxf(z, 0.f) + LN2 * __builtin_amdgcn_logf(1.0f + __builtin_amdgcn_exp2f(-fabsf(z) * L2E)); const bool st = (dq - c) >= 1; l0[r] = st ? -sp : 0.f; p0[r] = st ? (z - sp) : NEG; }
        { const float z = p1[r] * SCALE; const float sp = fmaxf(z, 0.f) + LN2 * __builtin_amdgcn_logf(1.0f + __builtin_amdgcn_exp2f(-fabsf(z) * L2E)); const bool st = (dq - c - 32) >= 1; l1[r] = st ? -sp : 0.f; p1[r] = st ? (z - sp) : NEG; } }
    float gs[8], pg[8], ps[8];
#pragma unroll
    for (int g = 0; g < 4; ++g) { gs[g] = (l0[4 * g] + l0[4 * g + 1]) + (l0[4 * g + 2] + l0[4 * g + 3]); gs[4 + g] = (l1[4 * g] + l1[4 * g + 1]) + (l1[4 * g + 2] + l1[4 * g + 3]); }
#pragma unroll
    for (int g = 0; g < 8; ++g) { auto rr = __builtin_amdgcn_permlane32_swap(__float_as_uint(gs[g]), __float_as_uint(gs[g]), false, false);
        const float lo = __uint_as_float(rr[0]), hv = __uint_as_float(rr[1]); ps[g] = lo + hv; pg[g] = hi ? lo : hv; }
    float acc = R;
#pragma unroll
    for (int g = 7; g >= 0; --g) {
        float run = hi ? acc : acc + pg[g];
        acc += ps[g];
        if (g >= 4) { const int b = 4 * (g - 4);
#pragma unroll
            for (int e = 3; e >= 0; --e) { const float t = l1[b + e]; p1[b + e] = __builtin_amdgcn_exp2f((p1[b + e] + run) * L2E); run += t; } }
        else { const int b = 4 * g;
#pragma unroll
            for (int e = 3; e >= 0; --e) { const float t = l0[b + e]; p0[b + e] = __builtin_amdgcn_exp2f((p0[b + e] + run) * L2E); run += t; } }
    }
    R = acc;
    bf16x8 pa0, pa1, pa2, pa3;
    PK4(p0, 0, pa0); PK4(p0, 8, pa1); PK4(p1, 0, pa2); PK4(p1, 8, pa3);
    pv_tile<BUF>(o, vb0, pa0, pa1, pa2, pa3);
}
__device__ __forceinline__ void sb_block(const BlockRef& cur, char* lds, const int WAVE_) {
    const int tid = TID(), wid = __builtin_amdgcn_readfirstlane(tid >> 6), lane = tid & 63, r32 = lane & 31, hi = lane >> 5;
    const int NT = (cur.P0 + QB - 1) / KVBLK + 1;
    const int qlo = cur.P0 + wid * QBLK, qm = qlo + r32 - 4 * hi;
    char* V_lds = lds; char* K_lds = lds + 2 * SHM_V;
    volatile LAS int* flg = (volatile LAS int*)(lds + OFF_FLAG);
    const int sr = tid >> 4, sc = (tid & 15) * 8, vst0 = v_st(sr, sc), vst1 = v_st(32 + sr, sc), kws = KSWZ(sr, sc * 2);
    const int vb0 = (int)(uintptr_t)V_lds + v_rd_base(lane);
    const bf16* Kh = cur.K; const bf16* Vh = cur.V;
    bf16x8 qr[8];
#pragma unroll
    for (int d0 = 0; d0 < 8; ++d0) qr[d0] = load8(cur.Q + (size_t)(wid * QBLK + r32) * PITCH + d0 * 16 + hi * 8);
    bf16x8 st_v0, st_v1, st_k0, st_k1;
#define SB_LOAD(k0) do { st_v0 = load8(ROW(Vh, k0, sr)); st_v1 = load8(ROW(Vh, k0, 32 + sr)); st_k0 = load8(ROW(Kh, k0, sr)); st_k1 = load8(ROW(Kh, k0, 32 + sr)); } while (0)
#define SB_WRITE(bf) do { *(bf16x8*)(V_lds + (bf) * SHM_V + vst0) = st_v0; *(bf16x8*)(V_lds + (bf) * SHM_V + vst1) = st_v1; \
                          *(bf16x8*)(K_lds + (bf) * SHM_K + kws) = st_k0; *(bf16x8*)(K_lds + (bf) * SHM_K + kws + 32 * 256) = st_k1; } while (0)
    f32x16 o[4] = {}; float R = 0.f; bool fin = false;
    SB_LOAD((NT - 1) * KVBLK); VMW(); SB_WRITE(0);
    if (NT > 1) SB_LOAD((NT - 2) * KVBLK);
    __syncthreads();
#define SB_STEP(t, BUF) do { const int kb_ = (NT - 1 - (t)) * KVBLK;                                                         \
        if (!fin && kb_ <= qlo + QBLK - 2) { sb_tile<BUF>(o, R, K_lds, vb0, r32, hi, qr, qm - kb_); fin = __all(R < -(float)(PRUNE_NATS + 1)); } \
        if ((t) + 1 < NT) { VMW(); SB_WRITE((BUF) ^ 1); if ((t) + 2 < NT) SB_LOAD((NT - 3 - (t)) * KVBLK); }                   \
        if (lane == 0) flg[(BUF) * 8 + wid] = fin ? 1 : 0;                                                                   \
        __syncthreads();                                                                                                      \
        { int all_ = 1; _Pragma("unroll") for (int w_ = 0; w_ < 8; ++w_) all_ &= flg[(BUF) * 8 + w_]; stop = all_ != 0; } } while (0)
    bool stop = false;
    for (int t = 0; t < NT; t += 2) {
        SB_STEP(t, 0);
        if (stop || t + 1 >= NT) break;
        SB_STEP(t + 1, 1);
        if (stop) break;
    }
    bf16* Ow = cur.O + (size_t)(wid * QBLK) * PITCH;
#pragma unroll
    for (int r = 0; r < 16; ++r) { const int orow = crow(r, hi);
#pragma unroll
        for (int d0 = 0; d0 < 4; ++d0) { const float v = o[d0][r];
            const float vn = __shfl_xor(v, 1);
            if ((r32 & 1) == 0) *(unsigned*)(Ow + (size_t)orow * PITCH + d0 * 32 + r32) = cvtpk(v, vn); } }
    __syncthreads();
#undef SB_LOAD
#undef SB_WRITE
#undef SB_STEP
}
#undef ROW
#undef VMW
#undef VMWN
#undef SLOAD_H
#undef SWRITE_HK
#undef SWRITE_HV
#undef SWRITE_H
#undef PK4
#undef KSWZ
}

constexpr int REP_X3 = 0;
constexpr int REP_X2 = 0;
constexpr int X1_PAD = 0;
constexpr bool GRELAX = false;
constexpr int X1_RELAX = 0;
constexpr int X1_STG = 0;
constexpr int X1_DIAG = 0;
constexpr int X1_ALIGN = 0, X1_SP2 = 1, X1_CONSTA = 0;
constexpr int REP_X1 = 0, REP_X1N = 20480;
constexpr int REP_ATT = 1;
constexpr int REP_P0W = 1, REP_P0R = 1;
constexpr int REP_P0 = 1, REP_P1 = 1, REP_FOX = 1, REP_SB = 1, REP_P3A = 1, REP_P5 = 1, REP_P5B = 1, REP_P7A = 1;
constexpr int TIMER_A = -2, TIMER_B = -2;
constexpr int SPLIT_TILES = 24;
constexpr int PARTS_MAIN = (int)((172 * MiB) / ((size_t)att::PART_F * 4)) - 4, PARTS_OVF = (int)((64 * MiB) / ((size_t)att::PART_F * 4));
__device__ __forceinline__ float* parts_base(unsigned char* ws, int slot0) {
    return (slot0 < PARTS_MAIN) ? (float*)(ws + WS_ACT) + (size_t)slot0 * att::PART_F : (float*)(ws + WS_MERGED) + (size_t)(slot0 - PARTS_MAIN) * att::PART_F;
}
constexpr int fox_worst_slots() { int s = 0; for (int qb = 0; qb < 32; ++qb) { const int nt = 4 * qb + 4; int np = (nt + SPLIT_TILES - 1) / SPLIT_TILES; np = np > 4 ? 4 : np; if (np > 1) s += np; } return s * NH; }
static_assert(fox_worst_slots() <= PARTS_MAIN + PARTS_OVF && fox_worst_slots() < 2048, "partial-result slots fit the scratch (and the 11-bit slot field)");
__device__ __forceinline__ void fox_table(const Frame& F, const float Uq) {
    const int WAVE_ = F.wave; const int lane = lane_id(), tid = WAVE_ * 64 + lane;
    LAS float* fbs = (LAS float*)(F.lds + RING_OFF + att::OFF_FBS); volatile LAS unsigned* tot = (volatile LAS unsigned*)(F.lds + RING_OFF + att::OFF_TOT);
    volatile LAS unsigned* tab = (volatile LAS unsigned*)(F.lds + RING_OFF + att::OFF_TAB); volatile LAS unsigned* spl = (volatile LAS unsigned*)(F.lds + RING_OFF + att::OFF_SPL);
    fbs[tid] = ((const float*)(F.ctl + CW_FBLK))[tid];
    __syncthreads();
    const int h = tid & 15, qb = 31 - (tid >> 4);
    const float thr = (float)att::PRUNE_NATS + 2.f * Uq * att::SCALE;
    float dec = 0.f; int nb = 0;
    while (nb < qb && dec > -thr) { dec += fbs[h * 32 + qb - 1 - nb]; ++nb; }
    const int NT0 = 4 * qb + 4; int Tn = 4 + 4 * nb + 1; Tn = Tn < NT0 ? Tn : NT0;
    int np = (Tn + SPLIT_TILES - 1) / SPLIT_TILES; np = np > 4 ? 4 : np;
    const int ps = (Tn + np - 1) / np;
    const unsigned mine = (unsigned)np | ((np > 1 ? (unsigned)np : 0u) << 12) | ((np > 1 ? 1u : 0u) << 23);
    unsigned incl = mine;
#pragma unroll
    for (int o = 1; o < 64; o <<= 1) { const unsigned t = (unsigned)__builtin_amdgcn_ds_bpermute((lane - o) << 2, (int)incl); if (lane >= o) incl += t; }
    if (lane == 63) tot[WAVE_] = incl;
    __syncthreads();
    unsigned base = incl - mine;
    for (int w = 0; w < WAVE_; ++w) base += tot[w];
    const unsigned s0 = (base >> 12) & 2047u, x0 = base >> 23;
    if (np > 1) spl[x0] = (unsigned)tid | ((unsigned)np << 11) | (s0 << 21);
    if (tid == NWAVES * 64 - 1) { tot[8] = (base & 4095u) + np; tot[9] = x0 + (np > 1 ? 1u : 0u); }
    volatile LAS unsigned* key = (volatile LAS unsigned*)(F.lds + RING_OFF + att::OFF_SPL + 2048 + 2048 + 64);
    key[tid] = ((unsigned)ps << 16) | (unsigned)np;
    __syncthreads();
    unsigned rank = 0;
    for (int j = 0; j < NWAVES * 64; ++j) { const unsigned kj = key[j]; const int psj = (int)(kj >> 16); if (psj > ps || (psj == ps && j < tid)) rank += kj & 0xffffu; }
    for (int p = 0; p < np; ++p) tab[rank + p] = (unsigned)tid | ((unsigned)p << 9) | ((unsigned)np << 11) | ((unsigned)ps << 14) | (s0 << 21);
    __syncthreads();
}
enum { PH_P0 = 0, PH_P1, PH_P1B, PH_ATT, PH_P3A, PH_P3B, PH_P4, PH_P5, PH_P5B, PH_P6, PH_P7A, PH_P7, PH_N };
__global__ void __launch_bounds__(NWAVES * 64, 2) mega_fwd(Params P) {
    extern __shared__ __attribute__((aligned(16))) unsigned char lds[];
    Frame F;
    F.lds = (LAS unsigned char*)lds;
    F.MISC = (volatile LAS unsigned*)(F.lds + MISC_OFF);
    F.wave = __builtin_amdgcn_readfirstlane((int)(__builtin_amdgcn_workitem_id_x() >> 6));
    const int WAVE_ = F.wave; const int f_tid = TID();
    F.G = gridDim.x; { const int bx = blockIdx.x; F.vcu = (F.G % 8 == 0) ? (bx % 8) * (F.G / 8) + bx / 8 : bx; }
    unsigned char* ws = P.ws;
    F.ctl = (gu32*)(ws + WS_CTL);
    for (int u = f_tid; u < (LDS_BYTES - LDSCTL_OFF) / 4; u += NWAVES * 64) ((LAS unsigned*)(F.lds + LDSCTL_OFF))[u] = 0u;
    __syncthreads();
    XcdBarrier bar = xcd_barrier_post((unsigned*)(F.ctl + CW_BAR) + P.li * XCD_BAR_WORDS, F.MISC + 8, F.wave);
    const int lo = P.ph_lo, hi = P.ph_hi;
    volatile LAS long long* tmv = (volatile LAS long long*)(F.lds + LDSCTL_OFF + 896);
    if (TIMER_A == -1 && TIMER_B >= 0 && f_tid == 0) tmv[0] = wall_clock64();
#define IN(k) (lo <= (k) && (k) < hi)
#define SEAM(k) do { if (IN(k) && IN((k) + 1)) xcd_barrier(bar); if (TIMER_B >= 0 && blockIdx.x == 0) { if ((k) == TIMER_A && TID() == 0) tmv[0] = wall_clock64(); if ((k) == TIMER_B && TID() == 0) tmv[1] = wall_clock64(); } } while (0)
    bf16* W_in = (bf16*)(ws + WS_WIN); bf16* XB = (bf16*)(ws + WS_XB);
    float* ss1 = (float*)(ws + WS_SS1); float* ss2 = (float*)(F.ctl + CW_SS2); float* ss3 = (float*)(F.ctl + CW_SS3);
    bf16* QKV = (bf16*)(ws + WS_QKV); bf16* GATES = (bf16*)(ws + WS_GATES); bf16* Y = (bf16*)(ws + WS_Y); bf16* MERGED = (bf16*)(ws + WS_MERGED);
    LAS unsigned char* ring = F.lds + RING_OFF;

    if (IN(PH_P0)) { for (int rep = 0; rep < REP_P0; ++rep) { for (int r2 = 0; r2 < REP_P0W; ++r2) p0_weights(F, P); for (int r2 = 0; r2 < REP_P0R; ++r2) p0_rows(F, P); } }
    SEAM(PH_P0);
    if (IN(PH_P1)) { p1b_qknorm_fgate(F, P);
      for (int rep = 0; rep < REP_P1; ++rep) {
        pg8::Gemm g{XB, W_in, S, NPROJ, DM}; ConvOrder So; So.init(S, NPROJ, F.G, (int)blockIdx.x); So.P = &P; So.wave = F.wave; So.slot = 0;
        pg8::EpiProj E{QKV, GATES, ss1, P.in[5], P.in[6], (LAS float*)(F.lds + XCH_OFF)};
        pg8::gemm_phase<pg8::EpiProj, ConvOrder, false, true, 0, 0, GRELAX>(ring, g, So, E, F.wave);
    } }
    if (IN(PH_P1)) { for (int rep = 0; rep < REP_X1; ++rep) {
        pg8::Gemm g{X1_CONSTA ? (bf16*)(ws + WS_ACT) : XB, W_in, S, REP_X1N, DM, DM + X1_PAD, DM + X1_PAD}; pg8::StaticOrder So; So.init(S, REP_X1N, F.G, (int)blockIdx.x);
        pg8::EpiNull E{};
        pg8::gemm_phase<pg8::EpiNull, pg8::StaticOrder, X1_ALIGN != 0, X1_SP2 != 0, X1_DIAG, X1_STG, X1_RELAX != 0>(ring, g, So, E, F.wave);
    } }
    if (IN(PH_P1)) { for (int rep = 0; rep < REP_X2; ++rep) {
        struct SameOrder : pg8::StaticOrder { __device__ bool next(int i, pg8::Unit& u) const { const bool ok = pg8::StaticOrder::next(i, u); u.pm = 0; u.pn = 0; return ok; } };
        pg8::Gemm g{XB, W_in, S, NPROJ, DM}; SameOrder So; So.init(S, NPROJ, F.G, (int)blockIdx.x);
        pg8::EpiNull E{};
        pg8::gemm_phase<pg8::EpiNull, SameOrder, true, true, 0, 0, GRELAX>(ring, g, So, E, F.wave);
    } }
    if (IN(PH_P1)) { for (int rep = 0; rep < REP_X3; ++rep) {
        const long long c0 = clock64();
        pg8::Gemm g{XB, W_in, S, NPROJ, DM}; pg8::StaticOrder So; So.init(S, NPROJ, F.G, (int)blockIdx.x);
        pg8::EpiNull E{};
        pg8::gemm_phase<pg8::EpiNull, pg8::StaticOrder, false, true, 0, 0, GRELAX>(ring, g, So, E, F.wave);
        const long long extra = (clock64() - c0) >> 7; const long long t1 = wall_clock64();
        while (wall_clock64() - t1 < extra) __builtin_amdgcn_s_sleep(10);
    } }
    SEAM(PH_P1);
    if (IN(PH_ATT)) {
        char* al = (char*)lds + RING_OFF;
        const size_t T = (size_t)S * WF;
        gu32* qctr = F.ctl + CW_QATT; volatile LAS int* nx = (volatile LAS int*)(F.lds + RING_OFF + att::OFF_NEXT);
        const int a_lane = lane_id(); const bool puller = (F.wave == 0 && a_lane == 0);
        float gqm = fmaxf(fabsf(P.in[5][a_lane]), fabsf(P.in[5][a_lane + 64])), gkm = fmaxf(fabsf(P.in[6][a_lane]), fabsf(P.in[6][a_lane + 64]));
#pragma unroll
        for (int o = 1; o < 64; o <<= 1) { gqm = fmaxf(gqm, __shfl_xor(gqm, o)); gkm = fmaxf(gkm, __shfl_xor(gkm, o)); }
        const float Uq = __builtin_bit_cast(float, __builtin_amdgcn_readfirstlane(__builtin_bit_cast(int, 128.0f * gqm * gkm * 1.02f)));
        for (int arep = 0; arep < REP_ATT; ++arep) {
        if (arep > 0) { xcd_barrier(bar); if (blockIdx.x == 0 && puller) __hip_atomic_store(qctr, 0u, RLX_AGENT); xcd_barrier(bar); }
        if (puller) nx[0] = (int)__hip_atomic_fetch_add(qctr, 1u, RLX_AGENT);
        if (arep == 0) fox_table(F, Uq);
        __syncthreads();
        const int NI = __builtin_amdgcn_readfirstlane(((volatile LAS int*)(F.lds + RING_OFF + att::OFF_TOT))[8]);
        if (TIMER_B >= 70 && TIMER_B < 80 && TID() == 0) tmv[2] = wall_clock64();
        if (TIMER_B == 60 && blockIdx.x == 0 && TID() == 0) { tmv[0] = 0; tmv[1] = 100ll * NI; }
        if (TIMER_B == 61 && blockIdx.x == 0 && TID() == 0) { tmv[0] = 0; tmv[1] = 100ll * ((volatile LAS int*)(F.lds + RING_OFF + att::OFF_TOT))[9]; }
        int item = nx[0];
        __syncthreads();
        {
            bool primed = false; att::Seam Sm;
#define FOX_REF(R, e_) do { const unsigned e__ = (e_); const int b_ = e__ & 511, h_ = b_ & 15, q_ = 31 - (b_ >> 4), p_ = (e__ >> 9) & 3, np_ = (e__ >> 11) & 7, ps_ = (e__ >> 14) & 127, sl_ = e__ >> 21;   \
                R.Q = QKV + (size_t)(q_ * 256) * WF + h_ * HD; R.K = QKV + T + h_ * HD; R.V = QKV + 2 * T + h_ * HD; R.O = Y + (size_t)(q_ * 256) * WF + h_ * HD; R.P0 = q_ * 256;                          \
                R.top = q_ * 4 + 3 - p_ * ps_; R.nst = (p_ == np_ - 1) ? R.top + 1 : ps_; R.part = (np_ > 1) ? parts_base(ws, sl_) + (size_t)p_ * att::PART_F : nullptr; } while (0)
            volatile LAS unsigned* tab = (volatile LAS unsigned*)(F.lds + RING_OFF + att::OFF_TAB);
            while (item < NI) {
                int pulled = 0;
                if (puller) pulled = (int)__hip_atomic_fetch_add(qctr, 1u, RLX_AGENT);
                const unsigned ent = __builtin_amdgcn_readfirstlane(tab[item]);
                att::cgate_scan((const float*)(ws + WS_LOGF) + (size_t)(ent & 15) * S, al, F.wave);
                if (puller) nx[0] = pulled;
                att::BlockRef cur; FOX_REF(cur, ent);
                if (!primed) att::fox_prime(cur, al, Sm, F.wave); else __syncthreads();
                const int nitem = nx[0];
                att::BlockRef nxt = cur; primed = false;
                if (nitem < NI) { const unsigned e2 = __builtin_amdgcn_readfirstlane(tab[nitem]); FOX_REF(nxt, e2); primed = true; }
                att::fox_block(cur, nxt, Uq, al, Sm, F.wave);
                item = nitem;
            }
#undef FOX_REF
        }
        if (TIMER_B == 50 && blockIdx.x == 0 && TID() == 0) tmv[1] = wall_clock64();
        if ((TIMER_B == 70 || TIMER_B == 71) && TID() == 0) { const unsigned d = (unsigned)(wall_clock64() - tmv[2]); __hip_atomic_fetch_add(F.ctl + 3072, d, RLX_AGENT); __hip_atomic_fetch_max(F.ctl + 3073, d, RLX_AGENT); }
        while (item < NI + NH * 32) {
            int pulled = 0;
            if (puller) pulled = (int)__hip_atomic_fetch_add(qctr, 1u, RLX_AGENT);
            const int L = item - NI, h = L & 15, qb = 31 - (L >> 4);
            att::BlockRef b; b.Q = QKV + 3 * T + (size_t)(qb * 256) * WF + h * HD; b.K = QKV + 4 * T + h * HD; b.V = QKV + 5 * T + h * HD; b.O = Y + T + (size_t)(qb * 256) * WF + h * HD; b.P0 = qb * 256; b.top = 0; b.nst = 0; b.part = nullptr;
            if (puller) nx[0] = pulled;
            att::sb_block(b, al, F.wave);
            item = nx[0];
            __syncthreads();
        }
        if (TIMER_B == 51 && blockIdx.x == 0 && TID() == 0) tmv[1] = wall_clock64();
        if ((TIMER_B == 72 || TIMER_B == 73) && TID() == 0) { const unsigned d = (unsigned)(wall_clock64() - tmv[2]); __hip_atomic_fetch_add(F.ctl + 3072, d, RLX_AGENT); __hip_atomic_fetch_max(F.ctl + 3073, d, RLX_AGENT); }
        }
    }
    SEAM(PH_ATT);
    if (IN(PH_P3A)) {
        const int nsp = __builtin_amdgcn_readfirstlane(((volatile LAS int*)(F.lds + RING_OFF + att::OFF_TOT))[9]);
        volatile LAS unsigned* spl = (volatile LAS unsigned*)(F.lds + RING_OFF + att::OFF_SPL);
        for (int si = F.vcu; si < nsp; si += F.G) {
            const unsigned e = __builtin_amdgcn_readfirstlane(spl[si]); const int b = e & 511, h = b & 15, qb = 31 - (b >> 4), np = (e >> 11) & 7, sl = e >> 21;
            att::fox_combine(parts_base(ws, sl), np, Y + (size_t)(qb * 256) * WF + h * HD, F.wave);
        }
    }
    SEAM(PH_P3A);
    if (IN(PH_P3B)) {
        pg8::Gemm g{Y, (bf16*)(ws + WS_WBF), S, DM, WF}; pg8::TwoPartOrder So; So.init(S, DM, F.G, (int)blockIdx.x); So.A1 = Y + (size_t)S * WF; So.B1 = (bf16*)(ws + WS_WBS);
        pg8::EpiGate2 E{MERGED, GATES, GATES + (size_t)S * DM};
        pg8::gemm_phase<pg8::EpiGate2, pg8::TwoPartOrder, false, true, 0, 0, GRELAX>(ring, g, So, E, F.wave);
    }
    SEAM(PH_P3B);
    if (IN(PH_P4)) {
        pg8::Gemm g{MERGED, (bf16*)(ws + WS_WOUT), S, DM, DM}; pg8::StaticOrder So; So.init(S, DM, F.G, (int)blockIdx.x);
        pg8::EpiResStat<true> E{nullptr, XB, ss2};
        pg8::gemm_phase<pg8::EpiResStat<true>, pg8::StaticOrder, false, true, 0, 0, GRELAX>(ring, g, So, E, F.wave);
    }
    SEAM(PH_P4);
    if (IN(PH_P5)) { for (int rep = 0; rep < REP_P5; ++rep) {
        pg8::Gemm g{XB, (bf16*)(ws + WS_WUP), S, 2 * DFF, DM}; pg8::StaticOrder So; So.init(S, 2 * DFF, F.G, (int)blockIdx.x);
        pg8::EpiConvGlu E{(bf16*)(ws + WS_ACT), (float*)(ws + WS_EDGE), ss2, P.in[12], P.in[13], (LAS float*)(F.lds + XCH_OFF)};
        pg8::gemm_phase<pg8::EpiConvGlu, pg8::StaticOrder, true, true, 0, 0, GRELAX>(ring, g, So, E, F.wave);
      }
      {
        const int nwg5 = (S / 256) * (2 * DFF / 256), n_extra = nwg5 % F.G, Gi = F.G - n_extra, ci = (int)blockIdx.x - n_extra;
        if (ci >= 0) {
            pg8::Gemm g{(bf16*)(ws + WS_PB), (bf16*)(ws + WS_WPP), S, DM, PLE}; pg8::StaticOrder So; So.init(S, DM, Gi, ci);
            pg8::EpiStoreBf16x4 E{(bf16*)(ws + WS_PP)};
            pg8::gemm_phase<pg8::EpiStoreBf16x4, pg8::StaticOrder, false, true, 0, 0, GRELAX>(ring, g, So, E, F.wave);
        }
      }
    }
    SEAM(PH_P5);
    if (IN(PH_P5B)) { for (int rep = 0; rep < REP_P5B; ++rep) p5c_fixup(F, P); }
    SEAM(PH_P5B);
    if (IN(PH_P6)) {
        pg8::Gemm g{(bf16*)(ws + WS_ACT), (bf16*)(ws + WS_WDN), S, DM, DFF}; pg8::StaticOrder So; So.init(S, DM, F.G, (int)blockIdx.x);
        pg8::EpiResStat<true> E{nullptr, XB, ss3};
        pg8::gemm_phase<pg8::EpiResStat<true>, pg8::StaticOrder, false, true, 0, 0, GRELAX>(ring, g, So, E, F.wave);
    }
    SEAM(PH_P6);
    if (IN(PH_P7)) {
        pg8::Gemm g{XB, (bf16*)(ws + WS_WPG), S, DM, DM}; pg8::StaticOrder So; So.init(S, DM, F.G, (int)blockIdx.x);
        pg8::EpiPle E{P.out, XB, (const bf16*)(ws + WS_PP), ss3};
        pg8::gemm_phase<pg8::EpiPle, pg8::StaticOrder, false, true, 0, 0, GRELAX>(ring, g, So, E, F.wave);
    }
    if (TIMER_B >= 0 && blockIdx.x == 0) {
        if (TIMER_B >= 70 && TIMER_B < 80 && TID() == 0) { tmv[0] = 0; tmv[1] = (TIMER_B & 1) ? (long long)__hip_atomic_load(F.ctl + 3073, RLX_AGENT) : (long long)(__hip_atomic_load(F.ctl + 3072, RLX_AGENT) / 256u); }
        __syncthreads();
        const long long t0 = wall_clock64(), w = ((TIMER_B == 99) ? t0 : tmv[1]) - tmv[0]; while (wall_clock64() - t0 < w) __builtin_amdgcn_s_sleep(20); }
#undef IN
#undef SEAM
}

extern "C" void kernel_launch(void* const* d_in, const int* in_sizes, int n_in, void* d_out, int out_size, void* d_ws, size_t ws_size, hipStream_t stream) {
    static int grid = 0;
    if (grid == 0) {
        if (n_in != 18 || out_size != S * DM || ws_size < WS_END) { fprintf(stderr, "kernel_launch: unexpected shapes / workspace (%d inputs, out %d, ws %zu < %zu)\n", n_in, out_size, ws_size, (size_t)WS_END); grid = -1; return; }
        int dev = 0, cus = 0, per_cu = 0;
        if (hipGetDevice(&dev) != hipSuccess || hipDeviceGetAttribute(&cus, hipDeviceAttributeMultiprocessorCount, dev) != hipSuccess) { grid = -1; return; }
        if (hipFuncSetAttribute((const void*)mega_fwd, hipFuncAttributeMaxDynamicSharedMemorySize, LDS_BYTES) != hipSuccess) { fprintf(stderr, "kernel_launch: hipFuncSetAttribute failed\n"); grid = -1; return; }
        if (hipOccupancyMaxActiveBlocksPerMultiprocessor(&per_cu, (const void*)mega_fwd, NWAVES * 64, LDS_BYTES) != hipSuccess || per_cu < 1)
            fprintf(stderr, "kernel_launch: note: occupancy query reports %d workgroups per CU\n", per_cu);
        (void)hipGetLastError();
        grid = cus;
    }
    if (grid < 0) return;
    if (hipMemsetAsync((char*)d_ws + WS_CTL, 0, CTL_ZERO_BYTES, stream) != hipSuccess) return;
    Params a{};
    for (int i = 0; i < 18; ++i) a.in[i] = (const float*)d_in[i];
    a.out = (float*)d_out; a.ws = (unsigned char*)d_ws;
    a.ph_lo = PH_P0; a.ph_hi = PH_N; a.li = 0;
    hipLaunchKernelGGL(mega_fwd, dim3(grid), dim3(NWAVES * 64), LDS_BYTES, stream, a);
}
```

```cpp
#include <hip/hip_runtime.h>
#include <cstdio>
#include <cstdint>
__device__ __forceinline__ int lane_id() { int l; asm volatile("v_mbcnt_lo_u32_b32 %0, -1, 0\n\tv_mbcnt_hi_u32_b32 %0, -1, %0" : "=v"(l)); return l; }
#define TID() (WAVE_ * 64 + lane_id())
namespace pg8 {
constexpr int PG8_AUXA = 0, PG8_AUXB = 0;
#define PG8_LAS __attribute__((address_space(3)))
typedef unsigned short bf16_t;
typedef short bf16x8 __attribute__((ext_vector_type(8)));
typedef float f32x4 __attribute__((ext_vector_type(4)));
typedef unsigned u32x4 __attribute__((ext_vector_type(4)));
constexpr int BM = 256, BK = 64, HALF = 128, HTB = HALF * BK * 2  , STAGE_BYTES = 8 * HTB, NXCD = 8, WGM = 8;

__host__ __device__ __forceinline__ int lds_byte(int r, int c) { const int st = (r >> 4) * 2 + (c >> 5), rr = r & 15, cc = c & 31, ob = rr * 64 + cc * 2; return st * 1024 + (ob ^ (((ob >> 9) & 1) << 5)); }
__host__ __device__ __forceinline__ void stage_rc(int b, int& R, int& C) { const int st = b / 1024, sb = b % 1024, swz = sb ^ (((sb >> 9) & 1) << 5); R = (st >> 1) * 16 + swz / 64; C = (st & 1) * 32 + (swz % 64) / 2; }
__host__ __device__ __forceinline__ int perm32(int rho) { const int n = rho >> 4, i = rho & 15; return 8 * (i >> 2) + 4 * n + (i & 3); }

struct Unit { int pm, pn, part; };
struct Gemm { const bf16_t* A; const bf16_t* Bt; int M, N, K, lda, ldb; };

struct StaticOrder {
    int nM, nN, nwg, G, c;
    __host__ __device__ void init(int M, int N, int G_, int c_) { nM = M / BM; nN = N / BM; nwg = nM * nN; G = G_; c = c_; }
    __host__ __device__ bool next(int i, Unit& u) const {
        const long L = (long)i * G + c; if (L >= nwg) return false;
        int wgid = (int)L; { const int q = nwg / NXCD, r = nwg % NXCD, xcd = wgid % NXCD, off = wgid / NXCD; wgid = (xcd < r ? xcd * (q + 1) : r * (q + 1) + (xcd - r) * q) + off; }
        const int nig = WGM * nN, gid = wgid / nig, fm = gid * WGM, gsz = (nM - fm) < WGM ? (nM - fm) : WGM;
        u.pm = fm + ((wgid % nig) % gsz); u.pn = (wgid % nig) / gsz; return true;
    }
    __device__ __forceinline__ void a_ready(const Unit&) const {}
    __device__ __forceinline__ void done(const Unit&) const {}
    __device__ __forceinline__ const bf16_t* baseA(const Gemm& g, const Unit&) const { return g.A; }
    __device__ __forceinline__ const bf16_t* baseB(const Gemm& g, const Unit&) const { return g.Bt; }
    __device__ __forceinline__ bool zero_after(const Unit&) const { return true; }
};

__device__ __forceinline__ unsigned cvt_pk_bf16(float lo, float hi) { unsigned r; asm volatile("v_cvt_pk_bf16_f32 %0, %1, %2" : "=v"(r) : "v"(lo), "v"(hi)); return r; }
typedef float f32x2 __attribute__((ext_vector_type(2)));
constexpr int SEQ_ = 8192, DM_ = 4096;
constexpr float EPS_ = 1e-6f;
__device__ __forceinline__ float sigm(float v) { return __builtin_amdgcn_rcpf(1.0f + __builtin_amdgcn_exp2f(-1.4426950408889634f * v)); }
__device__ __forceinline__ float rs_of(float ss) { return __builtin_amdgcn_rsqf(ss * (1.0f / DM_) + EPS_); }
typedef unsigned u32x2 __attribute__((ext_vector_type(2)));
__device__ __forceinline__ f32x4 bf4_to_f32(u32x2 w) { return (f32x4){__uint_as_float(w.x << 16), __uint_as_float(w.x & 0xffff0000u), __uint_as_float(w.y << 16), __uint_as_float(w.y & 0xffff0000u)}; }

#define EPI_ROWS(k) (row0 + ((k) >> 2) * HALF + ((k) & 3) * 16)
#define EPI_ACC(k, bj, n) acc[(k) >> 2][bj][(k) & 3][n]
__device__ __forceinline__ u32x4 pack8(const f32x4 v0, const f32x4 v1) { u32x4 w; w.x = cvt_pk_bf16(v0[0], v0[1]); w.y = cvt_pk_bf16(v0[2], v0[3]); w.z = cvt_pk_bf16(v1[0], v1[1]); w.w = cvt_pk_bf16(v1[2], v1[3]); return w; }

struct EpiProj {
    static constexpr bool PERM = true, AFTER_DRAIN = false;
    bf16_t* qkv; bf16_t* gates; const float* ss; const float* gq; const float* gk; PG8_LAS float* hx;
    __device__ __forceinline__ void operator()(f32x4 (&acc)[2][2][4][2], const Unit& u, int wr, int wc, int fr, int fq) const {
        const int row0 = u.pm * BM + wr * 64 + fr;
        bf16_t* base; int ldc, colt; const bool gate = u.pn >= 48, qknorm = u.pn < 16;
        if (!gate) { base = qkv + (size_t)(u.pn >> 3) * ((size_t)SEQ_ * 2048); ldc = 2048; colt = (u.pn & 7) * 256; }
        else { const int t = u.pn - 48; base = gates + (size_t)(t >> 4) * ((size_t)SEQ_ * 4096); ldc = 4096; colt = (t & 15) * 256; }
        const int col0 = colt + wc * 32 + 8 * fq;
        float rs[8];
#pragma unroll
        for (int k = 0; k < 8; ++k) rs[k] = ss[EPI_ROWS(k)];
        if (qknorm) {
            const float* g = (u.pn < 8 ? gq : gk) + wc * 32 + 8 * fq; const f32x4 g0 = *(const f32x4*)g, g1 = *(const f32x4*)(g + 4);
#pragma unroll
            for (int k = 0; k < 8; ++k) { const float r = rs_of(rs[k]); const int rl = wr * 64 + (k >> 2) * HALF + (k & 3) * 16 + fr;
#pragma unroll
                for (int bj = 0; bj < 2; ++bj) { f32x4 v0 = EPI_ACC(k, bj, 0) * r, v1 = EPI_ACC(k, bj, 1) * r; EPI_ACC(k, bj, 0) = v0; EPI_ACC(k, bj, 1) = v1;
                    float s = (v0[0] * v0[0] + v0[1] * v0[1]) + (v0[2] * v0[2] + v0[3] * v0[3]) + (v1[0] * v1[0] + v1[1] * v1[1]) + (v1[2] * v1[2] + v1[3] * v1[3]);
                    s += __shfl_xor(s, 16); s += __shfl_xor(s, 32);
                    if (fq == 0) hx[(rl * 2 + bj) * 4 + wc] = s; } }
            asm volatile("s_waitcnt lgkmcnt(0)" ::: "memory"); __builtin_amdgcn_s_barrier(); asm volatile("" ::: "memory");
#pragma unroll
            for (int k = 0; k < 8; ++k) { const int rl = wr * 64 + (k >> 2) * HALF + (k & 3) * 16 + fr; bf16_t* rowp = base + (size_t)EPI_ROWS(k) * ldc + col0;
#pragma unroll
                for (int bj = 0; bj < 2; ++bj) { const f32x4 p = *(const PG8_LAS f32x4*)(hx + (rl * 2 + bj) * 4);
                    const float r2 = __builtin_amdgcn_rsqf(((p[0] + p[1]) + (p[2] + p[3])) * (1.0f / 128.0f) + EPS_);
                    *(u32x4*)(rowp + bj * HALF) = pack8(EPI_ACC(k, bj, 0) * g0 * r2, EPI_ACC(k, bj, 1) * g1 * r2); } }
        } else {
#pragma unroll
            for (int k = 0; k < 8; ++k) { const float r = rs_of(rs[k]); bf16_t* rowp = base + (size_t)EPI_ROWS(k) * ldc + col0;
#pragma unroll
                for (int bj = 0; bj < 2; ++bj) { f32x4 v0 = EPI_ACC(k, bj, 0) * r, v1 = EPI_ACC(k, bj, 1) * r;
                    if (gate) {
#pragma unroll
                        for (int j = 0; j < 4; ++j) { v0[j] = sigm(v0[j]); v1[j] = sigm(v1[j]); } }
                    *(u32x4*)(rowp + bj * HALF) = pack8(v0, v1); } }
        }
    }
};
template <bool BASE_BF16> struct EpiResStat {
    static constexpr bool PERM = true, AFTER_DRAIN = false;
    const float* basef; bf16_t* xb; float* ss;
    __device__ __forceinline__ void operator()(const f32x4 (&acc)[2][2][4][2], const Unit& u, int wr, int wc, int fr, int fq) const {
        const int row0 = u.pm * BM + wr * 64 + fr, col0 = u.pn * BM + wc * 32 + 8 * fq;
        f32x4 b[2][2][2];
#define LD_(k) do { const size_t off_ = (size_t)EPI_ROWS(k) * DM_ + col0; _Pragma("unroll") for (int bj_ = 0; bj_ < 2; ++bj_) { \
            if constexpr (BASE_BF16) { const u32x4 w_ = *(const u32x4*)(xb + off_ + bj_ * HALF); b[(k) & 1][bj_][0] = bf4_to_f32((u32x2){w_.x, w_.y}); b[(k) & 1][bj_][1] = bf4_to_f32((u32x2){w_.z, w_.w}); } \
            else { b[(k) & 1][bj_][0] = *(const f32x4*)(basef + off_ + bj_ * HALF); b[(k) & 1][bj_][1] = *(const f32x4*)(basef + off_ + bj_ * HALF + 4); } } } while (0)
        LD_(0);
#pragma unroll
        for (int k = 0; k < 8; ++k) {
            if (k + 1 < 8) LD_(k + 1);
            const int r = EPI_ROWS(k); const size_t off = (size_t)r * DM_ + col0; float s = 0.f;
#pragma unroll
            for (int bj = 0; bj < 2; ++bj) { const f32x4 o0 = b[k & 1][bj][0] + EPI_ACC(k, bj, 0), o1 = b[k & 1][bj][1] + EPI_ACC(k, bj, 1);
                s += ((o0[0] * o0[0] + o0[1] * o0[1]) + (o0[2] * o0[2] + o0[3] * o0[3])) + ((o1[0] * o1[0] + o1[1] * o1[1]) + (o1[2] * o1[2] + o1[3] * o1[3]));
                *(u32x4*)(xb + off + bj * HALF) = pack8(o0, o1); }
            s += __shfl_xor(s, 16); s += __shfl_xor(s, 32);
            if (fq == 0) __hip_atomic_fetch_add(ss + r, s, __ATOMIC_RELAXED, __HIP_MEMORY_SCOPE_AGENT);
            asm volatile("" ::: "memory");
        }
#undef LD_
    }
};
struct EpiUp {
    static constexpr bool PERM = true, AFTER_DRAIN = false;
    bf16_t* O; int ldc; const float* ss;
    __device__ __forceinline__ void operator()(const f32x4 (&acc)[2][2][4][2], const Unit& u, int wr, int wc, int fr, int fq) const {
        const int row0 = u.pm * BM + wr * 64 + fr, col0 = u.pn * BM + wc * 32 + 8 * fq;
        float rs[8];
#pragma unroll
        for (int k = 0; k < 8; ++k) rs[k] = ss[EPI_ROWS(k)];
#pragma unroll
        for (int k = 0; k < 8; ++k) { const float r = rs_of(rs[k]); bf16_t* rowp = O + (size_t)EPI_ROWS(k) * ldc + col0;
#pragma unroll
            for (int bj = 0; bj < 2; ++bj) *(u32x4*)(rowp + bj * HALF) = pack8(EPI_ACC(k, bj, 0) * r, EPI_ACC(k, bj, 1) * r); }
    }
};
template <int CTRL> __device__ __forceinline__ float dpp_upd(float old, float src) { return __builtin_bit_cast(float, __builtin_amdgcn_update_dpp(__builtin_bit_cast(int, old), __builtin_bit_cast(int, src), CTRL, 0xf, 0xf, false)); }
struct EpiConvGlu {
    static constexpr bool PERM = false, AFTER_DRAIN = false;
    static constexpr int J = 11008, ROR1 = 0x121, ROR2 = 0x122, SHR1 = 0x111, SHR2 = 0x112;
    bf16_t* act; float* edge; const float* ss; const float* cw; const float* cb; PG8_LAS float* xch;
    __device__ __forceinline__ void operator()(f32x4 (&acc)[2][2][4][2], const Unit& u, int wr, int wc, int, int) const {
        const int l_ = lane_id(), fr = l_ & 15, fq = l_ >> 4;
        const int row0 = u.pm * BM + wr * 64 + fr, colt = wc * 32 + 4 * fq, j0 = u.pn * 128 + colt;
        {   float rs[8];
#pragma unroll
            for (int k = 0; k < 8; ++k) rs[k] = ss[EPI_ROWS(k)];
#pragma unroll
            for (int k = 0; k < 8; ++k) { const float r = rs_of(rs[k]);
#pragma unroll
                for (int bj = 0; bj < 2; ++bj)
#pragma unroll
                    for (int n = 0; n < 2; ++n) EPI_ACC(k, bj, n) = EPI_ACC(k, bj, n) * r; } }
#pragma unroll
        for (int ai = 0; ai < 2; ++ai) { const int b = 2 * ai + wr;
            if (fr >= 14) {
#pragma unroll
                for (int bj = 0; bj < 2; ++bj)
#pragma unroll
                    for (int n = 0; n < 2; ++n) *(PG8_LAS f32x4*)(xch + (b * 2 + (fr - 14)) * 256 + 128 * bj + colt + 16 * n) = acc[ai][bj][3][n];
                if (b == 3) {
#pragma unroll
                    for (int bj = 0; bj < 2; ++bj)
#pragma unroll
                        for (int n = 0; n < 2; ++n) *(f32x4*)(edge + ((size_t)u.pm * 4 + 2 + (fr - 14)) * (2 * J) + bj * J + j0 + 16 * n) = acc[ai][bj][3][n]; }
            }
            if (b == 0 && fr < 2) {
#pragma unroll
                for (int bj = 0; bj < 2; ++bj)
#pragma unroll
                    for (int n = 0; n < 2; ++n) *(f32x4*)(edge + ((size_t)u.pm * 4 + fr) * (2 * J) + bj * J + j0 + 16 * n) = acc[ai][bj][0][n]; }
        }
        asm volatile("s_waitcnt lgkmcnt(0)" ::: "memory"); __builtin_amdgcn_s_barrier(); asm volatile("" ::: "memory");
#pragma unroll
        for (int n = 0; n < 2; ++n) {
            f32x4 wgt[2][3], bia[2];
#pragma unroll
            for (int bj = 0; bj < 2; ++bj) { bia[bj] = *(const f32x4*)(cb + bj * J + j0 + 16 * n);
#pragma unroll
                for (int t = 0; t < 3; ++t) wgt[bj][t] = *(const f32x4*)(cw + (size_t)t * 2 * J + bj * J + j0 + 16 * n); }
#pragma unroll
            for (int k = 0; k < 8; ++k) { const int ai = k >> 2, m = k & 3, b = 2 * ai + wr;
                f32x4 x63[2], x62[2];
                if (m == 0) {
#pragma unroll
                    for (int bj = 0; bj < 2; ++bj) { const int pb = (b + 3) & 3; x63[bj] = *(const PG8_LAS f32x4*)(xch + (pb * 2 + 1) * 256 + 128 * bj + colt + 16 * n); x62[bj] = *(const PG8_LAS f32x4*)(xch + (pb * 2 + 0) * 256 + 128 * bj + colt + 16 * n); } }
                f32x4 res;
#pragma unroll
                for (int e = 0; e < 4; ++e) { float uu[2];
#pragma unroll
                    for (int bj = 0; bj < 2; ++bj) { const float c = acc[ai][bj][m][n][e]; float o1, o2;
                        if (m == 0) { o1 = x63[bj][e]; o2 = (fr == 0) ? x62[bj][e] : x63[bj][e]; }
                        else { const float pv = acc[ai][bj][m - 1][n][e]; o1 = dpp_upd<ROR1>(pv, pv); o2 = dpp_upd<ROR2>(pv, pv); }
                        const float p1 = dpp_upd<SHR1>(o1, c), p2 = dpp_upd<SHR2>(o2, c);
                        uu[bj] = bia[bj][e] + wgt[bj][0][e] * p2 + wgt[bj][1][e] * p1 + wgt[bj][2][e] * c; }
                    res[e] = uu[0] * sigm(uu[0]) * uu[1]; }
                if (!(b == 0 && m == 0 && fr < 2)) { u32x2 w; w.x = cvt_pk_bf16(res[0], res[1]); w.y = cvt_pk_bf16(res[2], res[3]); *(u32x2*)(act + (size_t)EPI_ROWS(k) * J + j0 + 16 * n) = w; }
            }
        }
    }
};
struct EpiPle {
    static constexpr bool PERM = true, AFTER_DRAIN = false;
    float* out; const bf16_t* xb; const bf16_t* pp; const float* ss;
    __device__ __forceinline__ void operator()(const f32x4 (&acc)[2][2][4][2], const Unit& u, int wr, int wc, int fr, int fq) const {
        const int row0 = u.pm * BM + wr * 64 + fr, col0 = u.pn * BM + wc * 32 + 8 * fq;
        float rs[8];
#pragma unroll
        for (int k = 0; k < 8; ++k) rs[k] = ss[EPI_ROWS(k)];
        u32x4 b2[2][2], q2[2][2];
#define LD_(k) do { const size_t off_ = (size_t)EPI_ROWS(k) * DM_ + col0; _Pragma("unroll") for (int bj_ = 0; bj_ < 2; ++bj_) { b2[(k) & 1][bj_] = *(const u32x4*)(xb + off_ + bj_ * HALF); q2[(k) & 1][bj_] = *(const u32x4*)(pp + off_ + bj_ * HALF); } } while (0)
        LD_(0);
#pragma unroll
        for (int k = 0; k < 8; ++k) {
            if (k + 1 < 8) LD_(k + 1);
            const size_t off = (size_t)EPI_ROWS(k) * DM_ + col0; const float r = rs_of(rs[k]);
#pragma unroll
            for (int bj = 0; bj < 2; ++bj) { const u32x4 bw = b2[k & 1][bj], qw = q2[k & 1][bj];
#pragma unroll
                for (int n = 0; n < 2; ++n) { const f32x4 a = EPI_ACC(k, bj, n) * r, pv = bf4_to_f32(n ? (u32x2){qw.z, qw.w} : (u32x2){qw.x, qw.y}), bb = bf4_to_f32(n ? (u32x2){bw.z, bw.w} : (u32x2){bw.x, bw.y});
                    f32x4 o; o[0] = bb[0] + sigm(a[0]) * pv[0]; o[1] = bb[1] + sigm(a[1]) * pv[1]; o[2] = bb[2] + sigm(a[2]) * pv[2]; o[3] = bb[3] + sigm(a[3]) * pv[3];
                    *(f32x4*)(out + off + bj * HALF + 4 * n) = o; } }
            asm volatile("" ::: "memory");
        }
#undef LD_
    }
};
struct EpiGate2 {
    static constexpr bool PERM = true, AFTER_DRAIN = false;
    bf16_t* merged; const bf16_t* sga; const bf16_t* sgb;
    __device__ __forceinline__ void operator()(f32x4 (&acc)[2][2][4][2], const Unit& u, int wr, int wc, int fr, int fq) const {
        const int row0 = u.pm * BM + wr * 64 + fr, col0 = u.pn * BM + wc * 32 + 8 * fq;
        if (u.part == 0) {
            u32x4 ga[2][2], gb[2][2];
#define LD_(k) do { const size_t off_ = (size_t)EPI_ROWS(k) * DM_ + col0; ga[(k) & 1][0] = *(const u32x4*)(sga + off_); ga[(k) & 1][1] = *(const u32x4*)(sga + off_ + HALF); gb[(k) & 1][0] = *(const u32x4*)(sgb + off_); gb[(k) & 1][1] = *(const u32x4*)(sgb + off_ + HALF); } while (0)
            LD_(0);
#pragma unroll
            for (int k = 0; k < 8; ++k) {
                if (k + 1 < 8) LD_(k + 1);
#pragma unroll
                for (int bj = 0; bj < 2; ++bj) { const u32x4 aw = ga[k & 1][bj], bw = gb[k & 1][bj];
                    const f32x4 ga0 = bf4_to_f32((u32x2){aw.x, aw.y}), ga1 = bf4_to_f32((u32x2){aw.z, aw.w}), gb0 = bf4_to_f32((u32x2){bw.x, bw.y}), gb1 = bf4_to_f32((u32x2){bw.z, bw.w});
#pragma unroll
                    for (int j = 0; j < 4; ++j) { EPI_ACC(k, bj, 0)[j] *= ga0[j] * __builtin_amdgcn_rcpf(fmaxf(gb0[j], 1e-20f)); EPI_ACC(k, bj, 1)[j] *= ga1[j] * __builtin_amdgcn_rcpf(fmaxf(gb1[j], 1e-20f)); } }
                asm volatile("" ::: "memory");
            }
#undef LD_
        } else {
            u32x4 gb[2][2];
#define LD_(k) do { const size_t off_ = (size_t)EPI_ROWS(k) * DM_ + col0; gb[(k) & 1][0] = *(const u32x4*)(sgb + off_); gb[(k) & 1][1] = *(const u32x4*)(sgb + off_ + HALF); } while (0)
            LD_(0);
#pragma unroll
            for (int k = 0; k < 8; ++k) {
                if (k + 1 < 8) LD_(k + 1);
                const size_t off = (size_t)EPI_ROWS(k) * DM_ + col0;
#pragma unroll
                for (int bj = 0; bj < 2; ++bj) { const u32x4 bw = gb[k & 1][bj]; const f32x4 gb0 = bf4_to_f32((u32x2){bw.x, bw.y}), gb1 = bf4_to_f32((u32x2){bw.z, bw.w});
                    f32x4 v0, v1;
#pragma unroll
                    for (int j = 0; j < 4; ++j) { v0[j] = EPI_ACC(k, bj, 0)[j] * fmaxf(gb0[j], 1e-20f); v1[j] = EPI_ACC(k, bj, 1)[j] * fmaxf(gb1[j], 1e-20f); }
                    *(u32x4*)(merged + off + bj * HALF) = pack8(v0, v1); }
                asm volatile("" ::: "memory");
            }
#undef LD_
        }
    }
};
struct TwoPartOrder : StaticOrder {
    const bf16_t* A1; const bf16_t* B1;
    __device__ bool next(int i, Unit& u) const { const bool ok = StaticOrder::next(i >> 1, u); u.part = i & 1; return ok; }
    __device__ __forceinline__ const bf16_t* baseA(const Gemm& g, const Unit& u) const { return u.part ? A1 : g.A; }
    __device__ __forceinline__ const bf16_t* baseB(const Gemm& g, const Unit& u) const { return u.part ? B1 : g.Bt; }
    __device__ __forceinline__ bool zero_after(const Unit& u) const { return u.part != 0; }
};
struct EpiStoreBf16x4 {
    static constexpr bool PERM = false, AFTER_DRAIN = false;
    bf16_t* C;
    __device__ __forceinline__ void operator()(const f32x4 (&acc)[2][2][4][2], const Unit& u, int wr, int wc, int fr, int fq) const {
        const int row0 = u.pm * BM + wr * 64 + fr, col0 = u.pn * BM + wc * 32 + 4 * fq;
#pragma unroll
        for (int ai = 0; ai < 2; ++ai)
#pragma unroll
            for (int m = 0; m < 4; ++m) { bf16_t* rowp = C + (size_t)(row0 + ai * HALF + m * 16) * DM_ + col0;
#pragma unroll
                for (int bj = 0; bj < 2; ++bj)
#pragma unroll
                    for (int n = 0; n < 2; ++n) { const f32x4 v = acc[ai][bj][m][n]; u32x2 w; w.x = cvt_pk_bf16(v[0], v[1]); w.y = cvt_pk_bf16(v[2], v[3]); *(u32x2*)(rowp + bj * HALF + n * 16) = w; } }
    }
};
struct EpiNull {
    static constexpr bool PERM = true, AFTER_DRAIN = false;
    __device__ __forceinline__ void operator()(const f32x4 (&acc)[2][2][4][2], const Unit& u, int wr, int wc, int fr, int fq) const {
#pragma unroll
        for (int ai = 0; ai < 2; ++ai)
#pragma unroll
            for (int bj = 0; bj < 2; ++bj)
#pragma unroll
                for (int m = 0; m < 4; ++m)
#pragma unroll
                    for (int n = 0; n < 2; ++n) asm volatile("" :: "v"(acc[ai][bj][m][n]));
    }
};
#undef EPI_ROWS
#undef EPI_ACC
template <class Epi, class Sched, bool ALIGN_EPI = false, bool SP2 = false, int DIAGMODE = 0, int STG = 0, bool RELAX1ST = false>
__device__ __forceinline__ void gemm_phase(PG8_LAS unsigned char* lds, const Gemm g, const Sched& S, const Epi& E, const int WAVE_) {
    const int tid = TID(), wid = __builtin_amdgcn_readfirstlane(tid >> 6), lane = tid & 63, wr = wid >> 2, wc = wid & 3, fr = lane & 15, fq = lane >> 4;
    const int K = g.K, nt = K / BK, lda = g.lda ? g.lda : K, ldb = g.ldb ? g.ldb : K;
    unsigned voffA[2], voffB[2];
#pragma unroll
    for (int i = 0; i < 2; ++i) { int R, C; stage_rc(tid * 16 + i * 8192, R, C); const int Rb = Epi::PERM ? ((R & ~31) + perm32(R & 31)) : R;
        voffA[i] = (unsigned)(R * lda + C) * 2u; voffB[i] = (unsigned)(Rb * ldb + C) * 2u; }
    const size_t kstep = (size_t)(BK * 2);
    const size_t hstepA = (size_t)HALF * lda * 2, hstepB = (size_t)HALF * ldb * 2;
    const size_t tstepA = 2 * hstepA, tstepB = 2 * hstepB;
    const unsigned ldsw = (unsigned)wid * 1024u;
    const int aoff = lds_byte(wr * 64 + fr, fq * 8), boff = lds_byte(wc * 32 + fr, fq * 8);
#define PG8_SA(b, h) (((b) * 2 + (h)) * HTB)
#define PG8_SB(b, h) ((4 + (b) * 2 + (h)) * HTB)
#define PG8_STAGE(bufoff, gbase, voff) do { if (DIAGMODE != 2 && DIAGMODE != 4 && DIAGMODE != 5) _Pragma("unroll") for (int _i = 0; _i < 2; ++_i) \
        { if ((bufoff) >= 4 * HTB) __builtin_amdgcn_global_load_lds((const unsigned*)((const char*)(gbase) + (voff)[_i]), (PG8_LAS unsigned*)(lds + (bufoff) + ldsw + _i * 8192), 16, 0, PG8_AUXB); else __builtin_amdgcn_global_load_lds((const unsigned*)((const char*)(gbase) + (voff)[_i]), (PG8_LAS unsigned*)(lds + (bufoff) + ldsw + _i * 8192), 16, 0, PG8_AUXA); } } while (0)
#define PG8_LDA(dst, b, h) do { if ((DIAGMODE != 1 && DIAGMODE != 4 && DIAGMODE != 5) || t == 0) _Pragma("unroll") for (int m = 0; m < 4; ++m) _Pragma("unroll") for (int k = 0; k < 2; ++k) dst[m][k] = *(const PG8_LAS bf16x8*)(lds + PG8_SA(b, h) + aoff + m * 2048 + k * 1024); } while (0)
#define PG8_LDB(dst, b, h) do { if ((DIAGMODE != 1 && DIAGMODE != 4 && DIAGMODE != 5) || t == 0) _Pragma("unroll") for (int n = 0; n < 2; ++n) _Pragma("unroll") for (int k = 0; k < 2; ++k) dst[n][k] = *(const PG8_LAS bf16x8*)(lds + PG8_SB(b, h) + boff + n * 2048 + k * 1024); } while (0)
#define PG8_MMA(ai, bj, At, Bt) do { __builtin_amdgcn_s_setprio(1); if (DIAGMODE != 3 && DIAGMODE != 4) _Pragma("unroll") for (int m = 0; m < 4; ++m) _Pragma("unroll") for (int n = 0; n < 2; ++n) _Pragma("unroll") for (int k = 0; k < 2; ++k) \
        acc[ai][bj][m][n] = __builtin_amdgcn_mfma_f32_16x16x32_bf16(Bt[n][k], At[m][k], acc[ai][bj][m][n], 0, 0, 0); __builtin_amdgcn_s_setprio(0); } while (0)
#define PG8_WAIT_V(n) asm volatile("s_waitcnt vmcnt(" #n ")" ::: "memory")
#define PG8_WAIT_L(n) asm volatile("s_waitcnt lgkmcnt(" #n ")" ::: "memory")
#define PG8_BAR __builtin_amdgcn_s_barrier()
#define PG8_SCHED __builtin_amdgcn_sched_barrier(0)
    Unit cur, nxt; int ui = 0;
    if (!S.next(0, cur)) return;
    f32x4 acc[2][2][4][2];
#pragma unroll
    for (int a = 0; a < 2; ++a)
#pragma unroll
        for (int b = 0; b < 2; ++b)
#pragma unroll
            for (int m = 0; m < 4; ++m)
#pragma unroll
                for (int n = 0; n < 2; ++n) acc[a][b][m][n] = (f32x4){0.f, 0.f, 0.f, 0.f};
    bf16x8 At[4][2], B0[2][2], B1[2][2];
    const char* cA = (const char*)S.baseA(g, cur) + (size_t)cur.pm * tstepA; const char* cB = (const char*)S.baseB(g, cur) + (size_t)cur.pn * tstepB;
    S.a_ready(cur);
    if constexpr (SP2) {
        PG8_STAGE(PG8_SB(0, 0), cB, voffB); PG8_STAGE(PG8_SB(0, 1), cB + hstepB, voffB); PG8_STAGE(PG8_SA(0, 0), cA, voffA); PG8_STAGE(PG8_SA(0, 1), cA + hstepA, voffA);
        if (wr == 1) PG8_BAR;
        PG8_WAIT_V(2); PG8_BAR;
        PG8_STAGE(PG8_SB(1, 0), cB + kstep, voffB); PG8_STAGE(PG8_SA(1, 0), cA + kstep, voffA); PG8_STAGE(PG8_SB(1, 1), cB + hstepB + kstep, voffB);
        PG8_WAIT_V(6); PG8_BAR;
    } else {
        PG8_STAGE(PG8_SB(0, 0), cB, voffB); PG8_STAGE(PG8_SA(0, 0), cA, voffA); PG8_STAGE(PG8_SB(0, 1), cB + hstepB, voffB); PG8_STAGE(PG8_SA(0, 1), cA + hstepA, voffA);
        if (wr == 1) PG8_BAR;
        PG8_WAIT_V(4); PG8_BAR;
        PG8_STAGE(PG8_SB(1, 0), cB + kstep, voffB); PG8_STAGE(PG8_SA(1, 0), cA + kstep, voffA); PG8_STAGE(PG8_SB(1, 1), cB + hstepB + kstep, voffB);
        PG8_WAIT_V(6); PG8_BAR;
    }
    for (;;) {
        const bool has_next = S.next(ui + 1, nxt);
        const char* nA = has_next ? (const char*)S.baseA(g, nxt) + (size_t)nxt.pm * tstepA : cA; const char* nB = has_next ? (const char*)S.baseB(g, nxt) + (size_t)nxt.pn * tstepB : cB;
        for (int t = 0; t < nt; t += 2) {
            const bool last = (t == nt - 2);
            const char* a1 = cA + (size_t)(t + 1) * kstep;
            const char* a2 = last ? nA : cA + (size_t)(t + 2) * kstep; const char* b2 = last ? nB : cB + (size_t)(t + 2) * kstep;
            const char* a3 = a2 + kstep; const char* b3 = b2 + kstep;
            if (last && has_next) S.a_ready(nxt);
            if constexpr (SP2) {
#define PG8_WAIT_VN(n) asm volatile("s_waitcnt vmcnt(%0)" :: "n"(n) : "memory")
#define PG8_WAIT_VC(n, flag) do { if constexpr (RELAX1ST) asm volatile("s_cmp_lg_u32 %1, 0\n\ts_cbranch_scc1 1f\n\ts_waitcnt vmcnt(%0)\n1:" :: "n"(n), "s"(__builtin_amdgcn_readfirstlane(flag)) : "memory", "scc"); else PG8_WAIT_VN(n); } while (0)
#define PG8_KT(b, pa11, pb, pa0, RELAX_) do { \
    constexpr bool A11_SEG = (STG == 0 || STG == 2 || STG == 4), B0_SEG = (STG != 1), B1_SEG = (STG == 0 || STG == 4 || STG == 5), A0_SEG = (STG == 0); \
    constexpr int W1 = A11_SEG ? 8 : 6, W2 = (STG == 0) ? 8 : (STG == 1) ? 2 : (STG == 2) ? 4 : 6; \
    PG8_LDB(B0, b, 0); PG8_LDB(B1, b, 1); PG8_SCHED; PG8_LDA(At, b, 0); if constexpr (A11_SEG) PG8_STAGE(PG8_SA((b) ^ 1, 1), pa11, voffA); \
    PG8_WAIT_VC(W1, RELAX_); PG8_WAIT_L(0); PG8_BAR; PG8_MMA(0, 0, At, B0); if constexpr (!A11_SEG) { PG8_SCHED; PG8_STAGE(PG8_SA((b) ^ 1, 1), pa11, voffA); PG8_SCHED; } PG8_MMA(0, 1, At, B1); PG8_BAR; PG8_SCHED; \
    PG8_LDA(At, b, 1); if constexpr (B0_SEG) PG8_STAGE(PG8_SB(b, 0), pb, voffB); if constexpr (B1_SEG) PG8_STAGE(PG8_SB(b, 1), (pb) + hstepB, voffB); if constexpr (A0_SEG) PG8_STAGE(PG8_SA(b, 0), pa0, voffA); \
    PG8_WAIT_VC(W2, RELAX_); PG8_WAIT_L(0); PG8_BAR; \
    if constexpr (!B0_SEG) { PG8_STAGE(PG8_SB(b, 0), pb, voffB); PG8_SCHED; } \
    PG8_MMA(1, 0, At, B0); \
    if constexpr (!B1_SEG) { PG8_SCHED; PG8_STAGE(PG8_SB(b, 1), (pb) + hstepB, voffB); PG8_SCHED; } \
    if constexpr (!A0_SEG && STG != 2) { PG8_SCHED; PG8_STAGE(PG8_SA(b, 0), pa0, voffA); PG8_SCHED; } \
    PG8_MMA(1, 1, At, B1); \
    if constexpr (!A0_SEG && STG == 2) { PG8_SCHED; PG8_STAGE(PG8_SA(b, 0), pa0, voffA); } \
    PG8_BAR; PG8_SCHED; } while (0)
            PG8_KT(0, a1 + hstepA, b2, a2, ((t == 0 && ui > 0) ? 1 : 0));
            PG8_KT(1, a2 + hstepA, b3, a3, 0);
#undef PG8_KT
            } else {
            PG8_LDB(B0, 0, 0); PG8_SCHED; PG8_LDA(At, 0, 0); PG8_STAGE(PG8_SA(1, 1), a1 + hstepA, voffA);
            PG8_WAIT_L(8); PG8_BAR; PG8_WAIT_L(0); PG8_MMA(0, 0, At, B0); PG8_BAR; PG8_SCHED;
            PG8_LDB(B1, 0, 1); PG8_STAGE(PG8_SB(0, 0), b2, voffB);
            PG8_BAR; PG8_WAIT_L(0); PG8_MMA(0, 1, At, B1); PG8_BAR;
            PG8_LDA(At, 0, 1); PG8_STAGE(PG8_SA(0, 0), a2, voffA);
            PG8_BAR; PG8_WAIT_L(0); PG8_MMA(1, 0, At, B0); PG8_BAR; PG8_SCHED;
            PG8_STAGE(PG8_SB(0, 1), b2 + hstepB, voffB);
            PG8_WAIT_V(6); PG8_BAR; PG8_MMA(1, 1, At, B1); PG8_BAR;
            PG8_LDB(B0, 1, 0); PG8_SCHED; PG8_LDA(At, 1, 0); PG8_STAGE(PG8_SA(0, 1), a2 + hstepA, voffA);
            PG8_WAIT_L(8); PG8_BAR; PG8_WAIT_L(0); PG8_MMA(0, 0, At, B0); PG8_BAR; PG8_SCHED;
            PG8_LDB(B1, 1, 1); PG8_STAGE(PG8_SB(1, 0), b3, voffB);
            PG8_BAR; PG8_WAIT_L(0); PG8_MMA(0, 1, At, B1); PG8_BAR;
            PG8_LDA(At, 1, 1); PG8_STAGE(PG8_SA(1, 0), a3, voffA);
            PG8_BAR; PG8_WAIT_L(0); PG8_MMA(1, 0, At, B0); PG8_BAR; PG8_SCHED;
            PG8_STAGE(PG8_SB(1, 1), b3 + hstepB, voffB);
            PG8_WAIT_V(6); PG8_BAR; PG8_MMA(1, 1, At, B1); PG8_BAR;
            }
        }
        if constexpr (ALIGN_EPI) { if (wr == 0) PG8_BAR; }
        if constexpr (!Epi::AFTER_DRAIN) { if constexpr (RELAX1ST) PG8_WAIT_V(0); E(acc, cur, wr, wc, fr, fq); S.done(cur); }
        if (!has_next) break;
        if (S.zero_after(cur))
#pragma unroll
        for (int a = 0; a < 2; ++a)
#pragma unroll
            for (int b = 0; b < 2; ++b)
#pragma unroll
                for (int m = 0; m < 4; ++m)
#pragma unroll
                    for (int n = 0; n < 2; ++n) acc[a][b][m][n] = (f32x4){0.f, 0.f, 0.f, 0.f};
        cur = nxt; cA = nA; cB = nB; ++ui;
        if constexpr (ALIGN_EPI) { if (wr == 1) PG8_BAR; }
    }
    PG8_WAIT_V(0);
    if constexpr (!ALIGN_EPI) { if (wr == 0) PG8_BAR; }
    PG8_BAR;
    if constexpr (Epi::AFTER_DRAIN) { E.fused(acc, cur, wr, wc, fr, fq, lds, wid, lane); S.done(cur); }
#undef PG8_SA
#undef PG8_SB
#undef PG8_STAGE
#undef PG8_LDA
#undef PG8_LDB
#undef PG8_MMA
#undef PG8_WAIT_V
#undef PG8_WAIT_L
#undef PG8_BAR
#undef PG8_SCHED
}
}
constexpr int NWAVES = 8;
constexpr int S = 8192, DM = 4096, HD = 128, NH = 16, WF = 2048, DFF = 11008, PLE = 256, NIN = 20496, NPROJ = 20480;
constexpr float EPS = 1e-6f;
constexpr float SCALE = 0.08838834764831845f;
constexpr size_t MiB = 1u << 20;
constexpr size_t WS_CTL = 0, CTL_ZERO_BYTES = 1 * MiB;
constexpr size_t WS_SS1 = 1 * MiB;
constexpr size_t WS_LOGF = WS_SS1 + 64 * 1024;
constexpr size_t WS_C = WS_LOGF + 512 * 1024;
constexpr size_t WS_WTF = WS_C + 512 * 1024;
constexpr size_t WS_WIN = 4 * MiB;
constexpr size_t WS_WBF = WS_WIN + 160 * MiB;
constexpr size_t WS_WBS = WS_WBF + 16 * MiB;
constexpr size_t WS_WOUT = WS_WBS + 16 * MiB;
constexpr size_t WS_WUP = WS_WOUT + 32 * MiB;
constexpr size_t WS_WDN = WS_WUP + 172 * MiB;
constexpr size_t WS_WPG = WS_WDN + 86 * MiB;
constexpr size_t WS_WPP = WS_WPG + 32 * MiB;
constexpr size_t WS_XB = WS_WPP + 2 * MiB;
constexpr size_t WS_PB = WS_XB + 64 * MiB;
constexpr size_t WS_QKV = WS_PB + 4 * MiB;
constexpr size_t WS_GATES = WS_QKV + 192 * MiB;
constexpr size_t WS_Y = WS_GATES + 128 * MiB;
constexpr size_t WS_EDGE = WS_QKV + 128 * MiB;
constexpr size_t WS_UP = WS_QKV;
constexpr size_t WS_MERGED = WS_Y + 64 * MiB;
constexpr size_t WS_ACT = WS_MERGED + 64 * MiB;
constexpr size_t WS_PP = WS_QKV;
constexpr size_t WS_END = WS_ACT + 172 * MiB;
static_assert(WS_UP + (size_t)S * 2 * DFF * 2 <= WS_MERGED, "up overlay");
constexpr int CW_BAR = 4096;
constexpr int CW_FBLK = 2560;
constexpr int CW_QATT = 2048;
constexpr int CW_SS2 = 32768, CW_SS3 = 32768 + 8192;
constexpr int N_BAR_REGIONS = 4;
constexpr int RING_OFF = 0, RING_BYTES = 131072;
constexpr int LDSCTL_OFF = RING_BYTES, MISC_OFF = LDSCTL_OFF + 320;
constexpr int XCH_OFF = LDSCTL_OFF + 1024;
constexpr int LDS_BYTES = 147456;
static_assert(XCH_OFF + 8192 <= LDS_BYTES, "LDS map");

#define GAS __attribute__((address_space(1)))
#define LAS __attribute__((address_space(3)))
typedef unsigned short bf16;
typedef unsigned v4u __attribute__((ext_vector_type(4)));
typedef unsigned v2u __attribute__((ext_vector_type(2)));
typedef float f32x4 __attribute__((ext_vector_type(4)));
typedef float f32x16 __attribute__((ext_vector_type(16)));
typedef short bf16x8 __attribute__((ext_vector_type(8)));
typedef GAS unsigned gu32;
#define RLX_AGENT __ATOMIC_RELAXED, __HIP_MEMORY_SCOPE_AGENT
#define LDS_WAIT() asm volatile("s_waitcnt lgkmcnt(0)" ::: "memory")
#define VM_WAIT() asm volatile("s_waitcnt vmcnt(0)" ::: "memory")
__device__ __forceinline__ unsigned pk2(float lo, float hi) { unsigned r; asm volatile("v_cvt_pk_bf16_f32 %0, %1, %2" : "=v"(r) : "v"(lo), "v"(hi)); return r; }
__device__ __forceinline__ float bf2f(bf16 b) { return __uint_as_float(((unsigned)b) << 16); }
__device__ __forceinline__ float bflo(unsigned w) { return __uint_as_float(w << 16); }
__device__ __forceinline__ float bfhi(unsigned w) { return __uint_as_float(w & 0xffff0000u); }
__device__ __forceinline__ float sigmoidf_(float v) { return 1.0f / (1.0f + __expf(-v)); }
__device__ __forceinline__ float log_sigmoidf_(float v) { return fminf(v, 0.f) - log1pf(__expf(-fabsf(v))); }
__device__ __forceinline__ float softplusf_(float v) { return fmaxf(v, 0.f) + log1pf(__expf(-fabsf(v))); }
__device__ __forceinline__ float wave_sum(float v) {
#pragma unroll
    for (int o = 1; o < 64; o <<= 1) v += __shfl_xor(v, o);
    return v;
}

#define XB_TMO      128
#define XB_XCNT(j)  (256  + 64 * (j))
#define XB_XSUB(j)  (1280 + 64 * (j))
#define XB_XGEN(j)  (2304 + 64 * (j))
#define XB_TOP      3328
#define XB_TOPGEN   3392
#define XCD_BAR_WORDS 3456
#define XB_SPIN_CAP (1u << 18)

__device__ __forceinline__ unsigned xb_ld(unsigned* p)              { return __hip_atomic_load(p, __ATOMIC_RELAXED, __HIP_MEMORY_SCOPE_AGENT); }
__device__ __forceinline__ unsigned xb_add(unsigned* p, unsigned v) { return __hip_atomic_fetch_add(p, v, __ATOMIC_RELAXED, __HIP_MEMORY_SCOPE_AGENT); }
__device__ __forceinline__ unsigned xb_xcc_id() { return (unsigned)__builtin_amdgcn_s_getreg((3 << 11) | 20) & 0xFu; }
#define XB_SPIN(cond, bar) do { unsigned _sp = 0; while (cond) { __builtin_amdgcn_s_sleep(1); \
    if ((++_sp & 255u) == 0u) { if (xb_ld(&(bar)[XB_TMO])) break; if (_sp > XB_SPIN_CAP) { atomicAdd(&(bar)[XB_TMO], 1u); break; } } } } while (0)

struct XcdBarrier {
    unsigned* bar; unsigned x; int wave;
    volatile LAS unsigned* st;
};

__device__ __forceinline__ XcdBarrier xcd_barrier_post(unsigned* bar, volatile LAS unsigned* st, const int WAVE_) {
    XcdBarrier b; b.wave = WAVE_; b.bar = bar; b.x = xb_xcc_id(); b.st = st;
    if (TID() == 0) (void)xb_add(&bar[XB_XCNT(b.x)], 1u);
    return b;
}
__device__ __forceinline__ void xcd_barrier_complete(unsigned* bar, unsigned x, unsigned& nloc, unsigned& nx) {
    const unsigned G = gridDim.x * gridDim.y * gridDim.z;
    unsigned sum, cnt, mine, sp = 0u;
    for (;;) {
        sum = 0u; cnt = 0u; mine = 0u;
#pragma unroll
        for (unsigned j = 0; j < 16; ++j) { const unsigned c = xb_ld(&bar[XB_XCNT(j)]); sum += c; cnt += (c > 0u) ? 1u : 0u; mine = (j == x) ? c : mine; }
        if (sum == G) break;
        __builtin_amdgcn_s_sleep(1);
        if ((++sp & 255u) == 0u) { if (xb_ld(&bar[XB_TMO])) break; if (sp > XB_SPIN_CAP) { atomicAdd(&bar[XB_TMO], 1u); break; } }
    }
    nloc = mine > 0u ? mine : 1u; nx = cnt > 0u ? cnt : 1u;
}

__device__ __forceinline__ void xcd_barrier(const XcdBarrier& b) {
    const int WAVE_ = b.wave;
    asm volatile("s_waitcnt vmcnt(0)" ::: "memory");
    __syncthreads();
    if (TID() == 0) {
        unsigned* bar = b.bar;
        __builtin_amdgcn_s_waitcnt(0);
        unsigned nloc = b.st[0], nx = b.st[1];
        if (nloc == 0u) { xcd_barrier_complete(bar, b.x, nloc, nx); b.st[0] = nloc; b.st[1] = nx; }
        const unsigned old = xb_add(&bar[XB_XSUB(b.x)], 1u);
        const unsigned gen = old / nloc;
        if (old + 1u == (gen + 1u) * nloc) {
            __builtin_amdgcn_fence(__ATOMIC_RELEASE, "agent");
            asm volatile("s_waitcnt vmcnt(0)" ::: "memory");
            const unsigned og = xb_add(&bar[XB_TOP], 1u);
            const unsigned tg = og / nx;
            if (og + 1u == (tg + 1u) * nx) xb_add(&bar[XB_TOPGEN], 1u);
            else XB_SPIN(xb_ld(&bar[XB_TOPGEN]) == tg, bar);
            __builtin_amdgcn_fence(__ATOMIC_ACQUIRE, "agent");
            xb_add(&bar[XB_XGEN(b.x)], 1u);
            asm volatile("s_waitcnt vmcnt(0)" ::: "memory");
        } else {
            XB_SPIN(xb_ld(&bar[XB_XGEN(b.x)]) == gen, bar);
            __builtin_amdgcn_fence(__ATOMIC_ACQUIRE, "agent");
            asm volatile("s_waitcnt vmcnt(0)" ::: "memory");
        }
    }
    __syncthreads();
}


struct Params {
    const float* in[18]; float* out; unsigned char* ws;
    int ph_lo, ph_hi, li, pad;
};
struct Frame {
    LAS unsigned char* lds; volatile LAS unsigned* MISC; gu32* ctl;
    int wave, vcu, G;
};

constexpr int CVT_WIN_TILES = 64 * 96 + 64 * 224;
constexpr int CVT_REST_TILES = 32 * 64 + 32 * 64 + 64 * 64 + 64 * 344 + 172 * 64 + 64 * 64 + 4 * 64;
struct CvtT { const float* src; const float* g; bf16* dst; int ldw, K; };
__device__ __forceinline__ CvtT cvt_decode(const Params& P, int it, int lane) {
    unsigned char* ws = P.ws;
    constexpr int T0 = 64 * 96, T1 = 64 * 224, T2 = 32 * 64, T3 = 32 * 64, T4 = 64 * 64, T5 = 64 * 344, T6 = 172 * 64, T7 = 64 * 64;
    const float* W; const float* g = nullptr; bf16* Wt; int ldw, srccol0 = 0, K, nrow0 = 0, NT; int r = it; bool is_up = false;
    if (r < T0) { W = P.in[3]; ldw = NIN; g = P.in[2]; Wt = (bf16*)(ws + WS_WIN); K = DM; NT = 96; }
    else if ((r -= T0) < T1) { W = P.in[3]; ldw = NIN; srccol0 = 6160; g = P.in[2]; Wt = (bf16*)(ws + WS_WIN); K = DM; nrow0 = 6144; NT = 224; }
    else if ((r -= T1) < T2) { W = P.in[7]; ldw = DM; Wt = (bf16*)(ws + WS_WBF); K = WF; NT = 64; }
    else if ((r -= T2) < T3) { W = P.in[8]; ldw = DM; Wt = (bf16*)(ws + WS_WBS); K = WF; NT = 64; }
    else if ((r -= T3) < T4) { W = P.in[9]; ldw = DM; Wt = (bf16*)(ws + WS_WOUT); K = DM; NT = 64; }
    else if ((r -= T4) < T5) { W = P.in[11]; ldw = 2 * DFF; g = P.in[10]; Wt = (bf16*)(ws + WS_WUP); K = DM; NT = 344; is_up = true; }
    else if ((r -= T5) < T6) { W = P.in[14]; ldw = DM; Wt = (bf16*)(ws + WS_WDN); K = DFF; NT = 64; }
    else if ((r -= T6) < T7) { W = P.in[16]; ldw = DM; g = P.in[15]; Wt = (bf16*)(ws + WS_WPG); K = DM; NT = 64; }
    else { r -= T7; W = P.in[17]; ldw = DM; Wt = (bf16*)(ws + WS_WPP); K = PLE; NT = 64; }
    const int nt = r % NT, kt = r / NT, nq = lane & 7, q = lane >> 3;
    CvtT T;
    int scol = srccol0 + 64 * nt;
    if (is_up) scol = ((nt & 3) >> 1) * DFF + 128 * (nt >> 2) + (nt & 1) * 64;
    T.src = W + (size_t)(64 * kt + 8 * q) * ldw + scol + 4 * nq;
    T.g = g ? g + 64 * kt + 8 * q : nullptr;
    T.dst = Wt + (size_t)(nrow0 + 64 * nt + 4 * nq) * K + 64 * kt + 8 * q;
    T.ldw = ldw; T.K = K;
    return T;
}
__device__ __forceinline__ void cvt_load(const CvtT& T, f32x4 (&v)[2][8]) {
#pragma unroll
    for (int p = 0; p < 2; ++p)
#pragma unroll
        for (int t = 0; t < 8; ++t) v[p][t] = __builtin_nontemporal_load((const f32x4*)(T.src + (size_t)t * T.ldw + 32 * p));
}
__device__ __forceinline__ void cvt_store(const CvtT& T, const f32x4 (&v)[2][8]) {
    f32x4 g0 = (f32x4){1.f, 1.f, 1.f, 1.f}, g1 = g0;
    if (T.g) { g0 = *(const f32x4*)T.g; g1 = *(const f32x4*)(T.g + 4); }
#pragma unroll
    for (int p = 0; p < 2; ++p)
#pragma unroll
        for (int i = 0; i < 4; ++i) {
            v4u w; w.x = pk2(v[p][0][i] * g0[0], v[p][1][i] * g0[1]); w.y = pk2(v[p][2][i] * g0[2], v[p][3][i] * g0[3]);
            w.z = pk2(v[p][4][i] * g1[0], v[p][5][i] * g1[1]); w.w = pk2(v[p][6][i] * g1[2], v[p][7][i] * g1[3]);
            *(v4u*)(T.dst + (size_t)(32 * p + i) * T.K) = w;
        }
}
__device__ __forceinline__ void p0_weights(const Frame& F, const Params& P) {
    const int WAVE_ = F.wave; const int f_lane = lane_id(), f_tid = TID();
    const int gw = F.vcu * NWAVES + F.wave, NGW = F.G * NWAVES, lane = f_lane;
    unsigned char* ws = P.ws;
    constexpr int NITEMS = CVT_WIN_TILES;
    f32x4 va[2][8], vb[2][8];
    int it = gw;
    if (it < NITEMS) {
        CvtT Ta = cvt_decode(P, it, lane); cvt_load(Ta, va);
        for (;;) {
            const int i1 = it + NGW; CvtT Tb = Ta;
            if (i1 < NITEMS) { Tb = cvt_decode(P, i1, lane); cvt_load(Tb, vb); }
            cvt_store(Ta, va);
            if (i1 >= NITEMS) break;
            const int i2 = i1 + NGW;
            if (i2 < NITEMS) { Ta = cvt_decode(P, i2, lane); cvt_load(Ta, va); }
            cvt_store(Tb, vb);
            if (i2 >= NITEMS) break;
            it = i2;
        }
    }
    { const float* w_in = P.in[3]; const float* g_mix = P.in[2]; bf16* wtf = (bf16*)(ws + WS_WTF);
      for (int i = blockIdx.x * 512 + f_tid; i < NH * (DM / 8); i += F.G * 512) { const int n = i / (DM / 8), kc = i % (DM / 8);
          float b[8];
#pragma unroll
          for (int t = 0; t < 8; ++t) b[t] = w_in[(size_t)(8 * kc + t) * NIN + 6144 + n] * g_mix[8 * kc + t];
          v4u w; w.x = pk2(b[0], b[1]); w.y = pk2(b[2], b[3]); w.z = pk2(b[4], b[5]); w.w = pk2(b[6], b[7]);
          *(v4u*)(wtf + (size_t)n * DM + 8 * kc) = w; } }
    const float* p = P.in[1]; bf16* pb = (bf16*)(ws + WS_PB);
    for (int i = blockIdx.x * 512 + f_tid; i < S * PLE / 8; i += F.G * 512) {
        const f32x4 a = *(const f32x4*)(p + (size_t)i * 8), b = *(const f32x4*)(p + (size_t)i * 8 + 4);
        v4u w; w.x = pk2(a[0], a[1]); w.y = pk2(a[2], a[3]); w.z = pk2(b[0], b[1]); w.w = pk2(b[2], b[3]);
        *(v4u*)(pb + (size_t)i * 8) = w;
    }
}
constexpr int CVT_SLOT = 18;
static_assert(2560 * CVT_SLOT >= CVT_REST_TILES, "conversion slots cover every tile");
struct ConvOrder : pg8::StaticOrder {
    const Params* P; int wave; mutable int slot;
    __device__ __forceinline__ void done(const pg8::Unit&) const {
        const int lane = lane_id();
        const int base = (slot * G + c) * CVT_SLOT; ++slot;
        const int i0 = base + wave, i1 = i0 + 8, i2 = i0 + 16;
        const int lim = (base + CVT_SLOT < CVT_REST_TILES) ? base + CVT_SLOT : CVT_REST_TILES;
        f32x4 va[2][8], vb[2][8];
        if (i0 < lim) {
            CvtT Ta = cvt_decode(*P, CVT_WIN_TILES + i0, lane); cvt_load(Ta, va);
            if (i1 < lim) {
                CvtT Tb = cvt_decode(*P, CVT_WIN_TILES + i1, lane); cvt_load(Tb, vb);
                cvt_store(Ta, va);
                if (i2 < lim) { Ta = cvt_decode(*P, CVT_WIN_TILES + i2, lane); cvt_load(Ta, va); cvt_store(Tb, vb); cvt_store(Ta, va); }
                else cvt_store(Tb, vb);
            } else cvt_store(Ta, va);
        }
    }
};
__device__ __forceinline__ void p0_rows(const Frame& F, const Params& P) {
    const int WAVE_ = F.wave; const int f_lane = lane_id();
    const float* x = P.in[0]; unsigned char* ws = P.ws;
    float* ss1 = (float*)(ws + WS_SS1); bf16* xb = (bf16*)(ws + WS_XB);
    const int gw = F.vcu * NWAVES + F.wave, NGW = F.G * NWAVES, lane = f_lane;
    for (int base = gw; base < S; base += 2 * NGW) {
        const int rowA = base, rowB = (base + NGW < S) ? base + NGW : base;
        const f32x4* xa = (const f32x4*)(x + (size_t)rowA * DM) + lane; const f32x4* xbp = (const f32x4*)(x + (size_t)rowB * DM) + lane;
        f32x4 va[16], vb[16]; float sa = 0.f, sb = 0.f;
#pragma unroll
        for (int j = 0; j < 16; ++j) va[j] = __builtin_nontemporal_load(xa + 64 * j);
#pragma unroll
        for (int j = 0; j < 16; ++j) vb[j] = __builtin_nontemporal_load(xbp + 64 * j);
#pragma unroll
        for (int j = 0; j < 16; ++j) sa += (va[j][0] * va[j][0] + va[j][1] * va[j][1]) + (va[j][2] * va[j][2] + va[j][3] * va[j][3]);
#pragma unroll
        for (int j = 0; j < 16; ++j) sb += (vb[j][0] * vb[j][0] + vb[j][1] * vb[j][1]) + (vb[j][2] * vb[j][2] + vb[j][3] * vb[j][3]);
        sa = wave_sum(sa); sb = wave_sum(sb);
        if (lane == 0) { ss1[rowA] = sa; ss1[rowB] = sb; }
        v2u* oa = (v2u*)(xb + (size_t)rowA * DM) + lane; v2u* ob = (v2u*)(xb + (size_t)rowB * DM) + lane;
#pragma unroll
        for (int j = 0; j < 16; ++j) { v2u w; w.x = pk2(va[j][0], va[j][1]); w.y = pk2(va[j][2], va[j][3]); oa[64 * j] = w; }
#pragma unroll
        for (int j = 0; j < 16; ++j) { v2u w; w.x = pk2(vb[j][0], vb[j][1]); w.y = pk2(vb[j][2], vb[j][3]); ob[64 * j] = w; }
    }
}

__device__ __forceinline__ void p1b_qknorm_fgate(const Frame& F, const Params& P) {
    const int WAVE_ = F.wave; const int f_lane = lane_id(), f_tid = TID();
    unsigned char* ws = P.ws;
    bf16* qkv = (bf16*)(ws + WS_QKV);
    const float* gq = P.in[5]; const float* gk = P.in[6];
    const int gw = F.vcu * NWAVES + F.wave, NGW = F.G * NWAVES, lane = f_lane, sub = lane >> 4, l16 = lane & 15;
    {
        const bf16* xb = (const bf16*)(ws + WS_XB); const bf16* wtf = (const bf16*)(ws + WS_WTF); const float* ss1 = (const float*)(ws + WS_SS1); const float* b_f = P.in[4];
        float* logf = (float*)(ws + WS_LOGF);
        LAS float* fbuf = (LAS float*)(F.lds + RING_OFF);
        const int wave = F.wave, rl = lane & 31, kg = lane >> 5;
        for (int grp = blockIdx.x; grp < S / 32; grp += F.G) {
            const int r0 = grp * 32;
            const bf16* pa = xb + (size_t)(r0 + rl) * DM + 512 * wave + 8 * kg;
            const bf16* pb = wtf + (size_t)(rl & 15) * DM + 512 * wave + 8 * kg;
            f32x16 acc = {};
#pragma unroll 8
            for (int ks = 0; ks < 32; ++ks) {
                const bf16x8 a = *(const bf16x8*)(pa + 16 * ks);
                bf16x8 b = *(const bf16x8*)(pb + 16 * ks);
                if (rl >= 16) b = (bf16x8){0, 0, 0, 0, 0, 0, 0, 0};
                acc = __builtin_amdgcn_mfma_f32_32x32x16_bf16(a, b, acc, 0, 0, 0);
            }
            if (rl < 16) {
#pragma unroll
                for (int r = 0; r < 16; ++r) { const int tok = (r & 3) + 8 * (r >> 2) + 4 * kg; fbuf[(wave * 32 + tok) * 16 + rl] = acc[r]; }
            }
            __syncthreads();
            {
                const int tok = f_tid >> 4, h = f_tid & 15; float fv = 0.f;
#pragma unroll
                for (int w = 0; w < 8; ++w) fv += fbuf[(w * 32 + tok) * 16 + h];
                fv = fv * rsqrtf(ss1[r0 + tok] * (1.0f / DM) + EPS) + b_f[h];
                const float lv = log_sigmoidf_(fv);
                logf[(size_t)h * S + r0 + tok] = lv;
                float bs = lv; bs += __shfl_xor(bs, 16); bs += __shfl_xor(bs, 32);
                if (lane < 16) __hip_atomic_fetch_add((float*)(F.ctl + CW_FBLK) + h * 32 + (r0 >> 8), bs, __ATOMIC_RELAXED, __HIP_MEMORY_SCOPE_AGENT);
            }
            __syncthreads();
        }
    }
}

__device__ __forceinline__ void p5c_fixup(const Frame& F, const Params& P) {
    const int WAVE_ = F.wave; const int f_tid = TID();
    unsigned char* ws = P.ws;
    const float* edge = (const float*)(ws + WS_EDGE); bf16* act = (bf16*)(ws + WS_ACT);
    const float* cw = P.in[12]; const float* cb = P.in[13];
    constexpr int NQ = DFF / 4;
    for (int i = blockIdx.x * 512 + f_tid; i < (S / 256) * 2 * NQ; i += F.G * 512) {
        const int row = i / NQ, jc = (i - row * NQ) * 4, p = row >> 1, rr = row & 1, t = 256 * p + rr;
        float uu[2][4];
#pragma unroll
        for (int h = 0; h < 2; ++h) {
            const size_t co = (size_t)h * DFF + jc; const f32x4 z = (f32x4){0.f, 0.f, 0.f, 0.f};
            const f32x4 c = *(const f32x4*)(edge + ((size_t)p * 4 + rr) * (2 * DFF) + co);
            const f32x4 l3 = p ? *(const f32x4*)(edge + ((size_t)(p - 1) * 4 + 3) * (2 * DFF) + co) : z;
            const f32x4 p1 = rr ? *(const f32x4*)(edge + ((size_t)p * 4 + 0) * (2 * DFF) + co) : l3;
            const f32x4 p2 = rr ? l3 : (p ? *(const f32x4*)(edge + ((size_t)(p - 1) * 4 + 2) * (2 * DFF) + co) : z);
            const f32x4 w0 = *(const f32x4*)(cw + co), w1 = *(const f32x4*)(cw + (size_t)2 * DFF + co), w2 = *(const f32x4*)(cw + (size_t)4 * DFF + co), bb = *(const f32x4*)(cb + co);
#pragma unroll
            for (int e = 0; e < 4; ++e) uu[h][e] = bb[e] + w0[e] * p2[e] + w1[e] * p1[e] + w2[e] * c[e];
        }
        v2u w; w.x = pk2(uu[0][0] * sigmoidf_(uu[0][0]) * uu[1][0], uu[0][1] * sigmoidf_(uu[0][1]) * uu[1][1]); w.y = pk2(uu[0][2] * sigmoidf_(uu[0][2]) * uu[1][2], uu[0][3] * sigmoidf_(uu[0][3]) * uu[1][3]);
        *(v2u*)(act + (size_t)t * DFF + jc) = w;
    }
}

namespace att {
constexpr int D = 128, PITCH = 2048, NW = 8, QBLK = 32, KVBLK = 64, QB = NW * QBLK;
constexpr int SHM_V = KVBLK * D * 2, SHM_K = KVBLK * D * 2;
constexpr int OFF_WS = 2 * SHM_V + 2 * SHM_K, OFF_FLAG = OFF_WS + NW * 64 * 4, OFF_WTOT = OFF_FLAG + 64, OFF_NEXT = OFF_WTOT + 64, OFF_C = 73728  , ATT_LDS_BYTES = OFF_C + 32768;
constexpr int OFF_TAB = ATT_LDS_BYTES  , OFF_SPL = OFF_TAB + 8192  , OFF_FBS = OFF_SPL + 2048  , OFF_TOT = OFF_FBS + 2048  ;
constexpr int PART_F = QB * D + 2 * QB;
constexpr float SCALE = 0.08838834764831845f;
constexpr float THR = 8.f;
constexpr int PRUNE_NATS = 40;
typedef short s16x4 __attribute__((ext_vector_type(4)));
typedef unsigned u32x4 __attribute__((ext_vector_type(4)));
#define KSWZ(row, colB) ((row) * 256 + ((colB) ^ (((row) & 7) << 4)))
#define SBAR() __builtin_amdgcn_sched_barrier(0)
__device__ __forceinline__ int v_st(int k, int c) { const int kk = (k & ~0xC) | ((k & 4) << 1) | ((k & 8) >> 1); return ((kk >> 3) * 4 + (c >> 5)) * 512 + ((kk & 7) * 32 + (c & 31)) * 2; }
__device__ __forceinline__ int v_rd_base(int lane) { return ((lane & 3) << 3) | (((lane >> 2) & 3) << 6) | (((lane >> 4) & 1) << 5) | (((lane >> 5) & 1) << 8); }
constexpr int v_rd_off(int d0, int ks, int half) { return d0 * 512 + ks * 4096 + half * 2048; }
__device__ __forceinline__ int crow(int r, int hi) { return (r & 3) + 8 * (r >> 2) + 4 * hi; }
__device__ __forceinline__ unsigned cvtpk(float lo, float hi) { unsigned r; asm volatile("v_cvt_pk_bf16_f32 %0, %1, %2" : "=v"(r) : "v"(lo), "v"(hi)); return r; }
__device__ __forceinline__ bf16x8 load8(const bf16* p) { return *reinterpret_cast<const bf16x8*>(p); }
__device__ __forceinline__ void mask_tile(f32x16& p0, f32x16& p1, int dq) {
    const float NEG = -__builtin_inff();
#pragma unroll
    for (int r = 0; r < 16; ++r) { const int c = (r & 3) + 8 * (r >> 2); if (dq - c < 0) p0[r] = NEG; if (dq - c - 32 < 0) p1[r] = NEG; }
}
__device__ __forceinline__ void partialSM(f32x16& p0, f32x16& p1, float& m_reg, float& mn, float& alpha) {
    float pmax = p0[0]; for (int r = 1; r < 16; ++r) pmax = fmaxf(pmax, p0[r]); for (int r = 0; r < 16; ++r) pmax = fmaxf(pmax, p1[r]);
    { auto rr = __builtin_amdgcn_permlane32_swap(__float_as_uint(pmax), __float_as_uint(pmax), false, false);
      pmax = fmaxf(__uint_as_float(rr[0]), __uint_as_float(rr[1])); }
    constexpr float C2 = 1.4426950408889634f * SCALE;
    if (__builtin_expect(__all((pmax - m_reg) * SCALE <= THR), 1)) { mn = m_reg; alpha = 1.f; }
    else { mn = fmaxf(m_reg, pmax); alpha = __builtin_amdgcn_exp2f((m_reg - mn) * C2); m_reg = mn; }
    const float mnL = -mn * C2;
    for (int r = 0; r < 16; ++r) p0[r] = fmaf(p0[r], C2, mnL); for (int r = 0; r < 16; ++r) p1[r] = fmaf(p1[r], C2, mnL);
    for (int r = 0; r < 16; ++r) p0[r] = __builtin_amdgcn_exp2f(p0[r]);
}
#define PK4(P, B_, OUT) do { unsigned a0 = cvtpk(P[B_+0], P[B_+1]), a1 = cvtpk(P[B_+2], P[B_+3]);                          \
        unsigned b0 = cvtpk(P[B_+4], P[B_+5]), b1 = cvtpk(P[B_+6], P[B_+7]);                                             \
        auto r0 = __builtin_amdgcn_permlane32_swap(a0, b0, false, false); auto r1 = __builtin_amdgcn_permlane32_swap(a1, b1, false, false); \
        u32x4 w = {r0[0], r1[0], r0[1], r1[1]}; OUT = *reinterpret_cast<bf16x8*>(&w); } while (0)
__device__ __forceinline__ void finishSM(f32x16& p0, f32x16& p1, float alpha, float& l_reg, bf16x8& pa0, bf16x8& pa1, bf16x8& pa2, bf16x8& pa3) {
    for (int r = 0; r < 16; ++r) p1[r] = __builtin_amdgcn_exp2f(p1[r]);
    float ps = 0; for (int r = 0; r < 16; ++r) ps += p0[r]; for (int r = 0; r < 16; ++r) ps += p1[r];
    { auto rr = __builtin_amdgcn_permlane32_swap(__float_as_uint(ps), __float_as_uint(ps), false, false);
      ps = __uint_as_float(rr[0]) + __uint_as_float(rr[1]); }
    l_reg = l_reg * alpha + ps;
    PK4(p0, 0, pa0); PK4(p0, 8, pa1); PK4(p1, 0, pa2); PK4(p1, 8, pa3);
}
template <int KB>
__device__ __forceinline__ void qkt(f32x16& p0, f32x16& p1, const char* K_lds, int r32, int hi, const bf16x8* qr) {
    p0 = f32x16{}; p1 = f32x16{};
    const char* kb[4];
#pragma unroll
    for (int dd = 0; dd < 4; ++dd) kb[dd] = K_lds + KB * SHM_K + KSWZ(r32, (dd * 16 + hi * 8) * 2);
#pragma unroll
    for (int d0 = 0; d0 < 8; ++d0) { const char* a = kb[d0 & 3] + (d0 >> 2) * 128;
        bf16x8 b0 = *reinterpret_cast<const bf16x8*>(a);
        bf16x8 b1 = *reinterpret_cast<const bf16x8*>(a + 32 * 256);
        p0 = __builtin_amdgcn_mfma_f32_32x32x16_bf16(b0, qr[d0], p0, 0, 0, 0);
        p1 = __builtin_amdgcn_mfma_f32_32x32x16_bf16(b1, qr[d0], p1, 0, 0, 0); }
}
template <int VB>
__device__ __forceinline__ void pv_tile(f32x16* o, int vb0, bf16x8 pa0, bf16x8 pa1, bf16x8 pa2, bf16x8 pa3) {
#define TRRD(dst, off) asm volatile("ds_read_b64_tr_b16 %0, %1 offset:%2" : "=&v"(dst) : "v"(vb0), "i"(off) : "memory")
#define PV_D0(d0) do { s16x4 l0, l1, l2, l3, h0, h1, h2, h3; constexpr int b_ = VB * SHM_V + v_rd_off(d0, 0, 0); \
        TRRD(l0, b_); TRRD(h0, b_ + 2048); TRRD(l1, b_ + 4096); TRRD(h1, b_ + 6144); TRRD(l2, b_ + 8192); TRRD(h2, b_ + 10240); TRRD(l3, b_ + 12288); TRRD(h3, b_ + 14336); \
        asm volatile("s_waitcnt lgkmcnt(0)" ::: "memory"); SBAR();   \
        o[d0] = __builtin_amdgcn_mfma_f32_32x32x16_bf16(pa0, (bf16x8){l0[0], l0[1], l0[2], l0[3], h0[0], h0[1], h0[2], h0[3]}, o[d0], 0, 0, 0);   \
        o[d0] = __builtin_amdgcn_mfma_f32_32x32x16_bf16(pa1, (bf16x8){l1[0], l1[1], l1[2], l1[3], h1[0], h1[1], h1[2], h1[3]}, o[d0], 0, 0, 0);   \
        o[d0] = __builtin_amdgcn_mfma_f32_32x32x16_bf16(pa2, (bf16x8){l2[0], l2[1], l2[2], l2[3], h2[0], h2[1], h2[2], h2[3]}, o[d0], 0, 0, 0);   \
        o[d0] = __builtin_amdgcn_mfma_f32_32x32x16_bf16(pa3, (bf16x8){l3[0], l3[1], l3[2], l3[3], h3[0], h3[1], h3[2], h3[3]}, o[d0], 0, 0, 0); } while (0)
    PV_D0(0); PV_D0(1); PV_D0(2); PV_D0(3);
#undef PV_D0
#undef TRRD
}
__device__ __forceinline__ void key_bias(f32x16& p0, f32x16& p1, const char* lds, int kbase, int hi) {
    const float* kbp = (const float*)(lds + OFF_C) + kbase + 4 * hi;
#pragma unroll
    for (int g = 0; g < 4; ++g) { const f32x4 b0 = *(const f32x4*)(kbp + 8 * g), b1 = *(const f32x4*)(kbp + 32 + 8 * g);
#pragma unroll
        for (int e = 0; e < 4; ++e) { p0[4 * g + e] -= b0[e]; p1[4 * g + e] -= b1[e]; } }
}
__device__ __forceinline__ void cgate_scan(const float* logf_h, char* lds, const int WAVE_) {
    const int lane = lane_id(), tid = WAVE_ * 64 + lane;
    float* Cl = (float*)(lds + OFF_C); float* wtot = (float*)(lds + OFF_WTOT);
    const float* src = logf_h + tid * 16;
    const f32x4 a = *(const f32x4*)src, b = *(const f32x4*)(src + 4), c = *(const f32x4*)(src + 8), d = *(const f32x4*)(src + 12);
    const float in[16] = {a[0], a[1], a[2], a[3], b[0], b[1], b[2], b[3], c[0], c[1], c[2], c[3], d[0], d[1], d[2], d[3]};
    float loc[16]; float s = 0.f;
#pragma unroll
    for (int j = 0; j < 16; ++j) { s += in[j]; loc[j] = s; }
    float incl = s;
#pragma unroll
    for (int o = 1; o < 64; o <<= 1) { const float t = __builtin_bit_cast(float, __builtin_amdgcn_ds_bpermute((lane - o) << 2, __builtin_bit_cast(int, incl))); if (lane >= o) incl += t; }
    if (lane == 63) wtot[WAVE_] = incl;
    __syncthreads();
    float base = incl - s;
    for (int w = 0; w < WAVE_; ++w) base += wtot[w];
#pragma unroll
    for (int j = 0; j < 16; j += 4) *(f32x4*)(Cl + tid * 16 + j) = (f32x4){base + loc[j], base + loc[j + 1], base + loc[j + 2], base + loc[j + 3]} * (1.0f / SCALE);
    __syncthreads();
}

struct BlockRef { const bf16* Q; const bf16* K; const bf16* V; bf16* O; int P0; int top, nst; float* part; };
struct Seam { bf16x8 qr[8]; bf16x8 st_v0, st_v1, st_k0, st_k1; };
#define ROW(p, k0, rr) ((p) + (size_t)((k0) + (rr)) * PITCH + sc)
#define VMW() asm volatile("s_waitcnt vmcnt(0)" ::: "memory")
#define VMWN(n) asm volatile("s_waitcnt vmcnt(%0)" :: "i"(n) : "memory")
#define SLOAD_H(Kp, Vp, k0) do { S.st_v0 = load8(ROW(Vp, k0, sr)); S.st_v1 = load8(ROW(Vp, k0, 32 + sr));              \
                         S.st_k0 = load8(ROW(Kp, k0, sr)); S.st_k1 = load8(ROW(Kp, k0, 32 + sr)); } while (0)
#define SWRITE_HK(bf) do { *(bf16x8*)(K_lds + (bf) * SHM_K + kws) = S.st_k0; *(bf16x8*)(K_lds + (bf) * SHM_K + kws + 32 * 256) = S.st_k1; } while (0)
#define SWRITE_HV(bf) do { *(bf16x8*)(V_lds + (bf) * SHM_V + vst0) = S.st_v0; *(bf16x8*)(V_lds + (bf) * SHM_V + vst1) = S.st_v1; } while (0)
#define SWRITE_H(bf) do { SWRITE_HV(bf); SWRITE_HK(bf); } while (0)
__device__ __forceinline__ void fox_prime(const BlockRef& cur, char* lds, Seam& S, const int WAVE_) {
    const int tid = TID(), wid = __builtin_amdgcn_readfirstlane(tid >> 6), lane = tid & 63, r32 = lane & 31, hi = lane >> 5;
    const int sr = tid >> 4, sc = (tid & 15) * 8, kws = KSWZ(sr, sc * 2); char* K_lds = lds + 2 * SHM_V;
    for (int d0 = 0; d0 < 8; ++d0) S.qr[d0] = load8(cur.Q + (size_t)(wid * QBLK + r32) * PITCH + d0 * 16 + hi * 8);
    SLOAD_H(cur.K, cur.V, cur.top * KVBLK); VMW(); SWRITE_HK(0);
    __syncthreads();
}
__device__ __forceinline__ void fox_block(const BlockRef& cur, const BlockRef& nxt, const float Uq, char* lds, Seam& S, const int WAVE_) {
    const int tid = TID(), wid = __builtin_amdgcn_readfirstlane(tid >> 6), lane = tid & 63, r32 = lane & 31, hi = lane >> 5;
    const int NT0 = cur.top + 1;
    int NT = cur.nst;
    volatile LAS int* flg = (volatile LAS int*)(lds + OFF_FLAG);
    const int qlo = cur.P0 + wid * QBLK, qm = qlo + r32 - 4 * hi;
    char* V_lds = lds; char* K_lds = lds + 2 * SHM_V;
    float* ws = (float*)(lds + OFF_WS) + wid * 64; float* li_l = ws, * al_l = ws + 32;
    float m_reg = -Uq - ((const float*)(lds + OFF_C))[cur.P0 + wid * QBLK + r32], l_reg = 0; f32x16 o[4] = {};
    const int sr = tid >> 4, sc = (tid & 15) * 8, vst0 = v_st(sr, sc), vst1 = v_st(32 + sr, sc), kws = KSWZ(sr, sc * 2);
    const int vb0 = (int)(uintptr_t)V_lds + v_rd_base(lane);
    const bf16* Kh = cur.K; const bf16* Vh = cur.V;
#define RESC(a) do { if (__any((a) < 1.f)) { if (hi == 0) al_l[r32] = (a); asm volatile("s_waitcnt lgkmcnt(0)" ::: "memory");              \
                     for (int d_ = 0; d_ < 4; ++d_) for (int r = 0; r < 16; ++r) o[d_][r] *= al_l[crow(r, hi)]; } } while (0)
#define KBASE(t) ((NT0 - 1 - (t)) * KVBLK)
#define MASKT(P0_, P1_, t, KBUF) do { const int kb_ = KBASE(t); key_bias(P0_, P1_, lds, kb_, hi); if (kb_ + KVBLK - 1 > qlo) mask_tile(P0_, P1_, qm - kb_); } while (0)
#define SEAM_K0() do { VMWN(8); SWRITE_HK(0); SBAR(); } while (0)
    f32x16 pA0, pA1, pB0, pB1; float mnA, mnB, alA, alB; bf16x8 pa0, pa1, pa2, pa3;
    SWRITE_HV(0); SBAR();
    if (NT > 1) { SLOAD_H(Kh, Vh, KBASE(1)); }
    SBAR(); qkt<0>(pA0, pA1, K_lds, r32, hi, S.qr);
    MASKT(pA0, pA1, 0, 0); partialSM(pA0, pA1, m_reg, mnA, alA);
    if (NT > 1) { VMW(); SWRITE_H(1); }
    __syncthreads();
#define VOTE(t) do { bool can_ = false; if ((t) + 2 < NT) { const float negc_ = -((const float*)(lds + OFF_C))[KBASE((t) + 2) + KVBLK - 1]; can_ = __all((Uq + negc_ - m_reg) * SCALE <= -(float)PRUNE_NATS) != 0; } \
                     if (lane == 0) flg[wid] = can_ ? 1 : 0; } while (0)
#define DECIDE(t) do { int all_ = 1; _Pragma("unroll") for (int w_ = 0; w_ < 8; ++w_) all_ &= flg[w_]; if (all_ && (t) + 2 < NT) NT = (t) + 2; } while (0)
#define HALF_STEP(PX0, PX1, mnX, alX, PY0, PY1, alY, t, KB, VB, SB) do {                                                      \
        SBAR(); qkt<KB>(PX0, PX1, K_lds, r32, hi, S.qr);                                                                     \
        finishSM(PY0, PY1, alY, l_reg, pa0, pa1, pa2, pa3); SBAR();                                                           \
        if ((t) + 1 < NT) { SLOAD_H(Kh, Vh, KBASE((t) + 1)); SBAR(); }                                                    \
        pv_tile<VB>(o, vb0, pa0, pa1, pa2, pa3); MASKT(PX0, PX1, (t), KB); partialSM(PX0, PX1, m_reg, mnX, alX); VOTE(t);    \
        __syncthreads(); DECIDE(t);                                                                                           \
        if ((t) + 1 < NT) { VMW(); SWRITE_H(SB); }                                                                            \
        RESC(alX); __syncthreads(); } while (0)
    for (int t = 1; t + 1 < NT; t += 2) {
        HALF_STEP(pB0, pB1, mnB, alB, pA0, pA1, alA, t, 1, 0, 0);
        HALF_STEP(pA0, pA1, mnA, alA, pB0, pB1, alB, t + 1, 0, 1, 1);
    }
    const bool even = (NT & 1) == 0;
    if (even) { SBAR(); qkt<1>(pB0, pB1, K_lds, r32, hi, S.qr); SBAR(); }
    SLOAD_H(nxt.K, nxt.V, nxt.top * KVBLK); SBAR();
#pragma unroll
    for (int d0 = 0; d0 < 8; ++d0) S.qr[d0] = load8(nxt.Q + (size_t)(wid * QBLK + r32) * PITCH + d0 * 16 + hi * 8);
    SBAR();
    finishSM(pA0, pA1, alA, l_reg, pa0, pa1, pa2, pa3); SBAR();
    pv_tile<0>(o, vb0, pa0, pa1, pa2, pa3);
    if (even) { MASKT(pB0, pB1, NT - 1, 1); partialSM(pB0, pB1, m_reg, mnB, alB); __syncthreads(); RESC(alB);
        finishSM(pB0, pB1, alB, l_reg, pa0, pa1, pa2, pa3); SBAR(); pv_tile<1>(o, vb0, pa0, pa1, pa2, pa3); }
    SBAR(); SEAM_K0();
    if (cur.part != nullptr) {
        float* po = cur.part + (size_t)(wid * QBLK) * D + r32;
#pragma unroll
        for (int r = 0; r < 16; ++r) { const int orow = crow(r, hi);
#pragma unroll
            for (int d0 = 0; d0 < 4; ++d0) po[orow * D + d0 * 32] = o[d0][r]; }
        if (hi == 0) { cur.part[QB * D + wid * QBLK + r32] = m_reg; cur.part[QB * D + QB + wid * QBLK + r32] = l_reg; }
    } else {
    if (hi == 0) li_l[r32] = l_reg; asm volatile("s_waitcnt lgkmcnt(0)" ::: "memory");
    float rli[16];
#pragma unroll
    for (int r = 0; r < 16; ++r) rli[r] = __builtin_amdgcn_rcpf(li_l[crow(r, hi)]);
    bf16* Ow = cur.O + (size_t)(wid * QBLK) * PITCH;
#pragma unroll
    for (int r = 0; r < 16; ++r) { const int orow = crow(r, hi);
#pragma unroll
        for (int d0 = 0; d0 < 4; ++d0) { const float v = o[d0][r] * rli[r];
            const float vn = __shfl_xor(v, 1);
            if ((r32 & 1) == 0) *(unsigned*)(Ow + (size_t)orow * PITCH + d0 * 32 + r32) = cvtpk(v, vn); } }
    }
    __syncthreads();
#undef RESC
#undef MASKT
#undef SEAM_K0
#undef HALF_STEP
#undef VOTE
#undef DECIDE
#undef KBASE
}

__device__ __forceinline__ void fox_combine(const float* __restrict__ slot0, const int np, bf16* __restrict__ O, const int WAVE_) {
    const int lane = lane_id(), c = (lane & 31) * 4;
    constexpr float C2 = 1.4426950408889634f * SCALE;
    const float NINF = -__builtin_inff();
    for (int it0 = 0; it0 < 16; it0 += 4) {
        float mv[4][4], lv[4][4]; f32x4 dv[4][4];
#pragma unroll
        for (int u = 0; u < 4; ++u) { const int row = WAVE_ * 32 + (it0 + u) * 2 + (lane >> 5);
#pragma unroll
            for (int p = 0; p < 4; ++p) { mv[u][p] = NINF; lv[u][p] = 0.f; dv[u][p] = (f32x4){0.f, 0.f, 0.f, 0.f};
                if (p < np) { const float* s = slot0 + (size_t)p * PART_F; mv[u][p] = s[QB * D + row]; lv[u][p] = s[QB * D + QB + row]; dv[u][p] = *(const f32x4*)(s + (size_t)row * D + c); } } }
#pragma unroll
        for (int u = 0; u < 4; ++u) { const int row = WAVE_ * 32 + (it0 + u) * 2 + (lane >> 5);
            const float M = fmaxf(fmaxf(mv[u][0], mv[u][1]), fmaxf(mv[u][2], mv[u][3]));
            float den = 0.f; f32x4 a = {0.f, 0.f, 0.f, 0.f};
#pragma unroll
            for (int p = 0; p < 4; ++p) { const float e = __builtin_amdgcn_exp2f((mv[u][p] - M) * C2); den += e * lv[u][p]; a += dv[u][p] * e; }
            a *= 1.0f / den;
            unsigned x, y;
            asm("v_cvt_pk_bf16_f32 %0, %1, %2" : "=v"(x) : "v"(a[0]), "v"(a[1]));
            asm("v_cvt_pk_bf16_f32 %0, %1, %2" : "=v"(y) : "v"(a[2]), "v"(a[3]));
            uint2 pk; pk.x = x; pk.y = y;
            *(uint2*)(O + (size_t)row * PITCH + c) = pk; }
    }
}

template <int BUF>
__device__ __forceinline__ void sb_tile(f32x16* o, float& R, const char* K_lds, int vb0, int r32, int hi, const bf16x8* qr, int dq) {
    f32x16 p0, p1;
    qkt<BUF>(p0, p1, K_lds, r32, hi, qr);
    constexpr float L2E = 1.4426950408889634f, LN2 = 0.6931471805599453f;
    f32x16 l0, l1;
    const float NEG = -__builtin_inff();
#pragma unroll
    for (int r = 0; r < 16; ++r) { const int c = (r & 3) + 8 * (r >> 2);
        { const float z = p0[r] * SCALE; const float sp = fmaxf(z, 0.f) + LN2 * __builtin_amdgcn_logf(1.0f + __builtin_amdgcn_exp2f(-fabsf(z) * L2E)); const bool st = (dq - c) >= 1; l0[r] = st ? -sp : 0.f; p0[r] = st ? (z - sp) : NEG; }
        { const float z = p1[r] * SCALE; const float sp = fmaxf(z, 0.f) + LN2 * __builtin_amdgcn_logf(1.0f + __builtin_amdgcn_exp2f(-fabsf(z) * L2E)); const bool st = (dq - c - 32) >= 1; l1[r] = st ? -sp : 0.f; p1[r] = st ? (z - sp) : NEG; } }
    float gs[8], pg[8], ps[8];
#pragma unroll
    for (int g = 0; g < 4; ++g) { gs[g] = (l0[4 * g] + l0[4 * g + 1]) + (l0[4 * g + 2] + l0[4 * g + 3]); gs[4 + g] = (l1[4 * g] + l1[4 * g + 1]) + (l1[4 * g + 2] + l1[4 * g + 3]); }
#pragma unroll
    for (int g = 0; g < 8; ++g) { auto rr = __builtin_amdgcn_permlane32_swap(__float_as_uint(gs[g]), __float_as_uint(gs[g]), false, false);
        const float lo = __uint_as_float(rr[0]), hv = __uint_as_float(rr[1]); ps[g] = lo + hv; pg[g] = hi ? lo : hv; }
    float acc = R;
#pragma unroll
    for (int g = 7; g >= 0; --g) {
        float run = hi ? acc : acc + pg[g];
        acc += ps[g];
        if (g >= 4) { const int b = 4 * (g - 4);
#pragma unroll
            for (int e = 3; e >= 0; --e) { const float t = l1[b + e]; p1[b + e] = __builtin_amdgcn_exp2f((p1[b + e] + run) * L2E); run += t; } }
        else { const int b = 4 * g;
#pragma unroll
            for (int e = 3; e >= 0; --e) { const float t = l0[b + e]; p0[b + e] = __builtin_amdgcn_exp2f((p0[b + e] + run) * L2E); run += t; } }
    }
    R = acc;
    bf16x8 pa0, pa1, pa2, pa3;
    PK4(p0, 0, pa0); PK4(p0, 8, pa1); PK4(p1, 0, pa2); PK4(p1, 8, pa3);
    pv_tile<BUF>(o, vb0, pa0, pa1, pa2, pa3);
}
__device__ __forceinline__ void sb_block(const BlockRef& cur, char* lds, const int WAVE_) {
    const int tid = TID(), wid = __builtin_amdgcn_readfirstlane(tid >> 6), lane = tid & 63, r32 = lane & 31, hi = lane >> 5;
    const int NT = (cur.P0 + QB - 1) / KVBLK + 1;
    const int qlo = cur.P0 + wid * QBLK, qm = qlo + r32 - 4 * hi;
    char* V_lds = lds; char* K_lds = lds + 2 * SHM_V;
    volatile LAS int* flg = (volatile LAS int*)(lds + OFF_FLAG);
    const int sr = tid >> 4, sc = (tid & 15) * 8, vst0 = v_st(sr, sc), vst1 = v_st(32 + sr, sc), kws = KSWZ(sr, sc * 2);
    const int vb0 = (int)(uintptr_t)V_lds + v_rd_base(lane);
    const bf16* Kh = cur.K; const bf16* Vh = cur.V;
    bf16x8 qr[8];
#pragma unroll
    for (int d0 = 0; d0 < 8; ++d0) qr[d0] = load8(cur.Q + (size_t)(wid * QBLK + r32) * PITCH + d0 * 16 + hi * 8);
    bf16x8 st_v0, st_v1, st_k0, st_k1;
#define SB_LOAD(k0) do { st_v0 = load8(ROW(Vh, k0, sr)); st_v1 = load8(ROW(Vh, k0, 32 + sr)); st_k0 = load8(ROW(Kh, k0, sr)); st_k1 = load8(ROW(Kh, k0, 32 + sr)); } while (0)
#define SB_WRITE(bf) do { *(bf16x8*)(V_lds + (bf) * SHM_V + vst0) = st_v0; *(bf16x8*)(V_lds + (bf) * SHM_V + vst1) = st_v1; \
                          *(bf16x8*)(K_lds + (bf) * SHM_K + kws) = st_k0; *(bf16x8*)(K_lds + (bf) * SHM_K + kws + 32 * 256) = st_k1; } while (0)
    f32x16 o[4] = {}; float R = 0.f; bool fin = false;
    SB_LOAD((NT - 1) * KVBLK); VMW(); SB_WRITE(0);
    if (NT > 1) SB_LOAD((NT - 2) * KVBLK);
    __syncthreads();
#define SB_STEP(t, BUF) do { const int kb_ = (NT - 1 - (t)) * KVBLK;                                                         \
        if (!fin && kb_ <= qlo + QBLK - 2) { sb_tile<BUF>(o, R, K_lds, vb0, r32, hi, qr, qm - kb_); fin = __all(R < -(float)(PRUNE_NATS + 1)); } \
        if ((t) + 1 < NT) { VMW(); SB_WRITE((BUF) ^ 1); if ((t) + 2 < NT) SB_LOAD((NT - 3 - (t)) * KVBLK); }                   \
        if (lane == 0) flg[(BUF) * 8 + wid] = fin ? 1 : 0;                                                                   \
        __syncthreads();                                                                                                      \
        { int all_ = 1; _Pragma("unroll") for (int w_ = 0; w_ < 8; ++w_) all_ &= flg[(BUF) * 8 + w_]; stop = all_ != 0; } } while (0)
    bool stop = false;
    for (int t = 0; t < NT; t += 2) {
        SB_STEP(t, 0);
        if (stop || t + 1 >= NT) break;
        SB_STEP(t + 1, 1);
        if (stop) break;
    }
    bf16* Ow = cur.O + (size_t)(wid * QBLK) * PITCH;
#pragma unroll
    for (int r = 0; r < 16; ++r) { const int orow = crow(r, hi);
#pragma unroll
        for (int d0 = 0; d0 < 4; ++d0) { const float v = o[d0][r];
            const float vn = __shfl_xor(v, 1);
            if ((r32 & 1) == 0) *(unsigned*)(Ow + (size_t)orow * PITCH + d0 * 32 + r32) = cvtpk(v, vn); } }
    __syncthreads();
#undef SB_LOAD
#undef SB_WRITE
#undef SB_STEP
}
#undef ROW
#undef VMW
#undef VMWN
#undef SLOAD_H
#undef SWRITE_HK
#undef SWRITE_HV
#undef SWRITE_H
#undef PK4
#undef KSWZ
}

constexpr int REP_X3 = 0;
constexpr int REP_X2 = 0;
constexpr int X1_PAD = 0;
constexpr bool GRELAX = false;
constexpr int X1_RELAX = 0;
constexpr int X1_STG = 0;
constexpr int X1_DIAG = 0;
constexpr int X1_ALIGN = 0, X1_SP2 = 1, X1_CONSTA = 0;
constexpr int REP_X1 = 0, REP_X1N = 20480;
constexpr int REP_ATT = 1;
constexpr int REP_P0W = 1, REP_P0R = 1;
constexpr int REP_P0 = 1, REP_P1 = 1, REP_FOX = 1, REP_SB = 1, REP_P3A = 1, REP_P5 = 1, REP_P5B = 1, REP_P7A = 1;
constexpr int TIMER_MUL = 1;
constexpr int TIMER_A = -2, TIMER_B = -2;
constexpr int SPLIT_TILES = 40;
constexpr int PARTS_MAIN = (int)((172 * MiB) / ((size_t)att::PART_F * 4)) - 4, PARTS_OVF = (int)((64 * MiB) / ((size_t)att::PART_F * 4));
__device__ __forceinline__ float* parts_base(unsigned char* ws, int slot0) {
    return (slot0 < PARTS_MAIN) ? (float*)(ws + WS_ACT) + (size_t)slot0 * att::PART_F : (float*)(ws + WS_MERGED) + (size_t)(slot0 - PARTS_MAIN) * att::PART_F;
}
constexpr int fox_worst_slots() { int s = 0; for (int qb = 0; qb < 32; ++qb) { const int nt = 4 * qb + 4; int np = (nt + SPLIT_TILES - 1) / SPLIT_TILES; np = np > 4 ? 4 : np; if (np > 1) s += np; } return s * NH; }
static_assert(fox_worst_slots() <= PARTS_MAIN + PARTS_OVF && fox_worst_slots() < 2048, "partial-result slots fit the scratch (and the 11-bit slot field)");
__device__ __forceinline__ void fox_table(const Frame& F, const float Uq) {
    const int WAVE_ = F.wave; const int lane = lane_id(), tid = WAVE_ * 64 + lane;
    LAS float* fbs = (LAS float*)(F.lds + RING_OFF + att::OFF_FBS); volatile LAS unsigned* tot = (volatile LAS unsigned*)(F.lds + RING_OFF + att::OFF_TOT);
    volatile LAS unsigned* tab = (volatile LAS unsigned*)(F.lds + RING_OFF + att::OFF_TAB); volatile LAS unsigned* spl = (volatile LAS unsigned*)(F.lds + RING_OFF + att::OFF_SPL);
    fbs[tid] = ((const float*)(F.ctl + CW_FBLK))[tid];
    __syncthreads();
    const int h = tid & 15, qb = 31 - (tid >> 4);
    const float thr = (float)att::PRUNE_NATS + 2.f * Uq * att::SCALE;
    float dec = 0.f; int nb = 0;
    while (nb < qb && dec > -thr) { dec += fbs[h * 32 + qb - 1 - nb]; ++nb; }
    const int NT0 = 4 * qb + 4; int Tn = 4 + 4 * nb + 1; Tn = Tn < NT0 ? Tn : NT0;
    int np = (Tn + SPLIT_TILES - 1) / SPLIT_TILES; np = np > 4 ? 4 : np;
    const int ps = (Tn + np - 1) / np;
    const int cls = (ps - 1) / 5, bk = 7 - (cls > 7 ? 7 : cls);
    const unsigned mine = (unsigned)np | ((np > 1 ? (unsigned)np : 0u) << 12) | ((np > 1 ? 1u : 0u) << 23);
    const unsigned fld = (unsigned)np << ((bk & 1) * 16);
    unsigned in[5] = {mine, (bk >> 1) == 0 ? fld : 0u, (bk >> 1) == 1 ? fld : 0u, (bk >> 1) == 2 ? fld : 0u, (bk >> 1) == 3 ? fld : 0u};
    unsigned inc[5] = {in[0], in[1], in[2], in[3], in[4]};
#pragma unroll
    for (int o = 1; o < 64; o <<= 1) {
#pragma unroll
        for (int k = 0; k < 5; ++k) { const unsigned t = (unsigned)__builtin_amdgcn_ds_bpermute((lane - o) << 2, (int)inc[k]); if (lane >= o) inc[k] += t; } }
    volatile LAS unsigned* wt = (volatile LAS unsigned*)(F.lds + RING_OFF + att::OFF_SPL + 2048 + 2048 + 64);
    if (lane == 63) {
#pragma unroll
        for (int k = 0; k < 5; ++k) wt[k * 8 + WAVE_] = inc[k]; }
    __syncthreads();
    unsigned base[5], total[5];
#pragma unroll
    for (int k = 0; k < 5; ++k) { base[k] = inc[k] - in[k]; total[k] = 0;
#pragma unroll
        for (int w = 0; w < 8; ++w) { const unsigned t = wt[k * 8 + w]; total[k] += t; if (w < WAVE_) base[k] += t; } }
    const unsigned s0 = (base[0] >> 12) & 2047u, x0 = base[0] >> 23;
    if (np > 1) spl[x0] = (unsigned)tid | ((unsigned)np << 11) | (s0 << 21);
    if (tid == 0) { tot[8] = total[0] & 4095u; tot[9] = total[0] >> 23; }
    unsigned rank = 0;
#pragma unroll
    for (int c = 0; c < 8; ++c) { const unsigned tc = (total[1 + (c >> 1)] >> ((c & 1) * 16)) & 0xffffu, bc = (base[1 + (c >> 1)] >> ((c & 1) * 16)) & 0xffffu;
        if (c < bk) rank += tc; else if (c == bk) rank += bc; }
    for (int p = 0; p < np; ++p) tab[rank + p] = (unsigned)tid | ((unsigned)p << 9) | ((unsigned)np << 11) | ((unsigned)ps << 14) | (s0 << 21);
    __syncthreads();
}
__device__ __forceinline__ void tm_put(int i, long long t) { asm volatile("ds_write_b64 %0, %1" :: "v"(LDSCTL_OFF + 896 + 8 * i), "v"(t) : "memory"); }
__device__ __forceinline__ long long tm_get(int i) { long long t; asm volatile("ds_read_b64 %0, %1\n\ts_waitcnt lgkmcnt(0)" : "=v"(t) : "v"(LDSCTL_OFF + 896 + 8 * i) : "memory"); return t; }
enum { PH_P0 = 0, PH_P1, PH_P1B, PH_ATT, PH_P3A, PH_P3B, PH_P4, PH_P5, PH_P5B, PH_P6, PH_P7A, PH_P7, PH_N };
__global__ void __launch_bounds__(NWAVES * 64, 2) mega_fwd(Params P) {
    extern __shared__ __attribute__((aligned(16))) unsigned char lds[];
    Frame F;
    F.lds = (LAS unsigned char*)lds;
    F.MISC = (volatile LAS unsigned*)(F.lds + MISC_OFF);
    F.wave = __builtin_amdgcn_readfirstlane((int)(__builtin_amdgcn_workitem_id_x() >> 6));
    const int WAVE_ = F.wave; const int f_tid = TID();
    F.G = gridDim.x; { const int bx = blockIdx.x; F.vcu = (F.G % 8 == 0) ? (bx % 8) * (F.G / 8) + bx / 8 : bx; }
    unsigned char* ws = P.ws;
    F.ctl = (gu32*)(ws + WS_CTL);
    for (int u = f_tid; u < (LDS_BYTES - LDSCTL_OFF) / 4; u += NWAVES * 64) ((LAS unsigned*)(F.lds + LDSCTL_OFF))[u] = 0u;
    __syncthreads();
    XcdBarrier bar = xcd_barrier_post((unsigned*)(F.ctl + CW_BAR) + P.li * XCD_BAR_WORDS, F.MISC + 8, F.wave);
    const int lo = P.ph_lo, hi = P.ph_hi;
    if (TIMER_A == -1 && TIMER_B >= 0 && f_tid == 0) tm_put(0, wall_clock64());
#define IN(k) (lo <= (k) && (k) < hi)
#define SEAM(k) do { if (IN(k) && IN((k) + 1)) xcd_barrier(bar); if (TIMER_B >= 0 && blockIdx.x == 0) { if ((k) == TIMER_A && TID() == 0) tm_put(0, wall_clock64()); if ((k) == TIMER_B && TID() == 0) tm_put(1, wall_clock64()); } } while (0)
    bf16* W_in = (bf16*)(ws + WS_WIN); bf16* XB = (bf16*)(ws + WS_XB);
    float* ss1 = (float*)(ws + WS_SS1); float* ss2 = (float*)(F.ctl + CW_SS2); float* ss3 = (float*)(F.ctl + CW_SS3);
    bf16* QKV = (bf16*)(ws + WS_QKV); bf16* GATES = (bf16*)(ws + WS_GATES); bf16* Y = (bf16*)(ws + WS_Y); bf16* MERGED = (bf16*)(ws + WS_MERGED);
    LAS unsigned char* ring = F.lds + RING_OFF;

    if (IN(PH_P0)) { for (int rep = 0; rep < REP_P0; ++rep) { for (int r2 = 0; r2 < REP_P0W; ++r2) p0_weights(F, P); for (int r2 = 0; r2 < REP_P0R; ++r2) p0_rows(F, P); } }
    SEAM(PH_P0);
    if (IN(PH_P1)) { p1b_qknorm_fgate(F, P);
      for (int rep = 0; rep < REP_P1; ++rep) {
        pg8::Gemm g{XB, W_in, S, NPROJ, DM}; ConvOrder So; So.init(S, NPROJ, F.G, (int)blockIdx.x); So.P = &P; So.wave = F.wave; So.slot = 0;
        pg8::EpiProj E{QKV, GATES, ss1, P.in[5], P.in[6], (LAS float*)(F.lds + XCH_OFF)};
        pg8::gemm_phase<pg8::EpiProj, ConvOrder, false, true, 0, 0, GRELAX>(ring, g, So, E, F.wave);
    } }
    if (IN(PH_P1)) { for (int rep = 0; rep < REP_X1; ++rep) {
        pg8::Gemm g{X1_CONSTA ? (bf16*)(ws + WS_ACT) : XB, W_in, S, REP_X1N, DM, DM + X1_PAD, DM + X1_PAD}; pg8::StaticOrder So; So.init(S, REP_X1N, F.G, (int)blockIdx.x);
        pg8::EpiNull E{};
        pg8::gemm_phase<pg8::EpiNull, pg8::StaticOrder, X1_ALIGN != 0, X1_SP2 != 0, X1_DIAG, X1_STG, X1_RELAX != 0>(ring, g, So, E, F.wave);
    } }
    if (IN(PH_P1)) { for (int rep = 0; rep < REP_X2; ++rep) {
        struct SameOrder : pg8::StaticOrder { __device__ bool next(int i, pg8::Unit& u) const { const bool ok = pg8::StaticOrder::next(i, u); u.pm = 0; u.pn = 0; return ok; } };
        pg8::Gemm g{XB, W_in, S, NPROJ, DM}; SameOrder So; So.init(S, NPROJ, F.G, (int)blockIdx.x);
        pg8::EpiNull E{};
        pg8::gemm_phase<pg8::EpiNull, SameOrder, true, true, 0, 0, GRELAX>(ring, g, So, E, F.wave);
    } }
    if (IN(PH_P1)) { for (int rep = 0; rep < REP_X3; ++rep) {
        const long long c0 = clock64();
        pg8::Gemm g{XB, W_in, S, NPROJ, DM}; pg8::StaticOrder So; So.init(S, NPROJ, F.G, (int)blockIdx.x);
        pg8::EpiNull E{};
        pg8::gemm_phase<pg8::EpiNull, pg8::StaticOrder, false, true, 0, 0, GRELAX>(ring, g, So, E, F.wave);
        const long long extra = (clock64() - c0) >> 7; const long long t1 = wall_clock64();
        while (wall_clock64() - t1 < extra) __builtin_amdgcn_s_sleep(10);
    } }
    SEAM(PH_P1);
    if (IN(PH_ATT)) {
        char* al = (char*)lds + RING_OFF;
        const size_t T = (size_t)S * WF;
        gu32* qctr = F.ctl + CW_QATT; volatile LAS int* nx = (volatile LAS int*)(F.lds + RING_OFF + att::OFF_NEXT);
        const int a_lane = lane_id(); const bool puller = (F.wave == 0 && a_lane == 0);
        float gqk = fmaxf(fabsf(P.in[5][a_lane] * P.in[6][a_lane]), fabsf(P.in[5][a_lane + 64] * P.in[6][a_lane + 64]));
#pragma unroll
        for (int o = 1; o < 64; o <<= 1) gqk = fmaxf(gqk, __shfl_xor(gqk, o));
        const float Uq = __builtin_bit_cast(float, __builtin_amdgcn_readfirstlane(__builtin_bit_cast(int, 128.0f * gqk * 1.02f)));
        for (int arep = 0; arep < REP_ATT; ++arep) {
        if (arep > 0) { xcd_barrier(bar); if (blockIdx.x == 0 && puller) __hip_atomic_store(qctr, 0u, RLX_AGENT); xcd_barrier(bar); }
        if (puller) nx[0] = (int)blockIdx.x;
        if (TIMER_B >= 76 && TIMER_B < 80 && TID() == 0) tm_put(2, wall_clock64());
        if (arep == 0) fox_table(F, Uq);
        __syncthreads();
        const int NI = __builtin_amdgcn_readfirstlane(((volatile LAS int*)(F.lds + RING_OFF + att::OFF_TOT))[8]);
        if (TIMER_B >= 70 && TIMER_B < 76 && TID() == 0) tm_put(2, wall_clock64());
        if (TIMER_B == 60 && blockIdx.x == 0 && TID() == 0) { tm_put(0, 0); tm_put(1, 100ll * NI); }
        if (TIMER_B == 61 && blockIdx.x == 0 && TID() == 0) { tm_put(0, 0); tm_put(1, 100ll * ((volatile LAS int*)(F.lds + RING_OFF + att::OFF_TOT))[9]); }
        int item = nx[0];
        __syncthreads();
        {
            bool primed = false; att::Seam Sm;
#define FOX_REF(R, e_) do { const unsigned e__ = (e_); const int b_ = e__ & 511, h_ = b_ & 15, q_ = 31 - (b_ >> 4), p_ = (e__ >> 9) & 3, np_ = (e__ >> 11) & 7, ps_ = (e__ >> 14) & 127, sl_ = e__ >> 21;   \
                R.Q = QKV + (size_t)(q_ * 256) * WF + h_ * HD; R.K = QKV + T + h_ * HD; R.V = QKV + 2 * T + h_ * HD; R.O = Y + (size_t)(q_ * 256) * WF + h_ * HD; R.P0 = q_ * 256;                          \
                R.top = q_ * 4 + 3 - p_ * ps_; R.nst = (p_ == np_ - 1) ? R.top + 1 : ps_; R.part = (np_ > 1) ? parts_base(ws, sl_) + (size_t)p_ * att::PART_F : nullptr; } while (0)
            volatile LAS unsigned* tab = (volatile LAS unsigned*)(F.lds + RING_OFF + att::OFF_TAB);
            while (item < NI) {
                int pulled = 0;
                if (puller) pulled = F.G + (int)__hip_atomic_fetch_add(qctr, 1u, RLX_AGENT);
                const unsigned ent = __builtin_amdgcn_readfirstlane(tab[item]);
                att::cgate_scan((const float*)(ws + WS_LOGF) + (size_t)(ent & 15) * S, al, F.wave);
                if (puller) nx[0] = pulled;
                att::BlockRef cur; FOX_REF(cur, ent);
                if (!primed) att::fox_prime(cur, al, Sm, F.wave); else __syncthreads();
                const int nitem = nx[0];
                att::BlockRef nxt = cur; primed = false;
                if (nitem < NI) { const unsigned e2 = __builtin_amdgcn_readfirstlane(tab[nitem]); FOX_REF(nxt, e2); primed = true; }
                att::fox_block(cur, nxt, Uq, al, Sm, F.wave);
                item = nitem;
            }
#undef FOX_REF
        }
        if (TIMER_B == 50 && blockIdx.x == 0 && TID() == 0) tm_put(1, wall_clock64());
        if ((TIMER_B == 70 || TIMER_B == 71) && TID() == 0) { const unsigned d = (unsigned)(wall_clock64() - tm_get(2)); __hip_atomic_fetch_add(F.ctl + 3072, d, RLX_AGENT); __hip_atomic_fetch_max(F.ctl + 3073, d, RLX_AGENT); }
        while (item < NI + NH * 32) {
            int pulled = 0;
            if (puller) pulled = F.G + (int)__hip_atomic_fetch_add(qctr, 1u, RLX_AGENT);
            const int L = item - NI, h = L & 15, qb = 31 - (L >> 4);
            att::BlockRef b; b.Q = QKV + 3 * T + (size_t)(qb * 256) * WF + h * HD; b.K = QKV + 4 * T + h * HD; b.V = QKV + 5 * T + h * HD; b.O = Y + T + (size_t)(qb * 256) * WF + h * HD; b.P0 = qb * 256; b.top = 0; b.nst = 0; b.part = nullptr;
            if (puller) nx[0] = pulled;
            att::sb_block(b, al, F.wave);
            item = nx[0];
            __syncthreads();
        }
        if (TIMER_B == 51 && blockIdx.x == 0 && TID() == 0) tm_put(1, wall_clock64());
        if ((TIMER_B == 72 || TIMER_B == 73 || TIMER_B == 76 || TIMER_B == 77) && TID() == 0) { const unsigned d = (unsigned)(wall_clock64() - tm_get(2)); __hip_atomic_fetch_add(F.ctl + 3072, d, RLX_AGENT); __hip_atomic_fetch_max(F.ctl + 3073, d, RLX_AGENT); }
        }
    }
    SEAM(PH_ATT);
    if (IN(PH_P3A)) {
        const int nsp = __builtin_amdgcn_readfirstlane(((volatile LAS int*)(F.lds + RING_OFF + att::OFF_TOT))[9]);
        volatile LAS unsigned* spl = (volatile LAS unsigned*)(F.lds + RING_OFF + att::OFF_SPL);
        for (int si = F.vcu; si < nsp; si += F.G) {
            const unsigned e = __builtin_amdgcn_readfirstlane(spl[si]); const int b = e & 511, h = b & 15, qb = 31 - (b >> 4), np = (e >> 11) & 7, sl = e >> 21;
            att::fox_combine(parts_base(ws, sl), np, Y + (size_t)(qb * 256) * WF + h * HD, F.wave);
        }
    }
    SEAM(PH_P3A);
    if (IN(PH_P3B)) {
        pg8::Gemm g{Y, (bf16*)(ws + WS_WBF), S, DM, WF}; pg8::TwoPartOrder So; So.init(S, DM, F.G, (int)blockIdx.x); So.A1 = Y + (size_t)S * WF; So.B1 = (bf16*)(ws + WS_WBS);
        pg8::EpiGate2 E{MERGED, GATES, GATES + (size_t)S * DM};
        pg8::gemm_phase<pg8::EpiGate2, pg8::TwoPartOrder, false, true, 0, 0, GRELAX>(ring, g, So, E, F.wave);
    }
    SEAM(PH_P3B);
    if (IN(PH_P4)) {
        pg8::Gemm g{MERGED, (bf16*)(ws + WS_WOUT), S, DM, DM}; pg8::StaticOrder So; So.init(S, DM, F.G, (int)blockIdx.x);
        pg8::EpiResStat<true> E{nullptr, XB, ss2};
        pg8::gemm_phase<pg8::EpiResStat<true>, pg8::StaticOrder, false, true, 0, 0, GRELAX>(ring, g, So, E, F.wave);
    }
    SEAM(PH_P4);
    if (IN(PH_P5)) { for (int rep = 0; rep < REP_P5; ++rep) {
        pg8::Gemm g{XB, (bf16*)(ws + WS_WUP), S, 2 * DFF, DM}; pg8::StaticOrder So; So.init(S, 2 * DFF, F.G, (int)blockIdx.x);
        pg8::EpiConvGlu E{(bf16*)(ws + WS_ACT), (float*)(ws + WS_EDGE), ss2, P.in[12], P.in[13], (LAS float*)(F.lds + XCH_OFF)};
        pg8::gemm_phase<pg8::EpiConvGlu, pg8::StaticOrder, true, true, 0, 0, GRELAX>(ring, g, So, E, F.wave);
      }
      {
        const int nwg5 = (S / 256) * (2 * DFF / 256), n_extra = nwg5 % F.G, Gi = F.G - n_extra, ci = (int)blockIdx.x - n_extra;
        if (ci >= 0) {
            pg8::Gemm g{(bf16*)(ws + WS_PB), (bf16*)(ws + WS_WPP), S, DM, PLE}; pg8::StaticOrder So; So.init(S, DM, Gi, ci);
            pg8::EpiStoreBf16x4 E{(bf16*)(ws + WS_PP)};
            pg8::gemm_phase<pg8::EpiStoreBf16x4, pg8::StaticOrder, false, true, 0, 0, GRELAX>(ring, g, So, E, F.wave);
        }
      }
    }
    SEAM(PH_P5);
    if (IN(PH_P5B)) { for (int rep = 0; rep < REP_P5B; ++rep) p5c_fixup(F, P); }
    SEAM(PH_P5B);
    if (IN(PH_P6)) {
        pg8::Gemm g{(bf16*)(ws + WS_ACT), (bf16*)(ws + WS_WDN), S, DM, DFF}; pg8::StaticOrder So; So.init(S, DM, F.G, (int)blockIdx.x);
        pg8::EpiResStat<true> E{nullptr, XB, ss3};
        pg8::gemm_phase<pg8::EpiResStat<true>, pg8::StaticOrder, false, true, 0, 0, GRELAX>(ring, g, So, E, F.wave);
    }
    SEAM(PH_P6);
    if (IN(PH_P7)) {
        pg8::Gemm g{XB, (bf16*)(ws + WS_WPG), S, DM, DM}; pg8::StaticOrder So; So.init(S, DM, F.G, (int)blockIdx.x);
        pg8::EpiPle E{P.out, XB, (const bf16*)(ws + WS_PP), ss3};
        pg8::gemm_phase<pg8::EpiPle, pg8::StaticOrder, false, true, 0, 0, GRELAX>(ring, g, So, E, F.wave);
    }
    if (TIMER_B >= 0 && blockIdx.x == 0) {
        if (TIMER_B >= 70 && TIMER_B < 80 && TID() == 0) { tm_put(0, 0); tm_put(1, (TIMER_B & 1) ? (long long)__hip_atomic_load(F.ctl + 3073, RLX_AGENT) : (long long)(__hip_atomic_load(F.ctl + 3072, RLX_AGENT) / 256u)); }
        __syncthreads();
        const long long t0 = wall_clock64(), w = ((TIMER_B == 99) ? t0 : tm_get(1)) - tm_get(0);
        for (int r_ = 0; r_ < TIMER_MUL; ++r_) { const long long t1 = wall_clock64(); while (wall_clock64() - t1 < w) __builtin_amdgcn_s_sleep(20); } }
#undef IN
#undef SEAM
}

extern "C" void kernel_launch(void* const* d_in, const int* in_sizes, int n_in, void* d_out, int out_size, void* d_ws, size_t ws_size, hipStream_t stream) {
    static int grid = 0;
    if (grid == 0) {
        if (n_in != 18 || out_size != S * DM || ws_size < WS_END) { fprintf(stderr, "kernel_launch: unexpected shapes / workspace (%d inputs, out %d, ws %zu < %zu)\n", n_in, out_size, ws_size, (size_t)WS_END); grid = -1; return; }
        int dev = 0, cus = 0, per_cu = 0;
        if (hipGetDevice(&dev) != hipSuccess || hipDeviceGetAttribute(&cus, hipDeviceAttributeMultiprocessorCount, dev) != hipSuccess) { grid = -1; return; }
        if (hipFuncSetAttribute((const void*)mega_fwd, hipFuncAttributeMaxDynamicSharedMemorySize, LDS_BYTES) != hipSuccess) { fprintf(stderr, "kernel_launch: hipFuncSetAttribute failed\n"); grid = -1; return; }
        if (hipOccupancyMaxActiveBlocksPerMultiprocessor(&per_cu, (const void*)mega_fwd, NWAVES * 64, LDS_BYTES) != hipSuccess || per_cu < 1)
            fprintf(stderr, "kernel_launch: note: occupancy query reports %d workgroups per CU\n", per_cu);
        (void)hipGetLastError();
        grid = cus;
    }
    if (grid < 0) return;
    if (hipMemsetAsync((char*)d_ws + WS_CTL, 0, CTL_ZERO_BYTES, stream) != hipSuccess) return;
    Params a{};
    for (int i = 0; i < 18; ++i) a.in[i] = (const float*)d_in[i];
    a.out = (float*)d_out; a.ws = (unsigned char*)d_ws;
    a.ph_lo = PH_P0; a.ph_hi = PH_N; a.li = 0;
    hipLaunchKernelGGL(mega_fwd, dim3(grid), dim3(NWAVES * 64), LDS_BYTES, stream, a);
}
```
